# Optimizing an MI355X kernel written in HIP

```python
import math
import jax, jax.numpy as jnp
from jax import lax
import numpy as np

D_MODEL = 1024
BATCH = 16
SEQ = 4096
DEPTH = 1

GRID_W = 64
CTX_LEN = 256
N_HEADS = 8
N_KV_HEADS = 2
Q_PER_KV = N_HEADS // N_KV_HEADS
HEAD_DIM = 64
ATTN_WIDTH = N_HEADS * HEAD_DIM
KV_WIDTH = N_KV_HEADS * HEAD_DIM
HYENA_WIDTH = 512
HYENA_ORDER = 2
MIX_WIDTH = ATTN_WIDTH + HYENA_WIDTH
Q_END = ATTN_WIDTH
K_END = Q_END + KV_WIDTH
V_END = K_END + KV_WIDTH
IN_COLS = V_END + (HYENA_ORDER + 1) * HYENA_WIDTH
Q_BLOCK = 128
ROPE_THETA = 10000.0
SHORT_CONV = 3
FILTER_EMB = 33
FILTER_ORDER = 64
FILTER_DECAY_FAST = 0.3
FILTER_DECAY_SLOW = 1.5
FILTER_TARGET = 1e-2
N_EXPERTS = 256
TOP_K = 8
N_GROUPS = 8
TOPK_GROUPS = 4
EXPERT_FF = 256
SHARED_FF = 256
ROUTE_SCALE = 2.5
DISPATCH_BLOCK = 128
EPS = 1e-6

kernel_name = "hymba_hyena_gqa_moe_dit_layer"


def rms_norm(x, w):
    xf = x.astype(jnp.float32)
    y = xf * lax.rsqrt(jnp.mean(xf * xf, axis=-1, keepdims=True) + EPS)
    return (y * w.astype(jnp.float32)).astype(x.dtype)


def adaln(cond, w, b):
    m = (jax.nn.silu(cond) @ w + b)[..., None, :]
    return jnp.split(m, 6, axis=-1)


def modulate(x, g, shift, scale):
    return rms_norm(x, g) * (1 + scale) + shift


def axial_rope(n_tokens):
    t = jnp.arange(n_tokens, dtype=jnp.int32)
    row = (t // GRID_W).astype(jnp.float32)
    col = (t % GRID_W).astype(jnp.float32)
    n_freq = HEAD_DIM // 4
    inv = ROPE_THETA ** (-jnp.arange(n_freq, dtype=jnp.float32) / n_freq)
    ang = jnp.concatenate([row[:, None] * inv, col[:, None] * inv], axis=-1)
    return jnp.cos(ang), jnp.sin(ang)


def apply_rope(x, cos, sin):
    xf = x.astype(jnp.float32).reshape(*x.shape[:-1], HEAD_DIM // 2, 2)
    x0, x1 = xf[..., 0], xf[..., 1]
    c, s = cos[None, :, None, :], sin[None, :, None, :]
    out = jnp.stack([x0 * c - x1 * s, x0 * s + x1 * c], axis=-1)
    return out.reshape(x.shape).astype(x.dtype)


def attention(q, keys, vals):
    B, L = q.shape[:2]
    n_blk = L // Q_BLOCK
    qb = q.reshape(B, n_blk, Q_BLOCK, N_KV_HEADS, Q_PER_KV, HEAD_DIM).transpose(1, 0, 2, 3, 4, 5)
    scale = HEAD_DIM ** -0.5

    def one_block(qblk):
        s = jnp.einsum('bqgrd,bkgd->bgrqk', qblk, keys, preferred_element_type=jnp.float32) * scale
        p = jax.nn.softmax(s, axis=-1).astype(vals.dtype)
        return jnp.einsum('bgrqk,bkgd->bqgrd', p, vals)

    out = lax.map(one_block, qb)
    return out.transpose(1, 0, 2, 3, 4, 5).reshape(B, L, ATTN_WIDTH)


def hyena_filters(n_tokens, w1, b1, w2, b2, w3, b3, w4, freq):
    L = n_tokens
    f32 = jnp.float32
    w1, b1, w2, b2, w3, b3, w4, freq = [a.astype(f32) for a in (w1, b1, w2, b2, w3, b3, w4, freq)]
    t = jnp.linspace(0.0, 1.0, L, dtype=f32)[:, None]
    bands = (FILTER_EMB - 1) // 2
    w = 2.0 * math.pi * jnp.arange(L, dtype=f32)[:, None] / L
    f = jnp.linspace(1e-4, bands - 1, bands, dtype=f32)[None, :]
    z = jnp.concatenate([t, jnp.cos(f * w), -jnp.sin(f * w)], axis=-1)
    act = lambda a: jnp.sin(freq * a)
    h = act(z @ w1 + b1)
    h = act(h @ w2 + b2)
    h = act(h @ w3 + b3)
    h = h @ w4
    min_decay = math.log(FILTER_TARGET) / FILTER_DECAY_FAST
    max_decay = math.log(FILTER_TARGET) / FILTER_DECAY_SLOW
    deltas = jnp.linspace(min_decay, max_decay, HYENA_WIDTH, dtype=f32)
    decay = jnp.exp(-t * jnp.abs(deltas))
    h_fwd = h[:, :HYENA_WIDTH] * decay
    h_bwd = h[:, HYENA_WIDTH:] * decay
    return jnp.concatenate([h_fwd, jnp.zeros((1, HYENA_WIDTH), f32), h_bwd[1:][::-1]], axis=0)


def bidir_fftconv(u, k2, bias):
    L = u.shape[1]
    uf = jnp.fft.rfft(u.astype(jnp.float32), n=2 * L, axis=1)
    kf = jnp.fft.rfft(k2, n=2 * L, axis=0)
    y = jnp.fft.irfft(uf * kf[None], n=2 * L, axis=1)[:, :L]
    return (y + u.astype(jnp.float32) * bias.astype(jnp.float32)).astype(u.dtype)


def hyena_mix(u3, conv_w, conv_b, hyena_bias, filt):
    L = u3.shape[1]
    half = SHORT_CONV // 2
    up = jnp.pad(u3, ((0, 0), (half, half), (0, 0)))
    uc = sum(conv_w[j] * up[:, j:j + L] for j in range(SHORT_CONV)) + conv_b
    x0, x1, v = jnp.split(uc, 3, axis=-1)
    k2 = hyena_filters(L, *filt)
    z = bidir_fftconv(v * x1, k2, hyena_bias)
    return z * x0


def project(h, w_in):
    B, L, _ = h.shape
    p = h @ w_in
    q = p[..., :Q_END].reshape(B, L, N_HEADS, HEAD_DIM)
    k = p[..., Q_END:K_END].reshape(B, L, N_KV_HEADS, HEAD_DIM)
    v = p[..., K_END:V_END].reshape(B, L, N_KV_HEADS, HEAD_DIM)
    return q, k, v, p[..., V_END:]


def merge(a, y, attn_out_norm_w, hyena_out_norm_w, w_out):
    return jnp.concatenate([rms_norm(a, attn_out_norm_w), rms_norm(y, hyena_out_norm_w)], axis=-1) @ w_out


def swiglu(h, wg, wu, wd):
    return (jax.nn.silu(h @ wg) * (h @ wu)) @ wd


def route(t, router_w, router_bias):
    T = t.shape[0]
    scores = jax.nn.sigmoid((t @ router_w).astype(jnp.float32))
    biased = scores + router_bias.astype(jnp.float32)
    per_group = N_EXPERTS // N_GROUPS
    grp_score = lax.top_k(biased.reshape(T, N_GROUPS, per_group), 2)[0].sum(-1)
    _, top_g = lax.top_k(grp_score, TOPK_GROUPS)
    gmask = jnp.any(top_g[..., None] == jnp.arange(N_GROUPS)[None, None, :], axis=1)
    masked = jnp.where(jnp.repeat(gmask, per_group, axis=1), biased, -jnp.inf)
    _, idx = lax.top_k(masked, TOP_K)
    w = jnp.take_along_axis(scores, idx, axis=1)
    w = w / jnp.sum(w, axis=-1, keepdims=True) * ROUTE_SCALE
    return idx, w


def routed_experts(t, idx, w, wg, wu, wd):
    T, D = t.shape
    A = T * TOP_K
    flat_e = idx.reshape(A).astype(jnp.int32)
    flat_t = jnp.repeat(jnp.arange(T, dtype=jnp.int32), TOP_K)
    flat_w = w.reshape(A)
    order = jnp.argsort(flat_e)
    se = flat_e[order]
    counts = jnp.bincount(flat_e, length=N_EXPERTS).astype(jnp.int32)
    padded = (counts + DISPATCH_BLOCK - 1) // DISPATCH_BLOCK * DISPATCH_BLOCK
    pad_end = jnp.cumsum(padded)
    pad_start = pad_end - padded
    start = jnp.cumsum(counts) - counts
    dest = pad_start[se] + jnp.arange(A, dtype=jnp.int32) - start[se]
    n_rows = (A + N_EXPERTS * (DISPATCH_BLOCK - 1) + DISPATCH_BLOCK - 1) // DISPATCH_BLOCK * DISPATCH_BLOCK
    n_blk = n_rows // DISPATCH_BLOCK
    row_tok = jnp.full((n_rows,), T, jnp.int32).at[dest].set(flat_t[order])
    row_w = jnp.zeros((n_rows,), t.dtype).at[dest].set(flat_w[order].astype(t.dtype))
    blk_e = jnp.minimum(jnp.searchsorted(pad_end, jnp.arange(n_blk, dtype=jnp.int32) * DISPATCH_BLOCK,
                                         side='right'), N_EXPERTS - 1)
    t_pad = jnp.concatenate([t, jnp.zeros((1, D), t.dtype)], axis=0)

    def one_block(args):
        toks, gate, e = args
        return swiglu(t_pad[toks], wg[e], wu[e], wd[e]) * gate[:, None]

    out = lax.map(one_block, (row_tok.reshape(n_blk, DISPATCH_BLOCK),
                              row_w.reshape(n_blk, DISPATCH_BLOCK), blk_e))
    y = jax.ops.segment_sum(out.reshape(n_rows, D), row_tok, num_segments=T + 1)
    return y[:T]


def moe_ffn(h, router_w, router_bias, wg, wu, wd, sh_wg, sh_wu, sh_wd):
    B, L, D = h.shape
    t = h.reshape(B * L, D)
    idx, w = route(t, router_w, router_bias)
    y = routed_experts(t, idx, w, wg, wu, wd) + swiglu(t, sh_wg, sh_wu, sh_wd)
    return y.reshape(B, L, D)


def setup_inputs(seed: int = 0) -> dict:
    key = jax.random.key(seed)
    ks = iter(jax.random.split(key, 48))
    nrm = lambda shape, scale: jax.random.normal(next(ks), shape, jnp.float32) * scale
    gain = lambda shape: 1.0 + nrm(shape, 0.05)
    L = DEPTH
    D = D_MODEL
    return {
        "x": nrm((BATCH, SEQ, D), 1.0),
        "c": nrm((BATCH, D), 1.0),
        "ctx": nrm((BATCH, CTX_LEN, D), 1.0),
        "c_ctx": nrm((D,), 1.0),
        "mod_w": nrm((L, D, 6 * D), 0.5 * D ** -0.5),
        "mod_b": nrm((L, 6 * D), 0.02),
        "norm1_w": gain((L, D)),
        "w_in": nrm((L, D, IN_COLS), D ** -0.5),
        "q_norm_w": gain((L, HEAD_DIM)),
        "k_norm_w": gain((L, HEAD_DIM)),
        "conv_w": nrm((L, SHORT_CONV, 3 * HYENA_WIDTH), SHORT_CONV ** -0.5),
        "conv_b": nrm((L, 3 * HYENA_WIDTH), 0.02),
        "filt_w1": nrm((L, FILTER_EMB, FILTER_ORDER), FILTER_EMB ** -0.5),
        "filt_b1": nrm((L, FILTER_ORDER), 0.02),
        "filt_w2": nrm((L, FILTER_ORDER, FILTER_ORDER), FILTER_ORDER ** -0.5),
        "filt_b2": nrm((L, FILTER_ORDER), 0.02),
        "filt_w3": nrm((L, FILTER_ORDER, FILTER_ORDER), FILTER_ORDER ** -0.5),
        "filt_b3": nrm((L, FILTER_ORDER), 0.02),
        "filt_w4": nrm((L, FILTER_ORDER, 2 * HYENA_WIDTH), FILTER_ORDER ** -0.5),
        "filt_freq": gain((L, FILTER_ORDER)),
        "hyena_bias": nrm((L, HYENA_WIDTH), 0.5),
        "attn_out_norm_w": gain((L, ATTN_WIDTH)),
        "hyena_out_norm_w": gain((L, HYENA_WIDTH)),
        "w_out": nrm((L, MIX_WIDTH, D), MIX_WIDTH ** -0.5),
        "norm2_w": gain((L, D)),
        "router_w": nrm((L, D, N_EXPERTS), D ** -0.5),
        "router_bias": nrm((L, N_EXPERTS), 0.01),
        "exp_w_gate": nrm((L, N_EXPERTS, D, EXPERT_FF), D ** -0.5),
        "exp_w_up": nrm((L, N_EXPERTS, D, EXPERT_FF), D ** -0.5),
        "exp_w_down": nrm((L, N_EXPERTS, EXPERT_FF, D), EXPERT_FF ** -0.5),
        "sh_w_gate": nrm((L, D, SHARED_FF), D ** -0.5),
        "sh_w_up": nrm((L, D, SHARED_FF), D ** -0.5),
        "sh_w_down": nrm((L, SHARED_FF, D), SHARED_FF ** -0.5),
        "final_norm_w": gain((D,)),
    }


def reference(x, c, ctx, c_ctx, mod_w, mod_b, norm1_w, w_in, q_norm_w, k_norm_w,
              conv_w, conv_b, filt_w1, filt_b1, filt_w2, filt_b2, filt_w3, filt_b3, filt_w4, filt_freq,
              hyena_bias, attn_out_norm_w, hyena_out_norm_w, w_out, norm2_w,
              router_w, router_bias, exp_w_gate, exp_w_up, exp_w_down,
              sh_w_gate, sh_w_up, sh_w_down, final_norm_w):
    B, S, _ = x.shape
    C = ctx.shape[1]
    cos, sin = axial_rope(S)
    ctx_h = ctx
    for i in range(DEPTH):
        last = i == DEPTH - 1
        sh1, sc1, g1, sh2, sc2, g2 = adaln(c, mod_w[i], mod_b[i])
        csh1, csc1, cg1, csh2, csc2, cg2 = adaln(c_ctx, mod_w[i], mod_b[i])
        filt = (filt_w1[i], filt_b1[i], filt_w2[i], filt_b2[i], filt_w3[i], filt_b3[i], filt_w4[i], filt_freq[i])
        moe_w = (router_w[i], router_bias[i], exp_w_gate[i], exp_w_up[i], exp_w_down[i],
                 sh_w_gate[i], sh_w_up[i], sh_w_down[i])

        hc = modulate(ctx_h, norm1_w[i], csh1, csc1)
        if last:
            kv = hc @ w_in[i][:, Q_END:V_END]
            kc = rms_norm(kv[..., :KV_WIDTH].reshape(B, C, N_KV_HEADS, HEAD_DIM), k_norm_w[i])
            vc = kv[..., KV_WIDTH:].reshape(B, C, N_KV_HEADS, HEAD_DIM)
        else:
            qc, kc, vc, uc = project(hc, w_in[i])
            qc = rms_norm(qc, q_norm_w[i])
            kc = rms_norm(kc, k_norm_w[i])
            ac = attention(qc, kc, vc)
            yc = hyena_mix(uc, conv_w[i], conv_b[i], hyena_bias[i], filt)
            ctx_h = ctx_h + cg1 * merge(ac, yc, attn_out_norm_w[i], hyena_out_norm_w[i], w_out[i])
            ctx_h = ctx_h + cg2 * moe_ffn(modulate(ctx_h, norm2_w[i], csh2, csc2), *moe_w)

        h = modulate(x, norm1_w[i], sh1, sc1)
        q, k, v, u = project(h, w_in[i])
        q = apply_rope(rms_norm(q, q_norm_w[i]), cos, sin)
        k = apply_rope(rms_norm(k, k_norm_w[i]), cos, sin)
        a = attention(q, jnp.concatenate([kc, k], axis=1), jnp.concatenate([vc, v], axis=1))
        y = hyena_mix(u, conv_w[i], conv_b[i], hyena_bias[i], filt)
        x = x + g1 * merge(a, y, attn_out_norm_w[i], hyena_out_norm_w[i], w_out[i])
        x = x + g2 * moe_ffn(modulate(x, norm2_w[i], sh2, sc2), *moe_w)
    return rms_norm(x, final_norm_w)
```

```cpp
#include <hip/hip_runtime.h>
#include <cstdio>
#include <cstdint>
#include <cmath>

#ifndef MK_N_LAUNCHES
#define MK_N_LAUNCHES 1
#endif

#define LAS __attribute__((address_space(3)))
#define GAS __attribute__((address_space(1)))
typedef unsigned short bf16_t;
typedef short bf16x8 __attribute__((ext_vector_type(8)));
typedef float f32x4 __attribute__((ext_vector_type(4)));
typedef float f32x2 __attribute__((ext_vector_type(2)));
typedef unsigned u32x4 __attribute__((ext_vector_type(4)));
typedef unsigned u32x2 __attribute__((ext_vector_type(2)));

constexpr int NB = 16, SEQ = 4096, DM = 1024, MTOK = NB * SEQ, CTXL = 256, MCTX = NB * CTXL;
constexpr int NH = 8, HD = 64, AW = 512, HW = 512, KVP = 128, KVLEN = CTXL + SEQ;
constexpr int NE = 256, TOPK = 8, FF = 256;
constexpr float EPS = 1e-6f;
constexpr int NPHASE = 14;

constexpr size_t MiB = 1u << 20;
constexpr size_t WS_CTL = 0, CTL_ZERO_BYTES = 1 * MiB;
constexpr size_t WS_MODV = 512 * 1024;
constexpr size_t WS_ROPE = 1 * MiB;
constexpr size_t WS_SS = 1 * MiB + 256 * 1024;
constexpr size_t WS_ASSIGN = 2 * MiB;
constexpr size_t WS_KR = 4 * MiB;
constexpr size_t WS_WQKV = 12 * MiB;
constexpr size_t WS_WU = 14 * MiB;
constexpr size_t WS_WO = 17 * MiB;
constexpr size_t WS_WR = 19 * MiB;
constexpr size_t WS_WSGU = 20 * MiB;
constexpr size_t WS_WSD = 21 * MiB;
constexpr size_t WS_WD = 22 * MiB;
constexpr size_t WS_ACT = 150 * MiB;
constexpr size_t WS_SLOT = 470 * MiB;
constexpr size_t WS_END = 1046 * MiB;
constexpr size_t WS_Q = 150 * MiB;
constexpr size_t WS_K = 214 * MiB;
constexpr size_t WS_V = 231 * MiB;
constexpr size_t WS_UT = 248 * MiB;
constexpr size_t WS_HC = 440 * MiB;
constexpr size_t WS_AY = 248 * MiB;
constexpr size_t WS_LOGIT = 150 * MiB;
constexpr size_t WS_WGU = 470 * MiB;
constexpr size_t WS_H = 726 * MiB;
constexpr size_t WS_LIST = 854 * MiB;
constexpr size_t WS_YT = 920 * MiB;
static_assert(WS_LIST + (size_t)257 * 65536 * 4 <= WS_YT && WS_YT + 64 * MiB <= WS_END, "ws map");
constexpr size_t MAXROWS_R = 524288 + 256 * 255;
static_assert(WS_SLOT + MAXROWS_R * 1024 <= WS_END && WS_ACT + (MAXROWS_R + 65536) * 512 <= WS_SLOT, "ws map 2");

constexpr int CW_TMO = 0, CW_CODE = 1;
constexpr int CW_BAR = 4096;
constexpr int CW_CNT = 16384;

constexpr int RING_OFF = 0, RING_BYTES = 131072;
constexpr int AUX_OFF = 131072, AUX_BYTES = 16384;
constexpr int MISC_OFF = AUX_OFF + AUX_BYTES;
constexpr int LDS_BYTES = MISC_OFF + 512;
constexpr int AUX_TP = 0, AUX_CNT = 2048, AUX_IDX = 4096;

constexpr int NWAVES = 8;
constexpr float C2 = 0.125f * 1.4426950408889634f;

__device__ __forceinline__ unsigned f2bf(float f) { unsigned u = __builtin_bit_cast(unsigned, f); return (u + 0x7fffu + ((u >> 16) & 1u)) >> 16; }
__device__ __forceinline__ unsigned pk2(float lo, float hi) { return f2bf(lo) | (f2bf(hi) << 16); }
__device__ __forceinline__ float bf2f(unsigned h) { return __builtin_bit_cast(float, h << 16); }
__device__ __forceinline__ unsigned cvt_pk_bf16(float lo, float hi) { unsigned r; asm volatile("v_cvt_pk_bf16_f32 %0, %1, %2" : "=v"(r) : "v"(lo), "v"(hi)); return r; }
__device__ __forceinline__ float wave_sum(float v) {
#pragma unroll
    for (int o = 1; o < 64; o <<= 1) v += __shfl_xor(v, o);
    return v;
}

namespace pg8 {
constexpr int BM = 256, BK = 64, HALF = 128, HTB = HALF * BK * 2, STAGE_BYTES = 8 * HTB;
__host__ __device__ __forceinline__ int lds_byte(int r, int c) { const int st = (r >> 4) * 2 + (c >> 5), rr = r & 15, cc = c & 31, ob = rr * 64 + cc * 2; return st * 1024 + (ob ^ (((ob >> 9) & 1) << 5)); }
__host__ __device__ __forceinline__ void stage_rc(int b, int& R, int& C) { const int st = b / 1024, sb = b % 1024, swz = sb ^ (((sb >> 9) & 1) << 5); R = (st >> 1) * 16 + swz / 64; C = (st & 1) * 32 + (swz % 64) / 2; }
__host__ __device__ __forceinline__ int perm32(int rho) { const int n = rho >> 4, i = rho & 15; return 8 * (i >> 2) + 4 * n + (i & 3); }

struct Unit { int pm, pn, aux, aux2; };

template <class Epi, class Sched, bool GATHER, bool ALIGN_EPI>
__device__ __forceinline__ void gemm_phase(LAS unsigned char* lds, LAS unsigned* idxw, const int K, const Sched& S, const Epi& E) {
    int tid_ = threadIdx.x; asm volatile("" : "+v"(tid_));
    const int tid = tid_, wid = __builtin_amdgcn_readfirstlane(tid >> 6), lane = tid & 63, wr = wid >> 2, wc = wid & 3, fr = lane & 15, fq = lane >> 4;
    const int nt = K / BK;
    int Rr[2], Cc[2]; unsigned voffB[2];
#pragma unroll
    for (int i = 0; i < 2; ++i) { stage_rc(tid * 16 + i * 8192, Rr[i], Cc[i]); const int Rb = (Rr[i] & ~31) + perm32(Rr[i] & 31); voffB[i] = (unsigned)(Rb * K + Cc[i]) * 2u; }
    const unsigned kstep = (unsigned)(BK * 2);
    const unsigned hstep = (unsigned)HALF * (unsigned)K * 2u;
    const unsigned ldsw = (unsigned)wid * 1024u;
    const int aoff = lds_byte(wr * 64 + fr, fq * 8), boff = lds_byte(wc * 32 + fr, fq * 8);
#define PG8_SA(b, h) (((b) * 2 + (h)) * HTB)
#define PG8_SB(b, h) ((4 + (b) * 2 + (h)) * HTB)
#define PG8_STAGE_B(bufoff, gbase) do { _Pragma("unroll") for (int _i = 0; _i < 2; ++_i) \
        __builtin_amdgcn_global_load_lds((const unsigned*)((const char*)(gbase) + voffB[_i]), (LAS unsigned*)(lds + (bufoff) + ldsw + _i * 8192), 16, 0, 0); } while (0)
#define PG8_STAGE_A(bufoff, gbase, VV, h) do { _Pragma("unroll") for (int _i = 0; _i < 2; ++_i) \
        __builtin_amdgcn_global_load_lds((const unsigned*)((const char*)(gbase) + VV[h][_i]), (LAS unsigned*)(lds + (bufoff) + ldsw + _i * 8192), 16, 0, 0); } while (0)
#define PG8_LDA(dst, b, h) do { _Pragma("unroll") for (int m = 0; m < 4; ++m) _Pragma("unroll") for (int k = 0; k < 2; ++k) dst[m][k] = *(const LAS bf16x8*)(lds + PG8_SA(b, h) + aoff + m * 2048 + k * 1024); } while (0)
#define PG8_LDB(dst, b, h) do { _Pragma("unroll") for (int n = 0; n < 2; ++n) _Pragma("unroll") for (int k = 0; k < 2; ++k) dst[n][k] = *(const LAS bf16x8*)(lds + PG8_SB(b, h) + boff + n * 2048 + k * 1024); } while (0)
#define PG8_MMA(ai, bj, At, Bt) do { __builtin_amdgcn_s_setprio(1); _Pragma("unroll") for (int m = 0; m < 4; ++m) _Pragma("unroll") for (int n = 0; n < 2; ++n) _Pragma("unroll") for (int k = 0; k < 2; ++k) \
        acc[ai][bj][m][n] = __builtin_amdgcn_mfma_f32_16x16x32_bf16(Bt[n][k], At[m][k], acc[ai][bj][m][n], 0, 0, 0); __builtin_amdgcn_s_setprio(0); } while (0)
#define PG8_WAIT_V(n) asm volatile("s_waitcnt vmcnt(" #n ")" ::: "memory")
#define PG8_WAIT_L(n) asm volatile("s_waitcnt lgkmcnt(" #n ")" ::: "memory")
#define PG8_BAR __builtin_amdgcn_s_barrier()
#define PG8_SCHED __builtin_amdgcn_sched_barrier(0)
    Unit cur, nxt; int ui = 0;
    if (!S.next(0, cur)) return;
    f32x4 acc[2][2][4][2];
#pragma unroll
    for (int a = 0; a < 2; ++a)
#pragma unroll
        for (int b = 0; b < 2; ++b)
#pragma unroll
            for (int m = 0; m < 4; ++m)
#pragma unroll
                for (int n = 0; n < 2; ++n) acc[a][b][m][n] = (f32x4){0.f, 0.f, 0.f, 0.f};
    bf16x8 At[4][2], B0[2][2], B1[2][2];
    unsigned va[2][2], vn[2][2];
    if constexpr (GATHER) {
        const unsigned* ip = S.idx_ptr(cur); const int nv = S.nvalid(cur);
#pragma unroll
        for (int h = 0; h < 2; ++h)
#pragma unroll
            for (int i = 0; i < 2; ++i) { const int r = Rr[i] + HALF * h; const unsigned e = ip[r]; const unsigned tok = r < nv ? (e >> 16) : 0u; va[h][i] = tok * (unsigned)K * 2u + (unsigned)Cc[i] * 2u; }
    } else {
#pragma unroll
        for (int h = 0; h < 2; ++h)
#pragma unroll
            for (int i = 0; i < 2; ++i) va[h][i] = (unsigned)((Rr[i] + HALF * h) * K + Cc[i]) * 2u;
    }
#pragma unroll
    for (int h = 0; h < 2; ++h)
#pragma unroll
        for (int i = 0; i < 2; ++i) vn[h][i] = va[h][i];
    const char* cA = S.a_base(cur); const char* cB = S.b_base(cur);
    PG8_STAGE_B(PG8_SB(0, 0), cB); PG8_STAGE_B(PG8_SB(0, 1), cB + hstep); PG8_STAGE_A(PG8_SA(0, 0), cA, va, 0); PG8_STAGE_A(PG8_SA(0, 1), cA, va, 1);
    if (wr == 1) PG8_BAR;
    PG8_WAIT_V(2); PG8_BAR;
    PG8_STAGE_B(PG8_SB(1, 0), cB + kstep); PG8_STAGE_A(PG8_SA(1, 0), cA + kstep, va, 0); PG8_STAGE_B(PG8_SB(1, 1), cB + hstep + kstep);
    PG8_WAIT_V(6); PG8_BAR;
    for (;;) {
        const bool has_next = S.next(ui + 1, nxt);
        const char* nA = has_next ? S.a_base(nxt) : cA; const char* nB = has_next ? S.b_base(nxt) : cB;
        int nvn = 0;
        if constexpr (GATHER) {
            if (has_next) { nvn = S.nvalid(nxt);
                __builtin_amdgcn_global_load_lds((const unsigned*)(S.idx_ptr(nxt) + lane * 4), (LAS unsigned*)idxw, 16, 0, 0); }
        }
#pragma unroll 1
        for (int t = 0; t < nt; t += 2) {
            const bool last = (t == nt - 2);
            if constexpr (GATHER) {
                if (last && has_next) {
                    asm volatile("" ::: "memory");
#pragma unroll
                    for (int h = 0; h < 2; ++h)
#pragma unroll
                        for (int i = 0; i < 2; ++i) { const int r = Rr[i] + HALF * h; const unsigned e = idxw[r]; const unsigned tok = r < nvn ? (e >> 16) : 0u; vn[h][i] = tok * (unsigned)K * 2u + (unsigned)Cc[i] * 2u; }
                }
            }
            unsigned v2[2][2];
#pragma unroll
            for (int h = 0; h < 2; ++h)
#pragma unroll
                for (int i = 0; i < 2; ++i) v2[h][i] = (GATHER && last) ? vn[h][i] : va[h][i];
            const char* a1 = cA + (size_t)(t + 1) * kstep;
            const char* a2 = last ? nA : cA + (size_t)(t + 2) * kstep; const char* b2 = last ? nB : cB + (size_t)(t + 2) * kstep;
            const char* a3 = a2 + kstep; const char* b3 = b2 + kstep;
            PG8_LDB(B0, 0, 0); PG8_LDB(B1, 0, 1); PG8_SCHED; PG8_LDA(At, 0, 0); PG8_STAGE_A(PG8_SA(1, 1), a1, va, 1);
            PG8_WAIT_V(8); PG8_WAIT_L(0); PG8_BAR; PG8_MMA(0, 0, At, B0); PG8_MMA(0, 1, At, B1); PG8_BAR; PG8_SCHED;
            PG8_LDA(At, 0, 1); PG8_STAGE_B(PG8_SB(0, 0), b2); PG8_STAGE_B(PG8_SB(0, 1), b2 + hstep); PG8_STAGE_A(PG8_SA(0, 0), a2, v2, 0);
            PG8_WAIT_V(8); PG8_WAIT_L(0); PG8_BAR; PG8_MMA(1, 0, At, B0); PG8_MMA(1, 1, At, B1); PG8_BAR; PG8_SCHED;
            PG8_LDB(B0, 1, 0); PG8_LDB(B1, 1, 1); PG8_SCHED; PG8_LDA(At, 1, 0); PG8_STAGE_A(PG8_SA(0, 1), a2, v2, 1);
            PG8_WAIT_V(8); PG8_WAIT_L(0); PG8_BAR; PG8_MMA(0, 0, At, B0); PG8_MMA(0, 1, At, B1); PG8_BAR; PG8_SCHED;
            PG8_LDA(At, 1, 1); PG8_STAGE_B(PG8_SB(1, 0), b3); PG8_STAGE_B(PG8_SB(1, 1), b3 + hstep); PG8_STAGE_A(PG8_SA(1, 0), a3, v2, 0);
            PG8_WAIT_V(8); PG8_WAIT_L(0); PG8_BAR; PG8_MMA(1, 0, At, B0); PG8_MMA(1, 1, At, B1); PG8_BAR; PG8_SCHED;
        }
        if constexpr (ALIGN_EPI) { if (wr == 0) PG8_BAR; }
        E(acc, cur, wr, wc, fr, fq);
        if (!has_next) break;
#pragma unroll
        for (int a = 0; a < 2; ++a)
#pragma unroll
            for (int b = 0; b < 2; ++b)
#pragma unroll
                for (int m = 0; m < 4; ++m)
#pragma unroll
                    for (int n = 0; n < 2; ++n) acc[a][b][m][n] = (f32x4){0.f, 0.f, 0.f, 0.f};
        cur = nxt; cA = nA; cB = nB; ++ui;
#pragma unroll
        for (int h = 0; h < 2; ++h)
#pragma unroll
            for (int i = 0; i < 2; ++i) va[h][i] = vn[h][i];
        if constexpr (ALIGN_EPI) { if (wr == 1) PG8_BAR; }
    }
    PG8_WAIT_V(0);
    if constexpr (!ALIGN_EPI) { if (wr == 0) PG8_BAR; }
    PG8_BAR;
#undef PG8_SA
#undef PG8_SB
#undef PG8_STAGE_A
#undef PG8_STAGE_B
#undef PG8_LDA
#undef PG8_LDB
#undef PG8_MMA
#undef PG8_WAIT_V
#undef PG8_WAIT_L
#undef PG8_BAR
#undef PG8_SCHED
}
}

using pg8::Unit;
struct MoeTab { const LAS int* tp; const LAS int* cnt; };
__device__ __forceinline__ int moe_find(const LAS int* tp, int T) {
    int lo = 0, hi = 256;
    while (lo < hi) { const int mid = (lo + hi + 1) >> 1; if (tp[mid] <= T) lo = mid; else hi = mid - 1; }
    return lo;
}

struct SchedQKV {
    const bf16_t *H; long hc_delta; const bf16_t *W; int G, c;
    __device__ __forceinline__ bool next(int i, Unit& u) const {
        const int L = i * G + c; if (L >= 784) return false;
        if (L < 768) { u.pm = L / 3; u.pn = L % 3; u.aux = 0; } else { u.pm = L - 768; u.pn = 2; u.aux = 1; }
        u.aux2 = 0; return true;
    }
    __device__ __forceinline__ const char* a_base(const Unit& u) const { return (const char*)H + (u.aux ? hc_delta : 0L) + (size_t)u.pm * (256 * 1024 * 2); }
    __device__ __forceinline__ const char* b_base(const Unit& u) const { return (const char*)W + (size_t)u.pn * (256 * 1024 * 2); }
    __device__ __forceinline__ const unsigned* idx_ptr(const Unit&) const { return nullptr; }
    __device__ __forceinline__ int nvalid(const Unit&) const { return 256; }
};
struct SchedDense {
    const bf16_t *A, *Bt; int K, nM, nN, G, c; bool m_fast;
    __device__ __forceinline__ bool next(int i, Unit& u) const {
        const int L = i * G + c; if (L >= nM * nN) return false;
        if (m_fast) { u.pm = L % nM; u.pn = L / nM; } else { u.pm = L / nN; u.pn = L % nN; }
        u.aux = 0; u.aux2 = 0; return true;
    }
    __device__ __forceinline__ const char* a_base(const Unit& u) const { return (const char*)A + (size_t)u.pm * 512 * (size_t)K; }
    __device__ __forceinline__ const char* b_base(const Unit& u) const { return (const char*)Bt + (size_t)u.pn * 512 * (size_t)K; }
    __device__ __forceinline__ const unsigned* idx_ptr(const Unit&) const { return nullptr; }
    __device__ __forceinline__ int nvalid(const Unit&) const { return 256; }
};
struct SchedGU {
    const bf16_t *H2, *WGU, *WSGU; const unsigned* LIST; MoeTab tab; int G, c;
    __device__ __forceinline__ bool next(int i, Unit& u) const {
        const int L = i * G + c; const int Ttot = __builtin_amdgcn_readfirstlane(tab.tp[257]); if (L >= 2 * Ttot) return false;
        const int T = L >> 1; const int e = __builtin_amdgcn_readfirstlane(moe_find(tab.tp, T));
        u.pm = T; u.pn = L & 1; u.aux = e; u.aux2 = __builtin_amdgcn_readfirstlane(T - tab.tp[e]); return true;
    }
    __device__ __forceinline__ const char* a_base(const Unit&) const { return (const char*)H2; }
    __device__ __forceinline__ const char* b_base(const Unit& u) const { return (const char*)(u.aux < 256 ? WGU + (size_t)u.aux * (512 * 1024) : WSGU) + (size_t)u.pn * (256 * 1024 * 2); }
    __device__ __forceinline__ const unsigned* idx_ptr(const Unit& u) const { return LIST + (size_t)u.aux * 65536 + (size_t)u.aux2 * 256; }
    __device__ __forceinline__ int nvalid(const Unit& u) const { const int r = __builtin_amdgcn_readfirstlane(tab.cnt[u.aux]) - u.aux2 * 256; return r < 256 ? r : 256; }
};
struct SchedDown {
    const bf16_t *ACT, *WD, *WSD; MoeTab tab; int hp, G, c;
    __device__ __forceinline__ bool next(int i, Unit& u) const {
        const int L = i * G + c; const int TR = __builtin_amdgcn_readfirstlane(tab.tp[256]), TT = __builtin_amdgcn_readfirstlane(tab.tp[257]); int T, pn;
        if (L < 2 * TR) { T = L >> 1; pn = 2 * hp + (L & 1); }
        else { if (hp) return false; const int L2 = L - 2 * TR; if (L2 >= 4 * (TT - TR)) return false; T = TR + (L2 >> 2); pn = L2 & 3; }
        const int e = __builtin_amdgcn_readfirstlane(moe_find(tab.tp, T));
        u.pm = T; u.pn = pn; u.aux = e; u.aux2 = 0; return true;
    }
    __device__ __forceinline__ const char* a_base(const Unit& u) const { return (const char*)ACT + (size_t)u.pm * (256 * 256 * 2); }
    __device__ __forceinline__ const char* b_base(const Unit& u) const { return (const char*)(u.aux < 256 ? WD + (size_t)u.aux * (1024 * 256) : WSD) + (size_t)u.pn * (256 * 256 * 2); }
    __device__ __forceinline__ const unsigned* idx_ptr(const Unit&) const { return nullptr; }
    __device__ __forceinline__ int nvalid(const Unit&) const { return 256; }
};

#define EPI_ARGS const f32x4 (&acc)[2][2][4][2], const Unit& u, int wr, int wc, int fr_, int fq_
#define EPI_PIN int fr = fr_, fq = fq_; asm volatile("" : "+v"(fr), "+v"(fq))
__device__ __forceinline__ u32x4 pack8(const f32x4& a, const f32x4& b) { u32x4 o; o.x = cvt_pk_bf16(a[0], a[1]); o.y = cvt_pk_bf16(a[2], a[3]); o.z = cvt_pk_bf16(b[0], b[1]); o.w = cvt_pk_bf16(b[2], b[3]); return o; }

struct EpiQKV {
    bf16_t *Q, *Kb, *Vb; const float *qnw, *knw; const f32x2* rope;
    __device__ __forceinline__ void operator()(EPI_ARGS) const {
        EPI_PIN;
        const bool ctx = u.aux != 0;
        const int kind = (u.pn < 2) ? 0 : (wc < 2 ? 1 : 2);
        f32x4 w[2][2];
#pragma unroll
        for (int bj = 0; bj < 2; ++bj)
#pragma unroll
            for (int n = 0; n < 2; ++n) w[bj][n] = (kind == 2) ? (f32x4){1.f, 1.f, 1.f, 1.f} : *(const f32x4*)((kind == 0 ? qnw : knw) + 32 * bj + 8 * fq + 4 * n);
#pragma unroll
        for (int ai = 0; ai < 2; ++ai)
#pragma unroll
            for (int m = 0; m < 4; ++m) {
                const int rl = ai * 128 + wr * 64 + m * 16 + fr; const int row = u.pm * 256 + rl;
                f32x4 v[2][2];
#pragma unroll
                for (int bj = 0; bj < 2; ++bj)
#pragma unroll
                    for (int n = 0; n < 2; ++n) v[bj][n] = acc[ai][bj][m][n];
                if (kind != 2) {
                    float ss = 0.f;
#pragma unroll
                    for (int bj = 0; bj < 2; ++bj)
#pragma unroll
                        for (int n = 0; n < 2; ++n) ss += (v[bj][n][0] * v[bj][n][0] + v[bj][n][1] * v[bj][n][1]) + (v[bj][n][2] * v[bj][n][2] + v[bj][n][3] * v[bj][n][3]);
                    ss += __shfl_xor(ss, 16); ss += __shfl_xor(ss, 32);
                    const float rs = rsqrtf(ss * (1.f / 64.f) + EPS);
#pragma unroll
                    for (int bj = 0; bj < 2; ++bj)
#pragma unroll
                        for (int n = 0; n < 2; ++n) v[bj][n] = v[bj][n] * rs * w[bj][n];
                    if (!ctx) {
                        const int t = row & (SEQ - 1);
#pragma unroll
                        for (int bj = 0; bj < 2; ++bj) {
                            const int pos = bj == 0 ? (t >> 6) : (t & 63);
                            const f32x4* rp = (const f32x4*)(rope + pos * 16 + 4 * fq);
#pragma unroll
                            for (int n = 0; n < 2; ++n) { const f32x4 cs = rp[n]; const f32x4 x = v[bj][n];
                                v[bj][n] = (f32x4){x[0] * cs[0] - x[1] * cs[1], x[0] * cs[1] + x[1] * cs[0], x[2] * cs[2] - x[3] * cs[3], x[2] * cs[3] + x[3] * cs[2]}; }
                        }
                    }
                    if (kind == 0) {
#pragma unroll
                        for (int bj = 0; bj < 2; ++bj)
#pragma unroll
                            for (int n = 0; n < 2; ++n) v[bj][n] = v[bj][n] * C2;
                    }
                }
                bf16_t* dst;
                if (kind == 0) dst = Q + (size_t)row * AW + 64 * (4 * u.pn + wc) + 8 * fq;
                else { const int kvrow = ctx ? (row >> 8) * KVLEN + (row & 255) : (row >> 12) * KVLEN + CTXL + (row & (SEQ - 1));
                       dst = (kind == 1 ? Kb : Vb) + (size_t)kvrow * KVP + 64 * (wc & 1) + 8 * fq; }
#pragma unroll
                for (int bj = 0; bj < 2; ++bj) *(u32x4*)(dst + 32 * bj) = pack8(v[bj][0], v[bj][1]);
                asm volatile("" ::: "memory");
            }
    }
};
struct EpiPlainBf16 {
    bf16_t* O; size_t ldc;
    __device__ __forceinline__ void operator()(EPI_ARGS) const {
        EPI_PIN;
#pragma unroll
        for (int ai = 0; ai < 2; ++ai)
#pragma unroll
            for (int m = 0; m < 4; ++m) { bf16_t* rowp = O + (size_t)(u.pm * 256 + ai * 128 + wr * 64 + m * 16 + fr) * ldc + u.pn * 256 + wc * 32 + 8 * fq;
#pragma unroll
                for (int bj = 0; bj < 2; ++bj) *(u32x4*)(rowp + bj * 128) = pack8(acc[ai][bj][m][0], acc[ai][bj][m][1]); }
    }
};
struct EpiOutProj {
    const float* x; float* out; const float* modv;
    __device__ __forceinline__ void operator()(EPI_ARGS) const {
        EPI_PIN;
        const float* g1 = modv + (size_t)(u.pm >> 4) * 6144 + 2 * 1024; const int col0 = u.pn * 256 + wc * 32 + 8 * fq;
        f32x4 gv[2][2];
#pragma unroll
        for (int bj = 0; bj < 2; ++bj)
#pragma unroll
            for (int n = 0; n < 2; ++n) gv[bj][n] = *(const f32x4*)(g1 + col0 + bj * 128 + 4 * n);
#pragma unroll
        for (int ai = 0; ai < 2; ++ai)
#pragma unroll
            for (int m = 0; m < 4; ++m) { const size_t off = (size_t)(u.pm * 256 + ai * 128 + wr * 64 + m * 16 + fr) * DM + col0;
#pragma unroll
                for (int bj = 0; bj < 2; ++bj)
#pragma unroll
                    for (int n = 0; n < 2; ++n) { const f32x4 xv = *(const f32x4*)(x + off + bj * 128 + 4 * n); *(f32x4*)(out + off + bj * 128 + 4 * n) = xv + gv[bj][n] * acc[ai][bj][m][n]; }
                asm volatile("" ::: "memory"); }
    }
};
struct EpiF32 {
    float* O; size_t ldc;
    __device__ __forceinline__ void operator()(EPI_ARGS) const {
        EPI_PIN;
#pragma unroll
        for (int ai = 0; ai < 2; ++ai)
#pragma unroll
            for (int m = 0; m < 4; ++m) { float* rowp = O + (size_t)(u.pm * 256 + ai * 128 + wr * 64 + m * 16 + fr) * ldc + u.pn * 256 + wc * 32 + 8 * fq;
#pragma unroll
                for (int bj = 0; bj < 2; ++bj)
#pragma unroll
                    for (int n = 0; n < 2; ++n) *(f32x4*)(rowp + bj * 128 + 4 * n) = acc[ai][bj][m][n]; }
    }
};
struct EpiGU {
    bf16_t* ACT; const unsigned* LIST; MoeTab tab;
    __device__ __forceinline__ void operator()(EPI_ARGS) const {
        EPI_PIN;
        const int e = u.aux, tile = u.aux2; int nv = __builtin_amdgcn_readfirstlane(tab.cnt[e]) - tile * 256; nv = nv < 256 ? nv : 256;
        const unsigned* ip = LIST + (size_t)e * 65536 + (size_t)tile * 256;
#pragma unroll
        for (int ai = 0; ai < 2; ++ai)
#pragma unroll
            for (int m = 0; m < 4; ++m) { const int rl = ai * 128 + wr * 64 + m * 16 + fr;
                const float wrow = rl < nv ? bf2f(ip[rl] & 0xffffu) : 0.f;
                f32x4 o[2];
#pragma unroll
                for (int n = 0; n < 2; ++n) { const f32x4 g = acc[ai][0][m][n], up = acc[ai][1][m][n];
#pragma unroll
                    for (int j = 0; j < 4; ++j) o[n][j] = g[j] * __builtin_amdgcn_rcpf(1.f + __builtin_amdgcn_exp2f(-1.4426950408889634f * g[j])) * up[j] * wrow; }
                *(u32x4*)(ACT + (size_t)(u.pm * 256 + rl) * FF + u.pn * 128 + wc * 32 + 8 * fq) = pack8(o[0], o[1]); }
    }
};
struct EpiDown {
    bf16_t* SLOT; float* out; const float* modv; MoeTab tab;
    __device__ __forceinline__ void operator()(EPI_ARGS) const {
        EPI_PIN;
        if (u.aux < 256) {
#pragma unroll
            for (int ai = 0; ai < 2; ++ai)
#pragma unroll
                for (int m = 0; m < 4; ++m) { bf16_t* rowp = SLOT + (size_t)(u.pm * 256 + ai * 128 + wr * 64 + m * 16 + fr) * 512 + (u.pn & 1) * 256 + wc * 32 + 8 * fq;
#pragma unroll
                    for (int bj = 0; bj < 2; ++bj) *(u32x4*)(rowp + bj * 128) = pack8(acc[ai][bj][m][0], acc[ai][bj][m][1]); }
        } else {
            const int ts = u.pm - __builtin_amdgcn_readfirstlane(tab.tp[256]);
            const float* g2 = modv + (size_t)(ts >> 4) * 6144 + 5 * 1024; const int col0 = u.pn * 256 + wc * 32 + 8 * fq;
            f32x4 gv[2][2];
#pragma unroll
            for (int bj = 0; bj < 2; ++bj)
#pragma unroll
                for (int n = 0; n < 2; ++n) gv[bj][n] = *(const f32x4*)(g2 + col0 + bj * 128 + 4 * n);
#pragma unroll
            for (int ai = 0; ai < 2; ++ai)
#pragma unroll
                for (int m = 0; m < 4; ++m) { const size_t off = (size_t)(ts * 256 + ai * 128 + wr * 64 + m * 16 + fr) * DM + col0;
#pragma unroll
                    for (int bj = 0; bj < 2; ++bj)
#pragma unroll
                        for (int n = 0; n < 2; ++n) { const f32x4 xv = *(const f32x4*)(out + off + bj * 128 + 4 * n); *(f32x4*)(out + off + bj * 128 + 4 * n) = xv + gv[bj][n] * acc[ai][bj][m][n]; }
                    asm volatile("" ::: "memory"); }
        }
    }
};
#include <hip/hip_bf16.h>
#include <cmath>
namespace attn_body {
using bf16=__hip_bfloat16;
using bf16x8=__attribute__((ext_vector_type(8)))short;
using s16x4=__attribute__((ext_vector_type(4)))short;
using f32x16=__attribute__((ext_vector_type(16)))float;
using u32x4=__attribute__((ext_vector_type(4)))unsigned;
constexpr int SEQ=4096,D=64,QP=512,KVP=128,KVLEN=4352;
constexpr int NW=8,QBLK=32,QB=QBLK*NW,KVBLK=64,NQB=SEQ/QB;
constexpr int ATTN_UNIT_ROWS=QB;
__device__ __forceinline__ int crow(int r,int hi){return (r&3)+8*(r>>2)+4*hi;}
#define SBAR() __builtin_amdgcn_sched_barrier(0)

constexpr int NSLOT=3, SLOTB=8192;
constexpr int LDS_K=0, LDS_V=NSLOT*SLOTB, LDS_WS=2*NSLOT*SLOTB, LDS_OST=LDS_WS+NW*64*4, LDS_BYTES=LDS_OST+NW*4096;
constexpr float C2=0.125f*1.4426950408889634f;
__device__ __forceinline__ void glds16(const void*gsrc,unsigned lds_dst){unsigned keep;
  asm volatile("s_mov_b32 %0, m0\n\ts_mov_b32 m0, %2\n\ts_nop 0\n\tglobal_load_lds_dwordx4 %1, off\n\ts_mov_b32 m0, %0":"=&s"(keep):"v"(gsrc),"s"(lds_dst):"memory");}
__device__ __forceinline__ float max3f(float a,float b,float c){float r;asm("v_max3_f32 %0, %1, %2, %3":"=v"(r):"v"(a),"v"(b),"v"(c));return r;}
__device__ __forceinline__ float max2f(float a,float b){float r;asm("v_max_f32_e32 %0, %1, %2":"=v"(r):"v"(a),"v"(b));return r;}
__device__ __forceinline__ float fadd_s(float a,float b){float r;asm("v_add_f32_e32 %0, %1, %2":"=v"(r):"v"(a),"v"(b));return r;}
__device__ __forceinline__ float fsub_s(float a,float b){float r;asm("v_sub_f32_e32 %0, %1, %2":"=v"(r):"v"(a),"v"(b));return r;}
typedef float f32x2_t __attribute__((ext_vector_type(2))); typedef __bf16 bf16x2_t __attribute__((ext_vector_type(2)));
__device__ __forceinline__ unsigned cvtpk_s(float lo,float hi){f32x2_t v={lo,hi};bf16x2_t b=__builtin_convertvector(v,bf16x2_t);return __builtin_bit_cast(unsigned,b);}
#define WAIT_BAR(N) asm volatile("s_waitcnt vmcnt(" #N ") lgkmcnt(0)\n\ts_barrier":::"memory")

__device__ __forceinline__ void qkt(f32x16&p0,f32x16&p1,const char*Kslot,const bf16x8*qr,const f32x16&negm,int r32,int hi){
  const char*kb=Kslot+hi*1024+r32*16;
  #pragma unroll
  for(int d0=0;d0<4;++d0){
    const bf16x8 b0=*reinterpret_cast<const bf16x8*>(kb+d0*2048);
    const bf16x8 b1=*reinterpret_cast<const bf16x8*>(kb+d0*2048+512);
    if(d0==0){p0=__builtin_amdgcn_mfma_f32_32x32x16_bf16(b0,qr[0],negm,0,0,0);p1=__builtin_amdgcn_mfma_f32_32x32x16_bf16(b1,qr[0],negm,0,0,0);}
    else{p0=__builtin_amdgcn_mfma_f32_32x32x16_bf16(b0,qr[d0],p0,0,0,0);p1=__builtin_amdgcn_mfma_f32_32x32x16_bf16(b1,qr[d0],p1,0,0,0);}}
}
typedef __attribute__((address_space(3))) const char* lds_cptr;
typedef short v4i16_t __attribute__((ext_vector_type(4)));
__device__ __forceinline__ void kload8(bf16x8*kf,lds_cptr kp){
  kf[0]=*(const __attribute__((address_space(3))) bf16x8*)(kp);      kf[1]=*(const __attribute__((address_space(3))) bf16x8*)(kp+512);
  kf[2]=*(const __attribute__((address_space(3))) bf16x8*)(kp+2048); kf[3]=*(const __attribute__((address_space(3))) bf16x8*)(kp+2560);
  kf[4]=*(const __attribute__((address_space(3))) bf16x8*)(kp+4096); kf[5]=*(const __attribute__((address_space(3))) bf16x8*)(kp+4608);
  kf[6]=*(const __attribute__((address_space(3))) bf16x8*)(kp+6144); kf[7]=*(const __attribute__((address_space(3))) bf16x8*)(kp+6656);
}
__device__ __forceinline__ void kload2(bf16x8*kf,lds_cptr kp,int j){ kf[2*j]=*(const __attribute__((address_space(3))) bf16x8*)(kp+j*2048); kf[2*j+1]=*(const __attribute__((address_space(3))) bf16x8*)(kp+j*2048+512); }
__device__ __forceinline__ s16x4 vtr(lds_cptr p){ return __builtin_bit_cast(s16x4,__builtin_amdgcn_ds_read_tr16_b64_v4i16((__attribute__((address_space(3))) v4i16_t*)p)); }
__device__ __forceinline__ float rowmax(const f32x16&p0,const f32x16&p1){
  float a=max3f(p0[0],p0[1],p1[0]),b=max3f(p0[2],p0[3],p1[1]);a=max3f(a,p1[2],p1[3]);
  #pragma unroll
  for(int r=4;r<16;r+=4){a=max3f(a,p0[r],p0[r+1]);b=max3f(b,p0[r+2],p0[r+3]);a=max3f(a,p1[r],p1[r+1]);b=max3f(b,p1[r+2],p1[r+3]);}
  const float m=max2f(a,b);
  auto rr=__builtin_amdgcn_permlane32_swap(__float_as_uint(m),__float_as_uint(m),false,false);
  return max2f(__uint_as_float(rr[0]),__uint_as_float(rr[1]));
}
__device__ __forceinline__ void pv(f32x16*o,int vb,bf16x8 pa0,bf16x8 pa1,bf16x8 pa2,bf16x8 pa3){
  #pragma unroll
  for(int d0=0;d0<2;++d0){s16x4 lo[4],hi[4];
    #pragma unroll
    for(int ks=0;ks<4;++ks){
      asm volatile("ds_read_b64_tr_b16 %0,%1 offset:%c2":"=&v"(lo[ks]):"v"(vb),"i"(d0*4096+ks*1024):"memory");
      asm volatile("ds_read_b64_tr_b16 %0,%1 offset:%c2":"=&v"(hi[ks]):"v"(vb),"i"(d0*4096+ks*1024+512):"memory");}
    asm volatile("s_waitcnt lgkmcnt(0)":::"memory");SBAR();
    #define PK(k) (bf16x8){lo[k][0],lo[k][1],lo[k][2],lo[k][3],hi[k][0],hi[k][1],hi[k][2],hi[k][3]}
    o[d0]=__builtin_amdgcn_mfma_f32_32x32x16_bf16(pa0,PK(0),o[d0],0,0,0);
    o[d0]=__builtin_amdgcn_mfma_f32_32x32x16_bf16(pa1,PK(1),o[d0],0,0,0);
    o[d0]=__builtin_amdgcn_mfma_f32_32x32x16_bf16(pa2,PK(2),o[d0],0,0,0);
    o[d0]=__builtin_amdgcn_mfma_f32_32x32x16_bf16(pa3,PK(3),o[d0],0,0,0);
    #undef PK
  }
}

#ifndef ATTN_STORE16
#define ATTN_STORE16(p,v) (*(u32x4*)(p)=(v))
#endif
template<int THRL> __device__ __forceinline__ void attn_unit(int b,int h,int qb,const bf16*Q,const bf16*__restrict__ K,const bf16*__restrict__ V,bf16*O,char*shm){
  const int tid=threadIdx.x,lane=tid&63,r32=lane&31,hi=lane>>5; const int wid=__builtin_amdgcn_readfirstlane(tid>>6);
  const int q0=qb*QB; const long qrow0=(long)b*SEQ+q0+wid*QBLK;
  const bf16*Qw=Q+qrow0*QP+h*D;
  const bf16*Kh=K+(long)b*KVLEN*KVP+(h>>2)*D,*Vh=V+(long)b*KVLEN*KVP+(h>>2)*D;
  const unsigned lds0=(unsigned)(uintptr_t)shm;
  float*wsf=(float*)(shm+LDS_WS)+wid*64;
  const bf16*ksrc=Kh+(long)lane*KVP+wid*8;
  const bf16*vsrc=Vh+(long)(16*(wid&3)+(lane>>2))*KVP+(wid>>2)*32+(lane&3)*8;
  const unsigned kdst=lds0+LDS_K+wid*1024, vdst=lds0+LDS_V+wid*1024;
  #define DMA_K(t,slot) glds16(ksrc+(long)(t)*KVBLK*KVP,(unsigned)__builtin_amdgcn_readfirstlane(kdst+(slot)))
  #define DMA_V(t,slot) glds16(vsrc+(long)(t)*KVBLK*KVP,(unsigned)__builtin_amdgcn_readfirstlane(vdst+(slot)))
  const int vb0=(int)(lds0+LDS_V)+((lane>>4)&1)*32+(lane&3)*8+(4*hi+((lane&15)>>2))*64;
  const char*Kbase=shm+LDS_K; bf16x8 kf[8];
  const lds_cptr shm3=(lds_cptr)shm; const lds_cptr kp0=shm3+LDS_K+hi*1024+r32*16; const lds_cptr vp0=shm3+LDS_V+((lane>>4)&1)*32+(lane&3)*8+(4*hi+((lane&15)>>2))*64;
  constexpr int NT=KVLEN/KVBLK;
  DMA_K(0,0);DMA_V(0,0);DMA_K(1,SLOTB);
  bf16x8 qr[4];
  #pragma unroll
  for(int d0=0;d0<4;++d0)qr[d0]=*reinterpret_cast<const bf16x8*>(&Qw[(long)r32*QP+d0*16+hi*8]);
  float mhat=0.f,l_reg=0.f;f32x16 o[2];o[0]=f32x16{};o[1]=f32x16{};f32x16 negm=f32x16{};asm volatile("":"+v"(negm));
  #define CMASK(P0,P1,t) do{}while(0)
  bool resc=false;
  #define START(P0,P1) do{ const float rm=rowmax(P0,P1); resc=false; \
    { const float dl=rm; mhat=fadd_s(mhat,dl); \
      _Pragma("unroll") for(int r=0;r<16;++r){P0[r]=fsub_s(P0[r],dl);P1[r]=fsub_s(P1[r],dl);} \
      _Pragma("unroll") for(int r=0;r<16;++r)negm[r]=-mhat; asm volatile("":"+v"(negm)); } \
    _Pragma("unroll") for(int r=0;r<16;++r)P0[r]=__builtin_amdgcn_exp2f(P0[r]); }while(0)
  #define RESC() do{ if(resc){ asm volatile("s_waitcnt lgkmcnt(0)":::"memory"); \
      _Pragma("unroll") for(int d_=0;d_<2;++d_) _Pragma("unroll") for(int r=0;r<16;++r)o[d_][r]*=wsf[crow(r,hi)]; } }while(0)
  f32x16 pA0,pA1,pB0,pB1;
  int sl_prev=0,sl_cur=0,sl_next=SLOTB;
  #define ROT() do{sl_prev=sl_cur;sl_cur=sl_next;sl_next=(sl_next==(NSLOT-1)*SLOTB)?0:sl_next+SLOTB;}while(0)
  DMA_K(2,2*SLOTB);
  WAIT_BAR(3);
  qkt(pA0,pA1,Kbase,qr,negm,r32,hi);asm volatile("s_nop 15\n\ts_nop 7":"+v"(pA0),"+v"(pA1));CMASK(pA0,pA1,0);
  START(pA0,pA1);
  _Pragma("unroll") for(int r=0;r<16;++r)pA1[r]=__builtin_amdgcn_exp2f(pA1[r]);
  WAIT_BAR(0);
  DMA_K(3,0);DMA_V(1,SLOTB);
  ROT();
  kload8(kf,kp0+sl_cur);
  WAIT_BAR(2);
  s16x4 vlo[8],vhi[8]; u32x4 pw0,pw1,pw2,pw3;
  #define PKW(P,B) cvtpk_s(P[B],P[B+1])
  #define PAF(k) __builtin_bit_cast(bf16x8,pw##k)
  #define VFR(i) (bf16x8){vlo[i][0],vlo[i][1],vlo[i][2],vlo[i][3],vhi[i][0],vhi[i][1],vhi[i][2],vhi[i][3]}
  #define PIN(x) asm volatile("":"+v"(x))
  #define MX3(a,b,c) __builtin_fmaxf(__builtin_fmaxf((a),(b)),(c))
  #define GAPA(MF,A0,A1,A2,A3,W0,W1,PW) do{ MF; sacc+=A0; sacc+=A1; sacc+=A2; sacc+=A3; PIN(sacc); W0; W1; PIN(PW); SBAR(); }while(0)
  #define EX(v) __builtin_amdgcn_exp2f(v)
  #define GAPB(MF,X,B) do{ MF; X[B]=EX(X[B]); X[B+1]=EX(X[B+1]); X[B+2]=EX(X[B+2]); X[B+3]=EX(X[B+3]); PIN(X); SBAR(); }while(0)
  #define VRD(i) do{ vlo[i]=vtr(vp_+(((i)>>2)*4096+((i)&3)*1024)); vhi[i]=vtr(vp_+(((i)>>2)*4096+((i)&3)*1024+512)); }while(0)
  #define KRD(G,j) do{ if(G){ kload2(kf,kp0+sl_next,j); SBAR(); } }while(0)
  #define STEP(C0,C1,P0,P1,t,GK,GV,GL) do{ SBAR(); \
    const lds_cptr vp_=vp0+sl_prev; \
    VRD(0); SBAR(); float sacc=(P0[0]+P0[1]); \
    GAPA(C0=__builtin_amdgcn_mfma_f32_32x32x16_bf16(kf[0],qr[0],negm,0,0,0), P0[2],P0[3],P0[4],P0[5],     pw0[0]=PKW(P0,0), pw0[1]=PKW(P0,2), pw0); \
    VRD(4); SBAR(); GAPA(C1=__builtin_amdgcn_mfma_f32_32x32x16_bf16(kf[1],qr[0],negm,0,0,0), P0[6],P0[7],P0[8],P0[9],     pw0[2]=PKW(P0,4), pw0[3]=PKW(P0,6), pw0); \
    VRD(1); SBAR(); GAPA(C0=__builtin_amdgcn_mfma_f32_32x32x16_bf16(kf[2],qr[1],C0,0,0,0),   P0[10],P0[11],P0[12],P0[13], pw1[0]=PKW(P0,8), pw1[1]=PKW(P0,10), pw1); \
    VRD(5); SBAR(); GAPA(C1=__builtin_amdgcn_mfma_f32_32x32x16_bf16(kf[3],qr[1],C1,0,0,0),   P0[14],P0[15],P1[0],P1[1],   pw1[2]=PKW(P0,12),pw1[3]=PKW(P0,14), pw1); \
    VRD(2); SBAR(); GAPA(C0=__builtin_amdgcn_mfma_f32_32x32x16_bf16(kf[4],qr[2],C0,0,0,0),   P1[2],P1[3],P1[4],P1[5],     pw2[0]=PKW(P1,0), pw2[1]=PKW(P1,2), pw2); \
    VRD(6); SBAR(); GAPA(C1=__builtin_amdgcn_mfma_f32_32x32x16_bf16(kf[5],qr[2],C1,0,0,0),   P1[6],P1[7],P1[8],P1[9],     pw2[2]=PKW(P1,4), pw2[3]=PKW(P1,6), pw2); \
    VRD(3); SBAR(); GAPA(C0=__builtin_amdgcn_mfma_f32_32x32x16_bf16(kf[6],qr[3],C0,0,0,0),   P1[10],P1[11],P1[12],P1[13], pw3[0]=PKW(P1,8), pw3[1]=PKW(P1,10), pw3); \
    VRD(7); SBAR(); GAPA(C1=__builtin_amdgcn_mfma_f32_32x32x16_bf16(kf[7],qr[3],C1,0,0,0),   P1[14],P1[15],0.f,0.f,       pw3[2]=PKW(P1,12),pw3[3]=PKW(P1,14), pw3); \
    l_reg+=sacc; \
    if(GK){DMA_K((t)+3,sl_cur);} if(GV){DMA_V((t)+1,sl_next);} \
    CMASK(C0,C1,t); \
    { float a=MX3(C0[0],C0[1],C1[0]),b=MX3(C0[2],C0[3],C1[1]); a=MX3(a,C1[2],C1[3]); \
      _Pragma("unroll") for(int r=4;r<16;r+=4){a=MX3(a,C0[r],C0[r+1]);b=MX3(b,C0[r+2],C0[r+3]);a=MX3(a,C1[r],C1[r+1]);b=MX3(b,C1[r+2],C1[r+3]);} \
      float rm=__builtin_fmaxf(a,b); { auto rr=__builtin_amdgcn_permlane32_swap(__float_as_uint(rm),__float_as_uint(rm),false,false); rm=__builtin_fmaxf(__uint_as_float(rr[0]),__uint_as_float(rr[1])); } \
      resc=false; \
      if(__builtin_expect(__any(rm>(float)THRL),0)){ const float dl=__builtin_fmaxf(rm,0.f); mhat+=dl; \
        _Pragma("unroll") for(int r=0;r<16;++r){C0[r]-=dl;C1[r]-=dl;} \
        _Pragma("unroll") for(int r=0;r<16;++r)negm[r]=-mhat; asm volatile("":"+v"(negm)); \
        const float f=__builtin_amdgcn_exp2f(-dl); l_reg*=f; if(hi==0)wsf[r32]=f; resc=true; } } \
    SBAR(); \
    GAPB(o[0]=__builtin_amdgcn_mfma_f32_32x32x16_bf16(PAF(0),VFR(0),o[0],0,0,0), C0,0); \
    GAPB(o[1]=__builtin_amdgcn_mfma_f32_32x32x16_bf16(PAF(0),VFR(4),o[1],0,0,0), C0,4); \
    KRD(GL,0); GAPB(o[0]=__builtin_amdgcn_mfma_f32_32x32x16_bf16(PAF(1),VFR(1),o[0],0,0,0), C0,8); \
    KRD(GL,1); GAPB(o[1]=__builtin_amdgcn_mfma_f32_32x32x16_bf16(PAF(1),VFR(5),o[1],0,0,0), C0,12); \
    KRD(GL,2); GAPB(o[0]=__builtin_amdgcn_mfma_f32_32x32x16_bf16(PAF(2),VFR(2),o[0],0,0,0), C1,0); \
    KRD(GL,3); GAPB(o[1]=__builtin_amdgcn_mfma_f32_32x32x16_bf16(PAF(2),VFR(6),o[1],0,0,0), C1,4); \
    GAPB(o[0]=__builtin_amdgcn_mfma_f32_32x32x16_bf16(PAF(3),VFR(3),o[0],0,0,0), C1,8); \
    GAPB(o[1]=__builtin_amdgcn_mfma_f32_32x32x16_bf16(PAF(3),VFR(7),o[1],0,0,0), C1,12); \
    }while(0)
  int t=1;
  #undef CMASK
  #define CMASK(P0,P1,t) do{}while(0)
  for(;t+5<NT;t+=2){
    STEP(pB0,pB1,pA0,pA1,t,true,true,true);     WAIT_BAR(2); RESC(); ROT();
    STEP(pA0,pA1,pB0,pB1,t+1,true,true,true);   WAIT_BAR(2); RESC(); ROT();
  }
  #undef CMASK
  #define CMASK(P0,P1,t) do{}while(0)
  #define ENDW(tt) do{ if((tt)+3<NT){WAIT_BAR(2);} else if((tt)+2<NT){WAIT_BAR(1);} else {WAIT_BAR(0);} }while(0)
  for(;t+1<NT;t+=2){
    STEP(pB0,pB1,pA0,pA1,t,(t+3<NT),(t+1<NT),(t+1<NT));       ENDW(t);   RESC(); ROT();
    STEP(pA0,pA1,pB0,pB1,t+1,(t+4<NT),(t+2<NT),(t+2<NT));     ENDW(t+1); RESC(); ROT();
  }
  STEP(pB0,pB1,pA0,pA1,NT-1,false,false,false); RESC();
  { float sacc=pB0[0]+pB0[1]; _Pragma("unroll") for(int r=2;r<16;++r)sacc+=pB0[r]; _Pragma("unroll") for(int r=0;r<16;++r)sacc+=pB1[r]; l_reg+=sacc;
    pw0=(u32x4){PKW(pB0,0),PKW(pB0,2),PKW(pB0,4),PKW(pB0,6)};pw1=(u32x4){PKW(pB0,8),PKW(pB0,10),PKW(pB0,12),PKW(pB0,14)};pw2=(u32x4){PKW(pB1,0),PKW(pB1,2),PKW(pB1,4),PKW(pB1,6)};pw3=(u32x4){PKW(pB1,8),PKW(pB1,10),PKW(pB1,12),PKW(pB1,14)};
    SBAR(); pv(o,vb0+sl_cur,PAF(0),PAF(1),PAF(2),PAF(3)); }
  #undef PKW
  #undef PAF
  #undef VFR
  #undef PIN
  #undef MX3
  #undef GAPA
  #undef GAPB
  #undef EX
  #undef VRD
  #undef KRD
  #undef STEP
  #undef ENDW
  {auto rr=__builtin_amdgcn_permlane32_swap(__float_as_uint(l_reg),__float_as_uint(l_reg),false,false);l_reg=__uint_as_float(rr[0])+__uint_as_float(rr[1]);}
  if(hi==0)wsf[32+r32]=l_reg;asm volatile("s_waitcnt lgkmcnt(0)":::"memory");
  float rli[16];
  #pragma unroll
  for(int r=0;r<16;++r)rli[r]=__builtin_amdgcn_rcpf(wsf[32+crow(r,hi)]);
  bf16*Ow=O+qrow0*QP+h*D;
  { bf16*stg=(bf16*)(shm+LDS_OST)+wid*2048;
    #pragma unroll
    for(int r=0;r<16;++r){const int orow=crow(r,hi);
      #pragma unroll
      for(int d0=0;d0<2;++d0)stg[orow*64+d0*32+r32]=__float2bfloat16(o[d0][r]*rli[r]);}
    asm volatile("s_waitcnt lgkmcnt(0)":::"memory");
    #pragma unroll
    for(int i=0;i<4;++i){const int row=i*8+(lane>>3),ch=lane&7; const u32x4 v=*(const u32x4*)(stg+row*64+ch*8); ATTN_STORE16(Ow+(long)row*QP+ch*8,v);} }
  asm volatile("s_waitcnt lgkmcnt(0)\n\ts_barrier":::"memory");
  #undef DMA_K
  #undef DMA_V
  #undef CMASK
  #undef START
  #undef RESC
  #undef ROT
}
constexpr int ATTN_LDS_BYTES=LDS_BYTES;
struct AttnTensors { const bf16* Q; const bf16* K; const bf16* V; bf16* O; };
struct AttnUnit { int b; int h; int qb; };
struct StaticOrder {
  int vcu;
  __device__ __forceinline__ explicit StaticOrder(int v):vcu(v){}
  __device__ __forceinline__ bool next(int i,AttnUnit&u)const{ if(i>=8)return false; const int xcd=vcu>>5,lc=vcu&31; const int grp=xcd*4+(i>>1); const int idx=(i&1)*32+lc;
    u.b=grp>>1; u.h=(grp&1)*4+(idx>>4); u.qb=idx&15; return true; }
};
template<class Sched,int THRL=8> __device__ __forceinline__ void attn_phase(char*lds,const AttnTensors&T,const Sched&S){
  AttnUnit u;
  for(int i=0;S.next(i,u);++i){ attn_unit<THRL>(u.b,u.h,u.qb,T.Q,T.K,T.V,T.O,lds); }
}
#undef SBAR
#undef WAIT_BAR
}
#define XB_TMO      128
#define XB_XCNT(j)  (256  + 64 * (j))
#define XB_XSUB(j)  (1280 + 64 * (j))
#define XB_XGEN(j)  (2304 + 64 * (j))
#define XB_TOP      3328
#define XB_TOPGEN   3392
#define XCD_BAR_WORDS 3456
#define XB_SPIN_CAP (1u << 18)

__device__ __forceinline__ unsigned xb_ld(unsigned* p)              { return __hip_atomic_load(p, __ATOMIC_RELAXED, __HIP_MEMORY_SCOPE_AGENT); }
__device__ __forceinline__ unsigned xb_add(unsigned* p, unsigned v) { return __hip_atomic_fetch_add(p, v, __ATOMIC_RELAXED, __HIP_MEMORY_SCOPE_AGENT); }
__device__ __forceinline__ unsigned xb_xcc_id() { return (unsigned)__builtin_amdgcn_s_getreg((3 << 11) | 20) & 0xFu; }
#define XB_SPIN(cond, bar) do { unsigned _sp = 0; while (cond) { __builtin_amdgcn_s_sleep(1); \
    if ((++_sp & 255u) == 0u) { if (xb_ld(&(bar)[XB_TMO])) break; if (_sp > XB_SPIN_CAP) { atomicAdd(&(bar)[XB_TMO], 1u); break; } } } } while (0)

struct XcdBarrier {
    unsigned* bar; unsigned x;
    volatile LAS unsigned* st;
};

__device__ __forceinline__ XcdBarrier xcd_barrier_post(unsigned* bar, volatile LAS unsigned* st) {
    XcdBarrier b; b.bar = bar; b.x = xb_xcc_id(); b.st = st;
    if (threadIdx.x == 0) (void)xb_add(&bar[XB_XCNT(b.x)], 1u);
    return b;
}
__device__ __forceinline__ void xcd_barrier_complete(unsigned* bar, unsigned x, unsigned& nloc, unsigned& nx) {
    const unsigned G = gridDim.x * gridDim.y * gridDim.z;
    unsigned sum, cnt, mine, sp = 0u;
    for (;;) {
        sum = 0u; cnt = 0u; mine = 0u;
#pragma unroll
        for (unsigned j = 0; j < 16; ++j) { const unsigned c = xb_ld(&bar[XB_XCNT(j)]); sum += c; cnt += (c > 0u) ? 1u : 0u; mine = (j == x) ? c : mine; }
        if (sum == G) break;
        __builtin_amdgcn_s_sleep(1);
        if ((++sp & 255u) == 0u) { if (xb_ld(&bar[XB_TMO])) break; if (sp > XB_SPIN_CAP) { atomicAdd(&bar[XB_TMO], 1u); break; } }
    }
    nloc = mine > 0u ? mine : 1u; nx = cnt > 0u ? cnt : 1u;
}

__device__ __forceinline__ void xcd_barrier(const XcdBarrier& b) {
    asm volatile("s_waitcnt vmcnt(0)" ::: "memory");
    __syncthreads();
    if (threadIdx.x == 0) {
        unsigned* bar = b.bar;
        __builtin_amdgcn_s_waitcnt(0);
        unsigned nloc = b.st[0], nx = b.st[1];
        if (nloc == 0u) { xcd_barrier_complete(bar, b.x, nloc, nx); b.st[0] = nloc; b.st[1] = nx; }
        const unsigned old = xb_add(&bar[XB_XSUB(b.x)], 1u);
        const unsigned gen = old / nloc;
        if (old + 1u == (gen + 1u) * nloc) {
            __builtin_amdgcn_fence(__ATOMIC_RELEASE, "agent");
            asm volatile("s_waitcnt vmcnt(0)" ::: "memory");
            const unsigned og = xb_add(&bar[XB_TOP], 1u);
            const unsigned tg = og / nx;
            if (og + 1u == (tg + 1u) * nx) xb_add(&bar[XB_TOPGEN], 1u);
            else XB_SPIN(xb_ld(&bar[XB_TOPGEN]) == tg, bar);
            __builtin_amdgcn_fence(__ATOMIC_ACQUIRE, "agent");
            xb_add(&bar[XB_XGEN(b.x)], 1u);
            asm volatile("s_waitcnt vmcnt(0)" ::: "memory");
        } else {
            XB_SPIN(xb_ld(&bar[XB_XGEN(b.x)]) == gen, bar);
            __builtin_amdgcn_fence(__ATOMIC_ACQUIRE, "agent");
            asm volatile("s_waitcnt vmcnt(0)" ::: "memory");
        }
    }
    __syncthreads();
}


typedef GAS unsigned gu32;
#define RLX_AGENT __ATOMIC_RELAXED, __HIP_MEMORY_SCOPE_AGENT
#define LDS_WAIT() asm volatile("s_waitcnt lgkmcnt(0)" ::: "memory")
#define VM_WAIT() asm volatile("s_waitcnt vmcnt(0)" ::: "memory")
constexpr int N_IN = 34;
enum { I_X = 0, I_C, I_CTX, I_CCTX, I_MODW, I_MODB, I_NORM1, I_WIN, I_QNW, I_KNW, I_CONVW, I_CONVB, I_FW1, I_FB1, I_FW2, I_FB2, I_FW3, I_FB3, I_FW4, I_FFREQ,
       I_HBIAS, I_AONW, I_HONW, I_WOUT, I_NORM2, I_RW, I_RB, I_EG, I_EU, I_ED, I_SG, I_SU, I_SD, I_FNW };
struct Frame {
    LAS unsigned char* lds;
    volatile LAS unsigned* MISC;
    unsigned* ctl;
    int tid, lane, wave, vcu, G;
    float* out; unsigned char* ws;
};
typedef const __attribute__((address_space(4))) char* kargp_t;
__device__ __forceinline__ const float* kin(int i) { kargp_t p = (kargp_t)__builtin_amdgcn_kernarg_segment_ptr(); asm volatile("" : "+s"(p)); return *(const float* const __attribute__((address_space(4)))*)(p + 8 * i); }
#define WSP(T, off) ((T*)(F.ws + (off)))

__device__ __forceinline__ void tr_item(const float* W, int ldw, int k0, int n0, bf16_t* WT, int Kd, int drow0, LAS float* scr, int lane) {
#pragma unroll 8
    for (int i = 0; i < 32; ++i) { const int kk = 2 * i + (lane >> 5); scr[kk * 33 + (lane & 31)] = W[(size_t)(k0 + kk) * ldw + n0 + (lane & 31)]; }
    LDS_WAIT(); asm volatile("" ::: "memory");
    const int c = lane & 7;
#pragma unroll
    for (int j = 0; j < 4; ++j) { const int n = (lane >> 3) + 8 * j; const LAS float* s = scr + (8 * c) * 33 + n;
        u32x4 o; o.x = pk2(s[0 * 33], s[1 * 33]); o.y = pk2(s[2 * 33], s[3 * 33]); o.z = pk2(s[4 * 33], s[5 * 33]); o.w = pk2(s[6 * 33], s[7 * 33]);
        *(u32x4*)(WT + (size_t)(drow0 + n) * Kd + k0 + 8 * c) = o; }
    LDS_WAIT(); asm volatile("" ::: "memory");
}
constexpr int IT_FILT = 1024, IT_MODV = 0, IT_ROPE = 1, IT_QKV = 384, IT_WU = 768, IT_WO = 512, IT_WR = 128, IT_SGU = 256, IT_SD = 128, IT_EXP = 256 * 384;
constexpr int IT_TOTAL = IT_FILT + IT_MODV + IT_ROPE + IT_QKV + IT_WU + IT_WO + IT_WR + IT_SGU + IT_SD + IT_EXP;

__device__ __forceinline__ void p0_filter_item(Frame& F, int item) {
    const int lane = F.lane; const int t0 = 4 * item;
    const float* w1 = kin(I_FW1); const float* b1 = kin(I_FB1); const float* w2 = kin(I_FW2); const float* b2 = kin(I_FB2);
    const float* w3 = kin(I_FW3); const float* b3 = kin(I_FB3); const float* w4 = kin(I_FW4); const float fr = kin(I_FFREQ)[lane];
    float z[4], h[4], a[4];
#pragma unroll
    for (int tt = 0; tt < 4; ++tt) { const int t = t0 + tt; float v = 0.f;
        if (lane == 0) v = (float)t * (1.0f / 4095.0f);
        else if (lane < 33) { const int m = (lane - 1) & 15; const float f = 1e-4f + (float)m * ((15.0f - 1e-4f) / 15.0f);
            float rev = f * ((float)t * (1.0f / 4096.0f)); rev -= floorf(rev); const float ang = 6.283185307179586f * rev;
            v = lane <= 16 ? cosf(ang) : -sinf(ang); }
        z[tt] = v; }
    { const float bb = b1[lane];
#pragma unroll
      for (int tt = 0; tt < 4; ++tt) a[tt] = bb;
      for (int i = 0; i < 33; ++i) { const float w = w1[i * 64 + lane];
#pragma unroll
          for (int tt = 0; tt < 4; ++tt) a[tt] += __shfl(z[tt], i) * w; }
#pragma unroll
      for (int tt = 0; tt < 4; ++tt) h[tt] = sinf(fr * a[tt]); }
#pragma unroll
    for (int l = 0; l < 2; ++l) { const float* ww = l == 0 ? w2 : w3; const float bb = (l == 0 ? b2 : b3)[lane];
#pragma unroll
      for (int tt = 0; tt < 4; ++tt) a[tt] = bb;
      for (int i = 0; i < 64; ++i) { const float w = ww[i * 64 + lane];
#pragma unroll
          for (int tt = 0; tt < 4; ++tt) a[tt] += __shfl(h[tt], i) * w; }
#pragma unroll
      for (int tt = 0; tt < 4; ++tt) h[tt] = sinf(fr * a[tt]); }
    bf16_t* KR = WSP(bf16_t, WS_KR);
    const float dmin = logf(1e-2f) / 0.3f, dmax = logf(1e-2f) / 1.5f;
#pragma unroll 1
    for (int qh = 0; qh < 4; ++qh) {
        float o[4][4];
#pragma unroll
        for (int tt = 0; tt < 4; ++tt)
#pragma unroll
            for (int q = 0; q < 4; ++q) o[tt][q] = 0.f;
        for (int i = 0; i < 64; ++i) { float hv[4];
#pragma unroll
            for (int tt = 0; tt < 4; ++tt) hv[tt] = __shfl(h[tt], i);
#pragma unroll
            for (int q = 0; q < 4; ++q) { const float w = w4[i * 1024 + lane + 64 * (4 * qh + q)];
#pragma unroll
                for (int tt = 0; tt < 4; ++tt) o[tt][q] += hv[tt] * w; } }
#pragma unroll
        for (int q = 0; q < 4; ++q) { const int n = lane + 64 * (4 * qh + q); const int c = n & 511; const bool bwd = n >= 512;
            const float delta = fabsf(dmin + (float)c * ((dmax - dmin) / 511.0f));
#pragma unroll
            for (int tt = 0; tt < 4; ++tt) { const int t = t0 + tt; const float tl = (float)t * (1.0f / 4095.0f);
                const float val = o[tt][q] * expf(-tl * delta);
                if (!(bwd && t == 0)) KR[(size_t)c * 8192 + (bwd ? 4096 + t : 4096 - t)] = (bf16_t)f2bf(val); } }
    }
}
__device__ __forceinline__ void p0_modv_block(Frame& F, int chunk) {
    const int lane = F.lane, kc = F.wave; const int n0 = 64 * chunk, k0 = 128 * kc;
    LAS float* sv = (LAS float*)(F.lds + RING_OFF + F.wave * 8704);
    LAS float* part = (LAS float*)(F.lds + RING_OFF + 8 * 8704);
    for (int r = 0; r < 17; ++r)
#pragma unroll
        for (int hh = 0; hh < 2; ++hh) { const int kk = lane + 64 * hh; const float v = r < 16 ? kin(I_C)[r * 1024 + k0 + kk] : kin(I_CCTX)[k0 + kk];
            sv[r * 128 + kk] = v / (1.0f + expf(-v)); }
    LDS_WAIT(); asm volatile("" ::: "memory");
    float acc[17];
#pragma unroll
    for (int r = 0; r < 17; ++r) acc[r] = 0.f;
    const float* W = kin(I_MODW) + (size_t)k0 * 6144 + n0 + lane;
    for (int k4 = 0; k4 < 32; ++k4) {
        const float w0 = W[(size_t)(4 * k4 + 0) * 6144], w1 = W[(size_t)(4 * k4 + 1) * 6144], w2 = W[(size_t)(4 * k4 + 2) * 6144], w3 = W[(size_t)(4 * k4 + 3) * 6144];
#pragma unroll
        for (int r = 0; r < 17; ++r) { const f32x4 s = *(const LAS f32x4*)(sv + r * 128 + 4 * k4); acc[r] += (s[0] * w0 + s[1] * w1) + (s[2] * w2 + s[3] * w3); }
    }
#pragma unroll
    for (int r = 0; r < 17; ++r) part[(kc * 17 + r) * 64 + lane] = acc[r];
    __syncthreads();
    if (F.wave == 0) { float* mv = WSP(float, WS_MODV); const float bb = kin(I_MODB)[n0 + lane];
#pragma unroll
        for (int r = 0; r < 17; ++r) { float s = bb;
#pragma unroll
            for (int k = 0; k < 8; ++k) s += part[(k * 17 + r) * 64 + lane];
            mv[r * 6144 + n0 + lane] = s; } }
    __syncthreads();
}
__device__ __forceinline__ void p0_prologue(Frame& F) {
    LAS float* scr = (LAS float*)(F.lds + RING_OFF + F.wave * 16384);
    const int gw = F.vcu * NWAVES + F.wave, NGW = F.G * NWAVES; const int lane = F.lane;
    for (int ch = F.vcu; ch < 96; ch += F.G) p0_modv_block(F, ch);
    for (int it = gw; it < IT_TOTAL; it += NGW) {
        int r = it;
        if (r < IT_FILT) { p0_filter_item(F, r); continue; } r -= IT_FILT;
        if (r < IT_ROPE) { f32x2* rope = WSP(f32x2, WS_ROPE);
            for (int idx = lane; idx < 1024; idx += 64) { const int pos = idx >> 4, f = idx & 15; const float inv = powf(10000.0f, -(float)f / 16.0f); const float ang = (float)pos * inv;
                rope[idx] = (f32x2){cosf(ang), sinf(ang)}; }
            continue; } r -= IT_ROPE;
        if (r < IT_QKV) { const int cb = r >> 4, kb = r & 15, n0 = 32 * cb; const int pn = n0 >> 8, hl = (n0 & 255) >> 6, dh = (n0 & 63) >> 5;
            tr_item(kin(I_WIN), 2304, 64 * kb, n0, WSP(bf16_t, WS_WQKV), 1024, 256 * pn + 128 * dh + 32 * hl, scr, lane); continue; } r -= IT_QKV;
        if (r < IT_WU) { const int cb = r >> 4, kb = r & 15; tr_item(kin(I_WIN), 2304, 64 * kb, 768 + 32 * cb, WSP(bf16_t, WS_WU), 1024, 32 * cb, scr, lane); continue; } r -= IT_WU;
        if (r < IT_WO) { const int cb = r >> 4, kb = r & 15; tr_item(kin(I_WOUT), 1024, 64 * kb, 32 * cb, WSP(bf16_t, WS_WO), 1024, 32 * cb, scr, lane); continue; } r -= IT_WO;
        if (r < IT_WR) { const int cb = r >> 4, kb = r & 15; tr_item(kin(I_RW), 256, 64 * kb, 32 * cb, WSP(bf16_t, WS_WR), 1024, 32 * cb, scr, lane); continue; } r -= IT_WR;
        if (r < IT_SGU) { const int which = r >> 7, rr = r & 127, cb = rr >> 4, kb = rr & 15, j0 = 32 * cb;
            tr_item(kin(which ? I_SU : I_SG), 256, 64 * kb, j0, WSP(bf16_t, WS_WSGU), 1024, 256 * (j0 >> 7) + 128 * which + (j0 & 127), scr, lane); continue; } r -= IT_SGU;
        if (r < IT_SD) { const int kb = r & 3, cb = r >> 2; tr_item(kin(I_SD), 1024, 64 * kb, 32 * cb, WSP(bf16_t, WS_WSD), 256, 32 * cb, scr, lane); continue; } r -= IT_SD;
        { const int e = r / 384, q = r % 384;
          if (q < 256) { const int which = q >> 7, rr = q & 127, cb = rr >> 4, kb = rr & 15, j0 = 32 * cb;
              tr_item(kin(which ? I_EU : I_EG) + (size_t)e * (1024 * 256), 256, 64 * kb, j0, WSP(bf16_t, WS_WGU) + (size_t)e * (512 * 1024), 1024, 256 * (j0 >> 7) + 128 * which + (j0 & 127), scr, lane); }
          else { const int rr = q - 256, kb = rr & 3, cb = rr >> 2;
              tr_item(kin(I_ED) + (size_t)e * (256 * 1024), 1024, 64 * kb, 32 * cb, WSP(bf16_t, WS_WD) + (size_t)e * (1024 * 256), 256, 32 * cb, scr, lane); } }
    }
}

__device__ __forceinline__ void modulate_rows(Frame& F, const float* src, bf16_t* dst, int row0, int nrows, const float* nw, const float* sc, const float* sh) {
    f32x4 A[4], Bv[4];
#pragma unroll
    for (int j = 0; j < 4; ++j) { const int c = 4 * F.lane + 256 * j; const f32x4 n4 = *(const f32x4*)(nw + c), s4 = *(const f32x4*)(sc + c); A[j] = n4 * (s4 + 1.0f); Bv[j] = *(const f32x4*)(sh + c); }
    for (int r = 0; r < nrows; ++r) {
        const f32x4* xr = (const f32x4*)(src + (size_t)(row0 + r) * DM) + F.lane;
        f32x4 v[4]; float ss = 0.f;
#pragma unroll
        for (int j = 0; j < 4; ++j) { v[j] = xr[64 * j]; ss += (v[j][0] * v[j][0] + v[j][1] * v[j][1]) + (v[j][2] * v[j][2] + v[j][3] * v[j][3]); }
        const float rs = rsqrtf(wave_sum(ss) * (1.0f / DM) + EPS);
        u32x2* o8 = (u32x2*)(dst + (size_t)(row0 + r) * DM) + F.lane;
#pragma unroll
        for (int j = 0; j < 4; ++j) { const f32x4 o = v[j] * rs * A[j] + Bv[j]; u32x2 w; w.x = pk2(o[0], o[1]); w.y = pk2(o[2], o[3]); o8[64 * j] = w; }
    }
}

__device__ __forceinline__ void hyena_unit(Frame& F, int c) {
    const int tid = F.tid, lane = F.lane, wid = F.wave;
    LAS unsigned char* Wl = F.lds + RING_OFF;
    LAS bf16_t* KRl = (LAS bf16_t*)(F.lds + AUX_OFF);
    const bf16_t* UT = WSP(const bf16_t, WS_UT);
    { const u32x4* src = (const u32x4*)(WSP(const bf16_t, WS_KR) + (size_t)c * 8192);
#pragma unroll
      for (int i = 0; i < 2; ++i) ((LAS u32x4*)KRl)[tid + 512 * i] = src[tid + 512 * i]; }
    const float* cw = kin(I_CONVW); const float* cb = kin(I_CONVB);
    {
        const bf16_t* vrow = UT + (size_t)(1024 + c) * MTOK; const bf16_t* x1row = UT + (size_t)(512 + c) * MTOK;
        const float v0 = cw[1024 + c], v1 = cw[1536 + 1024 + c], v2 = cw[3072 + 1024 + c], vb = cb[1024 + c];
        const float a0 = cw[512 + c], a1 = cw[1536 + 512 + c], a2 = cw[3072 + 512 + c], ab = cb[512 + c];
        for (int it = 0; it < 16; ++it) {
            const int g = tid + 512 * it; const int b = g >> 9, sc = g & 511, s0 = sc * 8; const size_t base = (size_t)b * SEQ + s0;
            const u32x4 vv = *(const u32x4*)(vrow + base), xx = *(const u32x4*)(x1row + base);
            float ve[10], xe[10];
            ve[0] = s0 > 0 ? bf2f(vrow[base - 1]) : 0.f; xe[0] = s0 > 0 ? bf2f(x1row[base - 1]) : 0.f;
            ve[9] = s0 + 8 < SEQ ? bf2f(vrow[base + 8]) : 0.f; xe[9] = s0 + 8 < SEQ ? bf2f(x1row[base + 8]) : 0.f;
#pragma unroll
            for (int j = 0; j < 4; ++j) { ve[1 + 2 * j] = bf2f(vv[j] & 0xffffu); ve[2 + 2 * j] = bf2f(vv[j] >> 16); xe[1 + 2 * j] = bf2f(xx[j] & 0xffffu); xe[2 + 2 * j] = bf2f(xx[j] >> 16); }
            float w[8];
#pragma unroll
            for (int j = 0; j < 8; ++j) w[j] = (v0 * ve[j] + v1 * ve[j + 1] + v2 * ve[j + 2] + vb) * (a0 * xe[j] + a1 * xe[j + 1] + a2 * xe[j + 2] + ab);
            u32x4 o; o.x = pk2(w[0], w[1]); o.y = pk2(w[2], w[3]); o.z = pk2(w[4], w[5]); o.w = pk2(w[6], w[7]);
            *(LAS u32x4*)(Wl + (size_t)(sc * 16 + b) * 16) = o;
        }
    }
    __syncthreads();
    const float x0w0 = cw[c], x0w1 = cw[1536 + c], x0w2 = cw[3072 + c], x0b = cb[c], hb = kin(I_HBIAS)[c];
    const bf16_t* x0row = UT + (size_t)c * MTOK; bf16_t* yrow = WSP(bf16_t, WS_YT) + (size_t)c * MTOK;
    const int li = lane & 15, lg = lane >> 4;
#pragma unroll 1
    for (int pass = 0; pass < 2; ++pass) {
        const int T0 = (pass * 8 + wid) * 256;
        f32x4 acc[16]; bf16x8 AF[16];
#pragma unroll
        for (int q = 0; q < 16; ++q) acc[q] = (f32x4){0.f, 0.f, 0.f, 0.f};
        const LAS bf16_t* kb = KRl + (4096 - T0 - li + 8 * lg);
#define HY_LOADA(dst, q) do { const LAS bf16_t* p_ = kb - 16 * (q); bf16x8 r_; _Pragma("unroll") for (int j_ = 0; j_ < 8; ++j_) r_[j_] = (short)p_[j_]; dst = r_; } while (0)
#pragma unroll
        for (int q = 0; q < 16; ++q) HY_LOADA(AF[q], q);
#pragma unroll 1
        for (int S8 = 0; S8 < 128; S8 += 8) {
#pragma unroll
            for (int v = 0; v < 8; ++v) { const int S = S8 + v;
                const bf16x8 Bf = *(const LAS bf16x8*)(Wl + (size_t)((S * 4 + lg) * 16 + li) * 16);
#pragma unroll
                for (int tau = 15; tau >= 0; --tau) acc[tau] = __builtin_amdgcn_mfma_f32_16x16x32_bf16(AF[(tau - 2 * v) & 15], Bf, acc[tau], 0, 0, 0);
                if (S + 1 < 128) { HY_LOADA(AF[(-2 * (v + 1)) & 15], -2 * (S + 1)); HY_LOADA(AF[(-2 * (v + 1) + 1) & 15], -2 * (S + 1) + 1); }
            }
        }
#undef HY_LOADA
#pragma unroll
        for (int tau = 0; tau < 16; ++tau) { const int t = T0 + 16 * tau + 4 * lg; const size_t base = (size_t)li * SEQ + t;
            const u32x2 wv = *(const LAS u32x2*)(Wl + (size_t)((t >> 3) * 16 + li) * 16 + (t & 7) * 2);
            const u32x2 xv = *(const u32x2*)(x0row + base);
            float xe[6]; xe[0] = t > 0 ? bf2f(x0row[base - 1]) : 0.f; xe[5] = t + 4 < SEQ ? bf2f(x0row[base + 4]) : 0.f;
            xe[1] = bf2f(xv.x & 0xffffu); xe[2] = bf2f(xv.x >> 16); xe[3] = bf2f(xv.y & 0xffffu); xe[4] = bf2f(xv.y >> 16);
            const float we[4] = {bf2f(wv.x & 0xffffu), bf2f(wv.x >> 16), bf2f(wv.y & 0xffffu), bf2f(wv.y >> 16)};
            float z[4];
#pragma unroll
            for (int j = 0; j < 4; ++j) z[j] = (acc[tau][j] + hb * we[j]) * (x0w0 * xe[j] + x0w1 * xe[j + 1] + x0w2 * xe[j + 2] + x0b);
            u32x2 o; o.x = pk2(z[0], z[1]); o.y = pk2(z[2], z[3]); *(u32x2*)(yrow + base) = o; }
    }
    __syncthreads();
}

__device__ __forceinline__ void p4_norm_tile(Frame& F, int it) {
    const int lane = F.lane, wid = F.wave, tid = F.tid; const int m0 = it * 64;
    bf16_t* AY = WSP(bf16_t, WS_AY); const bf16_t* A = WSP(const bf16_t, WS_Q); const bf16_t* YT = WSP(const bf16_t, WS_YT);
    constexpr int TP = 520;
    LAS bf16_t* T2 = (LAS bf16_t*)(F.lds + RING_OFF);
    {
        const u32x4* src = (const u32x4*)(YT + (size_t)tid * MTOK + m0);
#pragma unroll
        for (int i = 0; i < 8; ++i) { const u32x4 v = src[i];
#pragma unroll
            for (int j = 0; j < 4; ++j) { T2[(8 * i + 2 * j) * TP + tid] = (bf16_t)(v[j] & 0xffffu); T2[(8 * i + 2 * j + 1) * TP + tid] = (bf16_t)(v[j] >> 16); } }
    }
    { const float* gw = kin(I_AONW) + 8 * lane; const f32x4 g0 = *(const f32x4*)gw, g1 = *(const f32x4*)(gw + 4);
      for (int r = 0; r < 8; ++r) { const int row = m0 + wid * 8 + r; const u32x4 v = *(const u32x4*)(A + (size_t)row * AW + 8 * lane);
          float e[8]; float ss = 0.f;
#pragma unroll
          for (int j = 0; j < 4; ++j) { e[2 * j] = bf2f(v[j] & 0xffffu); e[2 * j + 1] = bf2f(v[j] >> 16); ss += e[2 * j] * e[2 * j] + e[2 * j + 1] * e[2 * j + 1]; }
          const float rs = rsqrtf(wave_sum(ss) * (1.0f / 512.0f) + EPS);
          u32x4 o; o.x = pk2(e[0] * rs * g0[0], e[1] * rs * g0[1]); o.y = pk2(e[2] * rs * g0[2], e[3] * rs * g0[3]); o.z = pk2(e[4] * rs * g1[0], e[5] * rs * g1[1]); o.w = pk2(e[6] * rs * g1[2], e[7] * rs * g1[3]);
          *(u32x4*)(AY + (size_t)row * DM + 8 * lane) = o; } }
    __syncthreads();
    { const float* gw = kin(I_HONW) + 8 * lane; const f32x4 g0 = *(const f32x4*)gw, g1 = *(const f32x4*)(gw + 4);
      for (int r = 0; r < 8; ++r) { const int tl = wid * 8 + r; const u32x4 v = *(const LAS u32x4*)(T2 + tl * TP + 8 * lane);
          float e[8]; float ss = 0.f;
#pragma unroll
          for (int j = 0; j < 4; ++j) { e[2 * j] = bf2f(v[j] & 0xffffu); e[2 * j + 1] = bf2f(v[j] >> 16); ss += e[2 * j] * e[2 * j] + e[2 * j + 1] * e[2 * j + 1]; }
          const float rs = rsqrtf(wave_sum(ss) * (1.0f / 512.0f) + EPS);
          u32x4 o; o.x = pk2(e[0] * rs * g0[0], e[1] * rs * g0[1]); o.y = pk2(e[2] * rs * g0[2], e[3] * rs * g0[3]); o.z = pk2(e[4] * rs * g1[0], e[5] * rs * g1[1]); o.w = pk2(e[6] * rs * g1[2], e[7] * rs * g1[3]);
          *(u32x4*)(AY + (size_t)(m0 + tl) * DM + 512 + 8 * lane) = o; } }
    __syncthreads();
}

__device__ __forceinline__ void p8_route_token(Frame& F, int t) {
    const int lane = F.lane;
    const f32x4 lg = *(const f32x4*)(WSP(const float, WS_LOGIT) + (size_t)t * NE + 4 * lane);
    const f32x4 rb = *(const f32x4*)(kin(I_RB) + 4 * lane);
    float s[4], val[4];
#pragma unroll
    for (int j = 0; j < 4; ++j) { s[j] = 1.0f / (1.0f + expf(-lg[j])); val[j] = s[j] + rb[j]; }
    float a1 = fmaxf(val[0], val[1]), a2 = fminf(val[0], val[1]);
#pragma unroll
    for (int j = 2; j < 4; ++j) { const float x = val[j]; a2 = fmaxf(a2, fminf(a1, x)); a1 = fmaxf(a1, x); }
#pragma unroll
    for (int off = 1; off < 8; off <<= 1) { const float b1 = __shfl_xor(a1, off), b2 = __shfl_xor(a2, off); const float n1 = fmaxf(a1, b1), n2 = fmaxf(fminf(a1, b1), fmaxf(a2, b2)); a1 = n1; a2 = n2; }
    const float gs = a1 + a2; const int mg = lane >> 3; int rank = 0;
#pragma unroll
    for (int j = 0; j < 8; ++j) { const float gj = __shfl(gs, 8 * j); rank += (gj > gs || (gj == gs && j < mg)) ? 1 : 0; }
    if (rank >= 4) {
#pragma unroll
        for (int j = 0; j < 4; ++j) val[j] = -INFINITY; }
    int se[8]; float sw[8]; float wsum = 0.f;
#pragma unroll
    for (int k = 0; k < 8; ++k) {
        float bv = val[0]; int bi = 4 * lane;
#pragma unroll
        for (int j = 1; j < 4; ++j) if (val[j] > bv) { bv = val[j]; bi = 4 * lane + j; }
#pragma unroll
        for (int off = 1; off < 64; off <<= 1) { const float ov = __shfl_xor(bv, off); const int oi = __shfl_xor(bi, off); if (ov > bv || (ov == bv && oi < bi)) { bv = ov; bi = oi; } }
        const int jj = bi & 3; const float mine = jj == 0 ? s[0] : jj == 1 ? s[1] : jj == 2 ? s[2] : s[3];
        const float sk = __shfl(mine, bi >> 2);
        if (lane == (bi >> 2)) {
#pragma unroll
            for (int j = 0; j < 4; ++j) if (j == jj) val[j] = -INFINITY; }
        se[k] = bi; sw[k] = sk; wsum += sk;
    }
    int e = se[0]; float w = sw[0];
#pragma unroll
    for (int k = 1; k < 8; ++k) if (lane == k) { e = se[k]; w = sw[k]; }
    unsigned* list = WSP(unsigned, WS_LIST);
    if (lane < 8) {
        w = w / wsum * 2.5f;
        const unsigned rk = __hip_atomic_fetch_add(F.ctl + CW_CNT + 32 * e, 1u, RLX_AGENT);
        list[(size_t)e * 65536 + rk] = ((unsigned)t << 16) | f2bf(w);
        WSP(unsigned, WS_ASSIGN)[(size_t)t * 8 + lane] = ((unsigned)e << 16) | rk;
    } else if (lane == 8) list[(size_t)256 * 65536 + t] = ((unsigned)t << 16) | 0x3F80u;
}

__device__ __forceinline__ MoeTab moe_tables(Frame& F) {
    LAS int* tp = (LAS int*)(F.lds + AUX_OFF + AUX_TP); LAS int* cnt = (LAS int*)(F.lds + AUX_OFF + AUX_CNT);
    __syncthreads();
    if (F.tid < 257) cnt[F.tid] = F.tid < 256 ? (int)__hip_atomic_load(F.ctl + CW_CNT + 32 * F.tid, RLX_AGENT) : MTOK;
    __syncthreads();
    if (F.tid < 258) { int run = 0; for (int j = 0; j < F.tid && j < 257; ++j) run += (cnt[j] + 255) >> 8; tp[F.tid] = run; }
    __syncthreads();
    MoeTab t; t.tp = tp; t.cnt = cnt; return t;
}

template <int HP> __device__ __forceinline__ void combine_token(Frame& F, const MoeTab& tab, int t) {
    const int lane = F.lane; const int b = t >> 12;
    const unsigned* asg = WSP(const unsigned, WS_ASSIGN) + (size_t)t * 8; const bf16_t* SLOT = WSP(const bf16_t, WS_SLOT);
    float a[8];
#pragma unroll
    for (int j = 0; j < 8; ++j) a[j] = 0.f;
#pragma unroll
    for (int k = 0; k < 8; ++k) { const unsigned av = asg[k]; const int e = av >> 16, rk = av & 0xffffu; const size_t R = (size_t)tab.tp[e] * 256 + rk;
        const u32x4 v = *(const u32x4*)(SLOT + R * 512 + 8 * lane);
#pragma unroll
        for (int j = 0; j < 4; ++j) { a[2 * j] += bf2f(v[j] & 0xffffu); a[2 * j + 1] += bf2f(v[j] >> 16); } }
    float* orow = F.out + (size_t)t * DM + 512 * HP + 8 * lane;
    const float* g2 = WSP(const float, WS_MODV) + (size_t)b * 6144 + 5 * 1024 + 512 * HP + 8 * lane;
    f32x4 x0 = *(const f32x4*)orow, x1 = *(const f32x4*)(orow + 4); const f32x4 g0 = *(const f32x4*)g2, g1 = *(const f32x4*)(g2 + 4);
    x0 = x0 + g0 * (f32x4){a[0], a[1], a[2], a[3]}; x1 = x1 + g1 * (f32x4){a[4], a[5], a[6], a[7]};
    float ss = (x0[0] * x0[0] + x0[1] * x0[1]) + (x0[2] * x0[2] + x0[3] * x0[3]) + (x1[0] * x1[0] + x1[1] * x1[1]) + (x1[2] * x1[2] + x1[3] * x1[3]);
    ss = wave_sum(ss);
    float* SS = WSP(float, WS_SS);
    if (HP == 0) { *(f32x4*)orow = x0; *(f32x4*)(orow + 4) = x1; if (lane == 0) SS[t] = ss; }
    else {
        const float rs = rsqrtf((ss + SS[t]) * (1.0f / DM) + EPS);
        const float* fw = kin(I_FNW) + 8 * lane;
        *(f32x4*)orow = x0 * rs * *(const f32x4*)(fw + 512); *(f32x4*)(orow + 4) = x1 * rs * *(const f32x4*)(fw + 516);
        float* o0 = F.out + (size_t)t * DM + 8 * lane;
        const f32x4 y0 = *(const f32x4*)o0, y1 = *(const f32x4*)(o0 + 4);
        *(f32x4*)o0 = y0 * rs * *(const f32x4*)fw; *(f32x4*)(o0 + 4) = y1 * rs * *(const f32x4*)(fw + 4);
    }
}

constexpr int N_LAUNCHES = MK_N_LAUNCHES;
static_assert(N_LAUNCHES == 1 || N_LAUNCHES == NPHASE, "MK_N_LAUNCHES must be 1 or 14");
struct Args { const float* in[N_IN]; float* out; unsigned char* ws; int ph_lo, ph_hi; };
__global__ void __launch_bounds__(NWAVES * 64, 2) fwd_kernel(Args args) {
    extern __shared__ __attribute__((aligned(16))) unsigned char lds[];
    Frame F;
    F.lds = (LAS unsigned char*)lds;
    F.MISC = (volatile LAS unsigned*)(F.lds + MISC_OFF);
    F.tid = threadIdx.x; F.lane = F.tid & 63; F.wave = __builtin_amdgcn_readfirstlane(F.tid >> 6);
    F.G = gridDim.x; { const int bx = blockIdx.x; F.vcu = (F.G % 8 == 0) ? (bx % 8) * (F.G / 8) + bx / 8 : bx; }
    F.out = args.out; F.ws = args.ws; F.ctl = (unsigned*)(args.ws + WS_CTL);
    if (F.tid < 128) ((LAS unsigned*)(F.lds + MISC_OFF))[F.tid] = 0u;
    __syncthreads();
    XcdBarrier bar; bar.bar = F.ctl + CW_BAR; bar.x = 0; bar.st = nullptr;
    if (N_LAUNCHES == 1) bar = xcd_barrier_post(F.ctl + CW_BAR, F.MISC + 8);
#define GRID_BAR() do { if (N_LAUNCHES == 1) xcd_barrier(bar); } while (0)
    const int lo = args.ph_lo, hi = args.ph_hi;
#ifndef PHASE_MASK
#define PHASE_MASK 0x3fff
#endif
#define IN(k) ((((PHASE_MASK) >> (k)) & 1) && lo <= (k) && (k) < hi)
#define SEAM(k) do { if (IN(k) && IN((k) + 1)) GRID_BAR(); } while (0)
#define PHASE_ENTER() do { int t_ = threadIdx.x; asm volatile("" : "+v"(t_)); F.tid = t_; F.lane = t_ & 63; unsigned char* w_ = args.ws; float* o_ = args.out; asm volatile("" : "+s"(w_), "+s"(o_)); F.ws = w_; F.out = o_; F.ctl = (unsigned*)(w_ + WS_CTL); } while (0)
    const int gw = F.vcu * NWAVES + F.wave, NGW = F.G * NWAVES;
#define modv WSP(const float, WS_MODV)
    LAS unsigned char* ring = F.lds + RING_OFF;
    LAS unsigned* idxw = (LAS unsigned*)(F.lds + AUX_OFF + AUX_IDX + F.wave * 1024);

    if (IN(0)) { PHASE_ENTER(); p0_prologue(F); }
    SEAM(0);
    if (IN(1)) { PHASE_ENTER();
        for (int rb = gw; rb < MTOK / 32; rb += NGW) { const int row0 = rb * 32; const int b = row0 >> 12;
            modulate_rows(F, kin(I_X), WSP(bf16_t, WS_H), row0, 32, kin(I_NORM1), modv + (size_t)b * 6144 + 1024, modv + (size_t)b * 6144); }
        for (int rb = gw; rb < MCTX / 2; rb += NGW)
            modulate_rows(F, kin(I_CTX), WSP(bf16_t, WS_HC), rb * 2, 2, kin(I_NORM1), modv + (size_t)16 * 6144 + 1024, modv + (size_t)16 * 6144);
    }
    SEAM(1);
    if (IN(2)) { PHASE_ENTER();
        { SchedQKV S{WSP(const bf16_t, WS_H), (long)WS_HC - (long)WS_H, WSP(const bf16_t, WS_WQKV), F.G, F.vcu};
          EpiQKV E{WSP(bf16_t, WS_Q), WSP(bf16_t, WS_K), WSP(bf16_t, WS_V), kin(I_QNW), kin(I_KNW), WSP(const f32x2, WS_ROPE)};
          pg8::gemm_phase<EpiQKV, SchedQKV, false, true>(ring, idxw, DM, S, E); }
        { SchedDense S{WSP(const bf16_t, WS_WU), WSP(const bf16_t, WS_H), DM, 6, MTOK / 256, F.G, F.vcu, true};
          EpiPlainBf16 E{WSP(bf16_t, WS_UT), (size_t)MTOK};
          pg8::gemm_phase<EpiPlainBf16, SchedDense, false, true>(ring, idxw, DM, S, E); }
    }
    SEAM(2);
    if (IN(3)) { PHASE_ENTER();
        const attn_body::AttnTensors AT{WSP(const attn_body::bf16, WS_Q), WSP(const attn_body::bf16, WS_K), WSP(const attn_body::bf16, WS_V), WSP(attn_body::bf16, WS_Q)};
        const attn_body::StaticOrder S(F.vcu);
        attn_body::attn_phase<attn_body::StaticOrder>((char*)lds + RING_OFF, AT, S);
        __syncthreads();
        for (int c = F.vcu; c < HW; c += F.G) hyena_unit(F, c);
    }
    SEAM(3);
    if (IN(4)) { PHASE_ENTER(); for (int it = F.vcu; it < MTOK / 64; it += F.G) p4_norm_tile(F, it); }
    SEAM(4);
    if (IN(5)) { PHASE_ENTER();
        SchedDense S{WSP(const bf16_t, WS_AY), WSP(const bf16_t, WS_WO), DM, MTOK / 256, 4, F.G, F.vcu, false};
        EpiOutProj E{kin(I_X), F.out, modv};
        pg8::gemm_phase<EpiOutProj, SchedDense, false, true>(ring, idxw, DM, S, E);
    }
    SEAM(5);
    if (IN(6)) { PHASE_ENTER();
        for (int rb = gw; rb < MTOK / 32; rb += NGW) { const int row0 = rb * 32; const int b = row0 >> 12;
            modulate_rows(F, F.out, WSP(bf16_t, WS_H), row0, 32, kin(I_NORM2), modv + (size_t)b * 6144 + 4 * 1024, modv + (size_t)b * 6144 + 3 * 1024); }
    }
    SEAM(6);
    if (IN(7)) { PHASE_ENTER();
        SchedDense S{WSP(const bf16_t, WS_H), WSP(const bf16_t, WS_WR), DM, MTOK / 256, 1, F.G, F.vcu, false};
        EpiF32 E{WSP(float, WS_LOGIT), (size_t)NE};
        pg8::gemm_phase<EpiF32, SchedDense, false, true>(ring, idxw, DM, S, E);
    }
    SEAM(7);
    if (IN(8)) { PHASE_ENTER(); for (int rb = gw; rb < MTOK / 32; rb += NGW) for (int r = 0; r < 32; ++r) p8_route_token(F, rb * 32 + r); }
    SEAM(8);
    if (IN(9)) { PHASE_ENTER();
        const MoeTab tab = moe_tables(F);
        SchedGU S{WSP(const bf16_t, WS_H), WSP(const bf16_t, WS_WGU), WSP(const bf16_t, WS_WSGU), WSP(const unsigned, WS_LIST), tab, F.G, F.vcu};
        EpiGU E{WSP(bf16_t, WS_ACT), WSP(const unsigned, WS_LIST), tab};
        pg8::gemm_phase<EpiGU, SchedGU, true, true>(ring, idxw, DM, S, E);
    }
    SEAM(9);
    if (IN(10)) { PHASE_ENTER();
        const MoeTab tab = moe_tables(F);
        SchedDown S{WSP(const bf16_t, WS_ACT), WSP(const bf16_t, WS_WD), WSP(const bf16_t, WS_WSD), tab, 0, F.G, F.vcu};
        EpiDown E{WSP(bf16_t, WS_SLOT), F.out, modv, tab};
        pg8::gemm_phase<EpiDown, SchedDown, false, true>(ring, idxw, FF, S, E);
    }
    SEAM(10);
    if (IN(11)) { PHASE_ENTER(); const MoeTab tab = moe_tables(F); for (int rb = gw; rb < MTOK / 32; rb += NGW) for (int r = 0; r < 32; ++r) combine_token<0>(F, tab, rb * 32 + r); }
    SEAM(11);
    if (IN(12)) { PHASE_ENTER();
        const MoeTab tab = moe_tables(F);
        SchedDown S{WSP(const bf16_t, WS_ACT), WSP(const bf16_t, WS_WD), WSP(const bf16_t, WS_WSD), tab, 1, F.G, F.vcu};
        EpiDown E{WSP(bf16_t, WS_SLOT), F.out, modv, tab};
        pg8::gemm_phase<EpiDown, SchedDown, false, true>(ring, idxw, FF, S, E);
    }
    SEAM(12);
    if (IN(13)) { PHASE_ENTER(); const MoeTab tab = moe_tables(F); for (int rb = gw; rb < MTOK / 32; rb += NGW) for (int r = 0; r < 32; ++r) combine_token<1>(F, tab, rb * 32 + r); }
#undef modv
#undef PHASE_ENTER
#undef IN
#undef SEAM
#undef GRID_BAR
}

extern "C" void kernel_launch(void* const* d_in, const int* in_sizes, int n_in, void* d_out, int out_size, void* d_ws, size_t ws_size, hipStream_t stream) {
    static int grid = 0;
    if (grid == 0) {
        if (n_in != N_IN || in_sizes[0] != MTOK * DM || out_size != MTOK * DM || ws_size < WS_END) {
            fprintf(stderr, "kernel_launch: unexpected problem (n_in %d, in0 %d, out %d, ws %zu < %zu); nothing launched\n", n_in, n_in > 0 ? in_sizes[0] : -1, out_size, ws_size, (size_t)WS_END); grid = -1; return; }
        int dev = 0, cus = 0, per_cu = 0;
        if (hipGetDevice(&dev) != hipSuccess || hipDeviceGetAttribute(&cus, hipDeviceAttributeMultiprocessorCount, dev) != hipSuccess) { grid = -1; return; }
        if (hipFuncSetAttribute((const void*)fwd_kernel, hipFuncAttributeMaxDynamicSharedMemorySize, LDS_BYTES) != hipSuccess) { fprintf(stderr, "kernel_launch: hipFuncSetAttribute failed\n"); grid = -1; return; }
        if (hipOccupancyMaxActiveBlocksPerMultiprocessor(&per_cu, (const void*)fwd_kernel, NWAVES * 64, LDS_BYTES) != hipSuccess || per_cu < 1)
            fprintf(stderr, "kernel_launch: note: occupancy query reports %d workgroups per CU\n", per_cu);
        (void)hipGetLastError();
        grid = cus;
    }
    if (grid < 0) return;
    if (hipMemsetAsync((char*)d_ws + WS_CTL, 0, CTL_ZERO_BYTES, stream) != hipSuccess) return;
    Args a{};
    for (int i = 0; i < N_IN; ++i) a.in[i] = (const float*)d_in[i];
    a.out = (float*)d_out; a.ws = (unsigned char*)d_ws;
    for (int li = 0; li < N_LAUNCHES; ++li) {
        a.ph_lo = (N_LAUNCHES == 1) ? 0 : li; a.ph_hi = (N_LAUNCHES == 1) ? NPHASE : li + 1;
        hipLaunchKernelGGL(fwd_kernel, dim3(grid), dim3(NWAVES * 64), LDS_BYTES, stream, a);
        const hipError_t le = hipPeekAtLastError();
        if (le != hipSuccess) { fprintf(stderr, "kernel_launch: launch %d failed: %s\n", li, hipGetErrorName(le)); break; }
    }
}
```

```cpp
#include <hip/hip_runtime.h>
#include <cstdio>
#include <cstdint>
#include <cmath>

#ifndef MK_N_LAUNCHES
#define MK_N_LAUNCHES 1
#endif

#define LAS __attribute__((address_space(3)))
#define GAS __attribute__((address_space(1)))
typedef unsigned short bf16_t;
typedef short bf16x8 __attribute__((ext_vector_type(8)));
typedef float f32x4 __attribute__((ext_vector_type(4)));
typedef float f32x2 __attribute__((ext_vector_type(2)));
typedef unsigned u32x4 __attribute__((ext_vector_type(4)));
typedef unsigned u32x2 __attribute__((ext_vector_type(2)));

constexpr int NB = 16, SEQ = 4096, DM = 1024, MTOK = NB * SEQ, CTXL = 256, MCTX = NB * CTXL;
constexpr int NH = 8, HD = 64, AW = 512, HW = 512, KVP = 128, KVLEN = CTXL + SEQ;
constexpr int NE = 256, TOPK = 8, FF = 256;
constexpr float EPS = 1e-6f;
constexpr int NPHASE = 14;

constexpr size_t MiB = 1u << 20;
constexpr size_t WS_CTL = 0, CTL_ZERO_BYTES = 1 * MiB;
constexpr size_t WS_MODV = 512 * 1024;
constexpr size_t WS_ROPE = 1 * MiB;
constexpr size_t WS_SS = 1 * MiB + 256 * 1024;
constexpr size_t WS_ASSIGN = 2 * MiB;
constexpr size_t WS_KR = 4 * MiB;
constexpr size_t WS_WQKV = 12 * MiB;
constexpr size_t WS_WU = 14 * MiB;
constexpr size_t WS_WO = 17 * MiB;
constexpr size_t WS_WR = 19 * MiB;
constexpr size_t WS_WSGU = 20 * MiB;
constexpr size_t WS_WSD = 21 * MiB;
constexpr size_t WS_WD = 22 * MiB;
constexpr size_t WS_ACT = 150 * MiB;
constexpr size_t WS_SLOT = 470 * MiB;
constexpr size_t WS_END = 1048 * MiB;
constexpr size_t WS_Q = 150 * MiB;
constexpr size_t WS_K = 214 * MiB;
constexpr size_t WS_V = 231 * MiB;
constexpr size_t WS_UT = 248 * MiB;
constexpr size_t WS_HC = 440 * MiB;
constexpr size_t WS_AY = 248 * MiB;
constexpr size_t WS_LOGIT = 150 * MiB;
constexpr size_t WS_WGU = 470 * MiB;
constexpr size_t WS_H = 726 * MiB;
constexpr size_t WS_HYW = 726 * MiB;
constexpr size_t WS_HYX = 790 * MiB;
constexpr size_t WS_LIST = 854 * MiB;
constexpr size_t WS_YT = 919 * MiB;
constexpr size_t WS_AO = 983 * MiB;
static_assert(WS_LIST + (size_t)257 * 65536 * 4 <= WS_YT && WS_YT + 64 * MiB <= WS_AO && WS_AO + 64 * MiB <= WS_END, "ws map");
constexpr size_t MAXROWS_R = 524288 + 256 * 255;
static_assert(WS_SLOT + MAXROWS_R * 1024 <= WS_END && WS_ACT + (MAXROWS_R + 65536) * 512 <= WS_SLOT, "ws map 2");

constexpr int CW_TMO = 0, CW_CODE = 1;
constexpr int CW_BAR = 4096;
constexpr int CW_CNT = 16384;

constexpr int RING_OFF = 0, RING_BYTES = 131072;
constexpr int AUX_OFF = 131072, AUX_BYTES = 16384;
constexpr int MISC_OFF = AUX_OFF + AUX_BYTES;
constexpr int LDS_BYTES = MISC_OFF + 512;
constexpr int AUX_TP = 0, AUX_CNT = 2048, AUX_IDX = 4096;

constexpr int NWAVES = 8;
constexpr float C2 = 0.125f * 1.4426950408889634f;

__device__ __forceinline__ unsigned f2bf(float f) { unsigned u = __builtin_bit_cast(unsigned, f); return (u + 0x7fffu + ((u >> 16) & 1u)) >> 16; }
__device__ __forceinline__ unsigned pk2(float lo, float hi) { return f2bf(lo) | (f2bf(hi) << 16); }
__device__ __forceinline__ float bf2f(unsigned h) { return __builtin_bit_cast(float, h << 16); }
__device__ __forceinline__ unsigned cvt_pk_bf16(float lo, float hi) { unsigned r; asm volatile("v_cvt_pk_bf16_f32 %0, %1, %2" : "=v"(r) : "v"(lo), "v"(hi)); return r; }
__device__ __forceinline__ float wave_sum(float v) {
#pragma unroll
    for (int o = 1; o < 64; o <<= 1) v += __shfl_xor(v, o);
    return v;
}

namespace pg8 {
constexpr int BM = 256, BK = 64, HALF = 128, HTB = HALF * BK * 2, STAGE_BYTES = 8 * HTB;
__host__ __device__ __forceinline__ int lds_byte(int r, int c) { const int st = (r >> 4) * 2 + (c >> 5), rr = r & 15, cc = c & 31, ob = rr * 64 + cc * 2; return st * 1024 + (ob ^ (((ob >> 9) & 1) << 5)); }
__host__ __device__ __forceinline__ void stage_rc(int b, int& R, int& C) { const int st = b / 1024, sb = b % 1024, swz = sb ^ (((sb >> 9) & 1) << 5); R = (st >> 1) * 16 + swz / 64; C = (st & 1) * 32 + (swz % 64) / 2; }
__host__ __device__ __forceinline__ int perm32(int rho) { const int n = rho >> 4, i = rho & 15; return 8 * (i >> 2) + 4 * n + (i & 3); }

struct Unit { int pm, pn, aux, aux2; };

template <class Epi, class Sched, bool GATHER, bool ALIGN_EPI>
__device__ __forceinline__ void gemm_phase(LAS unsigned char* lds, LAS unsigned* idxw, const int K, const Sched& S, const Epi& E) {
    int tid_ = threadIdx.x; asm volatile("" : "+v"(tid_));
    const int tid = tid_, wid = __builtin_amdgcn_readfirstlane(tid >> 6), lane = tid & 63, wr = wid >> 2, wc = wid & 3, fr = lane & 15, fq = lane >> 4;
    const int nt = K / BK;
    int Rr[2], Cc[2]; unsigned voffB[2];
#pragma unroll
    for (int i = 0; i < 2; ++i) { stage_rc(tid * 16 + i * 8192, Rr[i], Cc[i]); const int Rb = (Rr[i] & ~31) + perm32(Rr[i] & 31); voffB[i] = (unsigned)(Rb * K + Cc[i]) * 2u; }
    const unsigned kstep = (unsigned)(BK * 2);
    const unsigned hstep = (unsigned)HALF * (unsigned)K * 2u;
    const unsigned ldsw = (unsigned)wid * 1024u;
    const int aoff = lds_byte(wr * 64 + fr, fq * 8), boff = lds_byte(wc * 32 + fr, fq * 8);
#define PG8_SA(b, h) (((b) * 2 + (h)) * HTB)
#define PG8_SB(b, h) ((4 + (b) * 2 + (h)) * HTB)
#define PG8_STAGE_B(bufoff, gbase) do { _Pragma("unroll") for (int _i = 0; _i < 2; ++_i) \
        __builtin_amdgcn_global_load_lds((const unsigned*)((const char*)(gbase) + voffB[_i]), (LAS unsigned*)(lds + (bufoff) + ldsw + _i * 8192), 16, 0, 0); } while (0)
#define PG8_STAGE_A(bufoff, gbase, VV, h) do { _Pragma("unroll") for (int _i = 0; _i < 2; ++_i) \
        __builtin_amdgcn_global_load_lds((const unsigned*)((const char*)(gbase) + VV[h][_i]), (LAS unsigned*)(lds + (bufoff) + ldsw + _i * 8192), 16, 0, 0); } while (0)
#define PG8_LDA(dst, b, h) do { _Pragma("unroll") for (int m = 0; m < 4; ++m) _Pragma("unroll") for (int k = 0; k < 2; ++k) dst[m][k] = *(const LAS bf16x8*)(lds + PG8_SA(b, h) + aoff + m * 2048 + k * 1024); } while (0)
#define PG8_LDB(dst, b, h) do { _Pragma("unroll") for (int n = 0; n < 2; ++n) _Pragma("unroll") for (int k = 0; k < 2; ++k) dst[n][k] = *(const LAS bf16x8*)(lds + PG8_SB(b, h) + boff + n * 2048 + k * 1024); } while (0)
#define PG8_MMA(ai, bj, At, Bt) do { __builtin_amdgcn_s_setprio(1); _Pragma("unroll") for (int m = 0; m < 4; ++m) _Pragma("unroll") for (int n = 0; n < 2; ++n) _Pragma("unroll") for (int k = 0; k < 2; ++k) \
        acc[ai][bj][m][n] = __builtin_amdgcn_mfma_f32_16x16x32_bf16(Bt[n][k], At[m][k], acc[ai][bj][m][n], 0, 0, 0); __builtin_amdgcn_s_setprio(0); } while (0)
#define PG8_WAIT_V(n) asm volatile("s_waitcnt vmcnt(" #n ")" ::: "memory")
#define PG8_WAIT_L(n) asm volatile("s_waitcnt lgkmcnt(" #n ")" ::: "memory")
#define PG8_BAR __builtin_amdgcn_s_barrier()
#define PG8_SCHED __builtin_amdgcn_sched_barrier(0)
    Unit cur, nxt; int ui = 0;
    if (!S.next(0, cur)) return;
    f32x4 acc[2][2][4][2];
#pragma unroll
    for (int a = 0; a < 2; ++a)
#pragma unroll
        for (int b = 0; b < 2; ++b)
#pragma unroll
            for (int m = 0; m < 4; ++m)
#pragma unroll
                for (int n = 0; n < 2; ++n) acc[a][b][m][n] = (f32x4){0.f, 0.f, 0.f, 0.f};
    bf16x8 At[4][2], B0[2][2], B1[2][2];
    unsigned va[2][2], vn[2][2];
    if constexpr (GATHER) {
        const unsigned* ip = S.idx_ptr(cur); const int nv = S.nvalid(cur);
#pragma unroll
        for (int h = 0; h < 2; ++h)
#pragma unroll
            for (int i = 0; i < 2; ++i) { const int r = Rr[i] + HALF * h; const unsigned e = ip[r]; const unsigned tok = r < nv ? (e >> 16) : 0u; va[h][i] = tok * (unsigned)K * 2u + (unsigned)Cc[i] * 2u; }
    } else {
#pragma unroll
        for (int h = 0; h < 2; ++h)
#pragma unroll
            for (int i = 0; i < 2; ++i) va[h][i] = (unsigned)((Rr[i] + HALF * h) * K + Cc[i]) * 2u;
    }
#pragma unroll
    for (int h = 0; h < 2; ++h)
#pragma unroll
        for (int i = 0; i < 2; ++i) vn[h][i] = va[h][i];
    const char* cA = S.a_base(cur); const char* cB = S.b_base(cur);
    PG8_STAGE_B(PG8_SB(0, 0), cB); PG8_STAGE_B(PG8_SB(0, 1), cB + hstep); PG8_STAGE_A(PG8_SA(0, 0), cA, va, 0); PG8_STAGE_A(PG8_SA(0, 1), cA, va, 1);
    if (wr == 1) PG8_BAR;
    PG8_WAIT_V(2); PG8_BAR;
    PG8_STAGE_B(PG8_SB(1, 0), cB + kstep); PG8_STAGE_A(PG8_SA(1, 0), cA + kstep, va, 0); PG8_STAGE_B(PG8_SB(1, 1), cB + hstep + kstep);
    PG8_WAIT_V(6); PG8_BAR;
    for (;;) {
        const bool has_next = S.next(ui + 1, nxt);
        const char* nA = has_next ? S.a_base(nxt) : cA; const char* nB = has_next ? S.b_base(nxt) : cB;
        int nvn = 0;
        if constexpr (GATHER) {
            if (has_next) { nvn = S.nvalid(nxt);
                __builtin_amdgcn_global_load_lds((const unsigned*)(S.idx_ptr(nxt) + lane * 4), (LAS unsigned*)idxw, 16, 0, 0); }
        }
#pragma unroll 1
        for (int t = 0; t < nt; t += 2) {
            const bool last = (t == nt - 2);
            if constexpr (GATHER) {
                if (last && has_next) {
                    asm volatile("" ::: "memory");
#pragma unroll
                    for (int h = 0; h < 2; ++h)
#pragma unroll
                        for (int i = 0; i < 2; ++i) { const int r = Rr[i] + HALF * h; const unsigned e = idxw[r]; const unsigned tok = r < nvn ? (e >> 16) : 0u; vn[h][i] = tok * (unsigned)K * 2u + (unsigned)Cc[i] * 2u; }
                }
            }
            unsigned v2[2][2];
#pragma unroll
            for (int h = 0; h < 2; ++h)
#pragma unroll
                for (int i = 0; i < 2; ++i) v2[h][i] = (GATHER && last) ? vn[h][i] : va[h][i];
            const char* a1 = cA + (size_t)(t + 1) * kstep;
            const char* a2 = last ? nA : cA + (size_t)(t + 2) * kstep; const char* b2 = last ? nB : cB + (size_t)(t + 2) * kstep;
            const char* a3 = a2 + kstep; const char* b3 = b2 + kstep;
            PG8_LDB(B0, 0, 0); PG8_LDB(B1, 0, 1); PG8_SCHED; PG8_LDA(At, 0, 0); PG8_STAGE_A(PG8_SA(1, 1), a1, va, 1);
            PG8_WAIT_V(8); PG8_WAIT_L(0); PG8_BAR; PG8_MMA(0, 0, At, B0); PG8_MMA(0, 1, At, B1); PG8_BAR; PG8_SCHED;
            PG8_LDA(At, 0, 1); PG8_STAGE_B(PG8_SB(0, 0), b2); PG8_STAGE_B(PG8_SB(0, 1), b2 + hstep); PG8_STAGE_A(PG8_SA(0, 0), a2, v2, 0);
            PG8_WAIT_V(8); PG8_WAIT_L(0); PG8_BAR; PG8_MMA(1, 0, At, B0); PG8_MMA(1, 1, At, B1); PG8_BAR; PG8_SCHED;
            PG8_LDB(B0, 1, 0); PG8_LDB(B1, 1, 1); PG8_SCHED; PG8_LDA(At, 1, 0); PG8_STAGE_A(PG8_SA(0, 1), a2, v2, 1);
            PG8_WAIT_V(8); PG8_WAIT_L(0); PG8_BAR; PG8_MMA(0, 0, At, B0); PG8_MMA(0, 1, At, B1); PG8_BAR; PG8_SCHED;
            PG8_LDA(At, 1, 1); PG8_STAGE_B(PG8_SB(1, 0), b3); PG8_STAGE_B(PG8_SB(1, 1), b3 + hstep); PG8_STAGE_A(PG8_SA(1, 0), a3, v2, 0);
            PG8_WAIT_V(8); PG8_WAIT_L(0); PG8_BAR; PG8_MMA(1, 0, At, B0); PG8_MMA(1, 1, At, B1); PG8_BAR; PG8_SCHED;
        }
        if constexpr (ALIGN_EPI) { if (wr == 0) PG8_BAR; }
        E(acc, cur, wr, wc, fr, fq);
        if (!has_next) break;
#pragma unroll
        for (int a = 0; a < 2; ++a)
#pragma unroll
            for (int b = 0; b < 2; ++b)
#pragma unroll
                for (int m = 0; m < 4; ++m)
#pragma unroll
                    for (int n = 0; n < 2; ++n) acc[a][b][m][n] = (f32x4){0.f, 0.f, 0.f, 0.f};
        cur = nxt; cA = nA; cB = nB; ++ui;
#pragma unroll
        for (int h = 0; h < 2; ++h)
#pragma unroll
            for (int i = 0; i < 2; ++i) va[h][i] = vn[h][i];
        if constexpr (ALIGN_EPI) { if (wr == 1) PG8_BAR; }
    }
    PG8_WAIT_V(0);
    if constexpr (!ALIGN_EPI) { if (wr == 0) PG8_BAR; }
    PG8_BAR;
#undef PG8_SA
#undef PG8_SB
#undef PG8_STAGE_A
#undef PG8_STAGE_B
#undef PG8_LDA
#undef PG8_LDB
#undef PG8_MMA
#undef PG8_WAIT_V
#undef PG8_WAIT_L
#undef PG8_BAR
#undef PG8_SCHED
}
}

using pg8::Unit;
struct MoeTab { const LAS int* tp; const LAS int* cnt; };
__device__ __forceinline__ int moe_find(const LAS int* tp, int T) {
    int lo = 0, hi = 256;
    while (lo < hi) { const int mid = (lo + hi + 1) >> 1; if (tp[mid] <= T) lo = mid; else hi = mid - 1; }
    return lo;
}

struct SchedQKV {
    const bf16_t *H; long hc_delta; const bf16_t *W; int G, c;
    __device__ __forceinline__ bool next(int i, Unit& u) const {
        const int L = i * G + c; if (L >= 784) return false;
        if (L < 768) { u.pm = L / 3; u.pn = L % 3; u.aux = 0; } else { u.pm = L - 768; u.pn = 2; u.aux = 1; }
        u.aux2 = 0; return true;
    }
    __device__ __forceinline__ const char* a_base(const Unit& u) const { return (const char*)H + (u.aux ? hc_delta : 0L) + (size_t)u.pm * (256 * 1024 * 2); }
    __device__ __forceinline__ const char* b_base(const Unit& u) const { return (const char*)W + (size_t)u.pn * (256 * 1024 * 2); }
    __device__ __forceinline__ const unsigned* idx_ptr(const Unit&) const { return nullptr; }
    __device__ __forceinline__ int nvalid(const Unit&) const { return 256; }
};
struct SchedDense {
    const bf16_t *A, *Bt; int K, nM, nN, G, c; bool m_fast;
    __device__ __forceinline__ bool next(int i, Unit& u) const {
        const int L = i * G + c; if (L >= nM * nN) return false;
        if (m_fast) { u.pm = L % nM; u.pn = L / nM; } else { u.pm = L / nN; u.pn = L % nN; }
        u.aux = 0; u.aux2 = 0; return true;
    }
    __device__ __forceinline__ const char* a_base(const Unit& u) const { return (const char*)A + (size_t)u.pm * 512 * (size_t)K; }
    __device__ __forceinline__ const char* b_base(const Unit& u) const { return (const char*)Bt + (size_t)u.pn * 512 * (size_t)K; }
    __device__ __forceinline__ const unsigned* idx_ptr(const Unit&) const { return nullptr; }
    __device__ __forceinline__ int nvalid(const Unit&) const { return 256; }
};
struct SchedGU {
    const bf16_t *H2, *WGU, *WSGU; const unsigned* LIST; MoeTab tab; int G, c;
    __device__ __forceinline__ bool next(int i, Unit& u) const {
        const int L = i * G + c; const int Ttot = __builtin_amdgcn_readfirstlane(tab.tp[257]); if (L >= 2 * Ttot) return false;
        const int T = L >> 1; const int e = __builtin_amdgcn_readfirstlane(moe_find(tab.tp, T));
        u.pm = T; u.pn = L & 1; u.aux = e; u.aux2 = __builtin_amdgcn_readfirstlane(T - tab.tp[e]); return true;
    }
    __device__ __forceinline__ const char* a_base(const Unit&) const { return (const char*)H2; }
    __device__ __forceinline__ const char* b_base(const Unit& u) const { return (const char*)(u.aux < 256 ? WGU + (size_t)u.aux * (512 * 1024) : WSGU) + (size_t)u.pn * (256 * 1024 * 2); }
    __device__ __forceinline__ const unsigned* idx_ptr(const Unit& u) const { return LIST + (size_t)u.aux * 65536 + (size_t)u.aux2 * 256; }
    __device__ __forceinline__ int nvalid(const Unit& u) const { const int r = __builtin_amdgcn_readfirstlane(tab.cnt[u.aux]) - u.aux2 * 256; return r < 256 ? r : 256; }
};
struct SchedDown {
    const bf16_t *ACT, *WD, *WSD; MoeTab tab; int hp, G, c;
    __device__ __forceinline__ bool next(int i, Unit& u) const {
        const int L = i * G + c; const int TR = __builtin_amdgcn_readfirstlane(tab.tp[256]), TT = __builtin_amdgcn_readfirstlane(tab.tp[257]); int T, pn;
        if (L < 2 * TR) { T = L >> 1; pn = 2 * hp + (L & 1); }
        else { if (hp) return false; const int L2 = L - 2 * TR; if (L2 >= 4 * (TT - TR)) return false; T = TR + (L2 >> 2); pn = L2 & 3; }
        const int e = __builtin_amdgcn_readfirstlane(moe_find(tab.tp, T));
        u.pm = T; u.pn = pn; u.aux = e; u.aux2 = 0; return true;
    }
    __device__ __forceinline__ const char* a_base(const Unit& u) const { return (const char*)ACT + (size_t)u.pm * (256 * 256 * 2); }
    __device__ __forceinline__ const char* b_base(const Unit& u) const { return (const char*)(u.aux < 256 ? WD + (size_t)u.aux * (1024 * 256) : WSD) + (size_t)u.pn * (256 * 256 * 2); }
    __device__ __forceinline__ const unsigned* idx_ptr(const Unit&) const { return nullptr; }
    __device__ __forceinline__ int nvalid(const Unit&) const { return 256; }
};

#define EPI_ARGS const f32x4 (&acc)[2][2][4][2], const Unit& u, int wr, int wc, int fr_, int fq_
#define EPI_PIN int fr = fr_, fq = fq_; asm volatile("" : "+v"(fr), "+v"(fq))
__device__ __forceinline__ u32x4 pack8(const f32x4& a, const f32x4& b) { u32x4 o; o.x = cvt_pk_bf16(a[0], a[1]); o.y = cvt_pk_bf16(a[2], a[3]); o.z = cvt_pk_bf16(b[0], b[1]); o.w = cvt_pk_bf16(b[2], b[3]); return o; }

struct EpiQKV {
    bf16_t *Q, *Kb, *Vb; const float *qnw, *knw; const f32x2* rope;
    __device__ __forceinline__ void operator()(EPI_ARGS) const {
        EPI_PIN;
        const bool ctx = u.aux != 0;
        const int kind = (u.pn < 2) ? 0 : (wc < 2 ? 1 : 2);
        f32x4 w[2][2];
#pragma unroll
        for (int bj = 0; bj < 2; ++bj)
#pragma unroll
            for (int n = 0; n < 2; ++n) w[bj][n] = (kind == 2) ? (f32x4){1.f, 1.f, 1.f, 1.f} : *(const f32x4*)((kind == 0 ? qnw : knw) + 32 * bj + 8 * fq + 4 * n);
        f32x4 rrow[2][2], rcol[4][2];
        if (kind != 2 && !ctx) {
#pragma unroll
            for (int ai = 0; ai < 2; ++ai)
#pragma unroll
                for (int n = 0; n < 2; ++n) rrow[ai][n] = ((const f32x4*)(rope + (((u.pm * 4 + 2 * ai + wr) & 63) * 16) + 4 * fq))[n];
#pragma unroll
            for (int m = 0; m < 4; ++m)
#pragma unroll
                for (int n = 0; n < 2; ++n) rcol[m][n] = ((const f32x4*)(rope + (16 * m + fr) * 16 + 4 * fq))[n];
        }
#pragma unroll
        for (int ai = 0; ai < 2; ++ai)
#pragma unroll
            for (int m = 0; m < 4; ++m) {
                const int rl = ai * 128 + wr * 64 + m * 16 + fr; const int row = u.pm * 256 + rl;
                f32x4 v[2][2];
#pragma unroll
                for (int bj = 0; bj < 2; ++bj)
#pragma unroll
                    for (int n = 0; n < 2; ++n) v[bj][n] = acc[ai][bj][m][n];
                if (kind != 2) {
                    float ss = 0.f;
#pragma unroll
                    for (int bj = 0; bj < 2; ++bj)
#pragma unroll
                        for (int n = 0; n < 2; ++n) ss += (v[bj][n][0] * v[bj][n][0] + v[bj][n][1] * v[bj][n][1]) + (v[bj][n][2] * v[bj][n][2] + v[bj][n][3] * v[bj][n][3]);
                    ss += __shfl_xor(ss, 16); ss += __shfl_xor(ss, 32);
                    const float rs = rsqrtf(ss * (1.f / 64.f) + EPS);
#pragma unroll
                    for (int bj = 0; bj < 2; ++bj)
#pragma unroll
                        for (int n = 0; n < 2; ++n) v[bj][n] = v[bj][n] * rs * w[bj][n];
                    if (!ctx) {
#pragma unroll
                        for (int bj = 0; bj < 2; ++bj)
#pragma unroll
                            for (int n = 0; n < 2; ++n) { const f32x4 cs = bj == 0 ? rrow[ai][n] : rcol[m][n]; const f32x4 x = v[bj][n];
                                v[bj][n] = (f32x4){x[0] * cs[0] - x[1] * cs[1], x[0] * cs[1] + x[1] * cs[0], x[2] * cs[2] - x[3] * cs[3], x[2] * cs[3] + x[3] * cs[2]}; }
                    }
                    if (kind == 0) {
#pragma unroll
                        for (int bj = 0; bj < 2; ++bj)
#pragma unroll
                            for (int n = 0; n < 2; ++n) v[bj][n] = v[bj][n] * C2;
                    }
                }
                bf16_t* dst;
                if (kind == 0) dst = Q + (size_t)row * AW + 64 * (4 * u.pn + wc) + 8 * fq;
                else { const int kvrow = ctx ? (row >> 8) * KVLEN + (row & 255) : (row >> 12) * KVLEN + CTXL + (row & (SEQ - 1));
                       dst = (kind == 1 ? Kb : Vb) + (size_t)kvrow * KVP + 64 * (wc & 1) + 8 * fq; }
#pragma unroll
                for (int bj = 0; bj < 2; ++bj) *(u32x4*)(dst + 32 * bj) = pack8(v[bj][0], v[bj][1]);
            }
    }
};
struct EpiPlainBf16 {
    bf16_t* O; size_t ldc;
    __device__ __forceinline__ void operator()(EPI_ARGS) const {
        EPI_PIN;
#pragma unroll
        for (int ai = 0; ai < 2; ++ai)
#pragma unroll
            for (int m = 0; m < 4; ++m) { bf16_t* rowp = O + (size_t)(u.pm * 256 + ai * 128 + wr * 64 + m * 16 + fr) * ldc + u.pn * 256 + wc * 32 + 8 * fq;
#pragma unroll
                for (int bj = 0; bj < 2; ++bj) *(u32x4*)(rowp + bj * 128) = pack8(acc[ai][bj][m][0], acc[ai][bj][m][1]); }
    }
};
struct EpiOutProj {
    const float* x; float* out; const float* modv;
    __device__ __forceinline__ void operator()(EPI_ARGS) const {
        EPI_PIN;
        const float* g1 = modv + (size_t)(u.pm >> 4) * 6144 + 2 * 1024; const int col0 = u.pn * 256 + wc * 32 + 8 * fq;
        f32x4 gv[2][2];
#pragma unroll
        for (int bj = 0; bj < 2; ++bj)
#pragma unroll
            for (int n = 0; n < 2; ++n) gv[bj][n] = *(const f32x4*)(g1 + col0 + bj * 128 + 4 * n);
#pragma unroll
        for (int ai = 0; ai < 2; ++ai)
#pragma unroll
            for (int m = 0; m < 4; ++m) { const size_t off = (size_t)(u.pm * 256 + ai * 128 + wr * 64 + m * 16 + fr) * DM + col0;
#pragma unroll
                for (int bj = 0; bj < 2; ++bj)
#pragma unroll
                    for (int n = 0; n < 2; ++n) { const f32x4 xv = *(const f32x4*)(x + off + bj * 128 + 4 * n); *(f32x4*)(out + off + bj * 128 + 4 * n) = xv + gv[bj][n] * acc[ai][bj][m][n]; }
                if (m & 1) asm volatile("" ::: "memory"); }
    }
};
struct EpiF32 {
    float* O; size_t ldc;
    __device__ __forceinline__ void operator()(EPI_ARGS) const {
        EPI_PIN;
#pragma unroll
        for (int ai = 0; ai < 2; ++ai)
#pragma unroll
            for (int m = 0; m < 4; ++m) { float* rowp = O + (size_t)(u.pm * 256 + ai * 128 + wr * 64 + m * 16 + fr) * ldc + u.pn * 256 + wc * 32 + 8 * fq;
#pragma unroll
                for (int bj = 0; bj < 2; ++bj)
#pragma unroll
                    for (int n = 0; n < 2; ++n) *(f32x4*)(rowp + bj * 128 + 4 * n) = acc[ai][bj][m][n]; }
    }
};
struct EpiGU {
    bf16_t* ACT; const unsigned* LIST; MoeTab tab;
    __device__ __forceinline__ void operator()(EPI_ARGS) const {
        EPI_PIN;
        const int e = u.aux, tile = u.aux2; int nv = __builtin_amdgcn_readfirstlane(tab.cnt[e]) - tile * 256; nv = nv < 256 ? nv : 256;
        const unsigned* ip = LIST + (size_t)e * 65536 + (size_t)tile * 256;
#pragma unroll
        for (int ai = 0; ai < 2; ++ai)
#pragma unroll
            for (int m = 0; m < 4; ++m) { const int rl = ai * 128 + wr * 64 + m * 16 + fr;
                const float wrow = rl < nv ? bf2f(ip[rl] & 0xffffu) : 0.f;
                f32x4 o[2];
#pragma unroll
                for (int n = 0; n < 2; ++n) { const f32x4 g = acc[ai][0][m][n], up = acc[ai][1][m][n];
#pragma unroll
                    for (int j = 0; j < 4; ++j) o[n][j] = g[j] * __builtin_amdgcn_rcpf(1.f + __builtin_amdgcn_exp2f(-1.4426950408889634f * g[j])) * up[j] * wrow; }
                *(u32x4*)(ACT + (size_t)(u.pm * 256 + rl) * FF + u.pn * 128 + wc * 32 + 8 * fq) = pack8(o[0], o[1]); }
    }
};
struct EpiDown {
    bf16_t* SLOT; float* out; const float* modv; MoeTab tab;
    __device__ __forceinline__ void operator()(EPI_ARGS) const {
        EPI_PIN;
        if (u.aux < 256) {
#pragma unroll
            for (int ai = 0; ai < 2; ++ai)
#pragma unroll
                for (int m = 0; m < 4; ++m) { bf16_t* rowp = SLOT + (size_t)(u.pm * 256 + ai * 128 + wr * 64 + m * 16 + fr) * 512 + (u.pn & 1) * 256 + wc * 32 + 8 * fq;
#pragma unroll
                    for (int bj = 0; bj < 2; ++bj) *(u32x4*)(rowp + bj * 128) = pack8(acc[ai][bj][m][0], acc[ai][bj][m][1]); }
        } else {
            const int ts = u.pm - __builtin_amdgcn_readfirstlane(tab.tp[256]);
            const float* g2 = modv + (size_t)(ts >> 4) * 6144 + 5 * 1024; const int col0 = u.pn * 256 + wc * 32 + 8 * fq;
            f32x4 gv[2][2];
#pragma unroll
            for (int bj = 0; bj < 2; ++bj)
#pragma unroll
                for (int n = 0; n < 2; ++n) gv[bj][n] = *(const f32x4*)(g2 + col0 + bj * 128 + 4 * n);
#pragma unroll
            for (int ai = 0; ai < 2; ++ai)
#pragma unroll
                for (int m = 0; m < 4; ++m) { const size_t off = (size_t)(ts * 256 + ai * 128 + wr * 64 + m * 16 + fr) * DM + col0;
#pragma unroll
                    for (int bj = 0; bj < 2; ++bj)
#pragma unroll
                        for (int n = 0; n < 2; ++n) { const f32x4 xv = *(const f32x4*)(out + off + bj * 128 + 4 * n); *(f32x4*)(out + off + bj * 128 + 4 * n) = xv + gv[bj][n] * acc[ai][bj][m][n]; }
                    if (m & 1) asm volatile("" ::: "memory"); }
        }
    }
};
#include <hip/hip_bf16.h>
#include <cmath>
namespace attn_body {
using bf16=__hip_bfloat16;
using bf16x8=__attribute__((ext_vector_type(8)))short;
using s16x4=__attribute__((ext_vector_type(4)))short;
using f32x16=__attribute__((ext_vector_type(16)))float;
using u32x4=__attribute__((ext_vector_type(4)))unsigned;
constexpr int SEQ=4096,D=64,QP=512,KVP=128,KVLEN=4352;
constexpr int NW=8,QBLK=32,QB=QBLK*NW,KVBLK=64,NQB=SEQ/QB;
constexpr int ATTN_UNIT_ROWS=QB;
__device__ __forceinline__ int crow(int r,int hi){return (r&3)+8*(r>>2)+4*hi;}
#define SBAR() __builtin_amdgcn_sched_barrier(0)

constexpr int NSLOT=3, SLOTB=8192;
constexpr int LDS_K=0, LDS_V=NSLOT*SLOTB, LDS_WS=2*NSLOT*SLOTB, LDS_OST=LDS_WS+NW*64*4, LDS_BYTES=LDS_OST+NW*4096;
constexpr float C2=0.125f*1.4426950408889634f;
__device__ __forceinline__ void glds16(const void*gsrc,unsigned lds_dst){unsigned keep;
  asm volatile("s_mov_b32 %0, m0\n\ts_mov_b32 m0, %2\n\ts_nop 0\n\tglobal_load_lds_dwordx4 %1, off\n\ts_mov_b32 m0, %0":"=&s"(keep):"v"(gsrc),"s"(lds_dst):"memory");}
__device__ __forceinline__ float max3f(float a,float b,float c){float r;asm("v_max3_f32 %0, %1, %2, %3":"=v"(r):"v"(a),"v"(b),"v"(c));return r;}
__device__ __forceinline__ float max2f(float a,float b){float r;asm("v_max_f32_e32 %0, %1, %2":"=v"(r):"v"(a),"v"(b));return r;}
__device__ __forceinline__ float fadd_s(float a,float b){float r;asm("v_add_f32_e32 %0, %1, %2":"=v"(r):"v"(a),"v"(b));return r;}
__device__ __forceinline__ float fsub_s(float a,float b){float r;asm("v_sub_f32_e32 %0, %1, %2":"=v"(r):"v"(a),"v"(b));return r;}
typedef float f32x2_t __attribute__((ext_vector_type(2))); typedef __bf16 bf16x2_t __attribute__((ext_vector_type(2)));
__device__ __forceinline__ unsigned cvtpk_s(float lo,float hi){f32x2_t v={lo,hi};bf16x2_t b=__builtin_convertvector(v,bf16x2_t);return __builtin_bit_cast(unsigned,b);}
#define WAIT_BAR(N) asm volatile("s_waitcnt vmcnt(" #N ") lgkmcnt(0)\n\ts_barrier":::"memory")

__device__ __forceinline__ void qkt(f32x16&p0,f32x16&p1,const char*Kslot,const bf16x8*qr,const f32x16&negm,int r32,int hi){
  const char*kb=Kslot+hi*1024+r32*16;
  #pragma unroll
  for(int d0=0;d0<4;++d0){
    const bf16x8 b0=*reinterpret_cast<const bf16x8*>(kb+d0*2048);
    const bf16x8 b1=*reinterpret_cast<const bf16x8*>(kb+d0*2048+512);
    if(d0==0){p0=__builtin_amdgcn_mfma_f32_32x32x16_bf16(b0,qr[0],negm,0,0,0);p1=__builtin_amdgcn_mfma_f32_32x32x16_bf16(b1,qr[0],negm,0,0,0);}
    else{p0=__builtin_amdgcn_mfma_f32_32x32x16_bf16(b0,qr[d0],p0,0,0,0);p1=__builtin_amdgcn_mfma_f32_32x32x16_bf16(b1,qr[d0],p1,0,0,0);}}
}
typedef __attribute__((address_space(3))) const char* lds_cptr;
typedef short v4i16_t __attribute__((ext_vector_type(4)));
__device__ __forceinline__ void kload8(bf16x8*kf,lds_cptr kp){
  kf[0]=*(const __attribute__((address_space(3))) bf16x8*)(kp);      kf[1]=*(const __attribute__((address_space(3))) bf16x8*)(kp+512);
  kf[2]=*(const __attribute__((address_space(3))) bf16x8*)(kp+2048); kf[3]=*(const __attribute__((address_space(3))) bf16x8*)(kp+2560);
  kf[4]=*(const __attribute__((address_space(3))) bf16x8*)(kp+4096); kf[5]=*(const __attribute__((address_space(3))) bf16x8*)(kp+4608);
  kf[6]=*(const __attribute__((address_space(3))) bf16x8*)(kp+6144); kf[7]=*(const __attribute__((address_space(3))) bf16x8*)(kp+6656);
}
__device__ __forceinline__ void kload2(bf16x8*kf,lds_cptr kp,int j){ kf[2*j]=*(const __attribute__((address_space(3))) bf16x8*)(kp+j*2048); kf[2*j+1]=*(const __attribute__((address_space(3))) bf16x8*)(kp+j*2048+512); }
__device__ __forceinline__ s16x4 vtr(lds_cptr p){ return __builtin_bit_cast(s16x4,__builtin_amdgcn_ds_read_tr16_b64_v4i16((__attribute__((address_space(3))) v4i16_t*)p)); }
__device__ __forceinline__ float rowmax(const f32x16&p0,const f32x16&p1){
  float a=max3f(p0[0],p0[1],p1[0]),b=max3f(p0[2],p0[3],p1[1]);a=max3f(a,p1[2],p1[3]);
  #pragma unroll
  for(int r=4;r<16;r+=4){a=max3f(a,p0[r],p0[r+1]);b=max3f(b,p0[r+2],p0[r+3]);a=max3f(a,p1[r],p1[r+1]);b=max3f(b,p1[r+2],p1[r+3]);}
  const float m=max2f(a,b);
  auto rr=__builtin_amdgcn_permlane32_swap(__float_as_uint(m),__float_as_uint(m),false,false);
  return max2f(__uint_as_float(rr[0]),__uint_as_float(rr[1]));
}
__device__ __forceinline__ void pv(f32x16*o,int vb,bf16x8 pa0,bf16x8 pa1,bf16x8 pa2,bf16x8 pa3){
  #pragma unroll
  for(int d0=0;d0<2;++d0){s16x4 lo[4],hi[4];
    #pragma unroll
    for(int ks=0;ks<4;++ks){
      asm volatile("ds_read_b64_tr_b16 %0,%1 offset:%c2":"=&v"(lo[ks]):"v"(vb),"i"(d0*4096+ks*1024):"memory");
      asm volatile("ds_read_b64_tr_b16 %0,%1 offset:%c2":"=&v"(hi[ks]):"v"(vb),"i"(d0*4096+ks*1024+512):"memory");}
    asm volatile("s_waitcnt lgkmcnt(0)":::"memory");SBAR();
    #define PK(k) (bf16x8){lo[k][0],lo[k][1],lo[k][2],lo[k][3],hi[k][0],hi[k][1],hi[k][2],hi[k][3]}
    o[d0]=__builtin_amdgcn_mfma_f32_32x32x16_bf16(pa0,PK(0),o[d0],0,0,0);
    o[d0]=__builtin_amdgcn_mfma_f32_32x32x16_bf16(pa1,PK(1),o[d0],0,0,0);
    o[d0]=__builtin_amdgcn_mfma_f32_32x32x16_bf16(pa2,PK(2),o[d0],0,0,0);
    o[d0]=__builtin_amdgcn_mfma_f32_32x32x16_bf16(pa3,PK(3),o[d0],0,0,0);
    #undef PK
  }
}

#ifndef ATTN_STORE16
#define ATTN_STORE16(p,v) (*(u32x4*)(p)=(v))
#endif
template<int THRL> __device__ __forceinline__ void attn_unit(int b,int h,int qb,const bf16*Q,const bf16*__restrict__ K,const bf16*__restrict__ V,bf16*O,char*shm){
  const int tid=threadIdx.x,lane=tid&63,r32=lane&31,hi=lane>>5; const int wid=__builtin_amdgcn_readfirstlane(tid>>6);
  const int q0=qb*QB; const long qrow0=(long)b*SEQ+q0+wid*QBLK;
  const bf16*Qw=Q+qrow0*QP+h*D;
  const bf16*Kh=K+(long)b*KVLEN*KVP+(h>>2)*D,*Vh=V+(long)b*KVLEN*KVP+(h>>2)*D;
  const unsigned lds0=(unsigned)(uintptr_t)shm;
  float*wsf=(float*)(shm+LDS_WS)+wid*64;
  const bf16*ksrc=Kh+(long)lane*KVP+wid*8;
  const bf16*vsrc=Vh+(long)(16*(wid&3)+(lane>>2))*KVP+(wid>>2)*32+(lane&3)*8;
  const unsigned kdst=lds0+LDS_K+wid*1024, vdst=lds0+LDS_V+wid*1024;
  #define DMA_K(t,slot) glds16(ksrc+(long)(t)*KVBLK*KVP,(unsigned)__builtin_amdgcn_readfirstlane(kdst+(slot)))
  #define DMA_V(t,slot) glds16(vsrc+(long)(t)*KVBLK*KVP,(unsigned)__builtin_amdgcn_readfirstlane(vdst+(slot)))
  const int vb0=(int)(lds0+LDS_V)+((lane>>4)&1)*32+(lane&3)*8+(4*hi+((lane&15)>>2))*64;
  const char*Kbase=shm+LDS_K; bf16x8 kf[8];
  const lds_cptr shm3=(lds_cptr)shm; const lds_cptr kp0=shm3+LDS_K+hi*1024+r32*16; const lds_cptr vp0=shm3+LDS_V+((lane>>4)&1)*32+(lane&3)*8+(4*hi+((lane&15)>>2))*64;
  constexpr int NT=KVLEN/KVBLK;
  DMA_K(0,0);DMA_V(0,0);DMA_K(1,SLOTB);
  bf16x8 qr[4];
  #pragma unroll
  for(int d0=0;d0<4;++d0)qr[d0]=*reinterpret_cast<const bf16x8*>(&Qw[(long)r32*QP+d0*16+hi*8]);
  float mhat=0.f,l_reg=0.f;f32x16 o[2];o[0]=f32x16{};o[1]=f32x16{};f32x16 negm=f32x16{};asm volatile("":"+v"(negm));
  #define CMASK(P0,P1,t) do{}while(0)
  bool resc=false;
  #define START(P0,P1) do{ const float rm=rowmax(P0,P1); resc=false; \
    { const float dl=rm; mhat=fadd_s(mhat,dl); \
      _Pragma("unroll") for(int r=0;r<16;++r){P0[r]=fsub_s(P0[r],dl);P1[r]=fsub_s(P1[r],dl);} \
      _Pragma("unroll") for(int r=0;r<16;++r)negm[r]=-mhat; asm volatile("":"+v"(negm)); } \
    _Pragma("unroll") for(int r=0;r<16;++r)P0[r]=__builtin_amdgcn_exp2f(P0[r]); }while(0)
  #define RESC() do{ if(resc){ asm volatile("s_waitcnt lgkmcnt(0)":::"memory"); \
      _Pragma("unroll") for(int d_=0;d_<2;++d_) _Pragma("unroll") for(int r=0;r<16;++r)o[d_][r]*=wsf[crow(r,hi)]; } }while(0)
  f32x16 pA0,pA1,pB0,pB1;
  int sl_prev=0,sl_cur=0,sl_next=SLOTB;
  #define ROT() do{sl_prev=sl_cur;sl_cur=sl_next;sl_next=(sl_next==(NSLOT-1)*SLOTB)?0:sl_next+SLOTB;}while(0)
  DMA_K(2,2*SLOTB);
  WAIT_BAR(3);
  qkt(pA0,pA1,Kbase,qr,negm,r32,hi);asm volatile("s_nop 15\n\ts_nop 7":"+v"(pA0),"+v"(pA1));CMASK(pA0,pA1,0);
  START(pA0,pA1);
  _Pragma("unroll") for(int r=0;r<16;++r)pA1[r]=__builtin_amdgcn_exp2f(pA1[r]);
  WAIT_BAR(0);
  DMA_K(3,0);DMA_V(1,SLOTB);
  ROT();
  kload8(kf,kp0+sl_cur);
  WAIT_BAR(2);
  s16x4 vlo[8],vhi[8]; u32x4 pw0,pw1,pw2,pw3;
  #define PKW(P,B) cvtpk_s(P[B],P[B+1])
  #define PAF(k) __builtin_bit_cast(bf16x8,pw##k)
  #define VFR(i) (bf16x8){vlo[i][0],vlo[i][1],vlo[i][2],vlo[i][3],vhi[i][0],vhi[i][1],vhi[i][2],vhi[i][3]}
  #define PIN(x) asm volatile("":"+v"(x))
  #define MX3(a,b,c) __builtin_fmaxf(__builtin_fmaxf((a),(b)),(c))
  #define GAPA(MF,A0,A1,A2,A3,W0,W1,PW) do{ MF; sacc+=A0; sacc+=A1; sacc+=A2; sacc+=A3; PIN(sacc); W0; W1; PIN(PW); SBAR(); }while(0)
  #define EX(v) __builtin_amdgcn_exp2f(v)
  #define GAPB(MF,X,B) do{ MF; X[B]=EX(X[B]); X[B+1]=EX(X[B+1]); X[B+2]=EX(X[B+2]); X[B+3]=EX(X[B+3]); PIN(X); SBAR(); }while(0)
  #define VRD(i) do{ vlo[i]=vtr(vp_+(((i)>>2)*4096+((i)&3)*1024)); vhi[i]=vtr(vp_+(((i)>>2)*4096+((i)&3)*1024+512)); }while(0)
  #define KRD(G,j) do{ if(G){ kload2(kf,kp0+sl_next,j); SBAR(); } }while(0)
  #define STEP(C0,C1,P0,P1,t,GK,GV,GL) do{ SBAR(); \
    const lds_cptr vp_=vp0+sl_prev; \
    VRD(0); SBAR(); float sacc=(P0[0]+P0[1]); \
    GAPA(C0=__builtin_amdgcn_mfma_f32_32x32x16_bf16(kf[0],qr[0],negm,0,0,0), P0[2],P0[3],P0[4],P0[5],     pw0[0]=PKW(P0,0), pw0[1]=PKW(P0,2), pw0); \
    VRD(4); SBAR(); GAPA(C1=__builtin_amdgcn_mfma_f32_32x32x16_bf16(kf[1],qr[0],negm,0,0,0), P0[6],P0[7],P0[8],P0[9],     pw0[2]=PKW(P0,4), pw0[3]=PKW(P0,6), pw0); \
    VRD(1); SBAR(); GAPA(C0=__builtin_amdgcn_mfma_f32_32x32x16_bf16(kf[2],qr[1],C0,0,0,0),   P0[10],P0[11],P0[12],P0[13], pw1[0]=PKW(P0,8), pw1[1]=PKW(P0,10), pw1); \
    VRD(5); SBAR(); GAPA(C1=__builtin_amdgcn_mfma_f32_32x32x16_bf16(kf[3],qr[1],C1,0,0,0),   P0[14],P0[15],P1[0],P1[1],   pw1[2]=PKW(P0,12),pw1[3]=PKW(P0,14), pw1); \
    VRD(2); SBAR(); GAPA(C0=__builtin_amdgcn_mfma_f32_32x32x16_bf16(kf[4],qr[2],C0,0,0,0),   P1[2],P1[3],P1[4],P1[5],     pw2[0]=PKW(P1,0), pw2[1]=PKW(P1,2), pw2); \
    VRD(6); SBAR(); GAPA(C1=__builtin_amdgcn_mfma_f32_32x32x16_bf16(kf[5],qr[2],C1,0,0,0),   P1[6],P1[7],P1[8],P1[9],     pw2[2]=PKW(P1,4), pw2[3]=PKW(P1,6), pw2); \
    VRD(3); SBAR(); GAPA(C0=__builtin_amdgcn_mfma_f32_32x32x16_bf16(kf[6],qr[3],C0,0,0,0),   P1[10],P1[11],P1[12],P1[13], pw3[0]=PKW(P1,8), pw3[1]=PKW(P1,10), pw3); \
    VRD(7); SBAR(); GAPA(C1=__builtin_amdgcn_mfma_f32_32x32x16_bf16(kf[7],qr[3],C1,0,0,0),   P1[14],P1[15],0.f,0.f,       pw3[2]=PKW(P1,12),pw3[3]=PKW(P1,14), pw3); \
    l_reg+=sacc; \
    if(GK){DMA_K((t)+3,sl_cur);} if(GV){DMA_V((t)+1,sl_next);} \
    CMASK(C0,C1,t); \
    { float a=MX3(C0[0],C0[1],C1[0]),b=MX3(C0[2],C0[3],C1[1]); a=MX3(a,C1[2],C1[3]); \
      _Pragma("unroll") for(int r=4;r<16;r+=4){a=MX3(a,C0[r],C0[r+1]);b=MX3(b,C0[r+2],C0[r+3]);a=MX3(a,C1[r],C1[r+1]);b=MX3(b,C1[r+2],C1[r+3]);} \
      float rm=__builtin_fmaxf(a,b); { auto rr=__builtin_amdgcn_permlane32_swap(__float_as_uint(rm),__float_as_uint(rm),false,false); rm=__builtin_fmaxf(__uint_as_float(rr[0]),__uint_as_float(rr[1])); } \
      resc=false; \
      if(__builtin_expect(__any(rm>(float)THRL),0)){ const float dl=__builtin_fmaxf(rm,0.f); mhat+=dl; \
        _Pragma("unroll") for(int r=0;r<16;++r){C0[r]-=dl;C1[r]-=dl;} \
        _Pragma("unroll") for(int r=0;r<16;++r)negm[r]=-mhat; asm volatile("":"+v"(negm)); \
        const float f=__builtin_amdgcn_exp2f(-dl); l_reg*=f; if(hi==0)wsf[r32]=f; resc=true; } } \
    SBAR(); \
    GAPB(o[0]=__builtin_amdgcn_mfma_f32_32x32x16_bf16(PAF(0),VFR(0),o[0],0,0,0), C0,0); \
    GAPB(o[1]=__builtin_amdgcn_mfma_f32_32x32x16_bf16(PAF(0),VFR(4),o[1],0,0,0), C0,4); \
    KRD(GL,0); GAPB(o[0]=__builtin_amdgcn_mfma_f32_32x32x16_bf16(PAF(1),VFR(1),o[0],0,0,0), C0,8); \
    KRD(GL,1); GAPB(o[1]=__builtin_amdgcn_mfma_f32_32x32x16_bf16(PAF(1),VFR(5),o[1],0,0,0), C0,12); \
    KRD(GL,2); GAPB(o[0]=__builtin_amdgcn_mfma_f32_32x32x16_bf16(PAF(2),VFR(2),o[0],0,0,0), C1,0); \
    KRD(GL,3); GAPB(o[1]=__builtin_amdgcn_mfma_f32_32x32x16_bf16(PAF(2),VFR(6),o[1],0,0,0), C1,4); \
    GAPB(o[0]=__builtin_amdgcn_mfma_f32_32x32x16_bf16(PAF(3),VFR(3),o[0],0,0,0), C1,8); \
    GAPB(o[1]=__builtin_amdgcn_mfma_f32_32x32x16_bf16(PAF(3),VFR(7),o[1],0,0,0), C1,12); \
    }while(0)
  int t=1;
  #undef CMASK
  #define CMASK(P0,P1,t) do{}while(0)
  for(;t+5<NT;t+=2){
    STEP(pB0,pB1,pA0,pA1,t,true,true,true);     WAIT_BAR(2); RESC(); ROT();
    STEP(pA0,pA1,pB0,pB1,t+1,true,true,true);   WAIT_BAR(2); RESC(); ROT();
  }
  #undef CMASK
  #define CMASK(P0,P1,t) do{}while(0)
  #define ENDW(tt) do{ if((tt)+3<NT){WAIT_BAR(2);} else if((tt)+2<NT){WAIT_BAR(1);} else {WAIT_BAR(0);} }while(0)
  for(;t+1<NT;t+=2){
    STEP(pB0,pB1,pA0,pA1,t,(t+3<NT),(t+1<NT),(t+1<NT));       ENDW(t);   RESC(); ROT();
    STEP(pA0,pA1,pB0,pB1,t+1,(t+4<NT),(t+2<NT),(t+2<NT));     ENDW(t+1); RESC(); ROT();
  }
  STEP(pB0,pB1,pA0,pA1,NT-1,false,false,false); RESC();
  { float sacc=pB0[0]+pB0[1]; _Pragma("unroll") for(int r=2;r<16;++r)sacc+=pB0[r]; _Pragma("unroll") for(int r=0;r<16;++r)sacc+=pB1[r]; l_reg+=sacc;
    pw0=(u32x4){PKW(pB0,0),PKW(pB0,2),PKW(pB0,4),PKW(pB0,6)};pw1=(u32x4){PKW(pB0,8),PKW(pB0,10),PKW(pB0,12),PKW(pB0,14)};pw2=(u32x4){PKW(pB1,0),PKW(pB1,2),PKW(pB1,4),PKW(pB1,6)};pw3=(u32x4){PKW(pB1,8),PKW(pB1,10),PKW(pB1,12),PKW(pB1,14)};
    SBAR(); pv(o,vb0+sl_cur,PAF(0),PAF(1),PAF(2),PAF(3)); }
  #undef PKW
  #undef PAF
  #undef VFR
  #undef PIN
  #undef MX3
  #undef GAPA
  #undef GAPB
  #undef EX
  #undef VRD
  #undef KRD
  #undef STEP
  #undef ENDW
  {auto rr=__builtin_amdgcn_permlane32_swap(__float_as_uint(l_reg),__float_as_uint(l_reg),false,false);l_reg=__uint_as_float(rr[0])+__uint_as_float(rr[1]);}
  if(hi==0)wsf[32+r32]=l_reg;asm volatile("s_waitcnt lgkmcnt(0)":::"memory");
  float rli[16];
  #pragma unroll
  for(int r=0;r<16;++r)rli[r]=__builtin_amdgcn_rcpf(wsf[32+crow(r,hi)]);
  bf16*Ow=O+qrow0*QP+h*D;
  { bf16*stg=(bf16*)(shm+LDS_OST)+wid*2048;
    #pragma unroll
    for(int r=0;r<16;++r){const int orow=crow(r,hi);
      #pragma unroll
      for(int d0=0;d0<2;++d0)stg[orow*64+d0*32+r32]=__float2bfloat16(o[d0][r]*rli[r]);}
    asm volatile("s_waitcnt lgkmcnt(0)":::"memory");
    #pragma unroll
    for(int i=0;i<4;++i){const int row=i*8+(lane>>3),ch=lane&7; const u32x4 v=*(const u32x4*)(stg+row*64+ch*8); ATTN_STORE16(Ow+(long)row*QP+ch*8,v);} }
  asm volatile("s_waitcnt lgkmcnt(0)\n\ts_barrier":::"memory");
  #undef DMA_K
  #undef DMA_V
  #undef CMASK
  #undef START
  #undef RESC
  #undef ROT
}
constexpr int ATTN_LDS_BYTES=LDS_BYTES;
struct AttnTensors { const bf16* Q; const bf16* K; const bf16* V; bf16* O; };
struct AttnUnit { int b; int h; int qb; };
struct StaticOrder {
  int vcu;
  __device__ __forceinline__ explicit StaticOrder(int v):vcu(v){}
  __device__ __forceinline__ bool next(int i,AttnUnit&u)const{ if(i>=8)return false; const int xcd=vcu>>5,lc=vcu&31; const int grp=xcd*4+(i>>1); const int idx=(i&1)*32+lc;
    u.b=grp>>1; u.h=(grp&1)*4+(idx>>4); u.qb=idx&15; return true; }
};
template<class Sched,int THRL=8> __device__ __forceinline__ void attn_phase(char*lds,const AttnTensors&T,const Sched&S){
  AttnUnit u;
  for(int i=0;S.next(i,u);++i){ attn_unit<THRL>(u.b,u.h,u.qb,T.Q,T.K,T.V,T.O,lds); }
}
#undef SBAR
#undef WAIT_BAR
}
#define XB_TMO      128
#define XB_XCNT(j)  (256  + 64 * (j))
#define XB_XSUB(j)  (1280 + 64 * (j))
#define XB_XGEN(j)  (2304 + 64 * (j))
#define XB_TOP      3328
#define XB_TOPGEN   3392
#define XCD_BAR_WORDS 3456
#define XB_SPIN_CAP (1u << 18)

__device__ __forceinline__ unsigned xb_ld(unsigned* p)              { return __hip_atomic_load(p, __ATOMIC_RELAXED, __HIP_MEMORY_SCOPE_AGENT); }
__device__ __forceinline__ unsigned xb_add(unsigned* p, unsigned v) { return __hip_atomic_fetch_add(p, v, __ATOMIC_RELAXED, __HIP_MEMORY_SCOPE_AGENT); }
__device__ __forceinline__ unsigned xb_xcc_id() { return (unsigned)__builtin_amdgcn_s_getreg((3 << 11) | 20) & 0xFu; }
#define XB_SPIN(cond, bar) do { unsigned _sp = 0; while (cond) { __builtin_amdgcn_s_sleep(1); \
    if ((++_sp & 255u) == 0u) { if (xb_ld(&(bar)[XB_TMO])) break; if (_sp > XB_SPIN_CAP) { atomicAdd(&(bar)[XB_TMO], 1u); break; } } } } while (0)

struct XcdBarrier {
    unsigned* bar; unsigned x;
    volatile LAS unsigned* st;
};

__device__ __forceinline__ XcdBarrier xcd_barrier_post(unsigned* bar, volatile LAS unsigned* st) {
    XcdBarrier b; b.bar = bar; b.x = xb_xcc_id(); b.st = st;
    if (threadIdx.x == 0) (void)xb_add(&bar[XB_XCNT(b.x)], 1u);
    return b;
}
__device__ __forceinline__ void xcd_barrier_complete(unsigned* bar, unsigned x, unsigned& nloc, unsigned& nx) {
    const unsigned G = gridDim.x * gridDim.y * gridDim.z;
    unsigned sum, cnt, mine, sp = 0u;
    for (;;) {
        sum = 0u; cnt = 0u; mine = 0u;
#pragma unroll
        for (unsigned j = 0; j < 16; ++j) { const unsigned c = xb_ld(&bar[XB_XCNT(j)]); sum += c; cnt += (c > 0u) ? 1u : 0u; mine = (j == x) ? c : mine; }
        if (sum == G) break;
        __builtin_amdgcn_s_sleep(1);
        if ((++sp & 255u) == 0u) { if (xb_ld(&bar[XB_TMO])) break; if (sp > XB_SPIN_CAP) { atomicAdd(&bar[XB_TMO], 1u); break; } }
    }
    nloc = mine > 0u ? mine : 1u; nx = cnt > 0u ? cnt : 1u;
}

__device__ __forceinline__ void xcd_barrier(const XcdBarrier& b) {
    asm volatile("s_waitcnt vmcnt(0)" ::: "memory");
    __syncthreads();
    if (threadIdx.x == 0) {
        unsigned* bar = b.bar;
        __builtin_amdgcn_s_waitcnt(0);
        unsigned nloc = b.st[0], nx = b.st[1];
        if (nloc == 0u) { xcd_barrier_complete(bar, b.x, nloc, nx); b.st[0] = nloc; b.st[1] = nx; }
        const unsigned old = xb_add(&bar[XB_XSUB(b.x)], 1u);
        const unsigned gen = old / nloc;
        if (old + 1u == (gen + 1u) * nloc) {
            __builtin_amdgcn_fence(__ATOMIC_RELEASE, "agent");
            asm volatile("s_waitcnt vmcnt(0)" ::: "memory");
            const unsigned og = xb_add(&bar[XB_TOP], 1u);
            const unsigned tg = og / nx;
            if (og + 1u == (tg + 1u) * nx) xb_add(&bar[XB_TOPGEN], 1u);
            else XB_SPIN(xb_ld(&bar[XB_TOPGEN]) == tg, bar);
            __builtin_amdgcn_fence(__ATOMIC_ACQUIRE, "agent");
            xb_add(&bar[XB_XGEN(b.x)], 1u);
            asm volatile("s_waitcnt vmcnt(0)" ::: "memory");
        } else {
            XB_SPIN(xb_ld(&bar[XB_XGEN(b.x)]) == gen, bar);
            __builtin_amdgcn_fence(__ATOMIC_ACQUIRE, "agent");
            asm volatile("s_waitcnt vmcnt(0)" ::: "memory");
        }
    }
    __syncthreads();
}


typedef GAS unsigned gu32;
#define RLX_AGENT __ATOMIC_RELAXED, __HIP_MEMORY_SCOPE_AGENT
#define LDS_WAIT() asm volatile("s_waitcnt lgkmcnt(0)" ::: "memory")
#define VM_WAIT() asm volatile("s_waitcnt vmcnt(0)" ::: "memory")
constexpr int N_IN = 34;
enum { I_X = 0, I_C, I_CTX, I_CCTX, I_MODW, I_MODB, I_NORM1, I_WIN, I_QNW, I_KNW, I_CONVW, I_CONVB, I_FW1, I_FB1, I_FW2, I_FB2, I_FW3, I_FB3, I_FW4, I_FFREQ,
       I_HBIAS, I_AONW, I_HONW, I_WOUT, I_NORM2, I_RW, I_RB, I_EG, I_EU, I_ED, I_SG, I_SU, I_SD, I_FNW };
struct Frame {
    LAS unsigned char* lds;
    volatile LAS unsigned* MISC;
    unsigned* ctl;
    int tid, lane, wave, vcu, G;
    float* out; unsigned char* ws;
};
typedef const __attribute__((address_space(4))) char* kargp_t;
__device__ __forceinline__ const float* kin(int i) { kargp_t p = (kargp_t)__builtin_amdgcn_kernarg_segment_ptr(); asm volatile("" : "+s"(p)); return (const float*)*(const GAS float* const __attribute__((address_space(4)))*)(p + 8 * i); }
#define WSP(T, off) ((T*)(F.ws + (off)))

__device__ __forceinline__ void tr_item(const float* W, int ldw, int k0, int n0, bf16_t* WT, int Kd, int drow0, LAS float* scr, int lane) {
#pragma unroll 8
    for (int i = 0; i < 32; ++i) { const int kk = 2 * i + (lane >> 5); scr[kk * 33 + (lane & 31)] = W[(size_t)(k0 + kk) * ldw + n0 + (lane & 31)]; }
    LDS_WAIT(); asm volatile("" ::: "memory");
    const int c = lane & 7;
#pragma unroll
    for (int j = 0; j < 4; ++j) { const int n = (lane >> 3) + 8 * j; const LAS float* s = scr + (8 * c) * 33 + n;
        u32x4 o; o.x = pk2(s[0 * 33], s[1 * 33]); o.y = pk2(s[2 * 33], s[3 * 33]); o.z = pk2(s[4 * 33], s[5 * 33]); o.w = pk2(s[6 * 33], s[7 * 33]);
        *(u32x4*)(WT + (size_t)(drow0 + n) * Kd + k0 + 8 * c) = o; }
    LDS_WAIT(); asm volatile("" ::: "memory");
}
constexpr int IT_FILT = 1024, IT_MODV = 0, IT_ROPE = 1, IT_QKV = 384, IT_WU = 768, IT_WO = 512, IT_WR = 128, IT_SGU = 256, IT_SD = 128, IT_EXP = 256 * 384;
constexpr int IT_TOTAL = IT_FILT + IT_MODV + IT_ROPE + IT_QKV + IT_WU + IT_WO + IT_WR + IT_SGU + IT_SD + IT_EXP;

__device__ __forceinline__ void p0_filter_item(Frame& F, int item) {
    const int lane = F.lane; const int t0 = 4 * item;
    const float* w1 = kin(I_FW1); const float* b1 = kin(I_FB1); const float* w2 = kin(I_FW2); const float* b2 = kin(I_FB2);
    const float* w3 = kin(I_FW3); const float* b3 = kin(I_FB3); const float* w4 = kin(I_FW4); const float fr = kin(I_FFREQ)[lane];
    float z[4], h[4], a[4];
#pragma unroll
    for (int tt = 0; tt < 4; ++tt) { const int t = t0 + tt; float v = 0.f;
        if (lane == 0) v = (float)t * (1.0f / 4095.0f);
        else if (lane < 33) { const int m = (lane - 1) & 15; const float f = 1e-4f + (float)m * ((15.0f - 1e-4f) / 15.0f);
            float rev = f * ((float)t * (1.0f / 4096.0f)); rev -= floorf(rev); const float ang = 6.283185307179586f * rev;
            v = lane <= 16 ? cosf(ang) : -sinf(ang); }
        z[tt] = v; }
    { const float bb = b1[lane];
#pragma unroll
      for (int tt = 0; tt < 4; ++tt) a[tt] = bb;
      for (int i = 0; i < 33; ++i) { const float w = w1[i * 64 + lane];
#pragma unroll
          for (int tt = 0; tt < 4; ++tt) a[tt] += __shfl(z[tt], i) * w; }
#pragma unroll
      for (int tt = 0; tt < 4; ++tt) h[tt] = sinf(fr * a[tt]); }
#pragma unroll
    for (int l = 0; l < 2; ++l) { const float* ww = l == 0 ? w2 : w3; const float bb = (l == 0 ? b2 : b3)[lane];
#pragma unroll
      for (int tt = 0; tt < 4; ++tt) a[tt] = bb;
      for (int i = 0; i < 64; ++i) { const float w = ww[i * 64 + lane];
#pragma unroll
          for (int tt = 0; tt < 4; ++tt) a[tt] += __shfl(h[tt], i) * w; }
#pragma unroll
      for (int tt = 0; tt < 4; ++tt) h[tt] = sinf(fr * a[tt]); }
    bf16_t* KR = WSP(bf16_t, WS_KR);
    const float dmin = logf(1e-2f) / 0.3f, dmax = logf(1e-2f) / 1.5f;
#pragma unroll 1
    for (int qh = 0; qh < 4; ++qh) {
        float o[4][4];
#pragma unroll
        for (int tt = 0; tt < 4; ++tt)
#pragma unroll
            for (int q = 0; q < 4; ++q) o[tt][q] = 0.f;
        for (int i = 0; i < 64; ++i) { float hv[4];
#pragma unroll
            for (int tt = 0; tt < 4; ++tt) hv[tt] = __shfl(h[tt], i);
#pragma unroll
            for (int q = 0; q < 4; ++q) { const float w = w4[i * 1024 + lane + 64 * (4 * qh + q)];
#pragma unroll
                for (int tt = 0; tt < 4; ++tt) o[tt][q] += hv[tt] * w; } }
#pragma unroll
        for (int q = 0; q < 4; ++q) { const int n = lane + 64 * (4 * qh + q); const int c = n & 511; const bool bwd = n >= 512;
            const float delta = fabsf(dmin + (float)c * ((dmax - dmin) / 511.0f));
#pragma unroll
            for (int tt = 0; tt < 4; ++tt) { const int t = t0 + tt; const float tl = (float)t * (1.0f / 4095.0f);
                const float val = o[tt][q] * expf(-tl * delta);
                if (!(bwd && t == 0)) KR[(size_t)c * 8192 + (bwd ? 4096 + t : 4096 - t)] = (bf16_t)f2bf(val); } }
    }
}
__device__ __forceinline__ void p0_modv_block(Frame& F, int chunk) {
    const int lane = F.lane, kc = F.wave; const int n0 = 64 * chunk, k0 = 128 * kc;
    LAS float* sv = (LAS float*)(F.lds + RING_OFF + F.wave * 8704);
    LAS float* part = (LAS float*)(F.lds + RING_OFF + 8 * 8704);
    for (int r = 0; r < 17; ++r)
#pragma unroll
        for (int hh = 0; hh < 2; ++hh) { const int kk = lane + 64 * hh; const float v = r < 16 ? kin(I_C)[r * 1024 + k0 + kk] : kin(I_CCTX)[k0 + kk];
            sv[r * 128 + kk] = v / (1.0f + expf(-v)); }
    LDS_WAIT(); asm volatile("" ::: "memory");
    float acc[17];
#pragma unroll
    for (int r = 0; r < 17; ++r) acc[r] = 0.f;
    const float* W = kin(I_MODW) + (size_t)k0 * 6144 + n0 + lane;
    for (int k4 = 0; k4 < 32; ++k4) {
        const float w0 = W[(size_t)(4 * k4 + 0) * 6144], w1 = W[(size_t)(4 * k4 + 1) * 6144], w2 = W[(size_t)(4 * k4 + 2) * 6144], w3 = W[(size_t)(4 * k4 + 3) * 6144];
#pragma unroll
        for (int r = 0; r < 17; ++r) { const f32x4 s = *(const LAS f32x4*)(sv + r * 128 + 4 * k4); acc[r] += (s[0] * w0 + s[1] * w1) + (s[2] * w2 + s[3] * w3); }
    }
#pragma unroll
    for (int r = 0; r < 17; ++r) part[(kc * 17 + r) * 64 + lane] = acc[r];
    __syncthreads();
    if (F.wave == 0) { float* mv = WSP(float, WS_MODV); const float bb = kin(I_MODB)[n0 + lane];
#pragma unroll
        for (int r = 0; r < 17; ++r) { float s = bb;
#pragma unroll
            for (int k = 0; k < 8; ++k) s += part[(k * 17 + r) * 64 + lane];
            mv[r * 6144 + n0 + lane] = s; } }
    __syncthreads();
}
__device__ __forceinline__ void p0_prologue(Frame& F) {
    LAS float* scr = (LAS float*)(F.lds + RING_OFF + F.wave * 16384);
    const int gw = F.vcu * NWAVES + F.wave, NGW = F.G * NWAVES; const int lane = F.lane;
    __syncthreads();
    for (int ch = F.vcu; ch < 96; ch += F.G) p0_modv_block(F, ch);
    for (int it = gw; it < IT_TOTAL; it += NGW) {
        int r = it;
        if (r < IT_FILT) { p0_filter_item(F, r); continue; } r -= IT_FILT;
        if (r < IT_ROPE) { f32x2* rope = WSP(f32x2, WS_ROPE);
            for (int idx = lane; idx < 1024; idx += 64) { const int pos = idx >> 4, f = idx & 15; const float inv = powf(10000.0f, -(float)f / 16.0f); const float ang = (float)pos * inv;
                rope[idx] = (f32x2){cosf(ang), sinf(ang)}; }
            continue; } r -= IT_ROPE;
        if (r < IT_QKV) { const int cb = r >> 4, kb = r & 15, n0 = 32 * cb; const int pn = n0 >> 8, hl = (n0 & 255) >> 6, dh = (n0 & 63) >> 5;
            tr_item(kin(I_WIN), 2304, 64 * kb, n0, WSP(bf16_t, WS_WQKV), 1024, 256 * pn + 128 * dh + 32 * hl, scr, lane); continue; } r -= IT_QKV;
        if (r < IT_WU) { const int cb = r >> 4, kb = r & 15; tr_item(kin(I_WIN), 2304, 64 * kb, 768 + 32 * cb, WSP(bf16_t, WS_WU), 1024, 32 * cb, scr, lane); continue; } r -= IT_WU;
        if (r < IT_WO) { const int cb = r >> 4, kb = r & 15; tr_item(kin(I_WOUT), 1024, 64 * kb, 32 * cb, WSP(bf16_t, WS_WO), 1024, 32 * cb, scr, lane); continue; } r -= IT_WO;
        if (r < IT_WR) { const int cb = r >> 4, kb = r & 15; tr_item(kin(I_RW), 256, 64 * kb, 32 * cb, WSP(bf16_t, WS_WR), 1024, 32 * cb, scr, lane); continue; } r -= IT_WR;
        if (r < IT_SGU) { const int which = r >> 7, rr = r & 127, cb = rr >> 4, kb = rr & 15, j0 = 32 * cb;
            tr_item(kin(which ? I_SU : I_SG), 256, 64 * kb, j0, WSP(bf16_t, WS_WSGU), 1024, 256 * (j0 >> 7) + 128 * which + (j0 & 127), scr, lane); continue; } r -= IT_SGU;
        if (r < IT_SD) { const int kb = r & 3, cb = r >> 2; tr_item(kin(I_SD), 1024, 64 * kb, 32 * cb, WSP(bf16_t, WS_WSD), 256, 32 * cb, scr, lane); continue; } r -= IT_SD;
        { const int e = r / 384, q = r % 384;
          if (q < 256) { const int which = q >> 7, rr = q & 127, cb = rr >> 4, kb = rr & 15, j0 = 32 * cb;
              tr_item(kin(which ? I_EU : I_EG) + (size_t)e * (1024 * 256), 256, 64 * kb, j0, WSP(bf16_t, WS_WGU) + (size_t)e * (512 * 1024), 1024, 256 * (j0 >> 7) + 128 * which + (j0 & 127), scr, lane); }
          else { const int rr = q - 256, kb = rr & 3, cb = rr >> 2;
              tr_item(kin(I_ED) + (size_t)e * (256 * 1024), 1024, 64 * kb, 32 * cb, WSP(bf16_t, WS_WD) + (size_t)e * (1024 * 256), 256, 32 * cb, scr, lane); } }
    }
}

__device__ __forceinline__ void modulate_rows(Frame& F, const float* src, bf16_t* dst, int row0, int nrows, const float* nw, const float* sc, const float* sh) {
    f32x4 A[4], Bv[4];
#pragma unroll
    for (int j = 0; j < 4; ++j) { const int c = 4 * F.lane + 256 * j; const f32x4 n4 = *(const f32x4*)(nw + c), s4 = *(const f32x4*)(sc + c); A[j] = n4 * (s4 + 1.0f); Bv[j] = *(const f32x4*)(sh + c); }
    for (int r = 0; r < nrows; ++r) {
        const f32x4* xr = (const f32x4*)(src + (size_t)(row0 + r) * DM) + F.lane;
        f32x4 v[4]; float ss = 0.f;
#pragma unroll
        for (int j = 0; j < 4; ++j) { v[j] = xr[64 * j]; ss += (v[j][0] * v[j][0] + v[j][1] * v[j][1]) + (v[j][2] * v[j][2] + v[j][3] * v[j][3]); }
        const float rs = rsqrtf(wave_sum(ss) * (1.0f / DM) + EPS);
        u32x2* o8 = (u32x2*)(dst + (size_t)(row0 + r) * DM) + F.lane;
#pragma unroll
        for (int j = 0; j < 4; ++j) { const f32x4 o = v[j] * rs * A[j] + Bv[j]; u32x2 w; w.x = pk2(o[0], o[1]); w.y = pk2(o[2], o[3]); o8[64 * j] = w; }
    }
}

constexpr unsigned HY_SK_PACKED = 0xCB885410u;
__device__ __forceinline__ void hyena_unit(Frame& F, int c) {
    const int tid = F.tid, lane = F.lane, wid = F.wave;
    LAS unsigned char* Lc = F.lds + RING_OFF;
    const bf16_t* UT = WSP(const bf16_t, WS_UT);
    bf16_t* Wg = WSP(bf16_t, WS_HYW) + (size_t)c * MTOK;
    bf16_t* Xg = WSP(bf16_t, WS_HYX) + (size_t)c * MTOK;
    {
        const u32x4* src = (const u32x4*)(WSP(const bf16_t, WS_KR) + (size_t)c * 8192);
#pragma unroll
        for (int i = 0; i < 2; ++i) { const int jc = tid + 512 * i; const u32x4 lo = src[jc]; const u32x4 hi = jc < 1023 ? src[jc + 1] : (u32x4){0u, 0u, 0u, 0u};
            const unsigned w[8] = {lo.x, lo.y, lo.z, lo.w, hi.x, hi.y, hi.z, hi.w};
#pragma unroll
            for (int cc = 0; cc < 8; ++cc) { u32x4 o;
#pragma unroll
                for (int k = 0; k < 4; ++k) { const int idx = (cc >> 1) + k; o[k] = (cc & 1) ? __builtin_amdgcn_alignbyte(w[idx + 1], w[idx], 2u) : w[idx]; }
                *(LAS u32x4*)(Lc + cc * 16384 + 16 * ((HY_SK_PACKED >> (4 * cc)) & 15u) + 16 * jc) = o; } }
    }
    const float* cw = kin(I_CONVW); const float* cb = kin(I_CONVB);
    {
        const bf16_t* vrow = UT + (size_t)(1024 + c) * MTOK; const bf16_t* x1row = UT + (size_t)(512 + c) * MTOK; const bf16_t* x0row = UT + (size_t)c * MTOK;
        const float v0 = cw[1024 + c], v1 = cw[1536 + 1024 + c], v2 = cw[3072 + 1024 + c], vb = cb[1024 + c];
        const float a0 = cw[512 + c], a1 = cw[1536 + 512 + c], a2 = cw[3072 + 512 + c], ab = cb[512 + c];
        const float g0 = cw[c], g1 = cw[1536 + c], g2 = cw[3072 + c], gb = cb[c];
        const int s0 = tid * 8;
#pragma unroll 4
        for (int it = 0; it < 16; ++it) {
            const size_t base = (size_t)it * SEQ + s0;
            const u32x4 vv = *(const u32x4*)(vrow + base), xx = *(const u32x4*)(x1row + base), gg = *(const u32x4*)(x0row + base);
            float ve[10], xe[10], ge[10];
            ve[0] = s0 > 0 ? bf2f(vrow[base - 1]) : 0.f; xe[0] = s0 > 0 ? bf2f(x1row[base - 1]) : 0.f; ge[0] = s0 > 0 ? bf2f(x0row[base - 1]) : 0.f;
            ve[9] = s0 + 8 < SEQ ? bf2f(vrow[base + 8]) : 0.f; xe[9] = s0 + 8 < SEQ ? bf2f(x1row[base + 8]) : 0.f; ge[9] = s0 + 8 < SEQ ? bf2f(x0row[base + 8]) : 0.f;
#pragma unroll
            for (int j = 0; j < 4; ++j) { ve[1 + 2 * j] = bf2f(vv[j] & 0xffffu); ve[2 + 2 * j] = bf2f(vv[j] >> 16); xe[1 + 2 * j] = bf2f(xx[j] & 0xffffu); xe[2 + 2 * j] = bf2f(xx[j] >> 16);
                ge[1 + 2 * j] = bf2f(gg[j] & 0xffffu); ge[2 + 2 * j] = bf2f(gg[j] >> 16); }
            float w[8], g[8];
#pragma unroll
            for (int j = 0; j < 8; ++j) { w[j] = (v0 * ve[j] + v1 * ve[j + 1] + v2 * ve[j + 2] + vb) * (a0 * xe[j] + a1 * xe[j + 1] + a2 * xe[j + 2] + ab); g[j] = g0 * ge[j] + g1 * ge[j + 1] + g2 * ge[j + 2] + gb; }
            u32x4 o; o.x = pk2(w[0], w[1]); o.y = pk2(w[2], w[3]); o.z = pk2(w[4], w[5]); o.w = pk2(w[6], w[7]);
            *(u32x4*)(Wg + (size_t)(tid * 16 + it) * 8) = o;
            u32x4 p; p.x = pk2(g[0], g[1]); p.y = pk2(g[2], g[3]); p.z = pk2(g[4], g[5]); p.w = pk2(g[6], g[7]);
            *(u32x4*)(Xg + base) = p;
        }
    }
    VM_WAIT(); __syncthreads();
    const float hb = kin(I_HBIAS)[c];
    bf16_t* yrow = WSP(bf16_t, WS_YT) + (size_t)c * MTOK;
    const int li = lane & 15, lg = lane >> 4;
#pragma unroll 1
    for (int pass = 0; pass < 2; ++pass) {
        const int T0 = (pass * 8 + wid) * 256;
        f32x4 acc[16]; bf16x8 AF[16], Bf[8];
#pragma unroll
        for (int q = 0; q < 16; ++q) acc[q] = (f32x4){0.f, 0.f, 0.f, 0.f};
        const int xbase = 4096 - T0 - li + 8 * lg; const int cl = xbase & 7;
        const LAS unsigned char* pA = Lc + cl * 16384 + 16 * (int)((HY_SK_PACKED >> (4 * cl)) & 15u) + 2 * (xbase - cl);
        const bf16x8* Bg = (const bf16x8*)Wg + lg * 16 + li;
#define HY_LOADA(dst, q) dst = *(const LAS bf16x8*)(pA - 32 * (q))
#pragma unroll
        for (int q = 0; q < 16; ++q) HY_LOADA(AF[q], q);
#pragma unroll
        for (int v = 0; v < 8; ++v) Bf[v] = Bg[64 * v];
#pragma unroll 1
        for (int S8 = 0; S8 < 128; S8 += 8) {
#pragma unroll
            for (int v = 0; v < 8; ++v) { const int S = S8 + v;
#pragma unroll
                for (int tau = 15; tau >= 0; --tau) acc[tau] = __builtin_amdgcn_mfma_f32_16x16x32_bf16(AF[(tau - 2 * v) & 15], Bf[v], acc[tau], 0, 0, 0);
                if (S + 8 < 128) Bf[v] = Bg[64 * (S + 8)];
                if (S + 1 < 128) { HY_LOADA(AF[(-2 * (v + 1)) & 15], -2 * (S + 1)); HY_LOADA(AF[(-2 * (v + 1) + 1) & 15], -2 * (S + 1) + 1); }
            }
        }
#undef HY_LOADA
        u32x2 wv[16], xv[16];
#pragma unroll
        for (int tau = 0; tau < 16; ++tau) { const int t = T0 + 16 * tau + 4 * lg;
            wv[tau] = *(const u32x2*)(Wg + (size_t)((t >> 3) * 16 + li) * 8 + (t & 7)); xv[tau] = *(const u32x2*)(Xg + (size_t)li * SEQ + t); }
#pragma unroll
        for (int tau = 0; tau < 16; ++tau) { const int t = T0 + 16 * tau + 4 * lg;
            const float we[4] = {bf2f(wv[tau].x & 0xffffu), bf2f(wv[tau].x >> 16), bf2f(wv[tau].y & 0xffffu), bf2f(wv[tau].y >> 16)};
            const float xe[4] = {bf2f(xv[tau].x & 0xffffu), bf2f(xv[tau].x >> 16), bf2f(xv[tau].y & 0xffffu), bf2f(xv[tau].y >> 16)};
            float z[4];
#pragma unroll
            for (int j = 0; j < 4; ++j) z[j] = (acc[tau][j] + hb * we[j]) * xe[j];
            u32x2 o; o.x = pk2(z[0], z[1]); o.y = pk2(z[2], z[3]); *(u32x2*)(yrow + (size_t)li * SEQ + t) = o; }
    }
    __syncthreads();
}

__device__ __forceinline__ void p4_norm_tile(Frame& F, int it) {
    const int lane = F.lane, wid = F.wave, tid = F.tid; const int m0 = it * 64;
    bf16_t* AY = WSP(bf16_t, WS_AY); const bf16_t* A = WSP(const bf16_t, WS_AO); const bf16_t* YT = WSP(const bf16_t, WS_YT);
    constexpr int TP = 520;
    LAS bf16_t* T2 = (LAS bf16_t*)(F.lds + RING_OFF);
    {
        const u32x4* src = (const u32x4*)(YT + (size_t)tid * MTOK + m0);
#pragma unroll
        for (int i = 0; i < 8; ++i) { const u32x4 v = src[i];
#pragma unroll
            for (int j = 0; j < 4; ++j) { T2[(8 * i + 2 * j) * TP + tid] = (bf16_t)(v[j] & 0xffffu); T2[(8 * i + 2 * j + 1) * TP + tid] = (bf16_t)(v[j] >> 16); } }
    }
    { const float* gw = kin(I_AONW) + 8 * lane; const f32x4 g0 = *(const f32x4*)gw, g1 = *(const f32x4*)(gw + 4);
      for (int r = 0; r < 8; ++r) { const int row = m0 + wid * 8 + r; const u32x4 v = *(const u32x4*)(A + (size_t)row * AW + 8 * lane);
          float e[8]; float ss = 0.f;
#pragma unroll
          for (int j = 0; j < 4; ++j) { e[2 * j] = bf2f(v[j] & 0xffffu); e[2 * j + 1] = bf2f(v[j] >> 16); ss += e[2 * j] * e[2 * j] + e[2 * j + 1] * e[2 * j + 1]; }
          const float rs = rsqrtf(wave_sum(ss) * (1.0f / 512.0f) + EPS);
          u32x4 o; o.x = pk2(e[0] * rs * g0[0], e[1] * rs * g0[1]); o.y = pk2(e[2] * rs * g0[2], e[3] * rs * g0[3]); o.z = pk2(e[4] * rs * g1[0], e[5] * rs * g1[1]); o.w = pk2(e[6] * rs * g1[2], e[7] * rs * g1[3]);
          *(u32x4*)(AY + (size_t)row * DM + 8 * lane) = o; } }
    __syncthreads();
    { const float* gw = kin(I_HONW) + 8 * lane; const f32x4 g0 = *(const f32x4*)gw, g1 = *(const f32x4*)(gw + 4);
      for (int r = 0; r < 8; ++r) { const int tl = wid * 8 + r; const u32x4 v = *(const LAS u32x4*)(T2 + tl * TP + 8 * lane);
          float e[8]; float ss = 0.f;
#pragma unroll
          for (int j = 0; j < 4; ++j) { e[2 * j] = bf2f(v[j] & 0xffffu); e[2 * j + 1] = bf2f(v[j] >> 16); ss += e[2 * j] * e[2 * j] + e[2 * j + 1] * e[2 * j + 1]; }
          const float rs = rsqrtf(wave_sum(ss) * (1.0f / 512.0f) + EPS);
          u32x4 o; o.x = pk2(e[0] * rs * g0[0], e[1] * rs * g0[1]); o.y = pk2(e[2] * rs * g0[2], e[3] * rs * g0[3]); o.z = pk2(e[4] * rs * g1[0], e[5] * rs * g1[1]); o.w = pk2(e[6] * rs * g1[2], e[7] * rs * g1[3]);
          *(u32x4*)(AY + (size_t)(m0 + tl) * DM + 512 + 8 * lane) = o; } }
    __syncthreads();
}

__device__ __forceinline__ void p8_route_token(Frame& F, int t) {
    const int lane = F.lane;
    const f32x4 lg = *(const f32x4*)(WSP(const float, WS_LOGIT) + (size_t)t * NE + 4 * lane);
    const f32x4 rb = *(const f32x4*)(kin(I_RB) + 4 * lane);
    float s[4], val[4];
#pragma unroll
    for (int j = 0; j < 4; ++j) { s[j] = 1.0f / (1.0f + expf(-lg[j])); val[j] = s[j] + rb[j]; }
    float a1 = fmaxf(val[0], val[1]), a2 = fminf(val[0], val[1]);
#pragma unroll
    for (int j = 2; j < 4; ++j) { const float x = val[j]; a2 = fmaxf(a2, fminf(a1, x)); a1 = fmaxf(a1, x); }
#pragma unroll
    for (int off = 1; off < 8; off <<= 1) { const float b1 = __shfl_xor(a1, off), b2 = __shfl_xor(a2, off); const float n1 = fmaxf(a1, b1), n2 = fmaxf(fminf(a1, b1), fmaxf(a2, b2)); a1 = n1; a2 = n2; }
    const float gs = a1 + a2; const int mg = lane >> 3; int rank = 0;
#pragma unroll
    for (int j = 0; j < 8; ++j) { const float gj = __shfl(gs, 8 * j); rank += (gj > gs || (gj == gs && j < mg)) ? 1 : 0; }
    if (rank >= 4) {
#pragma unroll
        for (int j = 0; j < 4; ++j) val[j] = -INFINITY; }
    int se[8]; float sw[8]; float wsum = 0.f;
#pragma unroll
    for (int k = 0; k < 8; ++k) {
        float bv = val[0]; int bi = 4 * lane;
#pragma unroll
        for (int j = 1; j < 4; ++j) if (val[j] > bv) { bv = val[j]; bi = 4 * lane + j; }
#pragma unroll
        for (int off = 1; off < 64; off <<= 1) { const float ov = __shfl_xor(bv, off); const int oi = __shfl_xor(bi, off); if (ov > bv || (ov == bv && oi < bi)) { bv = ov; bi = oi; } }
        const int jj = bi & 3; const float mine = jj == 0 ? s[0] : jj == 1 ? s[1] : jj == 2 ? s[2] : s[3];
        const float sk = __shfl(mine, bi >> 2);
        if (lane == (bi >> 2)) {
#pragma unroll
            for (int j = 0; j < 4; ++j) if (j == jj) val[j] = -INFINITY; }
        se[k] = bi; sw[k] = sk; wsum += sk;
    }
    int e = se[0]; float w = sw[0];
#pragma unroll
    for (int k = 1; k < 8; ++k) if (lane == k) { e = se[k]; w = sw[k]; }
    unsigned* list = WSP(unsigned, WS_LIST);
    if (lane < 8) {
        w = w / wsum * 2.5f;
        const unsigned rk = __hip_atomic_fetch_add(F.ctl + CW_CNT + 32 * e, 1u, RLX_AGENT);
        list[(size_t)e * 65536 + rk] = ((unsigned)t << 16) | f2bf(w);
        WSP(unsigned, WS_ASSIGN)[(size_t)t * 8 + lane] = ((unsigned)e << 16) | rk;
    } else if (lane == 8) list[(size_t)256 * 65536 + t] = ((unsigned)t << 16) | 0x3F80u;
}

__device__ __forceinline__ MoeTab moe_tables(Frame& F) {
    LAS int* tp = (LAS int*)(F.lds + AUX_OFF + AUX_TP); LAS int* cnt = (LAS int*)(F.lds + AUX_OFF + AUX_CNT);
    __syncthreads();
    if (F.tid < 257) cnt[F.tid] = F.tid < 256 ? (int)__hip_atomic_load(F.ctl + CW_CNT + 32 * F.tid, RLX_AGENT) : MTOK;
    __syncthreads();
    if (F.tid < 258) { int run = 0; for (int j = 0; j < F.tid && j < 257; ++j) run += (cnt[j] + 255) >> 8; tp[F.tid] = run; }
    __syncthreads();
    MoeTab t; t.tp = tp; t.cnt = cnt; return t;
}

template <int HP> __device__ __forceinline__ void combine_token(Frame& F, const MoeTab& tab, int t) {
    const int lane = F.lane; const int b = t >> 12;
    const unsigned* asg = WSP(const unsigned, WS_ASSIGN) + (size_t)t * 8; const bf16_t* SLOT = WSP(const bf16_t, WS_SLOT);
    float a[8];
#pragma unroll
    for (int j = 0; j < 8; ++j) a[j] = 0.f;
#pragma unroll
    for (int k = 0; k < 8; ++k) { const unsigned av = asg[k]; const int e = av >> 16, rk = av & 0xffffu; const size_t R = (size_t)tab.tp[e] * 256 + rk;
        const u32x4 v = *(const u32x4*)(SLOT + R * 512 + 8 * lane);
#pragma unroll
        for (int j = 0; j < 4; ++j) { a[2 * j] += bf2f(v[j] & 0xffffu); a[2 * j + 1] += bf2f(v[j] >> 16); } }
    float* orow = F.out + (size_t)t * DM + 512 * HP + 8 * lane;
    const float* g2 = WSP(const float, WS_MODV) + (size_t)b * 6144 + 5 * 1024 + 512 * HP + 8 * lane;
    f32x4 x0 = *(const f32x4*)orow, x1 = *(const f32x4*)(orow + 4); const f32x4 g0 = *(const f32x4*)g2, g1 = *(const f32x4*)(g2 + 4);
    x0 = x0 + g0 * (f32x4){a[0], a[1], a[2], a[3]}; x1 = x1 + g1 * (f32x4){a[4], a[5], a[6], a[7]};
    float ss = (x0[0] * x0[0] + x0[1] * x0[1]) + (x0[2] * x0[2] + x0[3] * x0[3]) + (x1[0] * x1[0] + x1[1] * x1[1]) + (x1[2] * x1[2] + x1[3] * x1[3]);
    ss = wave_sum(ss);
    float* SS = WSP(float, WS_SS);
    if (HP == 0) { *(f32x4*)orow = x0; *(f32x4*)(orow + 4) = x1; if (lane == 0) SS[t] = ss; }
    else {
        const float rs = rsqrtf((ss + SS[t]) * (1.0f / DM) + EPS);
        const float* fw = kin(I_FNW) + 8 * lane;
        *(f32x4*)orow = x0 * rs * *(const f32x4*)(fw + 512); *(f32x4*)(orow + 4) = x1 * rs * *(const f32x4*)(fw + 516);
        float* o0 = F.out + (size_t)t * DM + 8 * lane;
        const f32x4 y0 = *(const f32x4*)o0, y1 = *(const f32x4*)(o0 + 4);
        *(f32x4*)o0 = y0 * rs * *(const f32x4*)fw; *(f32x4*)(o0 + 4) = y1 * rs * *(const f32x4*)(fw + 4);
    }
}

constexpr int N_LAUNCHES = MK_N_LAUNCHES;
static_assert(N_LAUNCHES == 1 || N_LAUNCHES == NPHASE, "MK_N_LAUNCHES must be 1 or 14");
struct Args { const float* in[N_IN]; float* out; unsigned char* ws; int ph_lo, ph_hi; };
__global__ void __launch_bounds__(NWAVES * 64, 2) fwd_kernel(Args args) {
    extern __shared__ __attribute__((aligned(16))) unsigned char lds[];
    Frame F;
    F.lds = (LAS unsigned char*)lds;
    F.MISC = (volatile LAS unsigned*)(F.lds + MISC_OFF);
    F.tid = threadIdx.x; F.lane = F.tid & 63; F.wave = __builtin_amdgcn_readfirstlane(F.tid >> 6);
    F.G = gridDim.x; { const int bx = blockIdx.x; F.vcu = (F.G % 8 == 0) ? (bx % 8) * (F.G / 8) + bx / 8 : bx; }
    F.out = args.out; F.ws = args.ws; F.ctl = (unsigned*)(args.ws + WS_CTL);
    if (F.tid < 128) ((LAS unsigned*)(F.lds + MISC_OFF))[F.tid] = 0u;
    __syncthreads();
    XcdBarrier bar; bar.bar = F.ctl + CW_BAR; bar.x = 0; bar.st = nullptr;
    if (N_LAUNCHES == 1) bar = xcd_barrier_post(F.ctl + CW_BAR, F.MISC + 8);
#define GRID_BAR() do { if (N_LAUNCHES == 1) xcd_barrier(bar); } while (0)
    const int lo = args.ph_lo, hi = args.ph_hi;
#ifndef PHASE_MASK
#define PHASE_MASK 0x3fff
#endif
#define IN(k) ((((PHASE_MASK) >> (k)) & 1) && lo <= (k) && (k) < hi)
#ifndef PHASE_DUP
#define PHASE_DUP 0
#endif
#define REPS(k) ((((PHASE_DUP) >> (k)) & 1) ? 2 : 1)
#define SEAM(k) do { if (IN(k) && IN((k) + 1)) GRID_BAR(); } while (0)
#define PHASE_ENTER() do { int t_ = threadIdx.x; asm volatile("" : "+v"(t_)); F.tid = t_; F.lane = t_ & 63; GAS unsigned char* w_ = (GAS unsigned char*)args.ws; GAS float* o_ = (GAS float*)args.out; asm volatile("" : "+s"(w_), "+s"(o_)); F.ws = (unsigned char*)w_; F.out = (float*)o_; F.ctl = (unsigned*)(F.ws + WS_CTL); } while (0)
    const int gw = F.vcu * NWAVES + F.wave, NGW = F.G * NWAVES;
#define modv WSP(const float, WS_MODV)
    LAS unsigned char* ring = F.lds + RING_OFF;
    LAS unsigned* idxw = (LAS unsigned*)(F.lds + AUX_OFF + AUX_IDX + F.wave * 1024);

    if (IN(0)) for (int rep_ = 0; rep_ < REPS(0); ++rep_) { PHASE_ENTER(); p0_prologue(F); }
    SEAM(0);
    if (IN(1)) for (int rep_ = 0; rep_ < REPS(1); ++rep_) { PHASE_ENTER();
        for (int rb = gw; rb < MTOK / 32; rb += NGW) { const int row0 = rb * 32; const int b = row0 >> 12;
            modulate_rows(F, kin(I_X), WSP(bf16_t, WS_H), row0, 32, kin(I_NORM1), modv + (size_t)b * 6144 + 1024, modv + (size_t)b * 6144); }
        for (int rb = gw; rb < MCTX / 2; rb += NGW)
            modulate_rows(F, kin(I_CTX), WSP(bf16_t, WS_HC), rb * 2, 2, kin(I_NORM1), modv + (size_t)16 * 6144 + 1024, modv + (size_t)16 * 6144);
    }
    SEAM(1);
    if (IN(2)) for (int rep_ = 0; rep_ < REPS(2); ++rep_) { PHASE_ENTER();
        { SchedQKV S{WSP(const bf16_t, WS_H), (long)WS_HC - (long)WS_H, WSP(const bf16_t, WS_WQKV), F.G, F.vcu};
          EpiQKV E{WSP(bf16_t, WS_Q), WSP(bf16_t, WS_K), WSP(bf16_t, WS_V), kin(I_QNW), kin(I_KNW), WSP(const f32x2, WS_ROPE)};
          pg8::gemm_phase<EpiQKV, SchedQKV, false, true>(ring, idxw, DM, S, E); }
        { SchedDense S{WSP(const bf16_t, WS_WU), WSP(const bf16_t, WS_H), DM, 6, MTOK / 256, F.G, F.vcu, true};
          EpiPlainBf16 E{WSP(bf16_t, WS_UT), (size_t)MTOK};
          pg8::gemm_phase<EpiPlainBf16, SchedDense, false, true>(ring, idxw, DM, S, E); }
    }
    SEAM(2);
    if (IN(3)) for (int rep_ = 0; rep_ < REPS(3); ++rep_) { PHASE_ENTER();
        const attn_body::AttnTensors AT{WSP(const attn_body::bf16, WS_Q), WSP(const attn_body::bf16, WS_K), WSP(const attn_body::bf16, WS_V), WSP(attn_body::bf16, WS_AO)};
        const attn_body::StaticOrder S(F.vcu);
        for (int r2_ = 0; r2_ < REPS(14); ++r2_) attn_body::attn_phase<attn_body::StaticOrder>((char*)lds + RING_OFF, AT, S);
        __syncthreads();
        for (int r2_ = 0; r2_ < REPS(15); ++r2_) for (int c = F.vcu; c < HW; c += F.G) hyena_unit(F, c);
    }
    SEAM(3);
    if (IN(4)) for (int rep_ = 0; rep_ < REPS(4); ++rep_) { PHASE_ENTER(); for (int it = F.vcu; it < MTOK / 64; it += F.G) p4_norm_tile(F, it); }
    SEAM(4);
    if (IN(5)) for (int rep_ = 0; rep_ < REPS(5); ++rep_) { PHASE_ENTER();
        SchedDense S{WSP(const bf16_t, WS_AY), WSP(const bf16_t, WS_WO), DM, MTOK / 256, 4, F.G, F.vcu, false};
        EpiOutProj E{kin(I_X), F.out, modv};
        pg8::gemm_phase<EpiOutProj, SchedDense, false, true>(ring, idxw, DM, S, E);
    }
    SEAM(5);
    if (IN(6)) for (int rep_ = 0; rep_ < REPS(6); ++rep_) { PHASE_ENTER();
        for (int rb = gw; rb < MTOK / 32; rb += NGW) { const int row0 = rb * 32; const int b = row0 >> 12;
            modulate_rows(F, F.out, WSP(bf16_t, WS_H), row0, 32, kin(I_NORM2), modv + (size_t)b * 6144 + 4 * 1024, modv + (size_t)b * 6144 + 3 * 1024); }
    }
    SEAM(6);
    if (IN(7)) for (int rep_ = 0; rep_ < REPS(7); ++rep_) { PHASE_ENTER();
        SchedDense S{WSP(const bf16_t, WS_H), WSP(const bf16_t, WS_WR), DM, MTOK / 256, 1, F.G, F.vcu, false};
        EpiF32 E{WSP(float, WS_LOGIT), (size_t)NE};
        pg8::gemm_phase<EpiF32, SchedDense, false, true>(ring, idxw, DM, S, E);
    }
    SEAM(7);
    if (IN(8)) for (int rep_ = 0; rep_ < REPS(8); ++rep_) { PHASE_ENTER(); for (int rb = gw; rb < MTOK / 32; rb += NGW) for (int r = 0; r < 32; ++r) p8_route_token(F, rb * 32 + r); }
    SEAM(8);
    if (IN(9)) for (int rep_ = 0; rep_ < REPS(9); ++rep_) { PHASE_ENTER();
        const MoeTab tab = moe_tables(F);
        SchedGU S{WSP(const bf16_t, WS_H), WSP(const bf16_t, WS_WGU), WSP(const bf16_t, WS_WSGU), WSP(const unsigned, WS_LIST), tab, F.G, F.vcu};
        EpiGU E{WSP(bf16_t, WS_ACT), WSP(const unsigned, WS_LIST), tab};
        pg8::gemm_phase<EpiGU, SchedGU, true, true>(ring, idxw, DM, S, E);
    }
    SEAM(9);
    if (IN(10)) for (int rep_ = 0; rep_ < REPS(10); ++rep_) { PHASE_ENTER();
        const MoeTab tab = moe_tables(F);
        SchedDown S{WSP(const bf16_t, WS_ACT), WSP(const bf16_t, WS_WD), WSP(const bf16_t, WS_WSD), tab, 0, F.G, F.vcu};
        EpiDown E{WSP(bf16_t, WS_SLOT), F.out, modv, tab};
        pg8::gemm_phase<EpiDown, SchedDown, false, true>(ring, idxw, FF, S, E);
    }
    SEAM(10);
    if (IN(11)) for (int rep_ = 0; rep_ < REPS(11); ++rep_) { PHASE_ENTER(); const MoeTab tab = moe_tables(F); for (int rb = gw; rb < MTOK / 32; rb += NGW) for (int r = 0; r < 32; ++r) combine_token<0>(F, tab, rb * 32 + r); }
    SEAM(11);
    if (IN(12)) for (int rep_ = 0; rep_ < REPS(12); ++rep_) { PHASE_ENTER();
        const MoeTab tab = moe_tables(F);
        SchedDown S{WSP(const bf16_t, WS_ACT), WSP(const bf16_t, WS_WD), WSP(const bf16_t, WS_WSD), tab, 1, F.G, F.vcu};
        EpiDown E{WSP(bf16_t, WS_SLOT), F.out, modv, tab};
        pg8::gemm_phase<EpiDown, SchedDown, false, true>(ring, idxw, FF, S, E);
    }
    SEAM(12);
    if (IN(13)) for (int rep_ = 0; rep_ < REPS(13); ++rep_) { PHASE_ENTER(); const MoeTab tab = moe_tables(F); for (int rb = gw; rb < MTOK / 32; rb += NGW) for (int r = 0; r < 32; ++r) combine_token<1>(F, tab, rb * 32 + r); }
#undef modv
#undef PHASE_ENTER
#undef IN
#undef SEAM
#undef GRID_BAR
}

extern "C" void kernel_launch(void* const* d_in, const int* in_sizes, int n_in, void* d_out, int out_size, void* d_ws, size_t ws_size, hipStream_t stream) {
    static int grid = 0;
    if (grid == 0) {
        if (n_in != N_IN || in_sizes[0] != MTOK * DM || out_size != MTOK * DM || ws_size < WS_END) {
            fprintf(stderr, "kernel_launch: unexpected problem (n_in %d, in0 %d, out %d, ws %zu < %zu); nothing launched\n", n_in, n_in > 0 ? in_sizes[0] : -1, out_size, ws_size, (size_t)WS_END); grid = -1; return; }
        int dev = 0, cus = 0, per_cu = 0;
        if (hipGetDevice(&dev) != hipSuccess || hipDeviceGetAttribute(&cus, hipDeviceAttributeMultiprocessorCount, dev) != hipSuccess) { grid = -1; return; }
        if (hipFuncSetAttribute((const void*)fwd_kernel, hipFuncAttributeMaxDynamicSharedMemorySize, LDS_BYTES) != hipSuccess) { fprintf(stderr, "kernel_launch: hipFuncSetAttribute failed\n"); grid = -1; return; }
        if (hipOccupancyMaxActiveBlocksPerMultiprocessor(&per_cu, (const void*)fwd_kernel, NWAVES * 64, LDS_BYTES) != hipSuccess || per_cu < 1)
            fprintf(stderr, "kernel_launch: note: occupancy query reports %d workgroups per CU\n", per_cu);
        (void)hipGetLastError();
        grid = cus;
    }
    if (grid < 0) return;
    if (hipMemsetAsync((char*)d_ws + WS_CTL, 0, CTL_ZERO_BYTES, stream) != hipSuccess) return;
    Args a{};
    for (int i = 0; i < N_IN; ++i) a.in[i] = (const float*)d_in[i];
    a.out = (float*)d_out; a.ws = (unsigned char*)d_ws;
    for (int li = 0; li < N_LAUNCHES; ++li) {
        a.ph_lo = (N_LAUNCHES == 1) ? 0 : li; a.ph_hi = (N_LAUNCHES == 1) ? NPHASE : li + 1;
        hipLaunchKernelGGL(fwd_kernel, dim3(grid), dim3(NWAVES * 64), LDS_BYTES, stream, a);
        const hipError_t le = hipPeekAtLastError();
        if (le != hipSuccess) { fprintf(stderr, "kernel_launch: launch %d failed: %s\n", li, hipGetErrorName(le)); break; }
    }
}
```

```cpp
#include <hip/hip_runtime.h>
#include <cstdio>
#include <cstdint>
#include <cmath>

#ifndef HYENA_FP8
#define HYENA_FP8 1
#endif
#ifndef MK_N_LAUNCHES
#define MK_N_LAUNCHES 1
#endif

#define LAS __attribute__((address_space(3)))
#define GAS __attribute__((address_space(1)))
typedef unsigned short bf16_t;
typedef short bf16x8 __attribute__((ext_vector_type(8)));
typedef float f32x4 __attribute__((ext_vector_type(4)));
typedef float f32x2 __attribute__((ext_vector_type(2)));
typedef unsigned u32x4 __attribute__((ext_vector_type(4)));
typedef unsigned u32x2 __attribute__((ext_vector_type(2)));

constexpr int NB = 16, SEQ = 4096, DM = 1024, MTOK = NB * SEQ, CTXL = 256, MCTX = NB * CTXL;
constexpr int NH = 8, HD = 64, AW = 512, HW = 512, KVP = 128, KVLEN = CTXL + SEQ;
constexpr int NE = 256, TOPK = 8, FF = 256;
constexpr float EPS = 1e-6f;
constexpr int NPHASE = 14;

constexpr size_t MiB = 1u << 20;
constexpr size_t WS_CTL = 0, CTL_ZERO_BYTES = 128 * 1024;
constexpr size_t WS_MODV = 512 * 1024;
constexpr size_t WS_ROPE = 1 * MiB;
constexpr size_t WS_SS = 1 * MiB + 256 * 1024;
constexpr size_t WS_ASSIGN = 2 * MiB;
constexpr size_t WS_KR = 4 * MiB;
constexpr size_t WS_WQKV = 12 * MiB;
constexpr size_t WS_WU = 14 * MiB;
constexpr size_t WS_WO = 17 * MiB;
constexpr size_t WS_WR = 19 * MiB;
constexpr size_t WS_WSGU = 20 * MiB;
constexpr size_t WS_WSD = 21 * MiB;
constexpr size_t WS_WD = 22 * MiB;
constexpr size_t WS_ACT = 150 * MiB;
constexpr size_t WS_SLOT = 406 * MiB;
constexpr size_t WS_END = 1048 * MiB;
constexpr size_t WS_Q = 150 * MiB;
constexpr size_t WS_K = 214 * MiB;
constexpr size_t WS_V = 231 * MiB;
constexpr size_t WS_UT = 248 * MiB;
constexpr size_t WS_HC = 440 * MiB;
constexpr size_t WS_AY = 248 * MiB;
constexpr size_t WS_LOGIT = 150 * MiB;
constexpr size_t WS_WGU = 470 * MiB;
constexpr size_t WS_H8 = 598 * MiB;
constexpr size_t WS_WSGU8 = 662 * MiB;
constexpr size_t WS_H = 726 * MiB;
constexpr size_t WS_HYW = 726 * MiB;
constexpr size_t WS_HYX = 790 * MiB;
constexpr size_t WS_LIST = 854 * MiB;
constexpr size_t WS_YT = 919 * MiB;
constexpr size_t WS_AO = 983 * MiB;
static_assert(WS_LIST + (size_t)257 * 65536 * 4 <= WS_YT && WS_YT + 64 * MiB <= WS_AO && WS_AO + 64 * MiB <= WS_END, "ws map");
constexpr size_t MAXROWS_R = 524288 + 256 * 255;
static_assert(WS_SLOT + (MAXROWS_R + 65536) * 1024 <= WS_END && WS_ACT + (MAXROWS_R + 65536) * 256 <= WS_SLOT, "ws map 2");

constexpr int CW_TMO = 0, CW_CODE = 1, CW_TILEQ = 64;
constexpr int CW_BAR = 4096;
constexpr int CW_CNT = 16384;
static_assert((CW_CNT + 257 * 32) * 4 <= (int)CTL_ZERO_BYTES && (CW_BAR + 3456) * 4 <= (int)CTL_ZERO_BYTES, "control words inside the memset region");

constexpr int RING_OFF = 0, RING_BYTES = 131072;
constexpr int AUX_OFF = 131072, AUX_BYTES = 16384;
constexpr int MISC_OFF = AUX_OFF + AUX_BYTES;
constexpr int LDS_BYTES = MISC_OFF + 512;
constexpr int AUX_TP = 0, AUX_CNT = 1280, AUX_T2E = 2560, AUX_IDX = 8192;

constexpr int NWAVES = 8;
constexpr float C2 = 0.125f * 1.4426950408889634f;

__device__ __forceinline__ unsigned f2bf(float f) { unsigned u = __builtin_bit_cast(unsigned, f); return (u + 0x7fffu + ((u >> 16) & 1u)) >> 16; }
__device__ __forceinline__ unsigned pk2(float lo, float hi) { unsigned r; asm("v_cvt_pk_bf16_f32 %0, %1, %2" : "=v"(r) : "v"(lo), "v"(hi)); return r; }
__device__ __forceinline__ float bf2f(unsigned h) { return __builtin_bit_cast(float, h << 16); }
__device__ __forceinline__ unsigned cvt_pk_bf16(float lo, float hi) { unsigned r; asm volatile("v_cvt_pk_bf16_f32 %0, %1, %2" : "=v"(r) : "v"(lo), "v"(hi)); return r; }
__device__ __forceinline__ int lane_id() { return (int)__builtin_amdgcn_mbcnt_hi(~0u, __builtin_amdgcn_mbcnt_lo(~0u, 0u)); }
__device__ __forceinline__ float wave_sum(float v) {
#pragma unroll
    for (int o = 1; o < 64; o <<= 1) v += __shfl_xor(v, o);
    return v;
}

namespace pg8 {
constexpr int BM = 256, BK = 64, HALF = 128, HTB = HALF * BK * 2, STAGE_BYTES = 8 * HTB;
__host__ __device__ __forceinline__ int lds_byte(int r, int c) { const int st = (r >> 4) * 2 + (c >> 5), rr = r & 15, cc = c & 31, ob = rr * 64 + cc * 2; return st * 1024 + (ob ^ (((ob >> 9) & 1) << 5)); }
__host__ __device__ __forceinline__ void stage_rc(int b, int& R, int& C) { const int st = b / 1024, sb = b % 1024, swz = sb ^ (((sb >> 9) & 1) << 5); R = (st >> 1) * 16 + swz / 64; C = (st & 1) * 32 + (swz % 64) / 2; }
__host__ __device__ __forceinline__ int perm32(int rho) { const int n = rho >> 4, i = rho & 15; return 8 * (i >> 2) + 4 * n + (i & 3); }

struct Unit { int pm, pn, aux, aux2; };
typedef int v8i __attribute__((ext_vector_type(8)));
typedef int v4i __attribute__((ext_vector_type(4)));
__device__ __forceinline__ void mfma_fp8(f32x4& acc, v8i a, v8i b) { asm volatile("v_mfma_f32_16x16x128_f8f6f4 %0, %1, %2, %0" : "+v"(acc) : "v"(a), "v"(b)); }
__device__ __forceinline__ v8i cat8(bf16x8 lo, bf16x8 hi) { const v4i a = __builtin_bit_cast(v4i, lo), b = __builtin_bit_cast(v4i, hi); return __builtin_shufflevector(a, b, 0, 1, 2, 3, 4, 5, 6, 7); }

template <class Epi, class Sched, bool GATHER, bool ALIGN_EPI, bool FP8 = false>
__device__ __forceinline__ void gemm_phase(LAS unsigned char* lds, LAS unsigned* idxw, const int K, const Sched& S, const Epi& E, const int wave) {
    int tid_ = wave * 64 + lane_id(); asm volatile("" : "+v"(tid_));
    const int tid = tid_, wid = __builtin_amdgcn_readfirstlane(tid >> 6), lane = tid & 63, wr = wid >> 2, wc = wid & 3, fr = lane & 15, fq = lane >> 4;
    const int nt = K / BK;
    int Rr[2], Cc[2]; unsigned voffB[2];
#pragma unroll
    for (int i = 0; i < 2; ++i) { stage_rc(tid * 16 + i * 8192, Rr[i], Cc[i]); const int Rb = (Rr[i] & ~31) + perm32(Rr[i] & 31); voffB[i] = (unsigned)(Rb * K + Cc[i]) * 2u; }
    const unsigned kstep = (unsigned)(BK * 2);
    const unsigned hstep = (unsigned)HALF * (unsigned)K * 2u;
    const unsigned ldsw = (unsigned)wid * 1024u;
    const int aoff = lds_byte(wr * 64 + fr, fq * 8), boff = lds_byte(wc * 32 + fr, fq * 8);
#define PG8_SA(b, h) (((b) * 2 + (h)) * HTB)
#define PG8_SB(b, h) ((4 + (b) * 2 + (h)) * HTB)
#define PG8_STAGE_B(bufoff, gbase) do { _Pragma("unroll") for (int _i = 0; _i < 2; ++_i) \
        __builtin_amdgcn_global_load_lds((const unsigned*)((const char*)(gbase) + voffB[_i]), (LAS unsigned*)(lds + (bufoff) + ldsw + _i * 8192), 16, 0, 0); } while (0)
#define PG8_STAGE_A(bufoff, gbase, VV, h) do { _Pragma("unroll") for (int _i = 0; _i < 2; ++_i) \
        __builtin_amdgcn_global_load_lds((const unsigned*)((const char*)(gbase) + VV[h][_i]), (LAS unsigned*)(lds + (bufoff) + ldsw + _i * 8192), 16, 0, 0); } while (0)
#define PG8_LDA(dst, b, h) do { _Pragma("unroll") for (int m = 0; m < 4; ++m) _Pragma("unroll") for (int k = 0; k < 2; ++k) dst[m][k] = *(const LAS bf16x8*)(lds + PG8_SA(b, h) + aoff + m * 2048 + k * 1024); } while (0)
#define PG8_LDB(dst, b, h) do { _Pragma("unroll") for (int n = 0; n < 2; ++n) _Pragma("unroll") for (int k = 0; k < 2; ++k) dst[n][k] = *(const LAS bf16x8*)(lds + PG8_SB(b, h) + boff + n * 2048 + k * 1024); } while (0)
#define PG8_MMA(ai, bj, At, Bt) do { __builtin_amdgcn_s_setprio(1); _Pragma("unroll") for (int m = 0; m < 4; ++m) _Pragma("unroll") for (int n = 0; n < 2; ++n) { \
        if constexpr (FP8) { mfma_fp8(acc[ai][bj][m][n], cat8(Bt[n][0], Bt[n][1]), cat8(At[m][0], At[m][1])); } \
        else { _Pragma("unroll") for (int k = 0; k < 2; ++k) acc[ai][bj][m][n] = __builtin_amdgcn_mfma_f32_16x16x32_bf16(Bt[n][k], At[m][k], acc[ai][bj][m][n], 0, 0, 0); } } __builtin_amdgcn_s_setprio(0); } while (0)
#define PG8_WAIT_V(n) asm volatile("s_waitcnt vmcnt(" #n ")" ::: "memory")
#define PG8_WAIT_L(n) asm volatile("s_waitcnt lgkmcnt(" #n ")" ::: "memory")
#define PG8_BAR __builtin_amdgcn_s_barrier()
#define PG8_SCHED __builtin_amdgcn_sched_barrier(0)
    Unit cur, nxt; int ui = 0;
    if (!S.next(0, cur)) return;
    f32x4 acc[2][2][4][2];
#pragma unroll
    for (int a = 0; a < 2; ++a)
#pragma unroll
        for (int b = 0; b < 2; ++b)
#pragma unroll
            for (int m = 0; m < 4; ++m)
#pragma unroll
                for (int n = 0; n < 2; ++n) { acc[a][b][m][n] = (f32x4){0.f, 0.f, 0.f, 0.f}; if constexpr (FP8) asm volatile("" : "+v"(acc[a][b][m][n])); }
    bf16x8 At[4][2], B0[2][2], B1[2][2];
    unsigned va[2][2], vn[2][2];
    if constexpr (GATHER) {
        const unsigned* ip = S.idx_ptr(cur); const int nv = S.nvalid(cur);
#pragma unroll
        for (int h = 0; h < 2; ++h)
#pragma unroll
            for (int i = 0; i < 2; ++i) { const int r = Rr[i] + HALF * h; const unsigned e = ip[r]; const unsigned tok = r < nv ? (e >> 16) : 0u; va[h][i] = tok * (unsigned)K * 2u + (unsigned)Cc[i] * 2u; }
    } else {
#pragma unroll
        for (int h = 0; h < 2; ++h)
#pragma unroll
            for (int i = 0; i < 2; ++i) va[h][i] = (unsigned)((Rr[i] + HALF * h) * K + Cc[i]) * 2u;
    }
#pragma unroll
    for (int h = 0; h < 2; ++h)
#pragma unroll
        for (int i = 0; i < 2; ++i) vn[h][i] = va[h][i];
    const char* cA = S.a_base(cur); const char* cB = S.b_base(cur);
    PG8_STAGE_B(PG8_SB(0, 0), cB); PG8_STAGE_B(PG8_SB(0, 1), cB + hstep); PG8_STAGE_A(PG8_SA(0, 0), cA, va, 0); PG8_STAGE_A(PG8_SA(0, 1), cA, va, 1);
    if (wr == 1) PG8_BAR;
    PG8_WAIT_V(2); PG8_BAR;
    PG8_STAGE_B(PG8_SB(1, 0), cB + kstep); PG8_STAGE_A(PG8_SA(1, 0), cA + kstep, va, 0); PG8_STAGE_B(PG8_SB(1, 1), cB + hstep + kstep);
    PG8_WAIT_V(6); PG8_BAR;
    for (;;) {
        const bool has_next = S.next(ui + 1, nxt);
        const char* nA = has_next ? S.a_base(nxt) : cA; const char* nB = has_next ? S.b_base(nxt) : cB;
        int nvn = 0;
        if constexpr (GATHER) {
            if (has_next) { nvn = S.nvalid(nxt);
                __builtin_amdgcn_global_load_lds((const unsigned*)(S.idx_ptr(nxt) + lane * 4), (LAS unsigned*)idxw, 16, 0, 0); }
        }
#pragma unroll 1
        for (int t = 0; t < nt; t += 2) {
            const bool last = (t == nt - 2);
            if constexpr (GATHER) {
                if (last && has_next) {
                    asm volatile("" ::: "memory");
#pragma unroll
                    for (int h = 0; h < 2; ++h)
#pragma unroll
                        for (int i = 0; i < 2; ++i) { const int r = Rr[i] + HALF * h; const unsigned e = idxw[r]; const unsigned tok = r < nvn ? (e >> 16) : 0u; vn[h][i] = tok * (unsigned)K * 2u + (unsigned)Cc[i] * 2u; }
                }
            }
            unsigned v2[2][2];
#pragma unroll
            for (int h = 0; h < 2; ++h)
#pragma unroll
                for (int i = 0; i < 2; ++i) v2[h][i] = (GATHER && last) ? vn[h][i] : va[h][i];
            const char* a1 = cA + (size_t)(t + 1) * kstep;
            const char* a2 = last ? nA : cA + (size_t)(t + 2) * kstep; const char* b2 = last ? nB : cB + (size_t)(t + 2) * kstep;
            const char* a3 = a2 + kstep; const char* b3 = b2 + kstep;
            PG8_LDB(B0, 0, 0); PG8_LDB(B1, 0, 1); PG8_SCHED; PG8_LDA(At, 0, 0); PG8_STAGE_A(PG8_SA(1, 1), a1, va, 1);
            PG8_WAIT_V(8); PG8_WAIT_L(0); PG8_BAR; PG8_MMA(0, 0, At, B0); PG8_MMA(0, 1, At, B1); PG8_BAR; PG8_SCHED;
            PG8_LDA(At, 0, 1); PG8_STAGE_B(PG8_SB(0, 0), b2); PG8_STAGE_B(PG8_SB(0, 1), b2 + hstep); PG8_STAGE_A(PG8_SA(0, 0), a2, v2, 0);
            PG8_WAIT_V(8); PG8_WAIT_L(0); PG8_BAR; PG8_MMA(1, 0, At, B0); PG8_MMA(1, 1, At, B1); PG8_BAR; PG8_SCHED;
            PG8_LDB(B0, 1, 0); PG8_LDB(B1, 1, 1); PG8_SCHED; PG8_LDA(At, 1, 0); PG8_STAGE_A(PG8_SA(0, 1), a2, v2, 1);
            PG8_WAIT_V(8); PG8_WAIT_L(0); PG8_BAR; PG8_MMA(0, 0, At, B0); PG8_MMA(0, 1, At, B1); PG8_BAR; PG8_SCHED;
            PG8_LDA(At, 1, 1); PG8_STAGE_B(PG8_SB(1, 0), b3); PG8_STAGE_B(PG8_SB(1, 1), b3 + hstep); PG8_STAGE_A(PG8_SA(1, 0), a3, v2, 0);
            PG8_WAIT_V(8); PG8_WAIT_L(0); PG8_BAR; PG8_MMA(1, 0, At, B0); PG8_MMA(1, 1, At, B1); PG8_BAR; PG8_SCHED;
        }
        if constexpr (ALIGN_EPI) { if (wr == 0) PG8_BAR; }
        if constexpr (FP8) {
#define PG8_A4(a, b) "+v"(acc[a][b][0][0]), "+v"(acc[a][b][0][1]), "+v"(acc[a][b][1][0]), "+v"(acc[a][b][1][1]), "+v"(acc[a][b][2][0]), "+v"(acc[a][b][2][1]), "+v"(acc[a][b][3][0]), "+v"(acc[a][b][3][1])
            asm volatile("s_nop 15\n\ts_nop 15" : PG8_A4(0, 0), PG8_A4(0, 1) :: "memory");
            asm volatile("" : PG8_A4(1, 0), PG8_A4(1, 1) :: "memory");
#undef PG8_A4
        }
        E(acc, cur, wr, wc, fr, fq);
        if (!has_next) break;
#pragma unroll
        for (int a = 0; a < 2; ++a)
#pragma unroll
            for (int b = 0; b < 2; ++b)
#pragma unroll
                for (int m = 0; m < 4; ++m)
#pragma unroll
                    for (int n = 0; n < 2; ++n) { acc[a][b][m][n] = (f32x4){0.f, 0.f, 0.f, 0.f}; if constexpr (FP8) asm volatile("" : "+v"(acc[a][b][m][n])); }
        cur = nxt; cA = nA; cB = nB; ++ui;
#pragma unroll
        for (int h = 0; h < 2; ++h)
#pragma unroll
            for (int i = 0; i < 2; ++i) va[h][i] = vn[h][i];
        if constexpr (ALIGN_EPI) { if (wr == 1) PG8_BAR; }
    }
    PG8_WAIT_V(0);
    if constexpr (!ALIGN_EPI) { if (wr == 0) PG8_BAR; }
    PG8_BAR;
#undef PG8_SA
#undef PG8_SB
#undef PG8_STAGE_A
#undef PG8_STAGE_B
#undef PG8_LDA
#undef PG8_LDB
#undef PG8_MMA
#undef PG8_WAIT_V
#undef PG8_WAIT_L
#undef PG8_BAR
#undef PG8_SCHED
}
}

using pg8::Unit;
struct MoeTab { const LAS int* tp; const LAS int* cnt; const LAS unsigned short* t2e; };
__device__ __forceinline__ int moe_find(const LAS int* tp, int T) {
    int lo = 0, hi = 256;
    while (lo < hi) { const int mid = (lo + hi + 1) >> 1; if (tp[mid] <= T) lo = mid; else hi = mid - 1; }
    return lo;
}

struct SchedQKV {
    const bf16_t *H; long hc_delta; const bf16_t *W; int G, c;
    __device__ __forceinline__ bool next(int i, Unit& u) const {
        const int L = i * G + c; if (L >= 784) return false;
        if (L < 768) { u.pm = L / 3; u.pn = L % 3; u.aux = 0; } else { u.pm = L - 768; u.pn = 2; u.aux = 1; }
        u.aux2 = 0; return true;
    }
    __device__ __forceinline__ const char* a_base(const Unit& u) const { return (const char*)H + (u.aux ? hc_delta : 0L) + (size_t)u.pm * (256 * 1024 * 2); }
    __device__ __forceinline__ const char* b_base(const Unit& u) const { return (const char*)W + (size_t)u.pn * (256 * 1024 * 2); }
    __device__ __forceinline__ const unsigned* idx_ptr(const Unit&) const { return nullptr; }
    __device__ __forceinline__ int nvalid(const Unit&) const { return 256; }
};
struct SchedDense {
    const bf16_t *A, *Bt; int K, nM, nN, G, c; bool m_fast;
    __device__ __forceinline__ bool next(int i, Unit& u) const {
        const int L = i * G + c; if (L >= nM * nN) return false;
        if (m_fast) { u.pm = L % nM; u.pn = L / nM; } else { u.pm = L / nN; u.pn = L % nN; }
        u.aux = 0; u.aux2 = 0; return true;
    }
    __device__ __forceinline__ const char* a_base(const Unit& u) const { return (const char*)A + (size_t)u.pm * 512 * (size_t)K; }
    __device__ __forceinline__ const char* b_base(const Unit& u) const { return (const char*)Bt + (size_t)u.pn * 512 * (size_t)K; }
    __device__ __forceinline__ const unsigned* idx_ptr(const Unit&) const { return nullptr; }
    __device__ __forceinline__ int nvalid(const Unit&) const { return 256; }
};
struct TileDeal {
    int nT, NP, G, c;
    __device__ __forceinline__ bool get(int i, int& tile, int& slot) const {
        const int full = nT / G, rem = nT - full * G;
        if (i < full * NP) { tile = (i / NP) * G + c; slot = i % NP; return true; }
        const int j = i - full * NP;
        if (rem * NP <= G) { if (j > 0 || c >= rem * NP) return false; tile = full * G + c / NP; slot = c % NP; return true; }
        if (j >= NP || c >= rem) return false; tile = full * G + c; slot = j; return true;
    }
};
struct SchedGU {
    const bf16_t *H2, *WGU, *WSGU; const unsigned* LIST; MoeTab tab; int G, c;
    __device__ __forceinline__ bool next(int i, Unit& u) const {
        const int Ttot = __builtin_amdgcn_readfirstlane(tab.tp[257]); const int L = i * G + c; if (L >= 2 * Ttot) return false;
        const int T = L >> 1, half = L & 1;
        const int e = __builtin_amdgcn_readfirstlane((int)tab.t2e[T]);
        u.pm = T; u.pn = half; u.aux = e; u.aux2 = __builtin_amdgcn_readfirstlane(T - tab.tp[e]); return true;
    }
    __device__ __forceinline__ const char* a_base(const Unit&) const { return (const char*)H2; }
    __device__ __forceinline__ const char* b_base(const Unit& u) const { return (u.aux < 256 ? (const char*)WGU + (size_t)u.aux * (512 * 1024) : (const char*)WSGU) + (size_t)u.pn * (256 * 1024); }
    __device__ __forceinline__ const unsigned* idx_ptr(const Unit& u) const { return LIST + (size_t)u.aux * 65536 + (size_t)u.aux2 * 256; }
    __device__ __forceinline__ int nvalid(const Unit& u) const { const int r = __builtin_amdgcn_readfirstlane(tab.cnt[u.aux]) - u.aux2 * 256; return r < 256 ? r : 256; }
};
struct SchedDown {
    const bf16_t *ACT, *WD, *WSD; MoeTab tab; int G, c;
    __device__ __forceinline__ bool next(int i, Unit& u) const {
        const int TT = __builtin_amdgcn_readfirstlane(tab.tp[257]);
        const int L = i * G + c; if (L >= 4 * TT) return false;
        u.pm = L >> 2; u.pn = L & 3;
        u.aux = __builtin_amdgcn_readfirstlane((int)tab.t2e[u.pm]); u.aux2 = 0; return true;
    }
    __device__ __forceinline__ const char* a_base(const Unit& u) const { return (const char*)ACT + (size_t)u.pm * (256 * 256); }
    __device__ __forceinline__ const char* b_base(const Unit& u) const { return (u.aux < 256 ? (const char*)WD + (size_t)u.aux * (1024 * 256) : (const char*)WSD) + (size_t)u.pn * (256 * 256); }
    __device__ __forceinline__ const unsigned* idx_ptr(const Unit&) const { return nullptr; }
    __device__ __forceinline__ int nvalid(const Unit&) const { return 256; }
};

#define EPI_ARGS const f32x4 (&acc)[2][2][4][2], const Unit& u, int wr, int wc, int fr_, int fq_
#define EPI_PIN int fr = fr_, fq = fq_; asm volatile("" : "+v"(fr), "+v"(fq))
__device__ __forceinline__ u32x4 pack8(const f32x4& a, const f32x4& b) { u32x4 o; o.x = cvt_pk_bf16(a[0], a[1]); o.y = cvt_pk_bf16(a[2], a[3]); o.z = cvt_pk_bf16(b[0], b[1]); o.w = cvt_pk_bf16(b[2], b[3]); return o; }

__device__ __forceinline__ unsigned pk4_fp8c(float a, float b, float c, float d) {
    a = __builtin_amdgcn_fmed3f(a, -440.f, 440.f); b = __builtin_amdgcn_fmed3f(b, -440.f, 440.f); c = __builtin_amdgcn_fmed3f(c, -440.f, 440.f); d = __builtin_amdgcn_fmed3f(d, -440.f, 440.f);
    int w = __builtin_amdgcn_cvt_pk_fp8_f32(a, b, 0, false); w = __builtin_amdgcn_cvt_pk_fp8_f32(c, d, w, true); return (unsigned)w; }
struct EpiQKV {
    bf16_t *Q, *Kb, *Vb; const float *qnw, *knw; const f32x2* rope;
    __device__ __forceinline__ void operator()(EPI_ARGS) const {
        EPI_PIN;
        const bool ctx = u.aux != 0;
        const int kind = (u.pn < 2) ? 0 : (wc < 2 ? 1 : 2);
        f32x4 w[2][2];
#pragma unroll
        for (int bj = 0; bj < 2; ++bj)
#pragma unroll
            for (int n = 0; n < 2; ++n) w[bj][n] = (kind == 2) ? (f32x4){1.f, 1.f, 1.f, 1.f} : *(const f32x4*)((kind == 0 ? qnw : knw) + 32 * bj + 8 * fq + 4 * n);
        f32x4 rrow[2][2], rcol[4][2];
        if (kind != 2 && !ctx) {
#pragma unroll
            for (int ai = 0; ai < 2; ++ai)
#pragma unroll
                for (int n = 0; n < 2; ++n) rrow[ai][n] = ((const f32x4*)(rope + (((u.pm * 4 + 2 * ai + wr) & 63) * 16) + 4 * fq))[n];
#pragma unroll
            for (int m = 0; m < 4; ++m)
#pragma unroll
                for (int n = 0; n < 2; ++n) rcol[m][n] = ((const f32x4*)(rope + (16 * m + fr) * 16 + 4 * fq))[n];
        }
#pragma unroll
        for (int ai = 0; ai < 2; ++ai)
#pragma unroll
            for (int m = 0; m < 4; ++m) {
                const int rl = ai * 128 + wr * 64 + m * 16 + fr; const int row = u.pm * 256 + rl;
                f32x4 v[2][2];
#pragma unroll
                for (int bj = 0; bj < 2; ++bj)
#pragma unroll
                    for (int n = 0; n < 2; ++n) v[bj][n] = acc[ai][bj][m][n];
                if (kind != 2) {
                    float ss = 0.f;
#pragma unroll
                    for (int bj = 0; bj < 2; ++bj)
#pragma unroll
                        for (int n = 0; n < 2; ++n) ss += (v[bj][n][0] * v[bj][n][0] + v[bj][n][1] * v[bj][n][1]) + (v[bj][n][2] * v[bj][n][2] + v[bj][n][3] * v[bj][n][3]);
                    ss += __shfl_xor(ss, 16); ss += __shfl_xor(ss, 32);
                    const float rs = rsqrtf(ss * (1.f / 64.f) + EPS);
#pragma unroll
                    for (int bj = 0; bj < 2; ++bj)
#pragma unroll
                        for (int n = 0; n < 2; ++n) v[bj][n] = v[bj][n] * rs * w[bj][n];
                    if (!ctx) {
#pragma unroll
                        for (int bj = 0; bj < 2; ++bj)
#pragma unroll
                            for (int n = 0; n < 2; ++n) { const f32x4 cs = bj == 0 ? rrow[ai][n] : rcol[m][n]; const f32x4 x = v[bj][n];
                                v[bj][n] = (f32x4){x[0] * cs[0] - x[1] * cs[1], x[0] * cs[1] + x[1] * cs[0], x[2] * cs[2] - x[3] * cs[3], x[2] * cs[3] + x[3] * cs[2]}; }
                    }
                    if (kind == 0) {
#pragma unroll
                        for (int bj = 0; bj < 2; ++bj)
#pragma unroll
                            for (int n = 0; n < 2; ++n) v[bj][n] = v[bj][n] * C2;
                    }
                }
                bf16_t* dst;
                if (kind == 0) dst = Q + (size_t)row * AW + 64 * (4 * u.pn + wc) + 8 * fq;
                else { const int kvrow = ctx ? (row >> 8) * KVLEN + (row & 255) : (row >> 12) * KVLEN + CTXL + (row & (SEQ - 1));
                       dst = (kind == 1 ? Kb : Vb) + (size_t)kvrow * KVP + 64 * (wc & 1) + 8 * fq; }
#pragma unroll
                for (int bj = 0; bj < 2; ++bj) *(u32x4*)(dst + 32 * bj) = pack8(v[bj][0], v[bj][1]);
            }
    }
};
struct EpiPlainBf16 {
    bf16_t* O; size_t ldc; float scale;
    __device__ __forceinline__ void operator()(EPI_ARGS) const {
        EPI_PIN;
#pragma unroll
        for (int ai = 0; ai < 2; ++ai)
#pragma unroll
            for (int m = 0; m < 4; ++m) { bf16_t* rowp = O + (size_t)(u.pm * 256 + ai * 128 + wr * 64 + m * 16 + fr) * ldc + u.pn * 256 + wc * 32 + 8 * fq;
#pragma unroll
                for (int bj = 0; bj < 2; ++bj) *(u32x4*)(rowp + bj * 128) = pack8(acc[ai][bj][m][0] * scale, acc[ai][bj][m][1] * scale); }
    }
};
struct EpiOutProj {
    const float* x; float* out; const float* modv; int pm0;
    __device__ __forceinline__ void operator()(EPI_ARGS) const {
        EPI_PIN;
        const int pmt = pm0 + u.pm;
        const float* g1 = modv + (size_t)(pmt >> 4) * 6144 + 2 * 1024; const int col0 = u.pn * 256 + wc * 32 + 8 * fq;
        f32x4 gv[2][2];
#pragma unroll
        for (int bj = 0; bj < 2; ++bj)
#pragma unroll
            for (int n = 0; n < 2; ++n) gv[bj][n] = *(const f32x4*)(g1 + col0 + bj * 128 + 4 * n);
#pragma unroll
        for (int ai = 0; ai < 2; ++ai)
#pragma unroll
            for (int m = 0; m < 4; ++m) { const size_t off = (size_t)(pmt * 256 + ai * 128 + wr * 64 + m * 16 + fr) * DM + col0;
#pragma unroll
                for (int bj = 0; bj < 2; ++bj)
#pragma unroll
                    for (int n = 0; n < 2; ++n) { const f32x4 xv = *(const f32x4*)(x + off + bj * 128 + 4 * n); *(f32x4*)(out + off + bj * 128 + 4 * n) = xv + gv[bj][n] * acc[ai][bj][m][n]; }
                if (m & 1) asm volatile("" ::: "memory"); }
    }
};
struct EpiF32 {
    float* O; size_t ldc;
    __device__ __forceinline__ void operator()(EPI_ARGS) const {
        EPI_PIN;
#pragma unroll
        for (int ai = 0; ai < 2; ++ai)
#pragma unroll
            for (int m = 0; m < 4; ++m) { float* rowp = O + (size_t)(u.pm * 256 + ai * 128 + wr * 64 + m * 16 + fr) * ldc + u.pn * 256 + wc * 32 + 8 * fq;
#pragma unroll
                for (int bj = 0; bj < 2; ++bj)
#pragma unroll
                    for (int n = 0; n < 2; ++n) *(f32x4*)(rowp + bj * 128 + 4 * n) = acc[ai][bj][m][n]; }
    }
};
struct EpiGU {
    unsigned char* ACT; const unsigned* LIST; MoeTab tab;
    __device__ __forceinline__ void operator()(EPI_ARGS) const {
        EPI_PIN;
        const int e = u.aux, tile = u.aux2; int nv = __builtin_amdgcn_readfirstlane(tab.cnt[e]) - tile * 256; nv = nv < 256 ? nv : 256;
        const unsigned* ip = LIST + (size_t)e * 65536 + (size_t)tile * 256;
        constexpr float C1 = -1.4426950408889634f / 256.0f;
#pragma unroll
        for (int ai = 0; ai < 2; ++ai)
#pragma unroll
            for (int m = 0; m < 4; ++m) { const int rl = ai * 128 + wr * 64 + m * 16 + fr;
                const float ws = rl < nv ? bf2f(ip[rl] & 0xffffu) * (4.0f / 65536.0f) : 0.f;
                unsigned pk[2];
#pragma unroll
                for (int n = 0; n < 2; ++n) { const f32x4 g = acc[ai][0][m][n], up = acc[ai][1][m][n]; f32x2 r[2];
#pragma unroll
                    for (int h = 0; h < 2; ++h) { const f32x2 gg = {g[2 * h], g[2 * h + 1]}, uu = {up[2 * h], up[2 * h + 1]};
                        const f32x2 ea = gg * C1; f32x2 d; d.x = __builtin_amdgcn_exp2f(ea.x); d.y = __builtin_amdgcn_exp2f(ea.y); d = d + 1.0f;
                        f32x2 q; q.x = __builtin_amdgcn_rcpf(d.x); q.y = __builtin_amdgcn_rcpf(d.y);
                        f32x2 p = (gg * uu) * (q * ws);
                        p.x = __builtin_amdgcn_fmed3f(p.x, -440.f, 440.f); p.y = __builtin_amdgcn_fmed3f(p.y, -440.f, 440.f); r[h] = p; }
                    int w = __builtin_amdgcn_cvt_pk_fp8_f32(r[0].x, r[0].y, 0, false); w = __builtin_amdgcn_cvt_pk_fp8_f32(r[1].x, r[1].y, w, true); pk[n] = (unsigned)w; }
                u32x2 o; o.x = pk[0]; o.y = pk[1];
                *(u32x2*)(ACT + (size_t)(u.pm * 256 + rl) * FF + u.pn * 128 + wc * 32 + 8 * fq) = o; }
    }
};
struct EpiDown {
    unsigned char* SLOT;
    __device__ __forceinline__ void operator()(EPI_ARGS) const {
        EPI_PIN;
#pragma unroll
        for (int ai = 0; ai < 2; ++ai)
#pragma unroll
            for (int m = 0; m < 4; ++m) { unsigned char* rowp = SLOT + (size_t)(u.pm * 256 + ai * 128 + wr * 64 + m * 16 + fr) * DM + u.pn * 256 + wc * 32 + 8 * fq;
#pragma unroll
                for (int bj = 0; bj < 2; ++bj) { const f32x4 a = acc[ai][bj][m][0] * 0.125f, b = acc[ai][bj][m][1] * 0.125f;
                    u32x2 pk; pk.x = pk4_fp8c(a[0], a[1], a[2], a[3]); pk.y = pk4_fp8c(b[0], b[1], b[2], b[3]); *(u32x2*)(rowp + bj * 128) = pk; } }
    }
};
#include <hip/hip_bf16.h>
#include <cmath>
namespace attn_body {
using bf16=__hip_bfloat16;
using bf16x8=__attribute__((ext_vector_type(8)))short;
using s16x4=__attribute__((ext_vector_type(4)))short;
using f32x16=__attribute__((ext_vector_type(16)))float;
using u32x4=__attribute__((ext_vector_type(4)))unsigned;
constexpr int SEQ=4096,D=64,QP=512,KVP=128,KVLEN=4352;
constexpr int NW=8,QBLK=32,QB=QBLK*NW,KVBLK=64,NQB=SEQ/QB;
constexpr int ATTN_UNIT_ROWS=QB;
__device__ __forceinline__ int crow(int r,int hi){return (r&3)+8*(r>>2)+4*hi;}
#define SBAR() __builtin_amdgcn_sched_barrier(0)

constexpr int NSLOT=3, SLOTB=8192;
constexpr int LDS_K=0, LDS_V=NSLOT*SLOTB, LDS_WS=2*NSLOT*SLOTB, LDS_OST=LDS_WS+NW*64*4, LDS_BYTES=LDS_OST+NW*4096;
constexpr float C2=0.125f*1.4426950408889634f;
__device__ __forceinline__ void glds16(const void*gsrc,unsigned lds_dst){unsigned keep;
  asm volatile("s_mov_b32 %0, m0\n\ts_mov_b32 m0, %2\n\ts_nop 0\n\tglobal_load_lds_dwordx4 %1, off\n\ts_mov_b32 m0, %0":"=&s"(keep):"v"(gsrc),"s"(lds_dst):"memory");}
__device__ __forceinline__ float max3f(float a,float b,float c){float r;asm("v_max3_f32 %0, %1, %2, %3":"=v"(r):"v"(a),"v"(b),"v"(c));return r;}
__device__ __forceinline__ float max2f(float a,float b){float r;asm("v_max_f32_e32 %0, %1, %2":"=v"(r):"v"(a),"v"(b));return r;}
__device__ __forceinline__ float fadd_s(float a,float b){float r;asm("v_add_f32_e32 %0, %1, %2":"=v"(r):"v"(a),"v"(b));return r;}
__device__ __forceinline__ float fsub_s(float a,float b){float r;asm("v_sub_f32_e32 %0, %1, %2":"=v"(r):"v"(a),"v"(b));return r;}
typedef float f32x2_t __attribute__((ext_vector_type(2))); typedef __bf16 bf16x2_t __attribute__((ext_vector_type(2)));
__device__ __forceinline__ unsigned cvtpk_s(float lo,float hi){f32x2_t v={lo,hi};bf16x2_t b=__builtin_convertvector(v,bf16x2_t);return __builtin_bit_cast(unsigned,b);}
#define WAIT_BAR(N) asm volatile("s_waitcnt vmcnt(" #N ") lgkmcnt(0)\n\ts_barrier":::"memory")

__device__ __forceinline__ void qkt(f32x16&p0,f32x16&p1,const char*Kslot,const bf16x8*qr,const f32x16&negm,int r32,int hi){
  const char*kb=Kslot+hi*1024+r32*16;
  #pragma unroll
  for(int d0=0;d0<4;++d0){
    const bf16x8 b0=*reinterpret_cast<const bf16x8*>(kb+d0*2048);
    const bf16x8 b1=*reinterpret_cast<const bf16x8*>(kb+d0*2048+512);
    if(d0==0){p0=__builtin_amdgcn_mfma_f32_32x32x16_bf16(b0,qr[0],negm,0,0,0);p1=__builtin_amdgcn_mfma_f32_32x32x16_bf16(b1,qr[0],negm,0,0,0);}
    else{p0=__builtin_amdgcn_mfma_f32_32x32x16_bf16(b0,qr[d0],p0,0,0,0);p1=__builtin_amdgcn_mfma_f32_32x32x16_bf16(b1,qr[d0],p1,0,0,0);}}
}
typedef __attribute__((address_space(3))) const char* lds_cptr;
typedef short v4i16_t __attribute__((ext_vector_type(4)));
__device__ __forceinline__ void kload8(bf16x8*kf,lds_cptr kp){
  kf[0]=*(const __attribute__((address_space(3))) bf16x8*)(kp);      kf[1]=*(const __attribute__((address_space(3))) bf16x8*)(kp+512);
  kf[2]=*(const __attribute__((address_space(3))) bf16x8*)(kp+2048); kf[3]=*(const __attribute__((address_space(3))) bf16x8*)(kp+2560);
  kf[4]=*(const __attribute__((address_space(3))) bf16x8*)(kp+4096); kf[5]=*(const __attribute__((address_space(3))) bf16x8*)(kp+4608);
  kf[6]=*(const __attribute__((address_space(3))) bf16x8*)(kp+6144); kf[7]=*(const __attribute__((address_space(3))) bf16x8*)(kp+6656);
}
__device__ __forceinline__ void kload2(bf16x8*kf,lds_cptr kp,int j){ kf[2*j]=*(const __attribute__((address_space(3))) bf16x8*)(kp+j*2048); kf[2*j+1]=*(const __attribute__((address_space(3))) bf16x8*)(kp+j*2048+512); }
__device__ __forceinline__ s16x4 vtr(lds_cptr p){ return __builtin_bit_cast(s16x4,__builtin_amdgcn_ds_read_tr16_b64_v4i16((__attribute__((address_space(3))) v4i16_t*)p)); }
__device__ __forceinline__ float rowmax(const f32x16&p0,const f32x16&p1){
  float a=max3f(p0[0],p0[1],p1[0]),b=max3f(p0[2],p0[3],p1[1]);a=max3f(a,p1[2],p1[3]);
  #pragma unroll
  for(int r=4;r<16;r+=4){a=max3f(a,p0[r],p0[r+1]);b=max3f(b,p0[r+2],p0[r+3]);a=max3f(a,p1[r],p1[r+1]);b=max3f(b,p1[r+2],p1[r+3]);}
  const float m=max2f(a,b);
  auto rr=__builtin_amdgcn_permlane32_swap(__float_as_uint(m),__float_as_uint(m),false,false);
  return max2f(__uint_as_float(rr[0]),__uint_as_float(rr[1]));
}
__device__ __forceinline__ void pv(f32x16*o,int vb,bf16x8 pa0,bf16x8 pa1,bf16x8 pa2,bf16x8 pa3){
  #pragma unroll
  for(int d0=0;d0<2;++d0){s16x4 lo[4],hi[4];
    #pragma unroll
    for(int ks=0;ks<4;++ks){
      asm volatile("ds_read_b64_tr_b16 %0,%1 offset:%c2":"=&v"(lo[ks]):"v"(vb),"i"(d0*4096+ks*1024):"memory");
      asm volatile("ds_read_b64_tr_b16 %0,%1 offset:%c2":"=&v"(hi[ks]):"v"(vb),"i"(d0*4096+ks*1024+512):"memory");}
    asm volatile("s_waitcnt lgkmcnt(0)":::"memory");SBAR();
    #define PK(k) (bf16x8){lo[k][0],lo[k][1],lo[k][2],lo[k][3],hi[k][0],hi[k][1],hi[k][2],hi[k][3]}
    o[d0]=__builtin_amdgcn_mfma_f32_32x32x16_bf16(pa0,PK(0),o[d0],0,0,0);
    o[d0]=__builtin_amdgcn_mfma_f32_32x32x16_bf16(pa1,PK(1),o[d0],0,0,0);
    o[d0]=__builtin_amdgcn_mfma_f32_32x32x16_bf16(pa2,PK(2),o[d0],0,0,0);
    o[d0]=__builtin_amdgcn_mfma_f32_32x32x16_bf16(pa3,PK(3),o[d0],0,0,0);
    #undef PK
  }
}

#ifndef ATTN_STORE16
#define ATTN_STORE16(p,v) (*(u32x4*)(p)=(v))
#endif
template<int THRL> __device__ __forceinline__ void attn_unit(int b,int h,int qb,const bf16*Q,const bf16*__restrict__ K,const bf16*__restrict__ V,bf16*O,char*shm,int wave_){
  const int lane=::lane_id(),tid=wave_*64+lane,r32=lane&31,hi=lane>>5; const int wid=wave_;
  const int q0=qb*QB; const long qrow0=(long)b*SEQ+q0+wid*QBLK;
  const bf16*Qw=Q+qrow0*QP+h*D;
  const bf16*Kh=K+(long)b*KVLEN*KVP+(h>>2)*D,*Vh=V+(long)b*KVLEN*KVP+(h>>2)*D;
  const unsigned lds0=(unsigned)(uintptr_t)shm;
  float*wsf=(float*)(shm+LDS_WS)+wid*64;
  const bf16*ksrc=Kh+(long)lane*KVP+wid*8;
  const bf16*vsrc=Vh+(long)(16*(wid&3)+(lane>>2))*KVP+(wid>>2)*32+(lane&3)*8;
  const unsigned kdst=lds0+LDS_K+wid*1024, vdst=lds0+LDS_V+wid*1024;
  #define DMA_K(t,slot) glds16(ksrc+(long)(t)*KVBLK*KVP,(unsigned)__builtin_amdgcn_readfirstlane(kdst+(slot)))
  #define DMA_V(t,slot) glds16(vsrc+(long)(t)*KVBLK*KVP,(unsigned)__builtin_amdgcn_readfirstlane(vdst+(slot)))
  const int vb0=(int)(lds0+LDS_V)+((lane>>4)&1)*32+(lane&3)*8+(4*hi+((lane&15)>>2))*64;
  const char*Kbase=shm+LDS_K; bf16x8 kf[8];
  const lds_cptr shm3=(lds_cptr)shm; const lds_cptr kp0=shm3+LDS_K+hi*1024+r32*16; const lds_cptr vp0=shm3+LDS_V+((lane>>4)&1)*32+(lane&3)*8+(4*hi+((lane&15)>>2))*64;
  constexpr int NT=KVLEN/KVBLK;
  DMA_K(0,0);DMA_V(0,0);DMA_K(1,SLOTB);
  bf16x8 qr[4];
  #pragma unroll
  for(int d0=0;d0<4;++d0)qr[d0]=*reinterpret_cast<const bf16x8*>(&Qw[(long)r32*QP+d0*16+hi*8]);
  float mhat=0.f,l_reg=0.f;f32x16 o[2];o[0]=f32x16{};o[1]=f32x16{};f32x16 negm=f32x16{};asm volatile("":"+v"(negm));
  #define CMASK(P0,P1,t) do{}while(0)
  bool resc=false;
  #define START(P0,P1) do{ const float rm=rowmax(P0,P1); resc=false; \
    { const float dl=rm; mhat=fadd_s(mhat,dl); \
      _Pragma("unroll") for(int r=0;r<16;++r){P0[r]=fsub_s(P0[r],dl);P1[r]=fsub_s(P1[r],dl);} \
      _Pragma("unroll") for(int r=0;r<16;++r)negm[r]=-mhat; asm volatile("":"+v"(negm)); } \
    _Pragma("unroll") for(int r=0;r<16;++r)P0[r]=__builtin_amdgcn_exp2f(P0[r]); }while(0)
  #define RESC() do{ if(resc){ asm volatile("s_waitcnt lgkmcnt(0)":::"memory"); \
      _Pragma("unroll") for(int d_=0;d_<2;++d_) _Pragma("unroll") for(int r=0;r<16;++r)o[d_][r]*=wsf[crow(r,hi)]; } }while(0)
  f32x16 pA0,pA1,pB0,pB1;
  int sl_prev=0,sl_cur=0,sl_next=SLOTB;
  #define ROT() do{sl_prev=sl_cur;sl_cur=sl_next;sl_next=(sl_next==(NSLOT-1)*SLOTB)?0:sl_next+SLOTB;}while(0)
  DMA_K(2,2*SLOTB);
  WAIT_BAR(3);
  qkt(pA0,pA1,Kbase,qr,negm,r32,hi);asm volatile("s_nop 15\n\ts_nop 7":"+v"(pA0),"+v"(pA1));CMASK(pA0,pA1,0);
  START(pA0,pA1);
  _Pragma("unroll") for(int r=0;r<16;++r)pA1[r]=__builtin_amdgcn_exp2f(pA1[r]);
  WAIT_BAR(0);
  DMA_K(3,0);DMA_V(1,SLOTB);
  ROT();
  kload8(kf,kp0+sl_cur);
  WAIT_BAR(2);
  s16x4 vlo[8],vhi[8]; u32x4 pw0,pw1,pw2,pw3;
  #define PKW(P,B) cvtpk_s(P[B],P[B+1])
  #define PAF(k) __builtin_bit_cast(bf16x8,pw##k)
  #define VFR(i) (bf16x8){vlo[i][0],vlo[i][1],vlo[i][2],vlo[i][3],vhi[i][0],vhi[i][1],vhi[i][2],vhi[i][3]}
  #define PIN(x) asm volatile("":"+v"(x))
  #define MX3(a,b,c) __builtin_fmaxf(__builtin_fmaxf((a),(b)),(c))
  #define GAPA(MF,A0,A1,A2,A3,W0,W1,PW) do{ MF; sacc+=A0; sacc+=A1; sacc+=A2; sacc+=A3; PIN(sacc); W0; W1; PIN(PW); SBAR(); }while(0)
  #define EX(v) __builtin_amdgcn_exp2f(v)
  #define GAPB(MF,X,B) do{ MF; X[B]=EX(X[B]); X[B+1]=EX(X[B+1]); X[B+2]=EX(X[B+2]); X[B+3]=EX(X[B+3]); PIN(X); SBAR(); }while(0)
  #define VRD(i) do{ vlo[i]=vtr(vp_+(((i)>>2)*4096+((i)&3)*1024)); vhi[i]=vtr(vp_+(((i)>>2)*4096+((i)&3)*1024+512)); }while(0)
  #define KRD(G,j) do{ if(G){ kload2(kf,kp0+sl_next,j); SBAR(); } }while(0)
  #define STEP(C0,C1,P0,P1,t,GK,GV,GL) do{ SBAR(); \
    const lds_cptr vp_=vp0+sl_prev; \
    VRD(0); SBAR(); float sacc=(P0[0]+P0[1]); \
    GAPA(C0=__builtin_amdgcn_mfma_f32_32x32x16_bf16(kf[0],qr[0],negm,0,0,0), P0[2],P0[3],P0[4],P0[5],     pw0[0]=PKW(P0,0), pw0[1]=PKW(P0,2), pw0); \
    VRD(4); SBAR(); GAPA(C1=__builtin_amdgcn_mfma_f32_32x32x16_bf16(kf[1],qr[0],negm,0,0,0), P0[6],P0[7],P0[8],P0[9],     pw0[2]=PKW(P0,4), pw0[3]=PKW(P0,6), pw0); \
    VRD(1); SBAR(); GAPA(C0=__builtin_amdgcn_mfma_f32_32x32x16_bf16(kf[2],qr[1],C0,0,0,0),   P0[10],P0[11],P0[12],P0[13], pw1[0]=PKW(P0,8), pw1[1]=PKW(P0,10), pw1); \
    VRD(5); SBAR(); GAPA(C1=__builtin_amdgcn_mfma_f32_32x32x16_bf16(kf[3],qr[1],C1,0,0,0),   P0[14],P0[15],P1[0],P1[1],   pw1[2]=PKW(P0,12),pw1[3]=PKW(P0,14), pw1); \
    VRD(2); SBAR(); GAPA(C0=__builtin_amdgcn_mfma_f32_32x32x16_bf16(kf[4],qr[2],C0,0,0,0),   P1[2],P1[3],P1[4],P1[5],     pw2[0]=PKW(P1,0), pw2[1]=PKW(P1,2), pw2); \
    VRD(6); SBAR(); GAPA(C1=__builtin_amdgcn_mfma_f32_32x32x16_bf16(kf[5],qr[2],C1,0,0,0),   P1[6],P1[7],P1[8],P1[9],     pw2[2]=PKW(P1,4), pw2[3]=PKW(P1,6), pw2); \
    VRD(3); SBAR(); GAPA(C0=__builtin_amdgcn_mfma_f32_32x32x16_bf16(kf[6],qr[3],C0,0,0,0),   P1[10],P1[11],P1[12],P1[13], pw3[0]=PKW(P1,8), pw3[1]=PKW(P1,10), pw3); \
    VRD(7); SBAR(); GAPA(C1=__builtin_amdgcn_mfma_f32_32x32x16_bf16(kf[7],qr[3],C1,0,0,0),   P1[14],P1[15],0.f,0.f,       pw3[2]=PKW(P1,12),pw3[3]=PKW(P1,14), pw3); \
    l_reg+=sacc; \
    if(GK){DMA_K((t)+3,sl_cur);} if(GV){DMA_V((t)+1,sl_next);} \
    CMASK(C0,C1,t); \
    { float a=MX3(C0[0],C0[1],C1[0]),b=MX3(C0[2],C0[3],C1[1]); a=MX3(a,C1[2],C1[3]); \
      _Pragma("unroll") for(int r=4;r<16;r+=4){a=MX3(a,C0[r],C0[r+1]);b=MX3(b,C0[r+2],C0[r+3]);a=MX3(a,C1[r],C1[r+1]);b=MX3(b,C1[r+2],C1[r+3]);} \
      float rm=__builtin_fmaxf(a,b); { auto rr=__builtin_amdgcn_permlane32_swap(__float_as_uint(rm),__float_as_uint(rm),false,false); rm=__builtin_fmaxf(__uint_as_float(rr[0]),__uint_as_float(rr[1])); } \
      resc=false; \
      if(__builtin_expect(__any(rm>(float)THRL),0)){ const float dl=__builtin_fmaxf(rm,0.f); mhat+=dl; \
        _Pragma("unroll") for(int r=0;r<16;++r){C0[r]-=dl;C1[r]-=dl;} \
        _Pragma("unroll") for(int r=0;r<16;++r)negm[r]=-mhat; asm volatile("":"+v"(negm)); \
        const float f=__builtin_amdgcn_exp2f(-dl); l_reg*=f; if(hi==0)wsf[r32]=f; resc=true; } } \
    SBAR(); \
    GAPB(o[0]=__builtin_amdgcn_mfma_f32_32x32x16_bf16(PAF(0),VFR(0),o[0],0,0,0), C0,0); \
    GAPB(o[1]=__builtin_amdgcn_mfma_f32_32x32x16_bf16(PAF(0),VFR(4),o[1],0,0,0), C0,4); \
    KRD(GL,0); GAPB(o[0]=__builtin_amdgcn_mfma_f32_32x32x16_bf16(PAF(1),VFR(1),o[0],0,0,0), C0,8); \
    KRD(GL,1); GAPB(o[1]=__builtin_amdgcn_mfma_f32_32x32x16_bf16(PAF(1),VFR(5),o[1],0,0,0), C0,12); \
    KRD(GL,2); GAPB(o[0]=__builtin_amdgcn_mfma_f32_32x32x16_bf16(PAF(2),VFR(2),o[0],0,0,0), C1,0); \
    KRD(GL,3); GAPB(o[1]=__builtin_amdgcn_mfma_f32_32x32x16_bf16(PAF(2),VFR(6),o[1],0,0,0), C1,4); \
    GAPB(o[0]=__builtin_amdgcn_mfma_f32_32x32x16_bf16(PAF(3),VFR(3),o[0],0,0,0), C1,8); \
    GAPB(o[1]=__builtin_amdgcn_mfma_f32_32x32x16_bf16(PAF(3),VFR(7),o[1],0,0,0), C1,12); \
    }while(0)
  int t=1;
  #undef CMASK
  #define CMASK(P0,P1,t) do{}while(0)
  for(;t+5<NT;t+=2){
    STEP(pB0,pB1,pA0,pA1,t,true,true,true);     WAIT_BAR(2); RESC(); ROT();
    STEP(pA0,pA1,pB0,pB1,t+1,true,true,true);   WAIT_BAR(2); RESC(); ROT();
  }
  #undef CMASK
  #define CMASK(P0,P1,t) do{}while(0)
  #define ENDW(tt) do{ if((tt)+3<NT){WAIT_BAR(2);} else if((tt)+2<NT){WAIT_BAR(1);} else {WAIT_BAR(0);} }while(0)
  for(;t+1<NT;t+=2){
    STEP(pB0,pB1,pA0,pA1,t,(t+3<NT),(t+1<NT),(t+1<NT));       ENDW(t);   RESC(); ROT();
    STEP(pA0,pA1,pB0,pB1,t+1,(t+4<NT),(t+2<NT),(t+2<NT));     ENDW(t+1); RESC(); ROT();
  }
  STEP(pB0,pB1,pA0,pA1,NT-1,false,false,false); RESC();
  { float sacc=pB0[0]+pB0[1]; _Pragma("unroll") for(int r=2;r<16;++r)sacc+=pB0[r]; _Pragma("unroll") for(int r=0;r<16;++r)sacc+=pB1[r]; l_reg+=sacc;
    pw0=(u32x4){PKW(pB0,0),PKW(pB0,2),PKW(pB0,4),PKW(pB0,6)};pw1=(u32x4){PKW(pB0,8),PKW(pB0,10),PKW(pB0,12),PKW(pB0,14)};pw2=(u32x4){PKW(pB1,0),PKW(pB1,2),PKW(pB1,4),PKW(pB1,6)};pw3=(u32x4){PKW(pB1,8),PKW(pB1,10),PKW(pB1,12),PKW(pB1,14)};
    SBAR(); pv(o,vb0+sl_cur,PAF(0),PAF(1),PAF(2),PAF(3)); }
  #undef PKW
  #undef PAF
  #undef VFR
  #undef PIN
  #undef MX3
  #undef GAPA
  #undef GAPB
  #undef EX
  #undef VRD
  #undef KRD
  #undef STEP
  #undef ENDW
  {auto rr=__builtin_amdgcn_permlane32_swap(__float_as_uint(l_reg),__float_as_uint(l_reg),false,false);l_reg=__uint_as_float(rr[0])+__uint_as_float(rr[1]);}
  if(hi==0)wsf[32+r32]=l_reg;asm volatile("s_waitcnt lgkmcnt(0)":::"memory");
  float rli[16];
  #pragma unroll
  for(int r=0;r<16;++r)rli[r]=__builtin_amdgcn_rcpf(wsf[32+crow(r,hi)]);
  bf16*Ow=O+qrow0*QP+h*D;
  { bf16*stg=(bf16*)(shm+LDS_OST)+wid*2048;
    #pragma unroll
    for(int r=0;r<16;++r){const int orow=crow(r,hi);
      #pragma unroll
      for(int d0=0;d0<2;++d0)stg[orow*64+d0*32+r32]=__float2bfloat16(o[d0][r]*rli[r]);}
    asm volatile("s_waitcnt lgkmcnt(0)":::"memory");
    #pragma unroll
    for(int i=0;i<4;++i){const int row=i*8+(lane>>3),ch=lane&7; const u32x4 v=*(const u32x4*)(stg+row*64+ch*8); ATTN_STORE16(Ow+(long)row*QP+ch*8,v);} }
  asm volatile("s_waitcnt lgkmcnt(0)\n\ts_barrier":::"memory");
  #undef DMA_K
  #undef DMA_V
  #undef CMASK
  #undef START
  #undef RESC
  #undef ROT
}
constexpr int ATTN_LDS_BYTES=LDS_BYTES;
struct AttnTensors { const bf16* Q; const bf16* K; const bf16* V; bf16* O; };
struct AttnUnit { int b; int h; int qb; };
struct StaticOrder {
  int vcu;
  __device__ __forceinline__ explicit StaticOrder(int v):vcu(v){}
  __device__ __forceinline__ bool next(int i,AttnUnit&u)const{ if(i>=8)return false; const int xcd=vcu>>5,lc=vcu&31; const int grp=xcd*4+(i>>1); const int idx=(i&1)*32+lc;
    u.b=grp>>1; u.h=(grp&1)*4+(idx>>4); u.qb=idx&15; return true; }
};
template<class Sched,int THRL=8> __device__ __forceinline__ void attn_phase(char*lds,const AttnTensors&T,const Sched&S,int wave_){
  AttnUnit u;
  for(int i=0;S.next(i,u);++i){ attn_unit<THRL>(u.b,u.h,u.qb,T.Q,T.K,T.V,T.O,lds,wave_); }
}
#undef SBAR
#undef WAIT_BAR
}
#define XB_TMO      128
#define XB_XCNT(j)  (256  + 64 * (j))
#define XB_XSUB(j)  (1280 + 64 * (j))
#define XB_XGEN(j)  (2304 + 64 * (j))
#define XB_TOP      3328
#define XB_TOPGEN   3392
#define XCD_BAR_WORDS 3456
#define XB_SPIN_CAP (1u << 18)

__device__ __forceinline__ unsigned xb_ld(unsigned* p)              { return __hip_atomic_load(p, __ATOMIC_RELAXED, __HIP_MEMORY_SCOPE_AGENT); }
__device__ __forceinline__ unsigned xb_add(unsigned* p, unsigned v) { return __hip_atomic_fetch_add(p, v, __ATOMIC_RELAXED, __HIP_MEMORY_SCOPE_AGENT); }
__device__ __forceinline__ unsigned xb_xcc_id() { return (unsigned)__builtin_amdgcn_s_getreg((3 << 11) | 20) & 0xFu; }
#define XB_SPIN(cond, bar) do { unsigned _sp = 0; while (cond) { __builtin_amdgcn_s_sleep(1); \
    if ((++_sp & 255u) == 0u) { if (xb_ld(&(bar)[XB_TMO])) break; if (_sp > XB_SPIN_CAP) { atomicAdd(&(bar)[XB_TMO], 1u); break; } } } } while (0)

struct XcdBarrier {
    unsigned wv; unsigned* bar; unsigned x;
    volatile LAS unsigned* st;
};

__device__ __forceinline__ XcdBarrier xcd_barrier_post(unsigned* bar, volatile LAS unsigned* st) {
    XcdBarrier b; b.bar = bar; b.x = xb_xcc_id(); b.st = st;
    if (threadIdx.x == 0) (void)xb_add(&bar[XB_XCNT(b.x)], 1u);
    b.wv = (unsigned)__builtin_amdgcn_readfirstlane((int)(threadIdx.x >> 6));
    return b;
}
__device__ __forceinline__ void xcd_barrier_complete(unsigned* bar, unsigned x, unsigned& nloc, unsigned& nx) {
    const unsigned G = gridDim.x * gridDim.y * gridDim.z;
    unsigned sum, cnt, mine, sp = 0u;
    for (;;) {
        sum = 0u; cnt = 0u; mine = 0u;
#pragma unroll
        for (unsigned j = 0; j < 16; ++j) { const unsigned c = xb_ld(&bar[XB_XCNT(j)]); sum += c; cnt += (c > 0u) ? 1u : 0u; mine = (j == x) ? c : mine; }
        if (sum == G) break;
        __builtin_amdgcn_s_sleep(1);
        if ((++sp & 255u) == 0u) { if (xb_ld(&bar[XB_TMO])) break; if (sp > XB_SPIN_CAP) { atomicAdd(&bar[XB_TMO], 1u); break; } }
    }
    nloc = mine > 0u ? mine : 1u; nx = cnt > 0u ? cnt : 1u;
}

__device__ __forceinline__ void xcd_barrier(const XcdBarrier& b) {
    asm volatile("s_waitcnt vmcnt(0)" ::: "memory");
    __syncthreads();
    if (b.wv == 0u && lane_id() == 0) {
        unsigned* bar = b.bar;
        __builtin_amdgcn_s_waitcnt(0);
        unsigned nloc = b.st[0], nx = b.st[1];
        if (nloc == 0u) { xcd_barrier_complete(bar, b.x, nloc, nx); b.st[0] = nloc; b.st[1] = nx; }
        const unsigned old = xb_add(&bar[XB_XSUB(b.x)], 1u);
        const unsigned gen = old / nloc;
        if (old + 1u == (gen + 1u) * nloc) {
            __builtin_amdgcn_fence(__ATOMIC_RELEASE, "agent");
            asm volatile("s_waitcnt vmcnt(0)" ::: "memory");
            const unsigned og = xb_add(&bar[XB_TOP], 1u);
            const unsigned tg = og / nx;
            if (og + 1u == (tg + 1u) * nx) xb_add(&bar[XB_TOPGEN], 1u);
            else XB_SPIN(xb_ld(&bar[XB_TOPGEN]) == tg, bar);
            __builtin_amdgcn_fence(__ATOMIC_ACQUIRE, "agent");
            xb_add(&bar[XB_XGEN(b.x)], 1u);
            asm volatile("s_waitcnt vmcnt(0)" ::: "memory");
        } else {
            XB_SPIN(xb_ld(&bar[XB_XGEN(b.x)]) == gen, bar);
            __builtin_amdgcn_fence(__ATOMIC_ACQUIRE, "agent");
            asm volatile("s_waitcnt vmcnt(0)" ::: "memory");
        }
    }
    __syncthreads();
}


typedef GAS unsigned gu32;
#define RLX_AGENT __ATOMIC_RELAXED, __HIP_MEMORY_SCOPE_AGENT
#define LDS_WAIT() asm volatile("s_waitcnt lgkmcnt(0)" ::: "memory")
#define VM_WAIT() asm volatile("s_waitcnt vmcnt(0)" ::: "memory")
constexpr int N_IN = 34;
enum { I_X = 0, I_C, I_CTX, I_CCTX, I_MODW, I_MODB, I_NORM1, I_WIN, I_QNW, I_KNW, I_CONVW, I_CONVB, I_FW1, I_FB1, I_FW2, I_FB2, I_FW3, I_FB3, I_FW4, I_FFREQ,
       I_HBIAS, I_AONW, I_HONW, I_WOUT, I_NORM2, I_RW, I_RB, I_EG, I_EU, I_ED, I_SG, I_SU, I_SD, I_FNW };
struct Frame {
    LAS unsigned char* lds;
    volatile LAS unsigned* MISC;
    unsigned* ctl;
    int tid, lane, wave, vcu, G;
    float* out; unsigned char* ws;
};
typedef const __attribute__((address_space(4))) char* kargp_t;
__device__ __forceinline__ const float* kin(int i) { kargp_t p = (kargp_t)__builtin_amdgcn_kernarg_segment_ptr(); asm volatile("" : "+s"(p)); return (const float*)*(const GAS float* const __attribute__((address_space(4)))*)(p + 8 * i); }
#define WSP(T, off) ((T*)(F.ws + (off)))

__device__ __forceinline__ void tr_item(const float* W, int ldw, int k0, int n0, bf16_t* WT, int Kd, int drow0, LAS float* scr, int lane) {
#pragma unroll 8
    for (int i = 0; i < 32; ++i) { const int kk = 2 * i + (lane >> 5); scr[kk * 33 + (lane & 31)] = W[(size_t)(k0 + kk) * ldw + n0 + (lane & 31)]; }
    LDS_WAIT(); asm volatile("" ::: "memory");
    const int c = lane & 7;
#pragma unroll
    for (int j = 0; j < 4; ++j) { const int n = (lane >> 3) + 8 * j; const LAS float* s = scr + (8 * c) * 33 + n;
        u32x4 o; o.x = pk2(s[0 * 33], s[1 * 33]); o.y = pk2(s[2 * 33], s[3 * 33]); o.z = pk2(s[4 * 33], s[5 * 33]); o.w = pk2(s[6 * 33], s[7 * 33]);
        *(u32x4*)(WT + (size_t)(drow0 + n) * Kd + k0 + 8 * c) = o; }
    LDS_WAIT(); asm volatile("" ::: "memory");
}
__device__ __forceinline__ unsigned pk4_fp8(float a, float b, float c, float d) { int w = __builtin_amdgcn_cvt_pk_fp8_f32(a, b, 0, false); w = __builtin_amdgcn_cvt_pk_fp8_f32(c, d, w, true); return (unsigned)w; }
__device__ __forceinline__ void tr_item8(const float* W, int ldw, int k0, int n0, unsigned char* WT, int Kd, int drow0, float scl, LAS float* scr, int lane) {
#pragma unroll 8
    for (int i = 0; i < 32; ++i) { const int kk = 2 * i + (lane >> 5); scr[kk * 33 + (lane & 31)] = W[(size_t)(k0 + kk) * ldw + n0 + (lane & 31)]; }
    LDS_WAIT(); asm volatile("" ::: "memory");
    const int c = lane & 7;
#pragma unroll
    for (int j = 0; j < 4; ++j) { const int n = (lane >> 3) + 8 * j; const LAS float* s = scr + (8 * c) * 33 + n;
        u32x2 o; o.x = pk4_fp8(s[0 * 33] * scl, s[1 * 33] * scl, s[2 * 33] * scl, s[3 * 33] * scl); o.y = pk4_fp8(s[4 * 33] * scl, s[5 * 33] * scl, s[6 * 33] * scl, s[7 * 33] * scl);
        *(u32x2*)(WT + (size_t)(drow0 + n) * Kd + k0 + 8 * c) = o; }
    LDS_WAIT(); asm volatile("" ::: "memory");
}
constexpr int IT_FILT = 2048, IT_MODV = 0, IT_ROPE = 1, IT_QKV = 384, IT_WU = 768, IT_WO = 512, IT_WR = 128, IT_SGU = 256, IT_SD = 128, IT_EXP = 256 * 384;
constexpr int IT_TILES = IT_QKV + IT_WU + IT_WO + IT_WR + IT_SGU + IT_SD;
constexpr int XP_TILES = 256 * 48;

template <int NT_> __device__ __forceinline__ void p0_filter_item(Frame& F, int item, LAS float* hsc) {
    const int lane = F.lane; const int t0 = NT_ * item;
    const float* w1 = kin(I_FW1); const float* b1 = kin(I_FB1); const float* w2 = kin(I_FW2); const float* b2 = kin(I_FB2);
    const float* w3 = kin(I_FW3); const float* b3 = kin(I_FB3); const float* w4 = kin(I_FW4); const float fr = kin(I_FFREQ)[lane];
    float h[NT_], a[NT_];
#pragma unroll
    for (int tt = 0; tt < NT_; ++tt) { const int t = t0 + tt; float v = 0.f;
        if (lane == 0) v = (float)t * (1.0f / 4095.0f);
        else if (lane < 33) { const int m = (lane - 1) & 15; const float f = 1e-4f + (float)m * ((15.0f - 1e-4f) / 15.0f);
            float rev = f * ((float)t * (1.0f / 4096.0f)); rev -= floorf(rev); const float ang = 6.283185307179586f * rev;
            v = lane <= 16 ? cosf(ang) : -sinf(ang); }
        h[tt] = v; }
#pragma unroll
    for (int l = 0; l < 3; ++l) { const float* ww = l == 0 ? w1 : l == 1 ? w2 : w3; const float bb = (l == 0 ? b1 : l == 1 ? b2 : b3)[lane];
        float wc[64];
#pragma unroll
        for (int i = 0; i < 64; ++i) wc[i] = (l == 0 && i >= 33) ? 0.f : ww[i * 64 + lane];
#pragma unroll
        for (int tt = 0; tt < NT_; ++tt) a[tt] = bb;
#pragma unroll
        for (int i = 0; i < 64; ++i) { if (l == 0 && i >= 33) break;
#pragma unroll
            for (int tt = 0; tt < NT_; ++tt) a[tt] += __shfl(h[tt], i) * wc[i]; }
#pragma unroll
        for (int tt = 0; tt < NT_; ++tt) h[tt] = sinf(fr * a[tt]); }
#pragma unroll
    for (int tt = 0; tt < NT_; ++tt) hsc[tt * 64 + lane] = h[tt];
    LDS_WAIT(); asm volatile("" ::: "memory");
    bf16_t* KR = WSP(bf16_t, WS_KR);
    const float dmin = logf(1e-2f) / 0.3f, dmax = logf(1e-2f) / 1.5f;
#pragma unroll 1
    for (int q = 0; q < 16; ++q) {
        const int n = lane + 64 * q; float wc[64];
#pragma unroll
        for (int i = 0; i < 64; ++i) wc[i] = w4[i * 1024 + n];
        float o[NT_];
#pragma unroll
        for (int tt = 0; tt < NT_; ++tt) o[tt] = 0.f;
#pragma unroll
        for (int i4 = 0; i4 < 16; ++i4)
#pragma unroll
            for (int tt = 0; tt < NT_; ++tt) { const f32x4 hv = *(const LAS f32x4*)(hsc + tt * 64 + 4 * i4);
                o[tt] += (hv[0] * wc[4 * i4] + hv[1] * wc[4 * i4 + 1]) + (hv[2] * wc[4 * i4 + 2] + hv[3] * wc[4 * i4 + 3]); }
        const int c = n & 511; const bool bwd = n >= 512;
        const float delta = fabsf(dmin + (float)c * ((dmax - dmin) / 511.0f));
#pragma unroll
        for (int tt = 0; tt < NT_; ++tt) { const int t = t0 + tt; const float tl = (float)t * (1.0f / 4095.0f);
            const float val = o[tt] * expf(-tl * delta);
            if (!(bwd && t == 0)) {
#if HYENA_FP8
                ((unsigned char*)KR)[(size_t)c * 8192 + (bwd ? 4096 + t : 4096 - t)] = (unsigned char)(pk4_fp8c(val * 64.0f, 0.f, 0.f, 0.f) & 0xffu);
#else
                KR[(size_t)c * 8192 + (bwd ? 4096 + t : 4096 - t)] = (bf16_t)f2bf(val);
#endif
            } }
    }
}
__device__ __forceinline__ void p0_modv_block(Frame& F, int chunk) {
    const int lane = F.lane, kc = F.wave; const int n0 = 64 * chunk, k0 = 128 * kc;
    LAS float* sv = (LAS float*)(F.lds + RING_OFF + F.wave * 8704);
    LAS float* part = (LAS float*)(F.lds + RING_OFF + 8 * 8704);
    for (int r = 0; r < 17; ++r)
#pragma unroll
        for (int hh = 0; hh < 2; ++hh) { const int kk = lane + 64 * hh; const float v = r < 16 ? kin(I_C)[r * 1024 + k0 + kk] : kin(I_CCTX)[k0 + kk];
            sv[r * 128 + kk] = v / (1.0f + expf(-v)); }
    LDS_WAIT(); asm volatile("" ::: "memory");
    float acc[17];
#pragma unroll
    for (int r = 0; r < 17; ++r) acc[r] = 0.f;
    const float* W = kin(I_MODW) + (size_t)k0 * 6144 + n0 + lane;
    for (int k4 = 0; k4 < 32; ++k4) {
        const float w0 = W[(size_t)(4 * k4 + 0) * 6144], w1 = W[(size_t)(4 * k4 + 1) * 6144], w2 = W[(size_t)(4 * k4 + 2) * 6144], w3 = W[(size_t)(4 * k4 + 3) * 6144];
#pragma unroll
        for (int r = 0; r < 17; ++r) { const f32x4 s = *(const LAS f32x4*)(sv + r * 128 + 4 * k4); acc[r] += (s[0] * w0 + s[1] * w1) + (s[2] * w2 + s[3] * w3); }
    }
#pragma unroll
    for (int r = 0; r < 17; ++r) part[(kc * 17 + r) * 64 + lane] = acc[r];
    __syncthreads();
    if (F.wave == 0) { float* mv = WSP(float, WS_MODV); const float bb = kin(I_MODB)[n0 + lane];
#pragma unroll
        for (int r = 0; r < 17; ++r) { float s = bb;
#pragma unroll
            for (int k = 0; k < 8; ++k) s += part[(k * 17 + r) * 64 + lane];
            mv[r * 6144 + n0 + lane] = s; } }
    __syncthreads();
}
struct XpT { const float* src; unsigned char* dst; int ldw, Kd, which; };
__device__ __forceinline__ XpT xp_params(Frame& F, int ti) {
    XpT p; const int e = ti / 48, q = ti % 48;
    if (q < 32) { const int which = q >> 4, kb = q & 15; p.src = kin(which ? I_EU : I_EG) + (size_t)e * (1024 * 256) + (size_t)(64 * kb) * 256; p.ldw = 256;
        p.dst = WSP(unsigned char, WS_WGU) + (size_t)e * (512 * 1024) + 64 * kb; p.Kd = 1024; p.which = which; }
    else { const int r = q - 32, kb = r & 3, cb = r >> 2; p.src = kin(I_ED) + (size_t)e * (256 * 1024) + (size_t)(64 * kb) * 1024 + 256 * cb; p.ldw = 1024;
        p.dst = WSP(unsigned char, WS_WD) + (size_t)e * (1024 * 256) + (size_t)(256 * cb) * 256 + 64 * kb; p.Kd = 256; p.which = -1; }
    return p;
}
__device__ __forceinline__ void xp_load(const XpT& p, f32x4 (&v)[8], int tid) {
#pragma unroll
    for (int i = 0; i < 8; ++i) { const int g = tid + 512 * i; v[i] = *(const f32x4*)(p.src + (size_t)(g >> 6) * p.ldw + 4 * (g & 63)); }
}
__device__ __forceinline__ void xp_tiles(Frame& F) {
    constexpr int PK = 65, PLANE = 64 * PK + 2, BUF = 4 * PLANE;
    LAS float* L0 = (LAS float*)(F.lds + RING_OFF);
    const int tid = F.tid;
    f32x4 va[8], vb[8], vc[8]; XpT pa, pb, pc;
    volatile LAS int* qw = (volatile LAS int*)(F.MISC + 16);
    if (tid == 0) { qw[0] = (int)__hip_atomic_fetch_add(F.ctl + CW_TILEQ, 1u, RLX_AGENT); qw[1] = (int)__hip_atomic_fetch_add(F.ctl + CW_TILEQ, 1u, RLX_AGENT); qw[2] = (int)__hip_atomic_fetch_add(F.ctl + CW_TILEQ, 1u, RLX_AGENT); }
    LDS_WAIT(); __syncthreads();
    int ti = qw[0], tn = qw[1], t2 = qw[2], par = 0;
    __syncthreads();
    if (ti < XP_TILES) { pa = xp_params(F, ti); xp_load(pa, va, tid); }
    if (tn < XP_TILES) { pb = xp_params(F, tn); xp_load(pb, vb, tid); }
    while (ti < XP_TILES) {
        const bool hn = tn < XP_TILES, h2 = t2 < XP_TILES;
        if (h2) { pc = xp_params(F, t2); xp_load(pc, vc, tid); }
        if (tid == 0) qw[4 + par] = h2 ? (int)__hip_atomic_fetch_add(F.ctl + CW_TILEQ, 1u, RLX_AGENT) : XP_TILES;
        LAS float* buf = L0 + par * BUF;
#pragma unroll
        for (int i = 0; i < 8; ++i) { const int g = tid + 512 * i; LAS float* d = buf + (g >> 6) * PK + (g & 63);
            d[0] = va[i][0]; d[PLANE] = va[i][1]; d[2 * PLANE] = va[i][2]; d[3 * PLANE] = va[i][3]; }
        LDS_WAIT(); __syncthreads();
        const int t3 = qw[4 + par];
#pragma unroll
        for (int i = 0; i < 4; ++i) { const int pr = tid + 512 * i; const int kc = pr & 7, n = pr >> 3;
            const LAS float* s = buf + (n & 3) * PLANE + (8 * kc) * PK + (n >> 2);
            u32x2 o; o.x = pk4_fp8(s[0] * 32.f, s[PK] * 32.f, s[2 * PK] * 32.f, s[3 * PK] * 32.f); o.y = pk4_fp8(s[4 * PK] * 32.f, s[5 * PK] * 32.f, s[6 * PK] * 32.f, s[7 * PK] * 32.f);
            const int row = pa.which < 0 ? n : 256 * (n >> 7) + 128 * pa.which + (n & 127);
            *(u32x2*)(pa.dst + (size_t)row * pa.Kd + 8 * kc) = o; }
        if (hn) { pa = pb; pb = pc;
#pragma unroll
            for (int i = 0; i < 8; ++i) { va[i] = vb[i]; vb[i] = vc[i]; } }
        ti = tn; tn = t2; t2 = t3; par ^= 1;
    }
    LDS_WAIT(); __syncthreads();
}
__device__ __forceinline__ void p0_prologue(Frame& F) {
    LAS float* scr = (LAS float*)(F.lds + RING_OFF + F.wave * 16384);
    const int gw = F.vcu * NWAVES + F.wave, NGW = F.G * NWAVES; const int lane = F.lane;
    __syncthreads();
    for (int ch = F.vcu; ch < 96; ch += F.G) p0_modv_block(F, ch);
    for (int it = gw; it < IT_FILT; it += NGW) { p0_filter_item<2>(F, it, scr); LDS_WAIT(); }
    if (gw == NGW - 1) { f32x2* rope = WSP(f32x2, WS_ROPE);
        for (int idx = lane; idx < 1024; idx += 64) { const int pos = idx >> 4, f = idx & 15; const float inv = powf(10000.0f, -(float)f / 16.0f); const float ang = (float)pos * inv;
            rope[idx] = (f32x2){cosf(ang), sinf(ang)}; } }
    for (int it = gw; it < IT_TILES; it += NGW) {
        int r = it;
        if (r < IT_QKV) { const int cb = r >> 4, kb = r & 15, n0 = 32 * cb; const int pn = n0 >> 8, hl = (n0 & 255) >> 6, dh = (n0 & 63) >> 5;
            tr_item(kin(I_WIN), 2304, 64 * kb, n0, WSP(bf16_t, WS_WQKV), 1024, 256 * pn + 128 * dh + 32 * hl, scr, lane); continue; } r -= IT_QKV;
        if (r < IT_WU) { const int cb = r >> 4, kb = r & 15; tr_item8(kin(I_WIN), 2304, 64 * kb, 768 + 32 * cb, WSP(unsigned char, WS_WU), 1024, 32 * cb, 32.0f, scr, lane); continue; } r -= IT_WU;
        if (r < IT_WO) { const int cb = r >> 4, kb = r & 15; tr_item(kin(I_WOUT), 1024, 64 * kb, 32 * cb, WSP(bf16_t, WS_WO), 1024, 32 * cb, scr, lane); continue; } r -= IT_WO;
        if (r < IT_WR) { const int cb = r >> 4, kb = r & 15; tr_item(kin(I_RW), 256, 64 * kb, 32 * cb, WSP(bf16_t, WS_WR), 1024, 32 * cb, scr, lane); continue; } r -= IT_WR;
        if (r < IT_SGU) { const int which = r >> 7, rr = r & 127, cb = rr >> 4, kb = rr & 15, j0 = 32 * cb;
            tr_item8(kin(which ? I_SU : I_SG), 256, 64 * kb, j0, WSP(unsigned char, WS_WSGU8), 1024, 256 * (j0 >> 7) + 128 * which + (j0 & 127), 32.0f, scr, lane); continue; } r -= IT_SGU;
        if (r < IT_SD) { const int kb = r & 3, cb = r >> 2; tr_item8(kin(I_SD), 1024, 64 * kb, 32 * cb, WSP(unsigned char, WS_WSD), 256, 32 * cb, 32.0f, scr, lane); continue; } r -= IT_SD;
    }
    __syncthreads();
    xp_tiles(F);
}

template <int NR, bool F8> __device__ __forceinline__ void modulate_group(Frame& F, const float* src, bf16_t* dst, unsigned char* dst8, int row, const f32x4 (&A)[4], const f32x4 (&Bv)[4]) {
    const f32x4* xr = (const f32x4*)(src + (size_t)row * DM) + F.lane;
    f32x4 v[NR][4]; float ss[NR];
#pragma unroll
    for (int q = 0; q < NR; ++q)
#pragma unroll
        for (int j = 0; j < 4; ++j) v[q][j] = xr[q * (DM / 4) + 64 * j];
#pragma unroll
    for (int q = 0; q < NR; ++q) { float a = 0.f;
#pragma unroll
        for (int j = 0; j < 4; ++j) a += (v[q][j][0] * v[q][j][0] + v[q][j][1] * v[q][j][1]) + (v[q][j][2] * v[q][j][2] + v[q][j][3] * v[q][j][3]);
        ss[q] = a; }
#pragma unroll
    for (int o = 1; o < 64; o <<= 1) {
#pragma unroll
        for (int q = 0; q < NR; ++q) ss[q] += __shfl_xor(ss[q], o); }
#pragma unroll
    for (int q = 0; q < NR; ++q) { const float rs = rsqrtf(ss[q] * (1.0f / DM) + EPS);
        u32x2* o8 = (u32x2*)(dst + (size_t)(row + q) * DM) + F.lane;
#pragma unroll
        for (int j = 0; j < 4; ++j) { const f32x4 o = v[q][j] * rs * A[j] + Bv[j]; u32x2 w; w.x = pk2(o[0], o[1]); w.y = pk2(o[2], o[3]); o8[64 * j] = w;
            if (F8) ((unsigned*)(dst8 + (size_t)(row + q) * DM))[F.lane + 64 * j] = pk4_fp8c(o[0] * 8.0f, o[1] * 8.0f, o[2] * 8.0f, o[3] * 8.0f); } }
}
template <bool F8 = false> __device__ __forceinline__ void modulate_rows(Frame& F, const float* src, bf16_t* dst, int row0, int nrows, const float* nw, const float* sc, const float* sh, unsigned char* dst8 = nullptr) {
    f32x4 A[4], Bv[4];
#pragma unroll
    for (int j = 0; j < 4; ++j) { const int c = 4 * F.lane + 256 * j; const f32x4 n4 = *(const f32x4*)(nw + c), s4 = *(const f32x4*)(sc + c); A[j] = n4 * (s4 + 1.0f); Bv[j] = *(const f32x4*)(sh + c); }
    int r = 0;
    for (; r + 4 <= nrows; r += 4) modulate_group<4, F8>(F, src, dst, dst8, row0 + r, A, Bv);
    if (r + 2 <= nrows) modulate_group<2, F8>(F, src, dst, dst8, row0 + r, A, Bv);
}

constexpr unsigned HY_SK_PACKED = 0xCB885410u;
__device__ __forceinline__ void hyena_unit(Frame& F, int c) {
    const int tid = F.tid, lane = F.lane, wid = F.wave;
    LAS unsigned char* Lc = F.lds + RING_OFF;
    const bf16_t* UT = WSP(const bf16_t, WS_UT);
    bf16_t* Wg = WSP(bf16_t, WS_HYW) + (size_t)c * MTOK;
    bf16_t* Xg = WSP(bf16_t, WS_HYX) + (size_t)c * MTOK;
    {
        const u32x4* src = (const u32x4*)(WSP(const bf16_t, WS_KR) + (size_t)c * 8192);
#pragma unroll
        for (int i = 0; i < 2; ++i) { const int jc = tid + 512 * i; const u32x4 lo = src[jc]; const u32x4 hi = jc < 1023 ? src[jc + 1] : (u32x4){0u, 0u, 0u, 0u};
            const unsigned w[8] = {lo.x, lo.y, lo.z, lo.w, hi.x, hi.y, hi.z, hi.w};
#pragma unroll
            for (int cc = 0; cc < 8; ++cc) { u32x4 o;
#pragma unroll
                for (int k = 0; k < 4; ++k) { const int idx = (cc >> 1) + k; o[k] = (cc & 1) ? __builtin_amdgcn_alignbyte(w[idx + 1], w[idx], 2u) : w[idx]; }
                *(LAS u32x4*)(Lc + cc * 16384 + 16 * ((HY_SK_PACKED >> (4 * cc)) & 15u) + 16 * jc) = o; } }
    }
    const float* cw = kin(I_CONVW); const float* cb = kin(I_CONVB);
    {
        const bf16_t* vrow = UT + (size_t)(1024 + c) * MTOK; const bf16_t* x1row = UT + (size_t)(512 + c) * MTOK; const bf16_t* x0row = UT + (size_t)c * MTOK;
        const float v0 = cw[1024 + c], v1 = cw[1536 + 1024 + c], v2 = cw[3072 + 1024 + c], vb = cb[1024 + c];
        const float a0 = cw[512 + c], a1 = cw[1536 + 512 + c], a2 = cw[3072 + 512 + c], ab = cb[512 + c];
        const float g0 = cw[c], g1 = cw[1536 + c], g2 = cw[3072 + c], gb = cb[c];
        const int s0 = tid * 8;
#pragma unroll 4
        for (int it = 0; it < 16; ++it) {
            const size_t base = (size_t)it * SEQ + s0;
            const u32x4 vv = *(const u32x4*)(vrow + base), xx = *(const u32x4*)(x1row + base), gg = *(const u32x4*)(x0row + base);
            float ve[10], xe[10], ge[10];
            ve[0] = s0 > 0 ? bf2f(vrow[base - 1]) : 0.f; xe[0] = s0 > 0 ? bf2f(x1row[base - 1]) : 0.f; ge[0] = s0 > 0 ? bf2f(x0row[base - 1]) : 0.f;
            ve[9] = s0 + 8 < SEQ ? bf2f(vrow[base + 8]) : 0.f; xe[9] = s0 + 8 < SEQ ? bf2f(x1row[base + 8]) : 0.f; ge[9] = s0 + 8 < SEQ ? bf2f(x0row[base + 8]) : 0.f;
#pragma unroll
            for (int j = 0; j < 4; ++j) { ve[1 + 2 * j] = bf2f(vv[j] & 0xffffu); ve[2 + 2 * j] = bf2f(vv[j] >> 16); xe[1 + 2 * j] = bf2f(xx[j] & 0xffffu); xe[2 + 2 * j] = bf2f(xx[j] >> 16);
                ge[1 + 2 * j] = bf2f(gg[j] & 0xffffu); ge[2 + 2 * j] = bf2f(gg[j] >> 16); }
            float w[8], g[8];
#pragma unroll
            for (int j = 0; j < 8; ++j) { w[j] = (v0 * ve[j] + v1 * ve[j + 1] + v2 * ve[j + 2] + vb) * (a0 * xe[j] + a1 * xe[j + 1] + a2 * xe[j + 2] + ab); g[j] = g0 * ge[j] + g1 * ge[j + 1] + g2 * ge[j + 2] + gb; }
            u32x4 o; o.x = pk2(w[0], w[1]); o.y = pk2(w[2], w[3]); o.z = pk2(w[4], w[5]); o.w = pk2(w[6], w[7]);
            *(u32x4*)(Wg + (size_t)(tid * 16 + it) * 8) = o;
            u32x4 p; p.x = pk2(g[0], g[1]); p.y = pk2(g[2], g[3]); p.z = pk2(g[4], g[5]); p.w = pk2(g[6], g[7]);
            *(u32x4*)(Xg + base) = p;
        }
    }
    VM_WAIT(); __syncthreads();
    const float hb = kin(I_HBIAS)[c];
    bf16_t* yrow = WSP(bf16_t, WS_YT) + (size_t)c * MTOK;
    const int li = lane & 15, lg = lane >> 4;
#pragma unroll 1
    for (int pass = 0; pass < 2; ++pass) {
        const int T0 = (pass * 8 + wid) * 256;
        f32x4 acc[16]; bf16x8 AF[16], Bf[8];
#pragma unroll
        for (int q = 0; q < 16; ++q) acc[q] = (f32x4){0.f, 0.f, 0.f, 0.f};
        const int xbase = 4096 - T0 - li + 8 * lg; const int cl = xbase & 7;
        const LAS unsigned char* pA = Lc + cl * 16384 + 16 * (int)((HY_SK_PACKED >> (4 * cl)) & 15u) + 2 * (xbase - cl);
        const bf16x8* Bg = (const bf16x8*)Wg + lg * 16 + li;
#define HY_LOADA(dst, q) dst = *(const LAS bf16x8*)(pA - 32 * (q))
#pragma unroll
        for (int q = 0; q < 16; ++q) HY_LOADA(AF[q], q);
#pragma unroll
        for (int v = 0; v < 8; ++v) Bf[v] = Bg[64 * v];
#pragma unroll 1
        for (int S8 = 0; S8 < 128; S8 += 8) {
#pragma unroll
            for (int v = 0; v < 8; ++v) { const int S = S8 + v;
#pragma unroll
                for (int tau = 15; tau >= 0; --tau) acc[tau] = __builtin_amdgcn_mfma_f32_16x16x32_bf16(AF[(tau - 2 * v) & 15], Bf[v], acc[tau], 0, 0, 0);
                if (S + 8 < 128) Bf[v] = Bg[64 * (S + 8)];
                if (S + 1 < 128) { HY_LOADA(AF[(-2 * (v + 1)) & 15], -2 * (S + 1)); HY_LOADA(AF[(-2 * (v + 1) + 1) & 15], -2 * (S + 1) + 1); }
            }
        }
#undef HY_LOADA
        u32x2 wv[16], xv[16];
#pragma unroll
        for (int tau = 0; tau < 16; ++tau) { const int t = T0 + 16 * tau + 4 * lg;
            wv[tau] = *(const u32x2*)(Wg + (size_t)((t >> 3) * 16 + li) * 8 + (t & 7)); xv[tau] = *(const u32x2*)(Xg + (size_t)li * SEQ + t); }
#pragma unroll
        for (int tau = 0; tau < 16; ++tau) { const int t = T0 + 16 * tau + 4 * lg;
            const float we[4] = {bf2f(wv[tau].x & 0xffffu), bf2f(wv[tau].x >> 16), bf2f(wv[tau].y & 0xffffu), bf2f(wv[tau].y >> 16)};
            const float xe[4] = {bf2f(xv[tau].x & 0xffffu), bf2f(xv[tau].x >> 16), bf2f(xv[tau].y & 0xffffu), bf2f(xv[tau].y >> 16)};
            float z[4];
#pragma unroll
            for (int j = 0; j < 4; ++j) z[j] = (acc[tau][j] + hb * we[j]) * xe[j];
            u32x2 o; o.x = pk2(z[0], z[1]); o.y = pk2(z[2], z[3]); *(u32x2*)(yrow + (size_t)li * SEQ + t) = o; }
    }
    __syncthreads();
}

constexpr unsigned long long HY8_SK = 0xea6eda965212d950ull; constexpr int HY8_STR = 8448;
__device__ __forceinline__ void hyena_unit8(Frame& F, int c) {
    int tid_ = F.tid; asm volatile("" : "+v"(tid_));
    const int tid = tid_, lane = tid & 63, wid = F.wave;
    LAS unsigned char* Lc = F.lds + RING_OFF;
    const bf16_t* UT = WSP(const bf16_t, WS_UT);
    unsigned char* W8 = WSP(unsigned char, WS_HYW) + (size_t)c * MTOK;
    bf16_t* Xg = WSP(bf16_t, WS_HYX) + (size_t)c * MTOK;
    {
        const u32x4* src = (const u32x4*)(WSP(const unsigned char, WS_KR) + (size_t)c * 8192);
        const u32x4 lo = src[tid]; const u32x4 hi = tid < 511 ? src[tid + 1] : (u32x4){0u, 0u, 0u, 0u};
        const unsigned w[8] = {lo.x, lo.y, lo.z, lo.w, hi.x, hi.y, hi.z, hi.w};
#pragma unroll
        for (int sh = 0; sh < 16; ++sh) { u32x4 o;
#pragma unroll
            for (int k = 0; k < 4; ++k) { const int idx = (sh >> 2) + k; o[k] = (sh & 3) ? __builtin_amdgcn_alignbyte(w[idx + 1], w[idx], (unsigned)(sh & 3)) : w[idx]; }
            *(LAS u32x4*)(Lc + sh * HY8_STR + 16 * (int)((HY8_SK >> (4 * sh)) & 15ull) + 16 * tid) = o; }
    }
    const float* cw = kin(I_CONVW); const float* cb = kin(I_CONVB);
    {
        const bf16_t* vrow = UT + (size_t)(1024 + c) * MTOK; const bf16_t* x1row = UT + (size_t)(512 + c) * MTOK; const bf16_t* x0row = UT + (size_t)c * MTOK;
        const float v0 = cw[1024 + c], v1 = cw[1536 + 1024 + c], v2 = cw[3072 + 1024 + c], vb = cb[1024 + c];
        const float a0 = cw[512 + c], a1 = cw[1536 + 512 + c], a2 = cw[3072 + 512 + c], ab = cb[512 + c];
        const float g0 = cw[c], g1 = cw[1536 + c], g2 = cw[3072 + c], gb = cb[c];
        const int s0 = tid * 8;
#pragma unroll 4
        for (int it = 0; it < 16; ++it) {
            const size_t base = (size_t)it * SEQ + s0;
            const u32x4 vv = *(const u32x4*)(vrow + base), xx = *(const u32x4*)(x1row + base), gg = *(const u32x4*)(x0row + base);
            float ve[10], xe[10], ge[10];
            ve[0] = s0 > 0 ? bf2f(vrow[base - 1]) : 0.f; xe[0] = s0 > 0 ? bf2f(x1row[base - 1]) : 0.f; ge[0] = s0 > 0 ? bf2f(x0row[base - 1]) : 0.f;
            ve[9] = s0 + 8 < SEQ ? bf2f(vrow[base + 8]) : 0.f; xe[9] = s0 + 8 < SEQ ? bf2f(x1row[base + 8]) : 0.f; ge[9] = s0 + 8 < SEQ ? bf2f(x0row[base + 8]) : 0.f;
#pragma unroll
            for (int j = 0; j < 4; ++j) { ve[1 + 2 * j] = bf2f(vv[j] & 0xffffu); ve[2 + 2 * j] = bf2f(vv[j] >> 16); xe[1 + 2 * j] = bf2f(xx[j] & 0xffffu); xe[2 + 2 * j] = bf2f(xx[j] >> 16);
                ge[1 + 2 * j] = bf2f(gg[j] & 0xffffu); ge[2 + 2 * j] = bf2f(gg[j] >> 16); }
            float w[8], g[8];
#pragma unroll
            for (int j = 0; j < 8; ++j) { w[j] = 8.0f * (v0 * ve[j] + v1 * ve[j + 1] + v2 * ve[j + 2] + vb) * (a0 * xe[j] + a1 * xe[j + 1] + a2 * xe[j + 2] + ab); g[j] = g0 * ge[j] + g1 * ge[j + 1] + g2 * ge[j + 2] + gb; }
            u32x2 o; o.x = pk4_fp8c(w[0], w[1], w[2], w[3]); o.y = pk4_fp8c(w[4], w[5], w[6], w[7]);
            *(u32x2*)(W8 + (size_t)((tid >> 2) * 16 + it) * 32 + (tid & 3) * 8) = o;
            u32x4 p; p.x = pk2(g[0], g[1]); p.y = pk2(g[2], g[3]); p.z = pk2(g[4], g[5]); p.w = pk2(g[6], g[7]);
            *(u32x4*)(Xg + base) = p;
        }
    }
    VM_WAIT(); __syncthreads();
    const float hb = kin(I_HBIAS)[c];
    bf16_t* yrow = WSP(bf16_t, WS_YT) + (size_t)c * MTOK;
    const int li = lane & 15, lg = lane >> 4;
#pragma unroll 1
    for (int pass = 0; pass < 2; ++pass) {
        const int T0 = (pass * 8 + wid) * 256;
        f32x4 acc[16]; pg8::v8i AF[16], Bf[2];
#pragma unroll
        for (int q = 0; q < 16; ++q) { acc[q] = (f32x4){0.f, 0.f, 0.f, 0.f}; asm volatile("" : "+v"(acc[q])); }
        const int x00 = 4096 - T0 - li + 32 * lg; const int cl = x00 & 15;
        const LAS unsigned char* pA = Lc + cl * HY8_STR + 16 * (int)((HY8_SK >> (4 * cl)) & 15ull) + (x00 - cl);
        const u32x4* Bg = (const u32x4*)W8 + (lg * 16 + li) * 2;
#define HY8_LOADA(dst, q) do { const LAS unsigned char* p_ = pA - 16 * (q); dst = pg8::cat8(*(const LAS bf16x8*)p_, *(const LAS bf16x8*)(p_ + 16)); } while (0)
#define HY8_LOADB(dst, S_) do { const u32x4 b0_ = Bg[128 * (S_)], b1_ = Bg[128 * (S_) + 1]; dst = pg8::cat8(__builtin_bit_cast(bf16x8, b0_), __builtin_bit_cast(bf16x8, b1_)); } while (0)
#pragma unroll
        for (int q = 0; q < 16; ++q) HY8_LOADA(AF[q], q);
#pragma unroll
        for (int v = 0; v < 2; ++v) HY8_LOADB(Bf[v], v);
#pragma unroll 1
        for (int S4 = 0; S4 < 32; S4 += 2) {
#pragma unroll
            for (int v = 0; v < 2; ++v) { const int S = S4 + v; const int p = v & 1;
                asm volatile("s_waitcnt lgkmcnt(0)\n\ts_nop 4" ::: "memory");
#pragma unroll
                for (int tau = 15; tau >= 0; --tau) pg8::mfma_fp8(acc[tau], AF[(tau - 8 * p) & 15], Bf[v]);
                if (S + 2 < 32) HY8_LOADB(Bf[v], S + 2);
                if (S + 1 < 32) {
#pragma unroll
                    for (int i = 0; i < 8; ++i) HY8_LOADA(AF[(i + 8 * (1 - p)) & 15], i - 8 * (S + 1)); }
            }
            asm volatile("s_nop 15\n\ts_nop 7" : "+v"(acc[0]), "+v"(acc[1]), "+v"(acc[2]), "+v"(acc[3]), "+v"(acc[4]), "+v"(acc[5]), "+v"(acc[6]), "+v"(acc[7]),
                         "+v"(acc[8]), "+v"(acc[9]), "+v"(acc[10]), "+v"(acc[11]), "+v"(acc[12]), "+v"(acc[13]), "+v"(acc[14]), "+v"(acc[15]));
        }
#undef HY8_LOADA
#undef HY8_LOADB
        asm volatile("s_nop 15\n\ts_nop 15" : "+v"(acc[0]), "+v"(acc[1]), "+v"(acc[2]), "+v"(acc[3]), "+v"(acc[4]), "+v"(acc[5]), "+v"(acc[6]), "+v"(acc[7]),
                     "+v"(acc[8]), "+v"(acc[9]), "+v"(acc[10]), "+v"(acc[11]), "+v"(acc[12]), "+v"(acc[13]), "+v"(acc[14]), "+v"(acc[15]) :: "memory");
        unsigned wv[16]; u32x2 xv[16];
#pragma unroll
        for (int tau = 0; tau < 16; ++tau) { const int t = T0 + 16 * tau + 4 * lg;
            wv[tau] = *(const unsigned*)(W8 + (size_t)((t >> 5) * 16 + li) * 32 + (t & 31)); xv[tau] = *(const u32x2*)(Xg + (size_t)li * SEQ + t); }
#pragma unroll
        for (int tau = 0; tau < 16; ++tau) { const int t = T0 + 16 * tau + 4 * lg;
            const f32x2 wlo = __builtin_amdgcn_cvt_pk_f32_fp8((int)wv[tau], false), whi = __builtin_amdgcn_cvt_pk_f32_fp8((int)wv[tau], true);
            const float we[4] = {wlo[0] * 0.125f, wlo[1] * 0.125f, whi[0] * 0.125f, whi[1] * 0.125f};
            const float xe[4] = {bf2f(xv[tau].x & 0xffffu), bf2f(xv[tau].x >> 16), bf2f(xv[tau].y & 0xffffu), bf2f(xv[tau].y >> 16)};
            float z[4];
#pragma unroll
            for (int j = 0; j < 4; ++j) z[j] = (acc[tau][j] * (1.0f / 512.0f) + hb * we[j]) * xe[j];
            u32x2 o; o.x = pk2(z[0], z[1]); o.y = pk2(z[2], z[3]); *(u32x2*)(yrow + (size_t)li * SEQ + t) = o; }
    }
    __syncthreads();
}

__device__ __forceinline__ void p4_norm_tile(Frame& F, int it) {
    const int lane = F.lane, wid = F.wave, tid = F.tid; const int m0 = it * 64;
    bf16_t* AY = WSP(bf16_t, WS_AY); const bf16_t* A = WSP(const bf16_t, WS_AO); const bf16_t* YT = WSP(const bf16_t, WS_YT);
    constexpr int TP = 520;
    LAS bf16_t* T2 = (LAS bf16_t*)(F.lds + RING_OFF);
    {
        const u32x4* src = (const u32x4*)(YT + (size_t)tid * MTOK + m0);
#pragma unroll
        for (int i = 0; i < 8; ++i) { const u32x4 v = src[i];
#pragma unroll
            for (int j = 0; j < 4; ++j) { T2[(8 * i + 2 * j) * TP + tid] = (bf16_t)(v[j] & 0xffffu); T2[(8 * i + 2 * j + 1) * TP + tid] = (bf16_t)(v[j] >> 16); } }
    }
#define P4_ROWS8(LOADV, GAIN, DSTCOL) do { const float* gw_ = (GAIN) + 8 * lane; const f32x4 g0 = *(const f32x4*)gw_, g1 = *(const f32x4*)(gw_ + 4); \
        u32x4 v_[8]; float ss_[8]; \
        _Pragma("unroll") for (int r = 0; r < 8; ++r) v_[r] = LOADV(r); \
        _Pragma("unroll") for (int r = 0; r < 8; ++r) { float a_ = 0.f; _Pragma("unroll") for (int j = 0; j < 4; ++j) { const float lo_ = bf2f(v_[r][j] & 0xffffu), hi_ = bf2f(v_[r][j] >> 16); a_ += lo_ * lo_ + hi_ * hi_; } ss_[r] = a_; } \
        _Pragma("unroll") for (int o = 1; o < 64; o <<= 1) { _Pragma("unroll") for (int r = 0; r < 8; ++r) ss_[r] += __shfl_xor(ss_[r], o); } \
        _Pragma("unroll") for (int r = 0; r < 8; ++r) { const float rs = rsqrtf(ss_[r] * (1.0f / 512.0f) + EPS); float e[8]; \
            _Pragma("unroll") for (int j = 0; j < 4; ++j) { e[2 * j] = bf2f(v_[r][j] & 0xffffu); e[2 * j + 1] = bf2f(v_[r][j] >> 16); } \
            u32x4 o; o.x = pk2(e[0] * rs * g0[0], e[1] * rs * g0[1]); o.y = pk2(e[2] * rs * g0[2], e[3] * rs * g0[3]); o.z = pk2(e[4] * rs * g1[0], e[5] * rs * g1[1]); o.w = pk2(e[6] * rs * g1[2], e[7] * rs * g1[3]); \
            *(u32x4*)(AY + (size_t)(m0 + wid * 8 + r) * DM + (DSTCOL) + 8 * lane) = o; } } while (0)
#define P4_LOAD_A(r) (*(const u32x4*)(A + (size_t)(m0 + wid * 8 + (r)) * AW + 8 * lane))
#define P4_LOAD_T(r) (*(const LAS u32x4*)(T2 + (wid * 8 + (r)) * TP + 8 * lane))
    P4_ROWS8(P4_LOAD_A, kin(I_AONW), 0);
    __syncthreads();
    P4_ROWS8(P4_LOAD_T, kin(I_HONW), 512);
#undef P4_ROWS8
#undef P4_LOAD_A
#undef P4_LOAD_T
    __syncthreads();
}


#define DPPF(x, ctrl) __builtin_bit_cast(float, __builtin_amdgcn_mov_dpp(__builtin_bit_cast(int, (x)), (ctrl), 0xf, 0xf, true))
#define DPPI(x, ctrl) __builtin_amdgcn_mov_dpp((x), (ctrl), 0xf, 0xf, true)
__device__ __forceinline__ void p8_route16(Frame& F, int t0) {
    const int lane = F.lane; const int j = lane & 3; const int t = t0 + (lane >> 2);
    const f32x4* lg = (const f32x4*)(WSP(const float, WS_LOGIT) + (size_t)t * NE + 64 * j);
    const f32x4* rbp = (const f32x4*)(kin(I_RB) + 64 * j);
    float b[64];
#pragma unroll
    for (int i = 0; i < 16; ++i) { const f32x4 v = lg[i], rb = rbp[i];
#pragma unroll
        for (int c = 0; c < 4; ++c) b[4 * i + c] = __builtin_amdgcn_rcpf(1.0f + __builtin_amdgcn_exp2f(-1.4426950408889634f * v[c])) + rb[c]; }
    float gsc[2];
#pragma unroll
    for (int g = 0; g < 2; ++g) { float a1 = fmaxf(b[32 * g], b[32 * g + 1]), a2 = fminf(b[32 * g], b[32 * g + 1]);
#pragma unroll
        for (int i = 2; i < 32; ++i) { const float x = b[32 * g + i]; a2 = fmaxf(a2, fminf(a1, x)); a1 = fmaxf(a1, x); }
        gsc[g] = a1 + a2; }
    float G[8];
    G[0] = DPPF(gsc[0], 0x00); G[1] = DPPF(gsc[1], 0x00); G[2] = DPPF(gsc[0], 0x55); G[3] = DPPF(gsc[1], 0x55);
    G[4] = DPPF(gsc[0], 0xAA); G[5] = DPPF(gsc[1], 0xAA); G[6] = DPPF(gsc[0], 0xFF); G[7] = DPPF(gsc[1], 0xFF);
#pragma unroll
    for (int g = 0; g < 2; ++g) { const int gid = 2 * j + g; int rank = 0;
#pragma unroll
        for (int h = 0; h < 8; ++h) rank += (G[h] > gsc[g] || (G[h] == gsc[g] && h < gid)) ? 1 : 0;
        if (rank >= 4) {
#pragma unroll
            for (int i = 0; i < 32; ++i) b[32 * g + i] = -INFINITY; } }
    unsigned key[64];
#pragma unroll
    for (int i = 0; i < 64; ++i) key[i] = b[i] == -INFINITY ? 0u : ((__builtin_bit_cast(unsigned, b[i] + 2.0f) & ~63u) | (unsigned)(63 - i));
    float lv[8]; int li[8];
#pragma unroll
    for (int r = 0; r < 8; ++r) { unsigned mx = key[0];
#pragma unroll
        for (int i = 1; i < 64; i += 2) { const unsigned a_ = key[i], b_ = i + 1 < 64 ? key[i + 1] : 0u; const unsigned m_ = a_ > b_ ? a_ : b_; mx = mx > m_ ? mx : m_; }
        lv[r] = mx ? __builtin_bit_cast(float, mx & ~63u) - 2.0f : -INFINITY; li[r] = mx ? 64 * j + 63 - (int)(mx & 63u) : 0x7ffffff0 + j;
#pragma unroll
        for (int i = 0; i < 64; ++i) key[i] = key[i] == mx ? 0u : key[i]; }
    int se[8]; float sv[8];
#pragma unroll
    for (int r = 0; r < 8; ++r) { float hv = lv[0]; int hi = li[0];
        { const float ov = DPPF(hv, 0xB1); const int oi = DPPI(hi, 0xB1); if (ov > hv || (ov == hv && oi < hi)) { hv = ov; hi = oi; } }
        { const float ov = DPPF(hv, 0x4E); const int oi = DPPI(hi, 0x4E); if (ov > hv || (ov == hv && oi < hi)) { hv = ov; hi = oi; } }
        se[r] = hi; sv[r] = hv;
        if (hi == li[0]) {
#pragma unroll
            for (int k = 0; k < 7; ++k) { lv[k] = lv[k + 1]; li[k] = li[k + 1]; }
            lv[7] = -INFINITY; li[7] = 0x7fffffff; } }
    const float* rbias = kin(I_RB); float wsum = 0.f;
#pragma unroll
    for (int r = 0; r < 8; ++r) { sv[r] -= rbias[se[r]]; wsum += sv[r]; }
    const float inv = 2.5f / wsum;
    const int ea = j == 0 ? se[0] : j == 1 ? se[2] : j == 2 ? se[4] : se[6], eb = j == 0 ? se[1] : j == 1 ? se[3] : j == 2 ? se[5] : se[7];
    const float wa = (j == 0 ? sv[0] : j == 1 ? sv[2] : j == 2 ? sv[4] : sv[6]) * inv, wb = (j == 0 ? sv[1] : j == 1 ? sv[3] : j == 2 ? sv[5] : sv[7]) * inv;
    unsigned* list = WSP(unsigned, WS_LIST); unsigned* asg = WSP(unsigned, WS_ASSIGN) + (size_t)t * 8 + 2 * j;
    const unsigned ra = __hip_atomic_fetch_add(F.ctl + CW_CNT + 32 * ea, 1u, RLX_AGENT), rb2 = __hip_atomic_fetch_add(F.ctl + CW_CNT + 32 * eb, 1u, RLX_AGENT);
    list[(size_t)ea * 65536 + ra] = ((unsigned)t << 16) | f2bf(wa); list[(size_t)eb * 65536 + rb2] = ((unsigned)t << 16) | f2bf(wb);
    asg[0] = ((unsigned)ea << 16) | ra; asg[1] = ((unsigned)eb << 16) | rb2;
    if (j == 0) list[(size_t)256 * 65536 + t] = ((unsigned)t << 16) | 0x3F80u;
}
#undef DPPF
#undef DPPI

__device__ __forceinline__ MoeTab moe_tables(Frame& F) {
    LAS int* tp = (LAS int*)(F.lds + AUX_OFF + AUX_TP); LAS int* cnt = (LAS int*)(F.lds + AUX_OFF + AUX_CNT); LAS unsigned short* t2e = (LAS unsigned short*)(F.lds + AUX_OFF + AUX_T2E);
    __syncthreads();
    if (F.tid < 257) cnt[F.tid] = F.tid < 256 ? (int)__hip_atomic_load(F.ctl + CW_CNT + 32 * F.tid, RLX_AGENT) : MTOK;
    __syncthreads();
    if (F.tid < 258) { int run = 0; for (int j = 0; j < F.tid && j < 257; ++j) run += (cnt[j] + 255) >> 8; tp[F.tid] = run; }
    __syncthreads();
    if (F.tid < 257) { const int t0 = tp[F.tid], t1 = tp[F.tid + 1]; for (int T = t0; T < t1; ++T) t2e[T] = (unsigned short)F.tid; }
    __syncthreads();
    MoeTab t; t.tp = tp; t.cnt = cnt; t.t2e = t2e; return t;
}

__device__ __forceinline__ void down_phase(Frame& F, const MoeTab& tab) {
    using namespace pg8;
    int tid_ = F.wave * 64 + lane_id(); asm volatile("" : "+v"(tid_));
    const int tid = tid_, wid = F.wave, lane = tid & 63, wq = wid, fr = lane & 15, fq = lane >> 4;
    LAS unsigned char* lds = F.lds + RING_OFF;
    const unsigned char* ACT = WSP(const unsigned char, WS_ACT); const unsigned char* WD = WSP(const unsigned char, WS_WD); const unsigned char* WSD = WSP(const unsigned char, WS_WSD);
    unsigned char* SLOT = WSP(unsigned char, WS_SLOT);
    unsigned voA[2], voB[2];
#pragma unroll
    for (int i = 0; i < 2; ++i) { int R, C; stage_rc(tid * 16 + i * 8192, R, C); const int rho = R & 63, ii = rho & 15, nn = rho >> 4; const int Rb = (R & ~63) + 16 * (ii >> 2) + 4 * nn + (ii & 3);
        voA[i] = (unsigned)(R * 256 + C * 2); voB[i] = (unsigned)(Rb * 256 + C * 2); }
    const unsigned ldsw = (unsigned)wid * 1024u;
#define DN_STAGE(buf, gptr, vo) do { _Pragma("unroll") for (int _i = 0; _i < 2; ++_i) \
        __builtin_amdgcn_global_load_lds((const unsigned*)((gptr) + (vo)[_i]), (LAS unsigned*)(lds + (buf) * HTB + ldsw + _i * 8192), 16, 0, 0); } while (0)
    const int arow = (wq & 3) * 32 + fr;
    const int aoff = lds_byte(arow, fq * 8), boff = lds_byte(fr, fq * 8);
    const int TT = __builtin_amdgcn_readfirstlane(tab.tp[257]);
#define DN_STAGE_A(Ag_) do { _Pragma("unroll") for (int ai = 0; ai < 2; ++ai) _Pragma("unroll") for (int kt = 0; kt < 2; ++kt) DN_STAGE(ai * 2 + kt, (Ag_) + (size_t)ai * (128 * 256) + kt * 128, voA); } while (0)
#define DN_STAGE_B(slot, Bg_, c_) do { _Pragma("unroll") for (int kt = 0; kt < 2; ++kt) DN_STAGE(4 + 2 * (slot) + kt, (Bg_) + (size_t)(c_) * (128 * 256) + kt * 128, voB); } while (0)
    int T = F.vcu;
    const unsigned char* Bg = WD;
    if (T < TT) { const int e0 = __builtin_amdgcn_readfirstlane((int)tab.t2e[T]); Bg = e0 < 256 ? WD + (size_t)e0 * (1024 * 256) : WSD;
        DN_STAGE_A(ACT + (size_t)T * (256 * 256)); DN_STAGE_B(0, Bg, 0); }
    for (; T < TT; T += F.G) {
        const int Tn = T + F.G; const bool hn = Tn < TT;
        const unsigned char* Bn = WD;
        if (hn) { const int en = __builtin_amdgcn_readfirstlane((int)tab.t2e[Tn]); Bn = en < 256 ? WD + (size_t)en * (1024 * 256) : WSD; }
        asm volatile("s_waitcnt vmcnt(0)" ::: "memory"); __builtin_amdgcn_s_barrier(); asm volatile("" ::: "memory");
        v8i Af[2][2];
#pragma unroll
        for (int m = 0; m < 2; ++m)
#pragma unroll
            for (int kt = 0; kt < 2; ++kt) { const LAS unsigned char* p = lds + ((wq >> 2) * 2 + kt) * HTB + aoff + m * 2048;
                Af[m][kt] = cat8(*(const LAS bf16x8*)p, *(const LAS bf16x8*)(p + 1024)); }
        asm volatile("s_waitcnt lgkmcnt(0)" ::: "memory");
#pragma unroll 1
        for (int c = 0; c < 8; ++c) {
            const int sb = c & 1;
            if (c > 0) { if (c == 3 && hn) asm volatile("s_waitcnt vmcnt(12)" ::: "memory"); else asm volatile("s_waitcnt vmcnt(4)" ::: "memory"); }
            __builtin_amdgcn_s_barrier(); asm volatile("" ::: "memory");
            if (c < 7) DN_STAGE_B(sb ^ 1, Bg, c + 1); else if (hn) DN_STAGE_B(0, Bn, 0);
            if (c == 2 && hn) DN_STAGE_A(ACT + (size_t)Tn * (256 * 256));
            f32x4 acc[2][8];
#pragma unroll
            for (int m = 0; m < 2; ++m)
#pragma unroll
                for (int n = 0; n < 8; ++n) { acc[m][n] = (f32x4){0.f, 0.f, 0.f, 0.f}; asm volatile("" : "+v"(acc[m][n])); }
#pragma unroll
            for (int g = 0; g < 2; ++g) {
                v8i Bf[4][2];
#pragma unroll
                for (int n = 0; n < 4; ++n)
#pragma unroll
                    for (int kt = 0; kt < 2; ++kt) { const LAS unsigned char* p = lds + (4 + 2 * sb + kt) * HTB + boff + (4 * g + n) * 2048;
                        Bf[n][kt] = cat8(*(const LAS bf16x8*)p, *(const LAS bf16x8*)(p + 1024)); }
                asm volatile("s_waitcnt lgkmcnt(0)\n\ts_nop 4" ::: "memory");
#pragma unroll
                for (int kt = 0; kt < 2; ++kt)
#pragma unroll
                    for (int m = 0; m < 2; ++m)
#pragma unroll
                        for (int n = 0; n < 4; ++n) mfma_fp8(acc[m][4 * g + n], Bf[n][kt], Af[m][kt]);
            }
            asm volatile("s_nop 15\n\ts_nop 15" : "+v"(acc[0][0]), "+v"(acc[0][1]), "+v"(acc[0][2]), "+v"(acc[0][3]), "+v"(acc[0][4]), "+v"(acc[0][5]), "+v"(acc[0][6]), "+v"(acc[0][7]),
                         "+v"(acc[1][0]), "+v"(acc[1][1]), "+v"(acc[1][2]), "+v"(acc[1][3]), "+v"(acc[1][4]), "+v"(acc[1][5]), "+v"(acc[1][6]), "+v"(acc[1][7]) :: "memory");
            unsigned char* orow = SLOT + (size_t)(T * 256 + (wq >> 2) * 128 + (wq & 3) * 32 + fr) * DM + c * 128 + 16 * fq;
#pragma unroll
            for (int m = 0; m < 2; ++m)
#pragma unroll
                for (int g = 0; g < 2; ++g) { u32x4 pk;
#pragma unroll
                    for (int n = 0; n < 4; ++n) { const f32x4 a = acc[m][4 * g + n] * 0.125f; pk[n] = pk4_fp8c(a[0], a[1], a[2], a[3]); }
                    *(u32x4*)(orow + (size_t)(16 * m) * DM + 64 * g) = pk; }
        }
        Bg = Bn;
    }
    asm volatile("s_waitcnt vmcnt(0) lgkmcnt(0)" ::: "memory"); __builtin_amdgcn_s_barrier(); asm volatile("" ::: "memory");
#undef DN_STAGE_A
#undef DN_STAGE_B
#undef DN_STAGE
}

__device__ __forceinline__ void combine_token(Frame& F, const MoeTab& tab, int t0) {
    const int lane = F.lane; const int b = t0 >> 12;
    const unsigned* asg = WSP(const unsigned, WS_ASSIGN) + (size_t)t0 * 8; const unsigned char* SLOT = WSP(const unsigned char, WS_SLOT);
    const size_t Rs = (size_t)tab.tp[256] * 256;
    u32x4 sv[2][9];
#pragma unroll
    for (int q = 0; q < 2; ++q) {
#pragma unroll
        for (int k = 0; k < 8; ++k) { const unsigned av = asg[q * 8 + k]; const int e = av >> 16, rk = av & 0xffffu; const size_t R = (size_t)tab.tp[e] * 256 + rk;
            sv[q][k] = *(const u32x4*)(SLOT + R * DM + 16 * lane); }
        sv[q][8] = *(const u32x4*)(SLOT + (Rs + t0 + q) * DM + 16 * lane); }
    const float* g2 = WSP(const float, WS_MODV) + (size_t)b * 6144 + 5 * 1024 + 16 * lane; const float* fw = kin(I_FNW) + 16 * lane;
    f32x4 x[2][4]; float ss[2];
#pragma unroll
    for (int q = 0; q < 2; ++q) { const float* xr = F.out + (size_t)(t0 + q) * DM + 16 * lane;
#pragma unroll
        for (int j = 0; j < 4; ++j) x[q][j] = *(const f32x4*)(xr + 4 * j); }
#pragma unroll
    for (int q = 0; q < 2; ++q) { float a[16];
#pragma unroll
        for (int j = 0; j < 16; ++j) a[j] = 0.f;
#pragma unroll
        for (int k = 0; k < 9; ++k)
#pragma unroll
            for (int j = 0; j < 4; ++j) { const f32x2 lo = __builtin_amdgcn_cvt_pk_f32_fp8((int)sv[q][k][j], false), hi = __builtin_amdgcn_cvt_pk_f32_fp8((int)sv[q][k][j], true);
                a[4 * j] += lo[0]; a[4 * j + 1] += lo[1]; a[4 * j + 2] += hi[0]; a[4 * j + 3] += hi[1]; }
        ss[q] = 0.f;
#pragma unroll
        for (int j = 0; j < 4; ++j) { const f32x4 g = *(const f32x4*)(g2 + 4 * j) * (1.0f / 16.0f);
            x[q][j] = x[q][j] + g * (f32x4){a[4 * j], a[4 * j + 1], a[4 * j + 2], a[4 * j + 3]};
            ss[q] += (x[q][j][0] * x[q][j][0] + x[q][j][1] * x[q][j][1]) + (x[q][j][2] * x[q][j][2] + x[q][j][3] * x[q][j][3]); } }
#pragma unroll
    for (int o = 1; o < 64; o <<= 1) { ss[0] += __shfl_xor(ss[0], o); ss[1] += __shfl_xor(ss[1], o); }
#pragma unroll
    for (int q = 0; q < 2; ++q) { const float rs = rsqrtf(ss[q] * (1.0f / DM) + EPS); float* orow = F.out + (size_t)(t0 + q) * DM + 16 * lane;
#pragma unroll
        for (int j = 0; j < 4; ++j) *(f32x4*)(orow + 4 * j) = x[q][j] * rs * *(const f32x4*)(fw + 4 * j); }
}

constexpr int N_LAUNCHES = MK_N_LAUNCHES;
static_assert(N_LAUNCHES == 1 || N_LAUNCHES == NPHASE, "MK_N_LAUNCHES must be 1 or 14");
struct Args { const float* in[N_IN]; float* out; unsigned char* ws; int ph_lo, ph_hi; };
__global__ void __launch_bounds__(NWAVES * 64, 2) fwd_kernel(Args args) {
    extern __shared__ __attribute__((aligned(16))) unsigned char lds[];
    Frame F;
    F.lds = (LAS unsigned char*)lds;
    F.MISC = (volatile LAS unsigned*)(F.lds + MISC_OFF);
    F.tid = threadIdx.x; F.lane = F.tid & 63; F.wave = __builtin_amdgcn_readfirstlane(F.tid >> 6);
    F.G = gridDim.x; { const int bx = blockIdx.x; F.vcu = (F.G % 8 == 0) ? (bx % 8) * (F.G / 8) + bx / 8 : bx; }
    F.out = args.out; F.ws = args.ws; F.ctl = (unsigned*)(args.ws + WS_CTL);
    if (F.tid < 128) ((LAS unsigned*)(F.lds + MISC_OFF))[F.tid] = 0u;
    __syncthreads();
    XcdBarrier bar; bar.wv = (unsigned)F.wave; bar.bar = F.ctl + CW_BAR; bar.x = 0; bar.st = nullptr;
    if (N_LAUNCHES == 1) bar = xcd_barrier_post(F.ctl + CW_BAR, F.MISC + 8);
#define GRID_BAR() do { if (N_LAUNCHES == 1) xcd_barrier(bar); } while (0)
    const int lo = args.ph_lo, hi = args.ph_hi;
#ifndef PHASE_MASK
#define PHASE_MASK 0x3fff
#endif
#define IN(k) ((((PHASE_MASK) >> (k)) & 1) && lo <= (k) && (k) < hi)
#ifndef PHASE_DUP
#define PHASE_DUP 0
#endif
#define REPS(k) ((((PHASE_DUP) >> (k)) & 1) ? 2 : 1)
#ifndef PROBE_K
#define PROBE_K (-1)
#endif
#ifndef PROBE_AMP
#define PROBE_AMP 8
#endif
    unsigned long long tA_ = 0, tB_ = 0;
#define STAMP(j) do { if (PROBE_K >= 0 && (j) == PROBE_K) tA_ = __builtin_amdgcn_s_memrealtime(); if (PROBE_K >= 0 && (j) == PROBE_K + 1) tB_ = __builtin_amdgcn_s_memrealtime(); } while (0)
#define SEAM(k) do { if (IN(k) && IN((k) + 1)) GRID_BAR(); STAMP((k) + 1); } while (0)
#define PHASE_ENTER() do { int t_ = F.wave * 64 + lane_id(); asm volatile("" : "+v"(t_)); F.tid = t_; F.lane = t_ & 63; GAS unsigned char* w_ = (GAS unsigned char*)args.ws; GAS float* o_ = (GAS float*)args.out; asm volatile("" : "+s"(w_), "+s"(o_)); F.ws = (unsigned char*)w_; F.out = (float*)o_; F.ctl = (unsigned*)(F.ws + WS_CTL); } while (0)
    const int gw = F.vcu * NWAVES + F.wave, NGW = F.G * NWAVES;
#define modv WSP(const float, WS_MODV)
    LAS unsigned char* ring = F.lds + RING_OFF;
    LAS unsigned* idxw = (LAS unsigned*)(F.lds + AUX_OFF + AUX_IDX + F.wave * 1024);

    STAMP(0);
    if (IN(0)) for (int rep_ = 0; rep_ < REPS(0); ++rep_) { PHASE_ENTER(); p0_prologue(F); }
    SEAM(0);
    if (IN(1)) for (int rep_ = 0; rep_ < REPS(1); ++rep_) { PHASE_ENTER();
        for (int rb = gw; rb < MTOK / 32; rb += NGW) { const int row0 = rb * 32; const int b = row0 >> 12;
            modulate_rows<true>(F, kin(I_X), WSP(bf16_t, WS_H), row0, 32, kin(I_NORM1), modv + (size_t)b * 6144 + 1024, modv + (size_t)b * 6144, WSP(unsigned char, WS_H8)); }
        for (int rb = gw; rb < MCTX / 2; rb += NGW)
            modulate_rows(F, kin(I_CTX), WSP(bf16_t, WS_HC), rb * 2, 2, kin(I_NORM1), modv + (size_t)16 * 6144 + 1024, modv + (size_t)16 * 6144);
    }
    SEAM(1);
    if (IN(2)) for (int rep_ = 0; rep_ < REPS(2); ++rep_) { PHASE_ENTER();
        { SchedQKV S{WSP(const bf16_t, WS_H), (long)WS_HC - (long)WS_H, WSP(const bf16_t, WS_WQKV), F.G, F.vcu};
          EpiQKV E{WSP(bf16_t, WS_Q), WSP(bf16_t, WS_K), WSP(bf16_t, WS_V), kin(I_QNW), kin(I_KNW), WSP(const f32x2, WS_ROPE)};
          pg8::gemm_phase<EpiQKV, SchedQKV, false, true>(ring, idxw, DM, S, E, F.wave); }
        { SchedDense S{WSP(const bf16_t, WS_WU), WSP(const bf16_t, WS_H8), DM / 2, 6, MTOK / 256, F.G, F.vcu, true};
          EpiPlainBf16 E{WSP(bf16_t, WS_UT), (size_t)MTOK, 1.0f / 256.0f};
          pg8::gemm_phase<EpiPlainBf16, SchedDense, false, true, true>(ring, idxw, DM / 2, S, E, F.wave); }
    }
    SEAM(2);
    if (IN(3)) for (int rep_ = 0; rep_ < REPS(3); ++rep_) { PHASE_ENTER();
        const attn_body::AttnTensors AT{WSP(const attn_body::bf16, WS_Q), WSP(const attn_body::bf16, WS_K), WSP(const attn_body::bf16, WS_V), WSP(attn_body::bf16, WS_AO)};
        const attn_body::StaticOrder S(F.vcu);
        for (int r2_ = 0; r2_ < REPS(14); ++r2_) attn_body::attn_phase<attn_body::StaticOrder>((char*)lds + RING_OFF, AT, S, F.wave);
        __syncthreads(); PHASE_ENTER();
        for (int r2_ = 0; r2_ < REPS(15); ++r2_) for (int c = F.vcu; c < HW; c += F.G) {
#if HYENA_FP8
            hyena_unit8(F, c);
#else
            hyena_unit(F, c);
#endif
        }
    }
    SEAM(3);
    if (IN(4)) for (int rep_ = 0; rep_ < REPS(4); ++rep_) { PHASE_ENTER();
        for (int pm = F.vcu; pm < MTOK / 256; pm += F.G) {
            for (int q4 = 0; q4 < 4; ++q4) p4_norm_tile(F, pm * 4 + q4);
            VM_WAIT(); __syncthreads(); PHASE_ENTER();
            { SchedDense S{WSP(const bf16_t, WS_AY) + (size_t)pm * 256 * DM, WSP(const bf16_t, WS_WO), DM, 1, 4, 1, 0, false};
              EpiOutProj E{kin(I_X), F.out, modv, pm};
              pg8::gemm_phase<EpiOutProj, SchedDense, false, true>(ring, idxw, DM, S, E, F.wave); }
            VM_WAIT(); __syncthreads(); PHASE_ENTER();
            { const int row0 = pm * 256 + F.wave * 32; const int b = row0 >> 12;
              modulate_rows<true>(F, F.out, WSP(bf16_t, WS_H), row0, 32, kin(I_NORM2), modv + (size_t)b * 6144 + 4 * 1024, modv + (size_t)b * 6144 + 3 * 1024, WSP(unsigned char, WS_H8)); }
            VM_WAIT(); __syncthreads(); PHASE_ENTER();
            { SchedDense S{WSP(const bf16_t, WS_H) + (size_t)pm * 256 * DM, WSP(const bf16_t, WS_WR), DM, 1, 1, 1, 0, false};
              EpiF32 E{WSP(float, WS_LOGIT) + (size_t)pm * 256 * NE, (size_t)NE};
              pg8::gemm_phase<EpiF32, SchedDense, false, true>(ring, idxw, DM, S, E, F.wave); }
            VM_WAIT(); __syncthreads(); PHASE_ENTER();
            for (int r = 0; r < 32; r += 16) p8_route16(F, pm * 256 + F.wave * 32 + r);
        }
    }
    SEAM(4); STAMP(6); STAMP(7); STAMP(8); STAMP(9);
    if (IN(9)) for (int rep_ = 0; rep_ < REPS(9); ++rep_) { PHASE_ENTER();
        const MoeTab tab = moe_tables(F);
        SchedGU S{WSP(const bf16_t, WS_H8), WSP(const bf16_t, WS_WGU), WSP(const bf16_t, WS_WSGU8), WSP(const unsigned, WS_LIST), tab, F.G, F.vcu};
        EpiGU E{WSP(unsigned char, WS_ACT), WSP(const unsigned, WS_LIST), tab};
        pg8::gemm_phase<EpiGU, SchedGU, true, true, true>(ring, idxw, DM / 2, S, E, F.wave);
    }
    SEAM(9);
    if (IN(10)) for (int rep_ = 0; rep_ < REPS(10); ++rep_) { PHASE_ENTER();
        const MoeTab tab = moe_tables(F);
        down_phase(F, tab);
    }
    SEAM(10);
    if (IN(11)) for (int rep_ = 0; rep_ < REPS(11); ++rep_) { PHASE_ENTER(); const MoeTab tab = moe_tables(F); for (int rb = gw; rb < MTOK / 32; rb += NGW) for (int r = 0; r < 32; r += 2) combine_token(F, tab, rb * 32 + r); }
    STAMP(12); STAMP(13); STAMP(14);
    if (PROBE_K >= 0 && blockIdx.x == 0) {
        const unsigned long long until = __builtin_amdgcn_s_memrealtime() + (unsigned long long)PROBE_AMP * (tB_ - tA_);
        while (__builtin_amdgcn_s_memrealtime() < until) __builtin_amdgcn_s_sleep(32);
    }
#undef modv
#undef PHASE_ENTER
#undef IN
#undef SEAM
#undef GRID_BAR
}

extern "C" void kernel_launch(void* const* d_in, const int* in_sizes, int n_in, void* d_out, int out_size, void* d_ws, size_t ws_size, hipStream_t stream) {
    static int grid = 0;
    if (grid == 0) {
        if (n_in != N_IN || in_sizes[0] != MTOK * DM || out_size != MTOK * DM || ws_size < WS_END) {
            fprintf(stderr, "kernel_launch: unexpected problem (n_in %d, in0 %d, out %d, ws %zu < %zu); nothing launched\n", n_in, n_in > 0 ? in_sizes[0] : -1, out_size, ws_size, (size_t)WS_END); grid = -1; return; }
        int dev = 0, cus = 0, per_cu = 0;
        if (hipGetDevice(&dev) != hipSuccess || hipDeviceGetAttribute(&cus, hipDeviceAttributeMultiprocessorCount, dev) != hipSuccess) { grid = -1; return; }
        if (hipFuncSetAttribute((const void*)fwd_kernel, hipFuncAttributeMaxDynamicSharedMemorySize, LDS_BYTES) != hipSuccess) { fprintf(stderr, "kernel_launch: hipFuncSetAttribute failed\n"); grid = -1; return; }
        if (hipOccupancyMaxActiveBlocksPerMultiprocessor(&per_cu, (const void*)fwd_kernel, NWAVES * 64, LDS_BYTES) != hipSuccess || per_cu < 1)
            fprintf(stderr, "kernel_launch: note: occupancy query reports %d workgroups per CU\n", per_cu);
        (void)hipGetLastError();
        grid = cus;
    }
    if (grid < 0) return;
    if (hipMemsetAsync((char*)d_ws + WS_CTL, 0, CTL_ZERO_BYTES, stream) != hipSuccess) return;
    Args a{};
    for (int i = 0; i < N_IN; ++i) a.in[i] = (const float*)d_in[i];
    a.out = (float*)d_out; a.ws = (unsigned char*)d_ws;
    for (int li = 0; li < N_LAUNCHES; ++li) {
        a.ph_lo = (N_LAUNCHES == 1) ? 0 : li; a.ph_hi = (N_LAUNCHES == 1) ? NPHASE : li + 1;
        hipLaunchKernelGGL(fwd_kernel, dim3(grid), dim3(NWAVES * 64), LDS_BYTES, stream, a);
        const hipError_t le = hipPeekAtLastError();
        if (le != hipSuccess) { fprintf(stderr, "kernel_launch: launch %d failed: %s\n", li, hipGetErrorName(le)); break; }
    }
}
```

```cpp
#include <hip/hip_runtime.h>
#include <cstdio>
#include <cstdint>
#include <cmath>

#ifndef HYENA_FP8
#define HYENA_FP8 1
#endif
#ifndef MK_N_LAUNCHES
#define MK_N_LAUNCHES 1
#endif

#define LAS __attribute__((address_space(3)))
#define GAS __attribute__((address_space(1)))
typedef unsigned short bf16_t;
typedef short bf16x8 __attribute__((ext_vector_type(8)));
typedef float f32x4 __attribute__((ext_vector_type(4)));
typedef float f32x2 __attribute__((ext_vector_type(2)));
typedef unsigned u32x4 __attribute__((ext_vector_type(4)));
typedef unsigned u32x2 __attribute__((ext_vector_type(2)));

constexpr int NB = 16, SEQ = 4096, DM = 1024, MTOK = NB * SEQ, CTXL = 256, MCTX = NB * CTXL;
constexpr int NH = 8, HD = 64, AW = 512, HW = 512, KVP = 128, KVLEN = CTXL + SEQ;
constexpr int NE = 256, TOPK = 8, FF = 256;
constexpr float EPS = 1e-6f;
constexpr int NPHASE = 14;

constexpr size_t MiB = 1u << 20;
constexpr size_t WS_CTL = 0, CTL_ZERO_BYTES = 128 * 1024;
constexpr size_t WS_MODV = 512 * 1024;
constexpr size_t WS_ROPE = 1 * MiB;
constexpr size_t WS_SS = 1 * MiB + 256 * 1024;
constexpr size_t WS_ASSIGN = 2 * MiB;
constexpr size_t WS_KR = 4 * MiB;
constexpr size_t WS_WQKV = 12 * MiB;
constexpr size_t WS_WU = 14 * MiB;
constexpr size_t WS_WO = 17 * MiB;
constexpr size_t WS_WR = 19 * MiB;
constexpr size_t WS_WSGU = 20 * MiB;
constexpr size_t WS_WSD = 21 * MiB;
constexpr size_t WS_WD = 22 * MiB;
constexpr size_t WS_ACT = 150 * MiB;
constexpr size_t WS_SLOT = 406 * MiB;
constexpr size_t WS_END = 1048 * MiB;
constexpr size_t WS_Q = 150 * MiB;
constexpr size_t WS_K = 214 * MiB;
constexpr size_t WS_V = 231 * MiB;
constexpr size_t WS_UT = 248 * MiB;
constexpr size_t WS_HC = 440 * MiB;
constexpr size_t WS_AY = 248 * MiB;
constexpr size_t WS_LOGIT = 150 * MiB;
constexpr size_t WS_WGU = 470 * MiB;
constexpr size_t WS_H8 = 598 * MiB;
constexpr size_t WS_WSGU8 = 662 * MiB;
constexpr size_t WS_H = 726 * MiB;
constexpr size_t WS_HYW = 726 * MiB;
constexpr size_t WS_HYX = 790 * MiB;
constexpr size_t WS_LIST = 854 * MiB;
constexpr size_t WS_YT = 919 * MiB;
constexpr size_t WS_AO = 983 * MiB;
static_assert(WS_LIST + (size_t)257 * 65536 * 4 <= WS_YT && WS_YT + 64 * MiB <= WS_AO && WS_AO + 64 * MiB <= WS_END, "ws map");
constexpr size_t MAXROWS_R = 524288 + 256 * 255;
static_assert(WS_SLOT + (MAXROWS_R + 65536) * 1024 <= WS_END && WS_ACT + (MAXROWS_R + 65536) * 256 <= WS_SLOT, "ws map 2");

constexpr int CW_TMO = 0, CW_CODE = 1, CW_TILEQ = 64;
constexpr int CW_BAR = 4096;
constexpr int CW_CNT = 16384;
static_assert((CW_CNT + 257 * 32) * 4 <= (int)CTL_ZERO_BYTES && (CW_BAR + 3456) * 4 <= (int)CTL_ZERO_BYTES, "control words inside the memset region");

constexpr int RING_OFF = 0, RING_BYTES = 131072;
constexpr int AUX_OFF = 131072, AUX_BYTES = 16384;
constexpr int MISC_OFF = AUX_OFF + AUX_BYTES;
constexpr int LDS_BYTES = MISC_OFF + 512;
constexpr int AUX_TP = 0, AUX_CNT = 1280, AUX_T2E = 2560, AUX_IDX = 8192;

constexpr int NWAVES = 8;
constexpr float C2 = 0.125f * 1.4426950408889634f;

__device__ __forceinline__ unsigned f2bf(float f) { unsigned u = __builtin_bit_cast(unsigned, f); return (u + 0x7fffu + ((u >> 16) & 1u)) >> 16; }
__device__ __forceinline__ unsigned pk2(float lo, float hi) { unsigned r; asm("v_cvt_pk_bf16_f32 %0, %1, %2" : "=v"(r) : "v"(lo), "v"(hi)); return r; }
__device__ __forceinline__ float bf2f(unsigned h) { return __builtin_bit_cast(float, h << 16); }
__device__ __forceinline__ unsigned cvt_pk_bf16(float lo, float hi) { unsigned r; asm volatile("v_cvt_pk_bf16_f32 %0, %1, %2" : "=v"(r) : "v"(lo), "v"(hi)); return r; }
__device__ __forceinline__ int lane_id() { return (int)__builtin_amdgcn_mbcnt_hi(~0u, __builtin_amdgcn_mbcnt_lo(~0u, 0u)); }
__device__ __forceinline__ float wave_sum(float v) {
#pragma unroll
    for (int o = 1; o < 64; o <<= 1) v += __shfl_xor(v, o);
    return v;
}

namespace pg8 {
constexpr int BM = 256, BK = 64, HALF = 128, HTB = HALF * BK * 2, STAGE_BYTES = 8 * HTB;
__host__ __device__ __forceinline__ int lds_byte(int r, int c) { const int st = (r >> 4) * 2 + (c >> 5), rr = r & 15, cc = c & 31, ob = rr * 64 + cc * 2; return st * 1024 + (ob ^ (((ob >> 9) & 1) << 5)); }
__host__ __device__ __forceinline__ void stage_rc(int b, int& R, int& C) { const int st = b / 1024, sb = b % 1024, swz = sb ^ (((sb >> 9) & 1) << 5); R = (st >> 1) * 16 + swz / 64; C = (st & 1) * 32 + (swz % 64) / 2; }
__host__ __device__ __forceinline__ int perm32(int rho) { const int n = rho >> 4, i = rho & 15; return 8 * (i >> 2) + 4 * n + (i & 3); }

struct Unit { int pm, pn, aux, aux2; };
typedef int v8i __attribute__((ext_vector_type(8)));
typedef int v4i __attribute__((ext_vector_type(4)));
__device__ __forceinline__ void mfma_fp8(f32x4& acc, v8i a, v8i b) { asm volatile("v_mfma_f32_16x16x128_f8f6f4 %0, %1, %2, %0" : "+v"(acc) : "v"(a), "v"(b)); }
__device__ __forceinline__ v8i cat8(bf16x8 lo, bf16x8 hi) { const v4i a = __builtin_bit_cast(v4i, lo), b = __builtin_bit_cast(v4i, hi); return __builtin_shufflevector(a, b, 0, 1, 2, 3, 4, 5, 6, 7); }

template <class Epi, class Sched, bool GATHER, bool ALIGN_EPI, bool FP8 = false>
__device__ __forceinline__ void gemm_phase(LAS unsigned char* lds, LAS unsigned* idxw, const int K, const Sched& S, const Epi& E, const int wave) {
    int tid_ = wave * 64 + lane_id(); asm volatile("" : "+v"(tid_));
    const int tid = tid_, wid = __builtin_amdgcn_readfirstlane(tid >> 6), lane = tid & 63, wr = wid >> 2, wc = wid & 3, fr = lane & 15, fq = lane >> 4;
    const int nt = K / BK;
    int Rr[2], Cc[2]; unsigned voffB[2];
#pragma unroll
    for (int i = 0; i < 2; ++i) { stage_rc(tid * 16 + i * 8192, Rr[i], Cc[i]); const int Rb = (Rr[i] & ~31) + perm32(Rr[i] & 31); voffB[i] = (unsigned)(Rb * K + Cc[i]) * 2u; }
    const unsigned kstep = (unsigned)(BK * 2);
    const unsigned hstep = (unsigned)HALF * (unsigned)K * 2u;
    const unsigned ldsw = (unsigned)wid * 1024u;
    const int aoff = lds_byte(wr * 64 + fr, fq * 8), boff = lds_byte(wc * 32 + fr, fq * 8);
#define PG8_SA(b, h) (((b) * 2 + (h)) * HTB)
#define PG8_SB(b, h) ((4 + (b) * 2 + (h)) * HTB)
#define PG8_STAGE_B(bufoff, gbase) do { _Pragma("unroll") for (int _i = 0; _i < 2; ++_i) \
        __builtin_amdgcn_global_load_lds((const unsigned*)((const char*)(gbase) + voffB[_i]), (LAS unsigned*)(lds + (bufoff) + ldsw + _i * 8192), 16, 0, 0); } while (0)
#define PG8_STAGE_A(bufoff, gbase, VV, h) do { _Pragma("unroll") for (int _i = 0; _i < 2; ++_i) \
        __builtin_amdgcn_global_load_lds((const unsigned*)((const char*)(gbase) + VV[h][_i]), (LAS unsigned*)(lds + (bufoff) + ldsw + _i * 8192), 16, 0, 0); } while (0)
#define PG8_LDA(dst, b, h) do { _Pragma("unroll") for (int m = 0; m < 4; ++m) _Pragma("unroll") for (int k = 0; k < 2; ++k) dst[m][k] = *(const LAS bf16x8*)(lds + PG8_SA(b, h) + aoff + m * 2048 + k * 1024); } while (0)
#define PG8_LDB(dst, b, h) do { _Pragma("unroll") for (int n = 0; n < 2; ++n) _Pragma("unroll") for (int k = 0; k < 2; ++k) dst[n][k] = *(const LAS bf16x8*)(lds + PG8_SB(b, h) + boff + n * 2048 + k * 1024); } while (0)
#define PG8_MMA(ai, bj, At, Bt) do { __builtin_amdgcn_s_setprio(1); _Pragma("unroll") for (int m = 0; m < 4; ++m) _Pragma("unroll") for (int n = 0; n < 2; ++n) { \
        if constexpr (FP8) { mfma_fp8(acc[ai][bj][m][n], cat8(Bt[n][0], Bt[n][1]), cat8(At[m][0], At[m][1])); } \
        else { _Pragma("unroll") for (int k = 0; k < 2; ++k) acc[ai][bj][m][n] = __builtin_amdgcn_mfma_f32_16x16x32_bf16(Bt[n][k], At[m][k], acc[ai][bj][m][n], 0, 0, 0); } } __builtin_amdgcn_s_setprio(0); } while (0)
#define PG8_WAIT_V(n) asm volatile("s_waitcnt vmcnt(" #n ")" ::: "memory")
#define PG8_WAIT_L(n) asm volatile("s_waitcnt lgkmcnt(" #n ")" ::: "memory")
#define PG8_BAR __builtin_amdgcn_s_barrier()
#define PG8_SCHED __builtin_amdgcn_sched_barrier(0)
    Unit cur, nxt; int ui = 0;
    if (!S.next(0, cur)) return;
    f32x4 acc[2][2][4][2];
#pragma unroll
    for (int a = 0; a < 2; ++a)
#pragma unroll
        for (int b = 0; b < 2; ++b)
#pragma unroll
            for (int m = 0; m < 4; ++m)
#pragma unroll
                for (int n = 0; n < 2; ++n) { acc[a][b][m][n] = (f32x4){0.f, 0.f, 0.f, 0.f}; if constexpr (FP8) asm volatile("" : "+v"(acc[a][b][m][n])); }
    bf16x8 At[4][2], B0[2][2], B1[2][2];
    unsigned va[2][2], vn[2][2];
    if constexpr (GATHER) {
        const unsigned* ip = S.idx_ptr(cur); const int nv = S.nvalid(cur);
#pragma unroll
        for (int h = 0; h < 2; ++h)
#pragma unroll
            for (int i = 0; i < 2; ++i) { const int r = Rr[i] + HALF * h; const unsigned e = ip[r]; const unsigned tok = r < nv ? (e >> 16) : 0u; va[h][i] = tok * (unsigned)K * 2u + (unsigned)Cc[i] * 2u; }
    } else {
#pragma unroll
        for (int h = 0; h < 2; ++h)
#pragma unroll
            for (int i = 0; i < 2; ++i) va[h][i] = (unsigned)((Rr[i] + HALF * h) * K + Cc[i]) * 2u;
    }
#pragma unroll
    for (int h = 0; h < 2; ++h)
#pragma unroll
        for (int i = 0; i < 2; ++i) vn[h][i] = va[h][i];
    const char* cA = S.a_base(cur); const char* cB = S.b_base(cur);
    PG8_STAGE_B(PG8_SB(0, 0), cB); PG8_STAGE_B(PG8_SB(0, 1), cB + hstep); PG8_STAGE_A(PG8_SA(0, 0), cA, va, 0); PG8_STAGE_A(PG8_SA(0, 1), cA, va, 1);
    if (wr == 1) PG8_BAR;
    PG8_WAIT_V(2); PG8_BAR;
    PG8_STAGE_B(PG8_SB(1, 0), cB + kstep); PG8_STAGE_A(PG8_SA(1, 0), cA + kstep, va, 0); PG8_STAGE_B(PG8_SB(1, 1), cB + hstep + kstep);
    PG8_WAIT_V(6); PG8_BAR;
    for (;;) {
        const bool has_next = S.next(ui + 1, nxt);
        const char* nA = has_next ? S.a_base(nxt) : cA; const char* nB = has_next ? S.b_base(nxt) : cB;
        int nvn = 0;
        if constexpr (GATHER) {
            if (has_next) { nvn = S.nvalid(nxt);
                __builtin_amdgcn_global_load_lds((const unsigned*)(S.idx_ptr(nxt) + lane * 4), (LAS unsigned*)idxw, 16, 0, 0); }
        }
#pragma unroll 1
        for (int t = 0; t < nt; t += 2) {
            const bool last = (t == nt - 2);
            if constexpr (GATHER) {
                if (last && has_next) {
                    asm volatile("" ::: "memory");
#pragma unroll
                    for (int h = 0; h < 2; ++h)
#pragma unroll
                        for (int i = 0; i < 2; ++i) { const int r = Rr[i] + HALF * h; const unsigned e = idxw[r]; const unsigned tok = r < nvn ? (e >> 16) : 0u; vn[h][i] = tok * (unsigned)K * 2u + (unsigned)Cc[i] * 2u; }
                }
            }
            unsigned v2[2][2];
#pragma unroll
            for (int h = 0; h < 2; ++h)
#pragma unroll
                for (int i = 0; i < 2; ++i) v2[h][i] = (GATHER && last) ? vn[h][i] : va[h][i];
            const char* a1 = cA + (size_t)(t + 1) * kstep;
            const char* a2 = last ? nA : cA + (size_t)(t + 2) * kstep; const char* b2 = last ? nB : cB + (size_t)(t + 2) * kstep;
            const char* a3 = a2 + kstep; const char* b3 = b2 + kstep;
            PG8_LDB(B0, 0, 0); PG8_LDB(B1, 0, 1); PG8_SCHED; PG8_LDA(At, 0, 0); PG8_STAGE_A(PG8_SA(1, 1), a1, va, 1);
            PG8_WAIT_V(8); PG8_WAIT_L(0); PG8_BAR; PG8_MMA(0, 0, At, B0); PG8_MMA(0, 1, At, B1); PG8_BAR; PG8_SCHED;
            PG8_LDA(At, 0, 1); PG8_STAGE_B(PG8_SB(0, 0), b2); PG8_STAGE_B(PG8_SB(0, 1), b2 + hstep); PG8_STAGE_A(PG8_SA(0, 0), a2, v2, 0);
            PG8_WAIT_V(8); PG8_WAIT_L(0); PG8_BAR; PG8_MMA(1, 0, At, B0); PG8_MMA(1, 1, At, B1); PG8_BAR; PG8_SCHED;
            PG8_LDB(B0, 1, 0); PG8_LDB(B1, 1, 1); PG8_SCHED; PG8_LDA(At, 1, 0); PG8_STAGE_A(PG8_SA(0, 1), a2, v2, 1);
            PG8_WAIT_V(8); PG8_WAIT_L(0); PG8_BAR; PG8_MMA(0, 0, At, B0); PG8_MMA(0, 1, At, B1); PG8_BAR; PG8_SCHED;
            PG8_LDA(At, 1, 1); PG8_STAGE_B(PG8_SB(1, 0), b3); PG8_STAGE_B(PG8_SB(1, 1), b3 + hstep); PG8_STAGE_A(PG8_SA(1, 0), a3, v2, 0);
            PG8_WAIT_V(8); PG8_WAIT_L(0); PG8_BAR; PG8_MMA(1, 0, At, B0); PG8_MMA(1, 1, At, B1); PG8_BAR; PG8_SCHED;
        }
        if constexpr (ALIGN_EPI) { if (wr == 0) PG8_BAR; }
        if constexpr (FP8) {
#define PG8_A4(a, b) "+v"(acc[a][b][0][0]), "+v"(acc[a][b][0][1]), "+v"(acc[a][b][1][0]), "+v"(acc[a][b][1][1]), "+v"(acc[a][b][2][0]), "+v"(acc[a][b][2][1]), "+v"(acc[a][b][3][0]), "+v"(acc[a][b][3][1])
            asm volatile("s_nop 15\n\ts_nop 15" : PG8_A4(0, 0), PG8_A4(0, 1) :: "memory");
            asm volatile("" : PG8_A4(1, 0), PG8_A4(1, 1) :: "memory");
#undef PG8_A4
        }
        E(acc, cur, wr, wc, fr, fq);
        if (!has_next) break;
#pragma unroll
        for (int a = 0; a < 2; ++a)
#pragma unroll
            for (int b = 0; b < 2; ++b)
#pragma unroll
                for (int m = 0; m < 4; ++m)
#pragma unroll
                    for (int n = 0; n < 2; ++n) { acc[a][b][m][n] = (f32x4){0.f, 0.f, 0.f, 0.f}; if constexpr (FP8) asm volatile("" : "+v"(acc[a][b][m][n])); }
        cur = nxt; cA = nA; cB = nB; ++ui;
#pragma unroll
        for (int h = 0; h < 2; ++h)
#pragma unroll
            for (int i = 0; i < 2; ++i) va[h][i] = vn[h][i];
        if constexpr (ALIGN_EPI) { if (wr == 1) PG8_BAR; }
    }
    PG8_WAIT_V(0);
    if constexpr (!ALIGN_EPI) { if (wr == 0) PG8_BAR; }
    PG8_BAR;
#undef PG8_SA
#undef PG8_SB
#undef PG8_STAGE_A
#undef PG8_STAGE_B
#undef PG8_LDA
#undef PG8_LDB
#undef PG8_MMA
#undef PG8_WAIT_V
#undef PG8_WAIT_L
#undef PG8_BAR
#undef PG8_SCHED
}
}

using pg8::Unit;
struct MoeTab { const LAS int* tp; const LAS int* cnt; const LAS unsigned short* t2e; };
__device__ __forceinline__ int moe_find(const LAS int* tp, int T) {
    int lo = 0, hi = 256;
    while (lo < hi) { const int mid = (lo + hi + 1) >> 1; if (tp[mid] <= T) lo = mid; else hi = mid - 1; }
    return lo;
}

struct SchedQKV {
    const bf16_t *H; long hc_delta; const bf16_t *W; int G, c;
    __device__ __forceinline__ bool next(int i, Unit& u) const {
        const int L = i * G + c; if (L >= 784) return false;
        if (L < 768) { u.pm = L / 3; u.pn = L % 3; u.aux = 0; } else { u.pm = L - 768; u.pn = 2; u.aux = 1; }
        u.aux2 = 0; return true;
    }
    __device__ __forceinline__ const char* a_base(const Unit& u) const { return (const char*)H + (u.aux ? hc_delta : 0L) + (size_t)u.pm * (256 * 1024 * 2); }
    __device__ __forceinline__ const char* b_base(const Unit& u) const { return (const char*)W + (size_t)u.pn * (256 * 1024 * 2); }
    __device__ __forceinline__ const unsigned* idx_ptr(const Unit&) const { return nullptr; }
    __device__ __forceinline__ int nvalid(const Unit&) const { return 256; }
};
struct SchedDense {
    const bf16_t *A, *Bt; int K, nM, nN, G, c; bool m_fast;
    __device__ __forceinline__ bool next(int i, Unit& u) const {
        const int L = i * G + c; if (L >= nM * nN) return false;
        if (m_fast) { u.pm = L % nM; u.pn = L / nM; } else { u.pm = L / nN; u.pn = L % nN; }
        u.aux = 0; u.aux2 = 0; return true;
    }
    __device__ __forceinline__ const char* a_base(const Unit& u) const { return (const char*)A + (size_t)u.pm * 512 * (size_t)K; }
    __device__ __forceinline__ const char* b_base(const Unit& u) const { return (const char*)Bt + (size_t)u.pn * 512 * (size_t)K; }
    __device__ __forceinline__ const unsigned* idx_ptr(const Unit&) const { return nullptr; }
    __device__ __forceinline__ int nvalid(const Unit&) const { return 256; }
};
struct TileDeal {
    int nT, NP, G, c;
    __device__ __forceinline__ bool get(int i, int& tile, int& slot) const {
        const int full = nT / G, rem = nT - full * G;
        if (i < full * NP) { tile = (i / NP) * G + c; slot = i % NP; return true; }
        const int j = i - full * NP;
        if (rem * NP <= G) { if (j > 0 || c >= rem * NP) return false; tile = full * G + c / NP; slot = c % NP; return true; }
        if (j >= NP || c >= rem) return false; tile = full * G + c; slot = j; return true;
    }
};
struct SchedGU {
    const bf16_t *H2, *WGU, *WSGU; const unsigned* LIST; MoeTab tab; int G, c;
    __device__ __forceinline__ bool next(int i, Unit& u) const {
        const int Ttot = __builtin_amdgcn_readfirstlane(tab.tp[257]); const int L = i * G + c; if (L >= 2 * Ttot) return false;
        const int T = L >> 1, half = L & 1;
        const int e = __builtin_amdgcn_readfirstlane((int)tab.t2e[T]);
        u.pm = T; u.pn = half; u.aux = e; u.aux2 = __builtin_amdgcn_readfirstlane(T - tab.tp[e]); return true;
    }
    __device__ __forceinline__ const char* a_base(const Unit&) const { return (const char*)H2; }
    __device__ __forceinline__ const char* b_base(const Unit& u) const { return (u.aux < 256 ? (const char*)WGU + (size_t)u.aux * (512 * 1024) : (const char*)WSGU) + (size_t)u.pn * (256 * 1024); }
    __device__ __forceinline__ const unsigned* idx_ptr(const Unit& u) const { return LIST + (size_t)u.aux * 65536 + (size_t)u.aux2 * 256; }
    __device__ __forceinline__ int nvalid(const Unit& u) const { const int r = __builtin_amdgcn_readfirstlane(tab.cnt[u.aux]) - u.aux2 * 256; return r < 256 ? r : 256; }
};
struct SchedDown {
    const bf16_t *ACT, *WD, *WSD; MoeTab tab; int G, c;
    __device__ __forceinline__ bool next(int i, Unit& u) const {
        const int TT = __builtin_amdgcn_readfirstlane(tab.tp[257]);
        const int L = i * G + c; if (L >= 4 * TT) return false;
        u.pm = L >> 2; u.pn = L & 3;
        u.aux = __builtin_amdgcn_readfirstlane((int)tab.t2e[u.pm]); u.aux2 = 0; return true;
    }
    __device__ __forceinline__ const char* a_base(const Unit& u) const { return (const char*)ACT + (size_t)u.pm * (256 * 256); }
    __device__ __forceinline__ const char* b_base(const Unit& u) const { return (u.aux < 256 ? (const char*)WD + (size_t)u.aux * (1024 * 256) : (const char*)WSD) + (size_t)u.pn * (256 * 256); }
    __device__ __forceinline__ const unsigned* idx_ptr(const Unit&) const { return nullptr; }
    __device__ __forceinline__ int nvalid(const Unit&) const { return 256; }
};

#define EPI_ARGS const f32x4 (&acc)[2][2][4][2], const Unit& u, int wr, int wc, int fr_, int fq_
#define EPI_PIN int fr = fr_, fq = fq_; asm volatile("" : "+v"(fr), "+v"(fq))
__device__ __forceinline__ u32x4 pack8(const f32x4& a, const f32x4& b) { u32x4 o; o.x = cvt_pk_bf16(a[0], a[1]); o.y = cvt_pk_bf16(a[2], a[3]); o.z = cvt_pk_bf16(b[0], b[1]); o.w = cvt_pk_bf16(b[2], b[3]); return o; }

__device__ __forceinline__ unsigned pk4_fp8c(float a, float b, float c, float d) {
    a = __builtin_amdgcn_fmed3f(a, -440.f, 440.f); b = __builtin_amdgcn_fmed3f(b, -440.f, 440.f); c = __builtin_amdgcn_fmed3f(c, -440.f, 440.f); d = __builtin_amdgcn_fmed3f(d, -440.f, 440.f);
    int w = __builtin_amdgcn_cvt_pk_fp8_f32(a, b, 0, false); w = __builtin_amdgcn_cvt_pk_fp8_f32(c, d, w, true); return (unsigned)w; }
struct EpiQKV {
    bf16_t *Q, *Kb, *Vb; const float *qnw, *knw; const f32x2* rope;
    __device__ __forceinline__ void operator()(EPI_ARGS) const {
        EPI_PIN;
        const bool ctx = u.aux != 0;
        const int kind = (u.pn < 2) ? 0 : (wc < 2 ? 1 : 2);
        f32x4 w[2][2];
#pragma unroll
        for (int bj = 0; bj < 2; ++bj)
#pragma unroll
            for (int n = 0; n < 2; ++n) w[bj][n] = (kind == 2) ? (f32x4){1.f, 1.f, 1.f, 1.f} : *(const f32x4*)((kind == 0 ? qnw : knw) + 32 * bj + 8 * fq + 4 * n);
        f32x4 rrow[2][2], rcol[4][2];
        if (kind != 2 && !ctx) {
#pragma unroll
            for (int ai = 0; ai < 2; ++ai)
#pragma unroll
                for (int n = 0; n < 2; ++n) rrow[ai][n] = ((const f32x4*)(rope + (((u.pm * 4 + 2 * ai + wr) & 63) * 16) + 4 * fq))[n];
#pragma unroll
            for (int m = 0; m < 4; ++m)
#pragma unroll
                for (int n = 0; n < 2; ++n) rcol[m][n] = ((const f32x4*)(rope + (16 * m + fr) * 16 + 4 * fq))[n];
        }
#pragma unroll
        for (int ai = 0; ai < 2; ++ai)
#pragma unroll
            for (int m = 0; m < 4; ++m) {
                const int rl = ai * 128 + wr * 64 + m * 16 + fr; const int row = u.pm * 256 + rl;
                f32x4 v[2][2];
#pragma unroll
                for (int bj = 0; bj < 2; ++bj)
#pragma unroll
                    for (int n = 0; n < 2; ++n) v[bj][n] = acc[ai][bj][m][n];
                if (kind != 2) {
                    float ss = 0.f;
#pragma unroll
                    for (int bj = 0; bj < 2; ++bj)
#pragma unroll
                        for (int n = 0; n < 2; ++n) ss += (v[bj][n][0] * v[bj][n][0] + v[bj][n][1] * v[bj][n][1]) + (v[bj][n][2] * v[bj][n][2] + v[bj][n][3] * v[bj][n][3]);
                    ss += __shfl_xor(ss, 16); ss += __shfl_xor(ss, 32);
                    const float rs = rsqrtf(ss * (1.f / 64.f) + EPS);
#pragma unroll
                    for (int bj = 0; bj < 2; ++bj)
#pragma unroll
                        for (int n = 0; n < 2; ++n) v[bj][n] = v[bj][n] * rs * w[bj][n];
                    if (!ctx) {
#pragma unroll
                        for (int bj = 0; bj < 2; ++bj)
#pragma unroll
                            for (int n = 0; n < 2; ++n) { const f32x4 cs = bj == 0 ? rrow[ai][n] : rcol[m][n]; const f32x4 x = v[bj][n];
                                v[bj][n] = (f32x4){x[0] * cs[0] - x[1] * cs[1], x[0] * cs[1] + x[1] * cs[0], x[2] * cs[2] - x[3] * cs[3], x[2] * cs[3] + x[3] * cs[2]}; }
                    }
                    if (kind == 0) {
#pragma unroll
                        for (int bj = 0; bj < 2; ++bj)
#pragma unroll
                            for (int n = 0; n < 2; ++n) v[bj][n] = v[bj][n] * C2;
                    }
                }
                bf16_t* dst;
                if (kind == 0) dst = Q + (size_t)row * AW + 64 * (4 * u.pn + wc) + 8 * fq;
                else { const int kvrow = ctx ? (row >> 8) * KVLEN + (row & 255) : (row >> 12) * KVLEN + CTXL + (row & (SEQ - 1));
                       dst = (kind == 1 ? Kb : Vb) + (size_t)kvrow * KVP + 64 * (wc & 1) + 8 * fq; }
#pragma unroll
                for (int bj = 0; bj < 2; ++bj) *(u32x4*)(dst + 32 * bj) = pack8(v[bj][0], v[bj][1]);
            }
    }
};
struct EpiPlainBf16 {
    bf16_t* O; size_t ldc; float scale;
    __device__ __forceinline__ void operator()(EPI_ARGS) const {
        EPI_PIN;
#pragma unroll
        for (int ai = 0; ai < 2; ++ai)
#pragma unroll
            for (int m = 0; m < 4; ++m) { bf16_t* rowp = O + (size_t)(u.pm * 256 + ai * 128 + wr * 64 + m * 16 + fr) * ldc + u.pn * 256 + wc * 32 + 8 * fq;
#pragma unroll
                for (int bj = 0; bj < 2; ++bj) *(u32x4*)(rowp + bj * 128) = pack8(acc[ai][bj][m][0] * scale, acc[ai][bj][m][1] * scale); }
    }
};
struct EpiOutProj {
    const float* x; float* out; const float* modv; int pm0;
    __device__ __forceinline__ void operator()(EPI_ARGS) const {
        EPI_PIN;
        const int pmt = pm0 + u.pm;
        const float* g1 = modv + (size_t)(pmt >> 4) * 6144 + 2 * 1024; const int col0 = u.pn * 256 + wc * 32 + 8 * fq;
        f32x4 gv[2][2];
#pragma unroll
        for (int bj = 0; bj < 2; ++bj)
#pragma unroll
            for (int n = 0; n < 2; ++n) gv[bj][n] = *(const f32x4*)(g1 + col0 + bj * 128 + 4 * n);
#pragma unroll
        for (int ai = 0; ai < 2; ++ai)
#pragma unroll
            for (int m = 0; m < 4; ++m) { const size_t off = (size_t)(pmt * 256 + ai * 128 + wr * 64 + m * 16 + fr) * DM + col0;
#pragma unroll
                for (int bj = 0; bj < 2; ++bj)
#pragma unroll
                    for (int n = 0; n < 2; ++n) { const f32x4 xv = *(const f32x4*)(x + off + bj * 128 + 4 * n); *(f32x4*)(out + off + bj * 128 + 4 * n) = xv + gv[bj][n] * acc[ai][bj][m][n]; }
                if (m & 1) asm volatile("" ::: "memory"); }
    }
};
struct EpiF32 {
    float* O; size_t ldc;
    __device__ __forceinline__ void operator()(EPI_ARGS) const {
        EPI_PIN;
#pragma unroll
        for (int ai = 0; ai < 2; ++ai)
#pragma unroll
            for (int m = 0; m < 4; ++m) { float* rowp = O + (size_t)(u.pm * 256 + ai * 128 + wr * 64 + m * 16 + fr) * ldc + u.pn * 256 + wc * 32 + 8 * fq;
#pragma unroll
                for (int bj = 0; bj < 2; ++bj)
#pragma unroll
                    for (int n = 0; n < 2; ++n) *(f32x4*)(rowp + bj * 128 + 4 * n) = acc[ai][bj][m][n]; }
    }
};
struct EpiGU {
    unsigned char* ACT; const unsigned* LIST; MoeTab tab;
    __device__ __forceinline__ void operator()(EPI_ARGS) const {
        EPI_PIN;
        const int e = u.aux, tile = u.aux2; int nv = __builtin_amdgcn_readfirstlane(tab.cnt[e]) - tile * 256; nv = nv < 256 ? nv : 256;
        const unsigned* ip = LIST + (size_t)e * 65536 + (size_t)tile * 256;
        constexpr float C1 = -1.4426950408889634f / 256.0f;
#pragma unroll
        for (int ai = 0; ai < 2; ++ai)
#pragma unroll
            for (int m = 0; m < 4; ++m) { const int rl = ai * 128 + wr * 64 + m * 16 + fr;
                const float ws = rl < nv ? bf2f(ip[rl] & 0xffffu) * (4.0f / 65536.0f) : 0.f;
                unsigned pk[2];
#pragma unroll
                for (int n = 0; n < 2; ++n) { const f32x4 g = acc[ai][0][m][n], up = acc[ai][1][m][n]; f32x2 r[2];
#pragma unroll
                    for (int h = 0; h < 2; ++h) { const f32x2 gg = {g[2 * h], g[2 * h + 1]}, uu = {up[2 * h], up[2 * h + 1]};
                        const f32x2 ea = gg * C1; f32x2 d; d.x = __builtin_amdgcn_exp2f(ea.x); d.y = __builtin_amdgcn_exp2f(ea.y); d = d + 1.0f;
                        f32x2 q; q.x = __builtin_amdgcn_rcpf(d.x); q.y = __builtin_amdgcn_rcpf(d.y);
                        f32x2 p = (gg * uu) * (q * ws);
                        p.x = __builtin_amdgcn_fmed3f(p.x, -440.f, 440.f); p.y = __builtin_amdgcn_fmed3f(p.y, -440.f, 440.f); r[h] = p; }
                    int w = __builtin_amdgcn_cvt_pk_fp8_f32(r[0].x, r[0].y, 0, false); w = __builtin_amdgcn_cvt_pk_fp8_f32(r[1].x, r[1].y, w, true); pk[n] = (unsigned)w; }
                u32x2 o; o.x = pk[0]; o.y = pk[1];
                *(u32x2*)(ACT + (size_t)(u.pm * 256 + rl) * FF + u.pn * 128 + wc * 32 + 8 * fq) = o; }
    }
};
struct EpiDown {
    unsigned char* SLOT;
    __device__ __forceinline__ void operator()(EPI_ARGS) const {
        EPI_PIN;
#pragma unroll
        for (int ai = 0; ai < 2; ++ai)
#pragma unroll
            for (int m = 0; m < 4; ++m) { unsigned char* rowp = SLOT + (size_t)(u.pm * 256 + ai * 128 + wr * 64 + m * 16 + fr) * DM + u.pn * 256 + wc * 32 + 8 * fq;
#pragma unroll
                for (int bj = 0; bj < 2; ++bj) { const f32x4 a = acc[ai][bj][m][0] * 0.125f, b = acc[ai][bj][m][1] * 0.125f;
                    u32x2 pk; pk.x = pk4_fp8c(a[0], a[1], a[2], a[3]); pk.y = pk4_fp8c(b[0], b[1], b[2], b[3]); *(u32x2*)(rowp + bj * 128) = pk; } }
    }
};
#include <hip/hip_bf16.h>
#include <cmath>
namespace attn_body {
using bf16=__hip_bfloat16;
using bf16x8=__attribute__((ext_vector_type(8)))short;
using s16x4=__attribute__((ext_vector_type(4)))short;
using f32x16=__attribute__((ext_vector_type(16)))float;
using u32x4=__attribute__((ext_vector_type(4)))unsigned;
constexpr int SEQ=4096,D=64,QP=512,KVP=128,KVLEN=4352;
constexpr int NW=8,QBLK=32,QB=QBLK*NW,KVBLK=64,NQB=SEQ/QB;
constexpr int ATTN_UNIT_ROWS=QB;
__device__ __forceinline__ int crow(int r,int hi){return (r&3)+8*(r>>2)+4*hi;}
#define SBAR() __builtin_amdgcn_sched_barrier(0)

constexpr int NSLOT=3, SLOTB=8192;
constexpr int LDS_K=0, LDS_V=NSLOT*SLOTB, LDS_WS=2*NSLOT*SLOTB, LDS_OST=LDS_WS+NW*64*4, LDS_BYTES=LDS_OST+NW*4096;
constexpr float C2=0.125f*1.4426950408889634f;
__device__ __forceinline__ void glds16(const void*gsrc,unsigned lds_dst){unsigned keep;
  asm volatile("s_mov_b32 %0, m0\n\ts_mov_b32 m0, %2\n\ts_nop 0\n\tglobal_load_lds_dwordx4 %1, off\n\ts_mov_b32 m0, %0":"=&s"(keep):"v"(gsrc),"s"(lds_dst):"memory");}
__device__ __forceinline__ float max3f(float a,float b,float c){float r;asm("v_max3_f32 %0, %1, %2, %3":"=v"(r):"v"(a),"v"(b),"v"(c));return r;}
__device__ __forceinline__ float max2f(float a,float b){float r;asm("v_max_f32_e32 %0, %1, %2":"=v"(r):"v"(a),"v"(b));return r;}
__device__ __forceinline__ float fadd_s(float a,float b){float r;asm("v_add_f32_e32 %0, %1, %2":"=v"(r):"v"(a),"v"(b));return r;}
__device__ __forceinline__ float fsub_s(float a,float b){float r;asm("v_sub_f32_e32 %0, %1, %2":"=v"(r):"v"(a),"v"(b));return r;}
typedef float f32x2_t __attribute__((ext_vector_type(2))); typedef __bf16 bf16x2_t __attribute__((ext_vector_type(2)));
__device__ __forceinline__ unsigned cvtpk_s(float lo,float hi){f32x2_t v={lo,hi};bf16x2_t b=__builtin_convertvector(v,bf16x2_t);return __builtin_bit_cast(unsigned,b);}
#define WAIT_BAR(N) asm volatile("s_waitcnt vmcnt(" #N ") lgkmcnt(0)\n\ts_barrier":::"memory")

__device__ __forceinline__ void qkt(f32x16&p0,f32x16&p1,const char*Kslot,const bf16x8*qr,const f32x16&negm,int r32,int hi){
  const char*kb=Kslot+hi*1024+r32*16;
  #pragma unroll
  for(int d0=0;d0<4;++d0){
    const bf16x8 b0=*reinterpret_cast<const bf16x8*>(kb+d0*2048);
    const bf16x8 b1=*reinterpret_cast<const bf16x8*>(kb+d0*2048+512);
    if(d0==0){p0=__builtin_amdgcn_mfma_f32_32x32x16_bf16(b0,qr[0],negm,0,0,0);p1=__builtin_amdgcn_mfma_f32_32x32x16_bf16(b1,qr[0],negm,0,0,0);}
    else{p0=__builtin_amdgcn_mfma_f32_32x32x16_bf16(b0,qr[d0],p0,0,0,0);p1=__builtin_amdgcn_mfma_f32_32x32x16_bf16(b1,qr[d0],p1,0,0,0);}}
}
typedef __attribute__((address_space(3))) const char* lds_cptr;
typedef short v4i16_t __attribute__((ext_vector_type(4)));
__device__ __forceinline__ void kload8(bf16x8*kf,lds_cptr kp){
  kf[0]=*(const __attribute__((address_space(3))) bf16x8*)(kp);      kf[1]=*(const __attribute__((address_space(3))) bf16x8*)(kp+512);
  kf[2]=*(const __attribute__((address_space(3))) bf16x8*)(kp+2048); kf[3]=*(const __attribute__((address_space(3))) bf16x8*)(kp+2560);
  kf[4]=*(const __attribute__((address_space(3))) bf16x8*)(kp+4096); kf[5]=*(const __attribute__((address_space(3))) bf16x8*)(kp+4608);
  kf[6]=*(const __attribute__((address_space(3))) bf16x8*)(kp+6144); kf[7]=*(const __attribute__((address_space(3))) bf16x8*)(kp+6656);
}
__device__ __forceinline__ void kload2(bf16x8*kf,lds_cptr kp,int j){ kf[2*j]=*(const __attribute__((address_space(3))) bf16x8*)(kp+j*2048); kf[2*j+1]=*(const __attribute__((address_space(3))) bf16x8*)(kp+j*2048+512); }
__device__ __forceinline__ s16x4 vtr(lds_cptr p){ return __builtin_bit_cast(s16x4,__builtin_amdgcn_ds_read_tr16_b64_v4i16((__attribute__((address_space(3))) v4i16_t*)p)); }
__device__ __forceinline__ float rowmax(const f32x16&p0,const f32x16&p1){
  float a=max3f(p0[0],p0[1],p1[0]),b=max3f(p0[2],p0[3],p1[1]);a=max3f(a,p1[2],p1[3]);
  #pragma unroll
  for(int r=4;r<16;r+=4){a=max3f(a,p0[r],p0[r+1]);b=max3f(b,p0[r+2],p0[r+3]);a=max3f(a,p1[r],p1[r+1]);b=max3f(b,p1[r+2],p1[r+3]);}
  const float m=max2f(a,b);
  auto rr=__builtin_amdgcn_permlane32_swap(__float_as_uint(m),__float_as_uint(m),false,false);
  return max2f(__uint_as_float(rr[0]),__uint_as_float(rr[1]));
}
__device__ __forceinline__ void pv(f32x16*o,int vb,bf16x8 pa0,bf16x8 pa1,bf16x8 pa2,bf16x8 pa3){
  #pragma unroll
  for(int d0=0;d0<2;++d0){s16x4 lo[4],hi[4];
    #pragma unroll
    for(int ks=0;ks<4;++ks){
      asm volatile("ds_read_b64_tr_b16 %0,%1 offset:%c2":"=&v"(lo[ks]):"v"(vb),"i"(d0*4096+ks*1024):"memory");
      asm volatile("ds_read_b64_tr_b16 %0,%1 offset:%c2":"=&v"(hi[ks]):"v"(vb),"i"(d0*4096+ks*1024+512):"memory");}
    asm volatile("s_waitcnt lgkmcnt(0)":::"memory");SBAR();
    #define PK(k) (bf16x8){lo[k][0],lo[k][1],lo[k][2],lo[k][3],hi[k][0],hi[k][1],hi[k][2],hi[k][3]}
    o[d0]=__builtin_amdgcn_mfma_f32_32x32x16_bf16(pa0,PK(0),o[d0],0,0,0);
    o[d0]=__builtin_amdgcn_mfma_f32_32x32x16_bf16(pa1,PK(1),o[d0],0,0,0);
    o[d0]=__builtin_amdgcn_mfma_f32_32x32x16_bf16(pa2,PK(2),o[d0],0,0,0);
    o[d0]=__builtin_amdgcn_mfma_f32_32x32x16_bf16(pa3,PK(3),o[d0],0,0,0);
    #undef PK
  }
}

#ifndef ATTN_STORE16
#define ATTN_STORE16(p,v) (*(u32x4*)(p)=(v))
#endif
template<int THRL> __device__ __forceinline__ void attn_unit(int b,int h,int qb,const bf16*Q,const bf16*__restrict__ K,const bf16*__restrict__ V,bf16*O,char*shm,int wave_){
  const int lane=::lane_id(),tid=wave_*64+lane,r32=lane&31,hi=lane>>5; const int wid=wave_;
  const int q0=qb*QB; const long qrow0=(long)b*SEQ+q0+wid*QBLK;
  const bf16*Qw=Q+qrow0*QP+h*D;
  const bf16*Kh=K+(long)b*KVLEN*KVP+(h>>2)*D,*Vh=V+(long)b*KVLEN*KVP+(h>>2)*D;
  const unsigned lds0=(unsigned)(uintptr_t)shm;
  float*wsf=(float*)(shm+LDS_WS)+wid*64;
  const bf16*ksrc=Kh+(long)lane*KVP+wid*8;
  const bf16*vsrc=Vh+(long)(16*(wid&3)+(lane>>2))*KVP+(wid>>2)*32+(lane&3)*8;
  const unsigned kdst=lds0+LDS_K+wid*1024, vdst=lds0+LDS_V+wid*1024;
  #define DMA_K(t,slot) glds16(ksrc+(long)(t)*KVBLK*KVP,(unsigned)__builtin_amdgcn_readfirstlane(kdst+(slot)))
  #define DMA_V(t,slot) glds16(vsrc+(long)(t)*KVBLK*KVP,(unsigned)__builtin_amdgcn_readfirstlane(vdst+(slot)))
  const int vb0=(int)(lds0+LDS_V)+((lane>>4)&1)*32+(lane&3)*8+(4*hi+((lane&15)>>2))*64;
  const char*Kbase=shm+LDS_K; bf16x8 kf[8];
  const lds_cptr shm3=(lds_cptr)shm; const lds_cptr kp0=shm3+LDS_K+hi*1024+r32*16; const lds_cptr vp0=shm3+LDS_V+((lane>>4)&1)*32+(lane&3)*8+(4*hi+((lane&15)>>2))*64;
  constexpr int NT=KVLEN/KVBLK;
  DMA_K(0,0);DMA_V(0,0);DMA_K(1,SLOTB);
  bf16x8 qr[4];
  #pragma unroll
  for(int d0=0;d0<4;++d0)qr[d0]=*reinterpret_cast<const bf16x8*>(&Qw[(long)r32*QP+d0*16+hi*8]);
  float mhat=0.f,l_reg=0.f;f32x16 o[2];o[0]=f32x16{};o[1]=f32x16{};f32x16 negm=f32x16{};asm volatile("":"+v"(negm));
  #define CMASK(P0,P1,t) do{}while(0)
  bool resc=false;
  #define START(P0,P1) do{ const float rm=rowmax(P0,P1); resc=false; \
    { const float dl=rm; mhat=fadd_s(mhat,dl); \
      _Pragma("unroll") for(int r=0;r<16;++r){P0[r]=fsub_s(P0[r],dl);P1[r]=fsub_s(P1[r],dl);} \
      _Pragma("unroll") for(int r=0;r<16;++r)negm[r]=-mhat; asm volatile("":"+v"(negm)); } \
    _Pragma("unroll") for(int r=0;r<16;++r)P0[r]=__builtin_amdgcn_exp2f(P0[r]); }while(0)
  #define RESC() do{ if(resc){ asm volatile("s_waitcnt lgkmcnt(0)":::"memory"); \
      _Pragma("unroll") for(int d_=0;d_<2;++d_) _Pragma("unroll") for(int r=0;r<16;++r)o[d_][r]*=wsf[crow(r,hi)]; } }while(0)
  f32x16 pA0,pA1,pB0,pB1;
  int sl_prev=0,sl_cur=0,sl_next=SLOTB;
  #define ROT() do{sl_prev=sl_cur;sl_cur=sl_next;sl_next=(sl_next==(NSLOT-1)*SLOTB)?0:sl_next+SLOTB;}while(0)
  DMA_K(2,2*SLOTB);
  WAIT_BAR(3);
  qkt(pA0,pA1,Kbase,qr,negm,r32,hi);asm volatile("s_nop 15\n\ts_nop 7":"+v"(pA0),"+v"(pA1));CMASK(pA0,pA1,0);
  START(pA0,pA1);
  _Pragma("unroll") for(int r=0;r<16;++r)pA1[r]=__builtin_amdgcn_exp2f(pA1[r]);
  WAIT_BAR(0);
  DMA_K(3,0);DMA_V(1,SLOTB);
  ROT();
  kload8(kf,kp0+sl_cur);
  WAIT_BAR(2);
  s16x4 vlo[8],vhi[8]; u32x4 pw0,pw1,pw2,pw3;
  #define PKW(P,B) cvtpk_s(P[B],P[B+1])
  #define PAF(k) __builtin_bit_cast(bf16x8,pw##k)
  #define VFR(i) (bf16x8){vlo[i][0],vlo[i][1],vlo[i][2],vlo[i][3],vhi[i][0],vhi[i][1],vhi[i][2],vhi[i][3]}
  #define PIN(x) asm volatile("":"+v"(x))
  #define MX3(a,b,c) __builtin_fmaxf(__builtin_fmaxf((a),(b)),(c))
  #define GAPA(MF,A0,A1,A2,A3,W0,W1,PW) do{ MF; sacc+=A0; sacc+=A1; sacc+=A2; sacc+=A3; PIN(sacc); W0; W1; PIN(PW); SBAR(); }while(0)
  #define EX(v) __builtin_amdgcn_exp2f(v)
  #define GAPB(MF,X,B) do{ MF; X[B]=EX(X[B]); X[B+1]=EX(X[B+1]); X[B+2]=EX(X[B+2]); X[B+3]=EX(X[B+3]); PIN(X); SBAR(); }while(0)
  #define VRD(i) do{ vlo[i]=vtr(vp_+(((i)>>2)*4096+((i)&3)*1024)); vhi[i]=vtr(vp_+(((i)>>2)*4096+((i)&3)*1024+512)); }while(0)
  #define KRD(G,j) do{ if(G){ kload2(kf,kp0+sl_next,j); SBAR(); } }while(0)
  #define STEP(C0,C1,P0,P1,t,GK,GV,GL) do{ SBAR(); \
    const lds_cptr vp_=vp0+sl_prev; \
    VRD(0); SBAR(); float sacc=(P0[0]+P0[1]); \
    GAPA(C0=__builtin_amdgcn_mfma_f32_32x32x16_bf16(kf[0],qr[0],negm,0,0,0), P0[2],P0[3],P0[4],P0[5],     pw0[0]=PKW(P0,0), pw0[1]=PKW(P0,2), pw0); \
    VRD(4); SBAR(); GAPA(C1=__builtin_amdgcn_mfma_f32_32x32x16_bf16(kf[1],qr[0],negm,0,0,0), P0[6],P0[7],P0[8],P0[9],     pw0[2]=PKW(P0,4), pw0[3]=PKW(P0,6), pw0); \
    VRD(1); SBAR(); GAPA(C0=__builtin_amdgcn_mfma_f32_32x32x16_bf16(kf[2],qr[1],C0,0,0,0),   P0[10],P0[11],P0[12],P0[13], pw1[0]=PKW(P0,8), pw1[1]=PKW(P0,10), pw1); \
    VRD(5); SBAR(); GAPA(C1=__builtin_amdgcn_mfma_f32_32x32x16_bf16(kf[3],qr[1],C1,0,0,0),   P0[14],P0[15],P1[0],P1[1],   pw1[2]=PKW(P0,12),pw1[3]=PKW(P0,14), pw1); \
    VRD(2); SBAR(); GAPA(C0=__builtin_amdgcn_mfma_f32_32x32x16_bf16(kf[4],qr[2],C0,0,0,0),   P1[2],P1[3],P1[4],P1[5],     pw2[0]=PKW(P1,0), pw2[1]=PKW(P1,2), pw2); \
    VRD(6); SBAR(); GAPA(C1=__builtin_amdgcn_mfma_f32_32x32x16_bf16(kf[5],qr[2],C1,0,0,0),   P1[6],P1[7],P1[8],P1[9],     pw2[2]=PKW(P1,4), pw2[3]=PKW(P1,6), pw2); \
    VRD(3); SBAR(); GAPA(C0=__builtin_amdgcn_mfma_f32_32x32x16_bf16(kf[6],qr[3],C0,0,0,0),   P1[10],P1[11],P1[12],P1[13], pw3[0]=PKW(P1,8), pw3[1]=PKW(P1,10), pw3); \
    VRD(7); SBAR(); GAPA(C1=__builtin_amdgcn_mfma_f32_32x32x16_bf16(kf[7],qr[3],C1,0,0,0),   P1[14],P1[15],0.f,0.f,       pw3[2]=PKW(P1,12),pw3[3]=PKW(P1,14), pw3); \
    l_reg+=sacc; \
    if(GK){DMA_K((t)+3,sl_cur);} if(GV){DMA_V((t)+1,sl_next);} \
    CMASK(C0,C1,t); \
    { float a=MX3(C0[0],C0[1],C1[0]),b=MX3(C0[2],C0[3],C1[1]); a=MX3(a,C1[2],C1[3]); \
      _Pragma("unroll") for(int r=4;r<16;r+=4){a=MX3(a,C0[r],C0[r+1]);b=MX3(b,C0[r+2],C0[r+3]);a=MX3(a,C1[r],C1[r+1]);b=MX3(b,C1[r+2],C1[r+3]);} \
      float rm=__builtin_fmaxf(a,b); { auto rr=__builtin_amdgcn_permlane32_swap(__float_as_uint(rm),__float_as_uint(rm),false,false); rm=__builtin_fmaxf(__uint_as_float(rr[0]),__uint_as_float(rr[1])); } \
      resc=false; \
      if(__builtin_expect(__any(rm>(float)THRL),0)){ const float dl=__builtin_fmaxf(rm,0.f); mhat+=dl; \
        _Pragma("unroll") for(int r=0;r<16;++r){C0[r]-=dl;C1[r]-=dl;} \
        _Pragma("unroll") for(int r=0;r<16;++r)negm[r]=-mhat; asm volatile("":"+v"(negm)); \
        const float f=__builtin_amdgcn_exp2f(-dl); l_reg*=f; if(hi==0)wsf[r32]=f; resc=true; } } \
    SBAR(); \
    GAPB(o[0]=__builtin_amdgcn_mfma_f32_32x32x16_bf16(PAF(0),VFR(0),o[0],0,0,0), C0,0); \
    GAPB(o[1]=__builtin_amdgcn_mfma_f32_32x32x16_bf16(PAF(0),VFR(4),o[1],0,0,0), C0,4); \
    KRD(GL,0); GAPB(o[0]=__builtin_amdgcn_mfma_f32_32x32x16_bf16(PAF(1),VFR(1),o[0],0,0,0), C0,8); \
    KRD(GL,1); GAPB(o[1]=__builtin_amdgcn_mfma_f32_32x32x16_bf16(PAF(1),VFR(5),o[1],0,0,0), C0,12); \
    KRD(GL,2); GAPB(o[0]=__builtin_amdgcn_mfma_f32_32x32x16_bf16(PAF(2),VFR(2),o[0],0,0,0), C1,0); \
    KRD(GL,3); GAPB(o[1]=__builtin_amdgcn_mfma_f32_32x32x16_bf16(PAF(2),VFR(6),o[1],0,0,0), C1,4); \
    GAPB(o[0]=__builtin_amdgcn_mfma_f32_32x32x16_bf16(PAF(3),VFR(3),o[0],0,0,0), C1,8); \
    GAPB(o[1]=__builtin_amdgcn_mfma_f32_32x32x16_bf16(PAF(3),VFR(7),o[1],0,0,0), C1,12); \
    }while(0)
  int t=1;
  #undef CMASK
  #define CMASK(P0,P1,t) do{}while(0)
  for(;t+5<NT;t+=2){
    STEP(pB0,pB1,pA0,pA1,t,true,true,true);     WAIT_BAR(2); RESC(); ROT();
    STEP(pA0,pA1,pB0,pB1,t+1,true,true,true);   WAIT_BAR(2); RESC(); ROT();
  }
  #undef CMASK
  #define CMASK(P0,P1,t) do{}while(0)
  #define ENDW(tt) do{ if((tt)+3<NT){WAIT_BAR(2);} else if((tt)+2<NT){WAIT_BAR(1);} else {WAIT_BAR(0);} }while(0)
  for(;t+1<NT;t+=2){
    STEP(pB0,pB1,pA0,pA1,t,(t+3<NT),(t+1<NT),(t+1<NT));       ENDW(t);   RESC(); ROT();
    STEP(pA0,pA1,pB0,pB1,t+1,(t+4<NT),(t+2<NT),(t+2<NT));     ENDW(t+1); RESC(); ROT();
  }
  STEP(pB0,pB1,pA0,pA1,NT-1,false,false,false); RESC();
  { float sacc=pB0[0]+pB0[1]; _Pragma("unroll") for(int r=2;r<16;++r)sacc+=pB0[r]; _Pragma("unroll") for(int r=0;r<16;++r)sacc+=pB1[r]; l_reg+=sacc;
    pw0=(u32x4){PKW(pB0,0),PKW(pB0,2),PKW(pB0,4),PKW(pB0,6)};pw1=(u32x4){PKW(pB0,8),PKW(pB0,10),PKW(pB0,12),PKW(pB0,14)};pw2=(u32x4){PKW(pB1,0),PKW(pB1,2),PKW(pB1,4),PKW(pB1,6)};pw3=(u32x4){PKW(pB1,8),PKW(pB1,10),PKW(pB1,12),PKW(pB1,14)};
    SBAR(); pv(o,vb0+sl_cur,PAF(0),PAF(1),PAF(2),PAF(3)); }
  #undef PKW
  #undef PAF
  #undef VFR
  #undef PIN
  #undef MX3
  #undef GAPA
  #undef GAPB
  #undef EX
  #undef VRD
  #undef KRD
  #undef STEP
  #undef ENDW
  {auto rr=__builtin_amdgcn_permlane32_swap(__float_as_uint(l_reg),__float_as_uint(l_reg),false,false);l_reg=__uint_as_float(rr[0])+__uint_as_float(rr[1]);}
  if(hi==0)wsf[32+r32]=l_reg;asm volatile("s_waitcnt lgkmcnt(0)":::"memory");
  float rli[16];
  #pragma unroll
  for(int r=0;r<16;++r)rli[r]=__builtin_amdgcn_rcpf(wsf[32+crow(r,hi)]);
  bf16*Ow=O+qrow0*QP+h*D;
  { bf16*stg=(bf16*)(shm+LDS_OST)+wid*2048;
    #pragma unroll
    for(int r=0;r<16;++r){const int orow=crow(r,hi);
      #pragma unroll
      for(int d0=0;d0<2;++d0)stg[orow*64+d0*32+r32]=__float2bfloat16(o[d0][r]*rli[r]);}
    asm volatile("s_waitcnt lgkmcnt(0)":::"memory");
    #pragma unroll
    for(int i=0;i<4;++i){const int row=i*8+(lane>>3),ch=lane&7; const u32x4 v=*(const u32x4*)(stg+row*64+ch*8); ATTN_STORE16(Ow+(long)row*QP+ch*8,v);} }
  asm volatile("s_waitcnt lgkmcnt(0)\n\ts_barrier":::"memory");
  #undef DMA_K
  #undef DMA_V
  #undef CMASK
  #undef START
  #undef RESC
  #undef ROT
}
constexpr int ATTN_LDS_BYTES=LDS_BYTES;
struct AttnTensors { const bf16* Q; const bf16* K; const bf16* V; bf16* O; };
struct AttnUnit { int b; int h; int qb; };
struct StaticOrder {
  int vcu;
  __device__ __forceinline__ explicit StaticOrder(int v):vcu(v){}
  __device__ __forceinline__ bool next(int i,AttnUnit&u)const{ if(i>=8)return false; const int xcd=vcu>>5,lc=vcu&31; const int grp=xcd*4+(i>>1); const int idx=(i&1)*32+lc;
    u.b=grp>>1; u.h=(grp&1)*4+(idx>>4); u.qb=idx&15; return true; }
};
template<class Sched,int THRL=8> __device__ __forceinline__ void attn_phase(char*lds,const AttnTensors&T,const Sched&S,int wave_){
  AttnUnit u;
  for(int i=0;S.next(i,u);++i){ attn_unit<THRL>(u.b,u.h,u.qb,T.Q,T.K,T.V,T.O,lds,wave_); }
}
#undef SBAR
#undef WAIT_BAR
}
#define XB_TMO      128
#define XB_XCNT(j)  (256  + 64 * (j))
#define XB_XSUB(j)  (1280 + 64 * (j))
#define XB_XGEN(j)  (2304 + 64 * (j))
#define XB_TOP      3328
#define XB_TOPGEN   3392
#define XCD_BAR_WORDS 3456
#define XB_SPIN_CAP (1u << 18)

__device__ __forceinline__ unsigned xb_ld(unsigned* p)              { return __hip_atomic_load(p, __ATOMIC_RELAXED, __HIP_MEMORY_SCOPE_AGENT); }
__device__ __forceinline__ unsigned xb_add(unsigned* p, unsigned v) { return __hip_atomic_fetch_add(p, v, __ATOMIC_RELAXED, __HIP_MEMORY_SCOPE_AGENT); }
__device__ __forceinline__ unsigned xb_xcc_id() { return (unsigned)__builtin_amdgcn_s_getreg((3 << 11) | 20) & 0xFu; }
#define XB_SPIN(cond, bar) do { unsigned _sp = 0; while (cond) { __builtin_amdgcn_s_sleep(1); \
    if ((++_sp & 255u) == 0u) { if (xb_ld(&(bar)[XB_TMO])) break; if (_sp > XB_SPIN_CAP) { atomicAdd(&(bar)[XB_TMO], 1u); break; } } } } while (0)

struct XcdBarrier {
    unsigned wv; unsigned* bar; unsigned x;
    volatile LAS unsigned* st;
};

__device__ __forceinline__ XcdBarrier xcd_barrier_post(unsigned* bar, volatile LAS unsigned* st) {
    XcdBarrier b; b.bar = bar; b.x = xb_xcc_id(); b.st = st;
    if (threadIdx.x == 0) (void)xb_add(&bar[XB_XCNT(b.x)], 1u);
    b.wv = (unsigned)__builtin_amdgcn_readfirstlane((int)(threadIdx.x >> 6));
    return b;
}
__device__ __forceinline__ void xcd_barrier_complete(unsigned* bar, unsigned x, unsigned& nloc, unsigned& nx) {
    const unsigned G = gridDim.x * gridDim.y * gridDim.z;
    unsigned sum, cnt, mine, sp = 0u;
    for (;;) {
        sum = 0u; cnt = 0u; mine = 0u;
#pragma unroll
        for (unsigned j = 0; j < 16; ++j) { const unsigned c = xb_ld(&bar[XB_XCNT(j)]); sum += c; cnt += (c > 0u) ? 1u : 0u; mine = (j == x) ? c : mine; }
        if (sum == G) break;
        __builtin_amdgcn_s_sleep(1);
        if ((++sp & 255u) == 0u) { if (xb_ld(&bar[XB_TMO])) break; if (sp > XB_SPIN_CAP) { atomicAdd(&bar[XB_TMO], 1u); break; } }
    }
    nloc = mine > 0u ? mine : 1u; nx = cnt > 0u ? cnt : 1u;
}

__device__ __forceinline__ void xcd_barrier(const XcdBarrier& b) {
    asm volatile("s_waitcnt vmcnt(0)" ::: "memory");
    __syncthreads();
    if (b.wv == 0u && lane_id() == 0) {
        unsigned* bar = b.bar;
        __builtin_amdgcn_s_waitcnt(0);
        unsigned nloc = b.st[0], nx = b.st[1];
        if (nloc == 0u) { xcd_barrier_complete(bar, b.x, nloc, nx); b.st[0] = nloc; b.st[1] = nx; }
        const unsigned old = xb_add(&bar[XB_XSUB(b.x)], 1u);
        const unsigned gen = old / nloc;
        if (old + 1u == (gen + 1u) * nloc) {
            __builtin_amdgcn_fence(__ATOMIC_RELEASE, "agent");
            asm volatile("s_waitcnt vmcnt(0)" ::: "memory");
            const unsigned og = xb_add(&bar[XB_TOP], 1u);
            const unsigned tg = og / nx;
            if (og + 1u == (tg + 1u) * nx) xb_add(&bar[XB_TOPGEN], 1u);
            else XB_SPIN(xb_ld(&bar[XB_TOPGEN]) == tg, bar);
            __builtin_amdgcn_fence(__ATOMIC_ACQUIRE, "agent");
            xb_add(&bar[XB_XGEN(b.x)], 1u);
            asm volatile("s_waitcnt vmcnt(0)" ::: "memory");
        } else {
            XB_SPIN(xb_ld(&bar[XB_XGEN(b.x)]) == gen, bar);
            __builtin_amdgcn_fence(__ATOMIC_ACQUIRE, "agent");
            asm volatile("s_waitcnt vmcnt(0)" ::: "memory");
        }
    }
    __syncthreads();
}


typedef GAS unsigned gu32;
#define RLX_AGENT __ATOMIC_RELAXED, __HIP_MEMORY_SCOPE_AGENT
#define LDS_WAIT() asm volatile("s_waitcnt lgkmcnt(0)" ::: "memory")
#define VM_WAIT() asm volatile("s_waitcnt vmcnt(0)" ::: "memory")
constexpr int N_IN = 34;
enum { I_X = 0, I_C, I_CTX, I_CCTX, I_MODW, I_MODB, I_NORM1, I_WIN, I_QNW, I_KNW, I_CONVW, I_CONVB, I_FW1, I_FB1, I_FW2, I_FB2, I_FW3, I_FB3, I_FW4, I_FFREQ,
       I_HBIAS, I_AONW, I_HONW, I_WOUT, I_NORM2, I_RW, I_RB, I_EG, I_EU, I_ED, I_SG, I_SU, I_SD, I_FNW };
struct Frame {
    LAS unsigned char* lds;
    volatile LAS unsigned* MISC;
    unsigned* ctl;
    int tid, lane, wave, vcu, G;
    float* out; unsigned char* ws;
};
typedef const __attribute__((address_space(4))) char* kargp_t;
__device__ __forceinline__ const float* kin(int i) { kargp_t p = (kargp_t)__builtin_amdgcn_kernarg_segment_ptr(); asm volatile("" : "+s"(p)); return (const float*)*(const GAS float* const __attribute__((address_space(4)))*)(p + 8 * i); }
#define WSP(T, off) ((T*)(F.ws + (off)))

__device__ __forceinline__ void tr_item(const float* W, int ldw, int k0, int n0, bf16_t* WT, int Kd, int drow0, LAS float* scr, int lane) {
#pragma unroll 8
    for (int i = 0; i < 32; ++i) { const int kk = 2 * i + (lane >> 5); scr[kk * 33 + (lane & 31)] = W[(size_t)(k0 + kk) * ldw + n0 + (lane & 31)]; }
    LDS_WAIT(); asm volatile("" ::: "memory");
    const int c = lane & 7;
#pragma unroll
    for (int j = 0; j < 4; ++j) { const int n = (lane >> 3) + 8 * j; const LAS float* s = scr + (8 * c) * 33 + n;
        u32x4 o; o.x = pk2(s[0 * 33], s[1 * 33]); o.y = pk2(s[2 * 33], s[3 * 33]); o.z = pk2(s[4 * 33], s[5 * 33]); o.w = pk2(s[6 * 33], s[7 * 33]);
        *(u32x4*)(WT + (size_t)(drow0 + n) * Kd + k0 + 8 * c) = o; }
    LDS_WAIT(); asm volatile("" ::: "memory");
}
__device__ __forceinline__ unsigned pk4_fp8(float a, float b, float c, float d) { int w = __builtin_amdgcn_cvt_pk_fp8_f32(a, b, 0, false); w = __builtin_amdgcn_cvt_pk_fp8_f32(c, d, w, true); return (unsigned)w; }
__device__ __forceinline__ void tr_item8(const float* W, int ldw, int k0, int n0, unsigned char* WT, int Kd, int drow0, float scl, LAS float* scr, int lane) {
#pragma unroll 8
    for (int i = 0; i < 32; ++i) { const int kk = 2 * i + (lane >> 5); scr[kk * 33 + (lane & 31)] = W[(size_t)(k0 + kk) * ldw + n0 + (lane & 31)]; }
    LDS_WAIT(); asm volatile("" ::: "memory");
    const int c = lane & 7;
#pragma unroll
    for (int j = 0; j < 4; ++j) { const int n = (lane >> 3) + 8 * j; const LAS float* s = scr + (8 * c) * 33 + n;
        u32x2 o; o.x = pk4_fp8(s[0 * 33] * scl, s[1 * 33] * scl, s[2 * 33] * scl, s[3 * 33] * scl); o.y = pk4_fp8(s[4 * 33] * scl, s[5 * 33] * scl, s[6 * 33] * scl, s[7 * 33] * scl);
        *(u32x2*)(WT + (size_t)(drow0 + n) * Kd + k0 + 8 * c) = o; }
    LDS_WAIT(); asm volatile("" ::: "memory");
}
constexpr int IT_FILT = 2048, IT_MODV = 0, IT_ROPE = 1, IT_QKV = 384, IT_WU = 768, IT_WO = 512, IT_WR = 128, IT_SGU = 256, IT_SD = 128, IT_EXP = 256 * 384;
constexpr int IT_TILES = IT_QKV + IT_WU + IT_WO + IT_WR + IT_SGU + IT_SD;
constexpr int XP_TILES = 256 * 48;

template <int NT_> __device__ __forceinline__ void p0_filter_item(Frame& F, int item, LAS float* hsc) {
    const int lane = F.lane; const int t0 = NT_ * item;
    const float* w1 = kin(I_FW1); const float* b1 = kin(I_FB1); const float* w2 = kin(I_FW2); const float* b2 = kin(I_FB2);
    const float* w3 = kin(I_FW3); const float* b3 = kin(I_FB3); const float* w4 = kin(I_FW4); const float fr = kin(I_FFREQ)[lane];
    float h[NT_], a[NT_];
#pragma unroll
    for (int tt = 0; tt < NT_; ++tt) { const int t = t0 + tt; float v = 0.f;
        if (lane == 0) v = (float)t * (1.0f / 4095.0f);
        else if (lane < 33) { const int m = (lane - 1) & 15; const float f = 1e-4f + (float)m * ((15.0f - 1e-4f) / 15.0f);
            float rev = f * ((float)t * (1.0f / 4096.0f)); rev -= floorf(rev); const float ang = 6.283185307179586f * rev;
            v = lane <= 16 ? cosf(ang) : -sinf(ang); }
        h[tt] = v; }
#pragma unroll
    for (int l = 0; l < 3; ++l) { const float* ww = l == 0 ? w1 : l == 1 ? w2 : w3; const float bb = (l == 0 ? b1 : l == 1 ? b2 : b3)[lane];
        float wc[64];
#pragma unroll
        for (int i = 0; i < 64; ++i) wc[i] = (l == 0 && i >= 33) ? 0.f : ww[i * 64 + lane];
#pragma unroll
        for (int tt = 0; tt < NT_; ++tt) a[tt] = bb;
#pragma unroll
        for (int i = 0; i < 64; ++i) { if (l == 0 && i >= 33) break;
#pragma unroll
            for (int tt = 0; tt < NT_; ++tt) a[tt] += __shfl(h[tt], i) * wc[i]; }
#pragma unroll
        for (int tt = 0; tt < NT_; ++tt) h[tt] = sinf(fr * a[tt]); }
#pragma unroll
    for (int tt = 0; tt < NT_; ++tt) hsc[tt * 64 + lane] = h[tt];
    LDS_WAIT(); asm volatile("" ::: "memory");
    bf16_t* KR = WSP(bf16_t, WS_KR);
    const float dmin = logf(1e-2f) / 0.3f, dmax = logf(1e-2f) / 1.5f;
#pragma unroll 1
    for (int q = 0; q < 16; ++q) {
        const int n = lane + 64 * q; float wc[64];
#pragma unroll
        for (int i = 0; i < 64; ++i) wc[i] = w4[i * 1024 + n];
        float o[NT_];
#pragma unroll
        for (int tt = 0; tt < NT_; ++tt) o[tt] = 0.f;
#pragma unroll
        for (int i4 = 0; i4 < 16; ++i4)
#pragma unroll
            for (int tt = 0; tt < NT_; ++tt) { const f32x4 hv = *(const LAS f32x4*)(hsc + tt * 64 + 4 * i4);
                o[tt] += (hv[0] * wc[4 * i4] + hv[1] * wc[4 * i4 + 1]) + (hv[2] * wc[4 * i4 + 2] + hv[3] * wc[4 * i4 + 3]); }
        const int c = n & 511; const bool bwd = n >= 512;
        const float delta = fabsf(dmin + (float)c * ((dmax - dmin) / 511.0f));
#pragma unroll
        for (int tt = 0; tt < NT_; ++tt) { const int t = t0 + tt; const float tl = (float)t * (1.0f / 4095.0f);
            const float val = o[tt] * expf(-tl * delta);
            if (!(bwd && t == 0)) {
#if HYENA_FP8
                ((unsigned char*)KR)[(size_t)c * 8192 + (bwd ? 4096 + t : 4096 - t)] = (unsigned char)(pk4_fp8c(val * 64.0f, 0.f, 0.f, 0.f) & 0xffu);
#else
                KR[(size_t)c * 8192 + (bwd ? 4096 + t : 4096 - t)] = (bf16_t)f2bf(val);
#endif
            } }
    }
}
__device__ __forceinline__ void p0_modv_block(Frame& F, int chunk) {
    const int lane = F.lane, kc = F.wave; const int n0 = 64 * chunk, k0 = 128 * kc;
    LAS float* sv = (LAS float*)(F.lds + RING_OFF + F.wave * 8704);
    LAS float* part = (LAS float*)(F.lds + RING_OFF + 8 * 8704);
    for (int r = 0; r < 17; ++r)
#pragma unroll
        for (int hh = 0; hh < 2; ++hh) { const int kk = lane + 64 * hh; const float v = r < 16 ? kin(I_C)[r * 1024 + k0 + kk] : kin(I_CCTX)[k0 + kk];
            sv[r * 128 + kk] = v / (1.0f + expf(-v)); }
    LDS_WAIT(); asm volatile("" ::: "memory");
    float acc[17];
#pragma unroll
    for (int r = 0; r < 17; ++r) acc[r] = 0.f;
    const float* W = kin(I_MODW) + (size_t)k0 * 6144 + n0 + lane;
    for (int k4 = 0; k4 < 32; ++k4) {
        const float w0 = W[(size_t)(4 * k4 + 0) * 6144], w1 = W[(size_t)(4 * k4 + 1) * 6144], w2 = W[(size_t)(4 * k4 + 2) * 6144], w3 = W[(size_t)(4 * k4 + 3) * 6144];
#pragma unroll
        for (int r = 0; r < 17; ++r) { const f32x4 s = *(const LAS f32x4*)(sv + r * 128 + 4 * k4); acc[r] += (s[0] * w0 + s[1] * w1) + (s[2] * w2 + s[3] * w3); }
    }
#pragma unroll
    for (int r = 0; r < 17; ++r) part[(kc * 17 + r) * 64 + lane] = acc[r];
    __syncthreads();
    if (F.wave == 0) { float* mv = WSP(float, WS_MODV); const float bb = kin(I_MODB)[n0 + lane];
#pragma unroll
        for (int r = 0; r < 17; ++r) { float s = bb;
#pragma unroll
            for (int k = 0; k < 8; ++k) s += part[(k * 17 + r) * 64 + lane];
            mv[r * 6144 + n0 + lane] = s; } }
    __syncthreads();
}
struct XpT { const float* src; unsigned char* dst; int ldw, Kd, which; };
__device__ __forceinline__ XpT xp_params(Frame& F, int ti) {
    XpT p; const int e = ti / 48, q = ti % 48;
    if (q < 32) { const int which = q >> 4, kb = q & 15; p.src = kin(which ? I_EU : I_EG) + (size_t)e * (1024 * 256) + (size_t)(64 * kb) * 256; p.ldw = 256;
        p.dst = WSP(unsigned char, WS_WGU) + (size_t)e * (512 * 1024) + 64 * kb; p.Kd = 1024; p.which = which; }
    else { const int r = q - 32, kb = r & 3, cb = r >> 2; p.src = kin(I_ED) + (size_t)e * (256 * 1024) + (size_t)(64 * kb) * 1024 + 256 * cb; p.ldw = 1024;
        p.dst = WSP(unsigned char, WS_WD) + (size_t)e * (1024 * 256) + (size_t)(256 * cb) * 256 + 64 * kb; p.Kd = 256; p.which = -1; }
    return p;
}
__device__ __forceinline__ void xp_load(const XpT& p, f32x4 (&v)[8], int tid) {
#pragma unroll
    for (int i = 0; i < 8; ++i) { const int g = tid + 512 * i; v[i] = *(const f32x4*)(p.src + (size_t)(g >> 6) * p.ldw + 4 * (g & 63)); }
}
__device__ __forceinline__ void xp_tiles(Frame& F) {
    constexpr int PK = 65, PLANE = 64 * PK + 2, BUF = 4 * PLANE;
    LAS float* L0 = (LAS float*)(F.lds + RING_OFF);
    const int tid = F.tid;
    f32x4 va[8], vb[8], vc[8]; XpT pa, pb, pc;
    volatile LAS int* qw = (volatile LAS int*)(F.MISC + 16);
    if (tid == 0) { qw[0] = (int)__hip_atomic_fetch_add(F.ctl + CW_TILEQ, 1u, RLX_AGENT); qw[1] = (int)__hip_atomic_fetch_add(F.ctl + CW_TILEQ, 1u, RLX_AGENT); qw[2] = (int)__hip_atomic_fetch_add(F.ctl + CW_TILEQ, 1u, RLX_AGENT); }
    LDS_WAIT(); __syncthreads();
    int ti = qw[0], tn = qw[1], t2 = qw[2], par = 0;
    __syncthreads();
    if (ti < XP_TILES) { pa = xp_params(F, ti); xp_load(pa, va, tid); }
    if (tn < XP_TILES) { pb = xp_params(F, tn); xp_load(pb, vb, tid); }
    while (ti < XP_TILES) {
        const bool hn = tn < XP_TILES, h2 = t2 < XP_TILES;
        if (h2) { pc = xp_params(F, t2); xp_load(pc, vc, tid); }
        if (tid == 0) qw[4 + par] = h2 ? (int)__hip_atomic_fetch_add(F.ctl + CW_TILEQ, 1u, RLX_AGENT) : XP_TILES;
        LAS float* buf = L0 + par * BUF;
#pragma unroll
        for (int i = 0; i < 8; ++i) { const int g = tid + 512 * i; LAS float* d = buf + (g >> 6) * PK + (g & 63);
            d[0] = va[i][0]; d[PLANE] = va[i][1]; d[2 * PLANE] = va[i][2]; d[3 * PLANE] = va[i][3]; }
        LDS_WAIT(); __syncthreads();
        const int t3 = qw[4 + par];
#pragma unroll
        for (int i = 0; i < 4; ++i) { const int pr = tid + 512 * i; const int kc = pr & 7, n = pr >> 3;
            const LAS float* s = buf + (n & 3) * PLANE + (8 * kc) * PK + (n >> 2);
            u32x2 o; o.x = pk4_fp8(s[0] * 32.f, s[PK] * 32.f, s[2 * PK] * 32.f, s[3 * PK] * 32.f); o.y = pk4_fp8(s[4 * PK] * 32.f, s[5 * PK] * 32.f, s[6 * PK] * 32.f, s[7 * PK] * 32.f);
            const int row = pa.which < 0 ? n : 256 * (n >> 7) + 128 * pa.which + (n & 127);
            *(u32x2*)(pa.dst + (size_t)row * pa.Kd + 8 * kc) = o; }
        if (hn) { pa = pb; pb = pc;
#pragma unroll
            for (int i = 0; i < 8; ++i) { va[i] = vb[i]; vb[i] = vc[i]; } }
        ti = tn; tn = t2; t2 = t3; par ^= 1;
    }
    LDS_WAIT(); __syncthreads();
}
__device__ __forceinline__ void p0_prologue(Frame& F) {
    LAS float* scr = (LAS float*)(F.lds + RING_OFF + F.wave * 16384);
    const int gw = F.vcu * NWAVES + F.wave, NGW = F.G * NWAVES; const int lane = F.lane;
    __syncthreads();
    for (int ch = F.vcu; ch < 96; ch += F.G) p0_modv_block(F, ch);
    for (int it = gw; it < IT_FILT; it += NGW) { p0_filter_item<2>(F, it, scr); LDS_WAIT(); }
    if (gw == NGW - 1) { f32x2* rope = WSP(f32x2, WS_ROPE);
        for (int idx = lane; idx < 1024; idx += 64) { const int pos = idx >> 4, f = idx & 15; const float inv = powf(10000.0f, -(float)f / 16.0f); const float ang = (float)pos * inv;
            rope[idx] = (f32x2){cosf(ang), sinf(ang)}; } }
    for (int it = gw; it < IT_TILES; it += NGW) {
        int r = it;
        if (r < IT_QKV) { const int cb = r >> 4, kb = r & 15, n0 = 32 * cb; const int pn = n0 >> 8, hl = (n0 & 255) >> 6, dh = (n0 & 63) >> 5;
            tr_item(kin(I_WIN), 2304, 64 * kb, n0, WSP(bf16_t, WS_WQKV), 1024, 256 * pn + 128 * dh + 32 * hl, scr, lane); continue; } r -= IT_QKV;
        if (r < IT_WU) { const int cb = r >> 4, kb = r & 15; tr_item8(kin(I_WIN), 2304, 64 * kb, 768 + 32 * cb, WSP(unsigned char, WS_WU), 1024, 32 * cb, 32.0f, scr, lane); continue; } r -= IT_WU;
        if (r < IT_WO) { const int cb = r >> 4, kb = r & 15; tr_item(kin(I_WOUT), 1024, 64 * kb, 32 * cb, WSP(bf16_t, WS_WO), 1024, 32 * cb, scr, lane); continue; } r -= IT_WO;
        if (r < IT_WR) { const int cb = r >> 4, kb = r & 15; tr_item(kin(I_RW), 256, 64 * kb, 32 * cb, WSP(bf16_t, WS_WR), 1024, 32 * cb, scr, lane); continue; } r -= IT_WR;
        if (r < IT_SGU) { const int which = r >> 7, rr = r & 127, cb = rr >> 4, kb = rr & 15, j0 = 32 * cb;
            tr_item8(kin(which ? I_SU : I_SG), 256, 64 * kb, j0, WSP(unsigned char, WS_WSGU8), 1024, 256 * (j0 >> 7) + 128 * which + (j0 & 127), 32.0f, scr, lane); continue; } r -= IT_SGU;
        if (r < IT_SD) { const int kb = r & 3, cb = r >> 2; tr_item8(kin(I_SD), 1024, 64 * kb, 32 * cb, WSP(unsigned char, WS_WSD), 256, 32 * cb, 32.0f, scr, lane); continue; } r -= IT_SD;
    }
    __syncthreads();
    xp_tiles(F);
}

template <int NR, bool F8> __device__ __forceinline__ void modulate_group(Frame& F, const float* src, bf16_t* dst, unsigned char* dst8, int row, const f32x4 (&A)[4], const f32x4 (&Bv)[4]) {
    const f32x4* xr = (const f32x4*)(src + (size_t)row * DM) + F.lane;
    f32x4 v[NR][4]; float ss[NR];
#pragma unroll
    for (int q = 0; q < NR; ++q)
#pragma unroll
        for (int j = 0; j < 4; ++j) v[q][j] = xr[q * (DM / 4) + 64 * j];
#pragma unroll
    for (int q = 0; q < NR; ++q) { float a = 0.f;
#pragma unroll
        for (int j = 0; j < 4; ++j) a += (v[q][j][0] * v[q][j][0] + v[q][j][1] * v[q][j][1]) + (v[q][j][2] * v[q][j][2] + v[q][j][3] * v[q][j][3]);
        ss[q] = a; }
#pragma unroll
    for (int o = 1; o < 64; o <<= 1) {
#pragma unroll
        for (int q = 0; q < NR; ++q) ss[q] += __shfl_xor(ss[q], o); }
#pragma unroll
    for (int q = 0; q < NR; ++q) { const float rs = rsqrtf(ss[q] * (1.0f / DM) + EPS);
        u32x2* o8 = (u32x2*)(dst + (size_t)(row + q) * DM) + F.lane;
#pragma unroll
        for (int j = 0; j < 4; ++j) { const f32x4 o = v[q][j] * rs * A[j] + Bv[j]; u32x2 w; w.x = pk2(o[0], o[1]); w.y = pk2(o[2], o[3]); o8[64 * j] = w;
            if (F8) ((unsigned*)(dst8 + (size_t)(row + q) * DM))[F.lane + 64 * j] = pk4_fp8c(o[0] * 8.0f, o[1] * 8.0f, o[2] * 8.0f, o[3] * 8.0f); } }
}
template <bool F8 = false> __device__ __forceinline__ void modulate_rows(Frame& F, const float* src, bf16_t* dst, int row0, int nrows, const float* nw, const float* sc, const float* sh, unsigned char* dst8 = nullptr) {
    f32x4 A[4], Bv[4];
#pragma unroll
    for (int j = 0; j < 4; ++j) { const int c = 4 * F.lane + 256 * j; const f32x4 n4 = *(const f32x4*)(nw + c), s4 = *(const f32x4*)(sc + c); A[j] = n4 * (s4 + 1.0f); Bv[j] = *(const f32x4*)(sh + c); }
    int r = 0;
    for (; r + 4 <= nrows; r += 4) modulate_group<4, F8>(F, src, dst, dst8, row0 + r, A, Bv);
    if (r + 2 <= nrows) modulate_group<2, F8>(F, src, dst, dst8, row0 + r, A, Bv);
}

constexpr unsigned HY_SK_PACKED = 0xCB885410u;
__device__ __forceinline__ void hyena_unit(Frame& F, int c) {
    const int tid = F.tid, lane = F.lane, wid = F.wave;
    LAS unsigned char* Lc = F.lds + RING_OFF;
    const bf16_t* UT = WSP(const bf16_t, WS_UT);
    bf16_t* Wg = WSP(bf16_t, WS_HYW) + (size_t)c * MTOK;
    bf16_t* Xg = WSP(bf16_t, WS_HYX) + (size_t)c * MTOK;
    {
        const u32x4* src = (const u32x4*)(WSP(const bf16_t, WS_KR) + (size_t)c * 8192);
#pragma unroll
        for (int i = 0; i < 2; ++i) { const int jc = tid + 512 * i; const u32x4 lo = src[jc]; const u32x4 hi = jc < 1023 ? src[jc + 1] : (u32x4){0u, 0u, 0u, 0u};
            const unsigned w[8] = {lo.x, lo.y, lo.z, lo.w, hi.x, hi.y, hi.z, hi.w};
#pragma unroll
            for (int cc = 0; cc < 8; ++cc) { u32x4 o;
#pragma unroll
                for (int k = 0; k < 4; ++k) { const int idx = (cc >> 1) + k; o[k] = (cc & 1) ? __builtin_amdgcn_alignbyte(w[idx + 1], w[idx], 2u) : w[idx]; }
                *(LAS u32x4*)(Lc + cc * 16384 + 16 * ((HY_SK_PACKED >> (4 * cc)) & 15u) + 16 * jc) = o; } }
    }
    const float* cw = kin(I_CONVW); const float* cb = kin(I_CONVB);
    {
        const bf16_t* vrow = UT + (size_t)(1024 + c) * MTOK; const bf16_t* x1row = UT + (size_t)(512 + c) * MTOK; const bf16_t* x0row = UT + (size_t)c * MTOK;
        const float v0 = cw[1024 + c], v1 = cw[1536 + 1024 + c], v2 = cw[3072 + 1024 + c], vb = cb[1024 + c];
        const float a0 = cw[512 + c], a1 = cw[1536 + 512 + c], a2 = cw[3072 + 512 + c], ab = cb[512 + c];
        const float g0 = cw[c], g1 = cw[1536 + c], g2 = cw[3072 + c], gb = cb[c];
        const int s0 = tid * 8;
#pragma unroll 4
        for (int it = 0; it < 16; ++it) {
            const size_t base = (size_t)it * SEQ + s0;
            const u32x4 vv = *(const u32x4*)(vrow + base), xx = *(const u32x4*)(x1row + base), gg = *(const u32x4*)(x0row + base);
            float ve[10], xe[10], ge[10];
            ve[0] = s0 > 0 ? bf2f(vrow[base - 1]) : 0.f; xe[0] = s0 > 0 ? bf2f(x1row[base - 1]) : 0.f; ge[0] = s0 > 0 ? bf2f(x0row[base - 1]) : 0.f;
            ve[9] = s0 + 8 < SEQ ? bf2f(vrow[base + 8]) : 0.f; xe[9] = s0 + 8 < SEQ ? bf2f(x1row[base + 8]) : 0.f; ge[9] = s0 + 8 < SEQ ? bf2f(x0row[base + 8]) : 0.f;
#pragma unroll
            for (int j = 0; j < 4; ++j) { ve[1 + 2 * j] = bf2f(vv[j] & 0xffffu); ve[2 + 2 * j] = bf2f(vv[j] >> 16); xe[1 + 2 * j] = bf2f(xx[j] & 0xffffu); xe[2 + 2 * j] = bf2f(xx[j] >> 16);
                ge[1 + 2 * j] = bf2f(gg[j] & 0xffffu); ge[2 + 2 * j] = bf2f(gg[j] >> 16); }
            float w[8], g[8];
#pragma unroll
            for (int j = 0; j < 8; ++j) { w[j] = (v0 * ve[j] + v1 * ve[j + 1] + v2 * ve[j + 2] + vb) * (a0 * xe[j] + a1 * xe[j + 1] + a2 * xe[j + 2] + ab); g[j] = g0 * ge[j] + g1 * ge[j + 1] + g2 * ge[j + 2] + gb; }
            u32x4 o; o.x = pk2(w[0], w[1]); o.y = pk2(w[2], w[3]); o.z = pk2(w[4], w[5]); o.w = pk2(w[6], w[7]);
            *(u32x4*)(Wg + (size_t)(tid * 16 + it) * 8) = o;
            u32x4 p; p.x = pk2(g[0], g[1]); p.y = pk2(g[2], g[3]); p.z = pk2(g[4], g[5]); p.w = pk2(g[6], g[7]);
            *(u32x4*)(Xg + base) = p;
        }
    }
    VM_WAIT(); __syncthreads();
    const float hb = kin(I_HBIAS)[c];
    bf16_t* yrow = WSP(bf16_t, WS_YT) + (size_t)c * MTOK;
    const int li = lane & 15, lg = lane >> 4;
#pragma unroll 1
    for (int pass = 0; pass < 2; ++pass) {
        const int T0 = (pass * 8 + wid) * 256;
        f32x4 acc[16]; bf16x8 AF[16], Bf[8];
#pragma unroll
        for (int q = 0; q < 16; ++q) acc[q] = (f32x4){0.f, 0.f, 0.f, 0.f};
        const int xbase = 4096 - T0 - li + 8 * lg; const int cl = xbase & 7;
        const LAS unsigned char* pA = Lc + cl * 16384 + 16 * (int)((HY_SK_PACKED >> (4 * cl)) & 15u) + 2 * (xbase - cl);
        const bf16x8* Bg = (const bf16x8*)Wg + lg * 16 + li;
#define HY_LOADA(dst, q) dst = *(const LAS bf16x8*)(pA - 32 * (q))
#pragma unroll
        for (int q = 0; q < 16; ++q) HY_LOADA(AF[q], q);
#pragma unroll
        for (int v = 0; v < 8; ++v) Bf[v] = Bg[64 * v];
#pragma unroll 1
        for (int S8 = 0; S8 < 128; S8 += 8) {
#pragma unroll
            for (int v = 0; v < 8; ++v) { const int S = S8 + v;
#pragma unroll
                for (int tau = 15; tau >= 0; --tau) acc[tau] = __builtin_amdgcn_mfma_f32_16x16x32_bf16(AF[(tau - 2 * v) & 15], Bf[v], acc[tau], 0, 0, 0);
                if (S + 8 < 128) Bf[v] = Bg[64 * (S + 8)];
                if (S + 1 < 128) { HY_LOADA(AF[(-2 * (v + 1)) & 15], -2 * (S + 1)); HY_LOADA(AF[(-2 * (v + 1) + 1) & 15], -2 * (S + 1) + 1); }
            }
        }
#undef HY_LOADA
        u32x2 wv[16], xv[16];
#pragma unroll
        for (int tau = 0; tau < 16; ++tau) { const int t = T0 + 16 * tau + 4 * lg;
            wv[tau] = *(const u32x2*)(Wg + (size_t)((t >> 3) * 16 + li) * 8 + (t & 7)); xv[tau] = *(const u32x2*)(Xg + (size_t)li * SEQ + t); }
#pragma unroll
        for (int tau = 0; tau < 16; ++tau) { const int t = T0 + 16 * tau + 4 * lg;
            const float we[4] = {bf2f(wv[tau].x & 0xffffu), bf2f(wv[tau].x >> 16), bf2f(wv[tau].y & 0xffffu), bf2f(wv[tau].y >> 16)};
            const float xe[4] = {bf2f(xv[tau].x & 0xffffu), bf2f(xv[tau].x >> 16), bf2f(xv[tau].y & 0xffffu), bf2f(xv[tau].y >> 16)};
            float z[4];
#pragma unroll
            for (int j = 0; j < 4; ++j) z[j] = (acc[tau][j] + hb * we[j]) * xe[j];
            u32x2 o; o.x = pk2(z[0], z[1]); o.y = pk2(z[2], z[3]); *(u32x2*)(yrow + (size_t)li * SEQ + t) = o; }
    }
    __syncthreads();
}

constexpr unsigned long long HY8_SK = 0xea6eda965212d950ull; constexpr int HY8_STR = 8448;
__device__ __forceinline__ void hyena_unit8(Frame& F, int c) {
    int tid_ = F.tid; asm volatile("" : "+v"(tid_));
    const int tid = tid_, lane = tid & 63, wid = F.wave;
    LAS unsigned char* Lc = F.lds + RING_OFF;
    const bf16_t* UT = WSP(const bf16_t, WS_UT);
    unsigned char* W8 = WSP(unsigned char, WS_HYW) + (size_t)c * MTOK;
    bf16_t* Xg = WSP(bf16_t, WS_HYX) + (size_t)c * MTOK;
    {
        const u32x4* src = (const u32x4*)(WSP(const unsigned char, WS_KR) + (size_t)c * 8192);
        const u32x4 lo = src[tid]; const u32x4 hi = tid < 511 ? src[tid + 1] : (u32x4){0u, 0u, 0u, 0u};
        const unsigned w[8] = {lo.x, lo.y, lo.z, lo.w, hi.x, hi.y, hi.z, hi.w};
#pragma unroll
        for (int sh = 0; sh < 16; ++sh) { u32x4 o;
#pragma unroll
            for (int k = 0; k < 4; ++k) { const int idx = (sh >> 2) + k; o[k] = (sh & 3) ? __builtin_amdgcn_alignbyte(w[idx + 1], w[idx], (unsigned)(sh & 3)) : w[idx]; }
            *(LAS u32x4*)(Lc + sh * HY8_STR + 16 * (int)((HY8_SK >> (4 * sh)) & 15ull) + 16 * tid) = o; }
    }
    const float* cw = kin(I_CONVW); const float* cb = kin(I_CONVB);
    {
        const bf16_t* vrow = UT + (size_t)(1024 + c) * MTOK; const bf16_t* x1row = UT + (size_t)(512 + c) * MTOK; const bf16_t* x0row = UT + (size_t)c * MTOK;
        const float v0 = cw[1024 + c], v1 = cw[1536 + 1024 + c], v2 = cw[3072 + 1024 + c], vb = cb[1024 + c];
        const float a0 = cw[512 + c], a1 = cw[1536 + 512 + c], a2 = cw[3072 + 512 + c], ab = cb[512 + c];
        const float g0 = cw[c], g1 = cw[1536 + c], g2 = cw[3072 + c], gb = cb[c];
        const int s0 = tid * 8;
#pragma unroll 4
        for (int it = 0; it < 16; ++it) {
            const size_t base = (size_t)it * SEQ + s0;
            const u32x4 vv = *(const u32x4*)(vrow + base), xx = *(const u32x4*)(x1row + base), gg = *(const u32x4*)(x0row + base);
            float ve[10], xe[10], ge[10];
            ve[0] = s0 > 0 ? bf2f(vrow[base - 1]) : 0.f; xe[0] = s0 > 0 ? bf2f(x1row[base - 1]) : 0.f; ge[0] = s0 > 0 ? bf2f(x0row[base - 1]) : 0.f;
            ve[9] = s0 + 8 < SEQ ? bf2f(vrow[base + 8]) : 0.f; xe[9] = s0 + 8 < SEQ ? bf2f(x1row[base + 8]) : 0.f; ge[9] = s0 + 8 < SEQ ? bf2f(x0row[base + 8]) : 0.f;
#pragma unroll
            for (int j = 0; j < 4; ++j) { ve[1 + 2 * j] = bf2f(vv[j] & 0xffffu); ve[2 + 2 * j] = bf2f(vv[j] >> 16); xe[1 + 2 * j] = bf2f(xx[j] & 0xffffu); xe[2 + 2 * j] = bf2f(xx[j] >> 16);
                ge[1 + 2 * j] = bf2f(gg[j] & 0xffffu); ge[2 + 2 * j] = bf2f(gg[j] >> 16); }
            float w[8], g[8];
#pragma unroll
            for (int j = 0; j < 8; ++j) { w[j] = 8.0f * (v0 * ve[j] + v1 * ve[j + 1] + v2 * ve[j + 2] + vb) * (a0 * xe[j] + a1 * xe[j + 1] + a2 * xe[j + 2] + ab); g[j] = g0 * ge[j] + g1 * ge[j + 1] + g2 * ge[j + 2] + gb; }
            u32x2 o; o.x = pk4_fp8c(w[0], w[1], w[2], w[3]); o.y = pk4_fp8c(w[4], w[5], w[6], w[7]);
            *(u32x2*)(W8 + (size_t)((tid >> 2) * 16 + it) * 32 + (tid & 3) * 8) = o;
            u32x4 p; p.x = pk2(g[0], g[1]); p.y = pk2(g[2], g[3]); p.z = pk2(g[4], g[5]); p.w = pk2(g[6], g[7]);
            *(u32x4*)(Xg + base) = p;
        }
    }
    VM_WAIT(); __syncthreads();
    const float hb = kin(I_HBIAS)[c];
    bf16_t* yrow = WSP(bf16_t, WS_YT) + (size_t)c * MTOK;
    const int li = lane & 15, lg = lane >> 4;
#pragma unroll 1
    for (int pass = 0; pass < 2; ++pass) {
        const int T0 = (pass * 8 + wid) * 256;
        f32x4 acc[16]; pg8::v8i AF[16], Bf[2];
#pragma unroll
        for (int q = 0; q < 16; ++q) { acc[q] = (f32x4){0.f, 0.f, 0.f, 0.f}; asm volatile("" : "+v"(acc[q])); }
        const int x00 = 4096 - T0 - li + 32 * lg; const int cl = x00 & 15;
        const LAS unsigned char* pA = Lc + cl * HY8_STR + 16 * (int)((HY8_SK >> (4 * cl)) & 15ull) + (x00 - cl);
        const u32x4* Bg = (const u32x4*)W8 + (lg * 16 + li) * 2;
#define HY8_LOADA(dst, q) do { const LAS unsigned char* p_ = pA - 16 * (q); dst = pg8::cat8(*(const LAS bf16x8*)p_, *(const LAS bf16x8*)(p_ + 16)); } while (0)
#define HY8_LOADB(dst, S_) do { const u32x4 b0_ = Bg[128 * (S_)], b1_ = Bg[128 * (S_) + 1]; dst = pg8::cat8(__builtin_bit_cast(bf16x8, b0_), __builtin_bit_cast(bf16x8, b1_)); } while (0)
#pragma unroll
        for (int q = 0; q < 16; ++q) HY8_LOADA(AF[q], q);
#pragma unroll
        for (int v = 0; v < 2; ++v) HY8_LOADB(Bf[v], v);
#pragma unroll 1
        for (int S4 = 0; S4 < 32; S4 += 2) {
#pragma unroll
            for (int v = 0; v < 2; ++v) { const int S = S4 + v; const int p = v & 1;
                asm volatile("s_waitcnt lgkmcnt(0)\n\ts_nop 4" ::: "memory");
#pragma unroll
                for (int tau = 15; tau >= 0; --tau) pg8::mfma_fp8(acc[tau], AF[(tau - 8 * p) & 15], Bf[v]);
                if (S + 2 < 32) HY8_LOADB(Bf[v], S + 2);
                if (S + 1 < 32) {
#pragma unroll
                    for (int i = 0; i < 8; ++i) HY8_LOADA(AF[(i + 8 * (1 - p)) & 15], i - 8 * (S + 1)); }
            }
            asm volatile("s_nop 15\n\ts_nop 7" : "+v"(acc[0]), "+v"(acc[1]), "+v"(acc[2]), "+v"(acc[3]), "+v"(acc[4]), "+v"(acc[5]), "+v"(acc[6]), "+v"(acc[7]),
                         "+v"(acc[8]), "+v"(acc[9]), "+v"(acc[10]), "+v"(acc[11]), "+v"(acc[12]), "+v"(acc[13]), "+v"(acc[14]), "+v"(acc[15]));
        }
#undef HY8_LOADA
#undef HY8_LOADB
        asm volatile("s_nop 15\n\ts_nop 15" : "+v"(acc[0]), "+v"(acc[1]), "+v"(acc[2]), "+v"(acc[3]), "+v"(acc[4]), "+v"(acc[5]), "+v"(acc[6]), "+v"(acc[7]),
                     "+v"(acc[8]), "+v"(acc[9]), "+v"(acc[10]), "+v"(acc[11]), "+v"(acc[12]), "+v"(acc[13]), "+v"(acc[14]), "+v"(acc[15]) :: "memory");
        unsigned wv[16]; u32x2 xv[16];
#pragma unroll
        for (int tau = 0; tau < 16; ++tau) { const int t = T0 + 16 * tau + 4 * lg;
            wv[tau] = *(const unsigned*)(W8 + (size_t)((t >> 5) * 16 + li) * 32 + (t & 31)); xv[tau] = *(const u32x2*)(Xg + (size_t)li * SEQ + t); }
#pragma unroll
        for (int tau = 0; tau < 16; ++tau) { const int t = T0 + 16 * tau + 4 * lg;
            const f32x2 wlo = __builtin_amdgcn_cvt_pk_f32_fp8((int)wv[tau], false), whi = __builtin_amdgcn_cvt_pk_f32_fp8((int)wv[tau], true);
            const float we[4] = {wlo[0] * 0.125f, wlo[1] * 0.125f, whi[0] * 0.125f, whi[1] * 0.125f};
            const float xe[4] = {bf2f(xv[tau].x & 0xffffu), bf2f(xv[tau].x >> 16), bf2f(xv[tau].y & 0xffffu), bf2f(xv[tau].y >> 16)};
            float z[4];
#pragma unroll
            for (int j = 0; j < 4; ++j) z[j] = (acc[tau][j] * (1.0f / 512.0f) + hb * we[j]) * xe[j];
            u32x2 o; o.x = pk2(z[0], z[1]); o.y = pk2(z[2], z[3]); *(u32x2*)(yrow + (size_t)li * SEQ + t) = o; }
    }
    __syncthreads();
}

__device__ __forceinline__ void p4_norm_tile(Frame& F, int it) {
    const int lane = F.lane, wid = F.wave, tid = F.tid; const int m0 = it * 64;
    bf16_t* AY = WSP(bf16_t, WS_AY); const bf16_t* A = WSP(const bf16_t, WS_AO); const bf16_t* YT = WSP(const bf16_t, WS_YT);
    constexpr int TP = 520;
    LAS bf16_t* T2 = (LAS bf16_t*)(F.lds + RING_OFF);
    {
        const u32x4* src = (const u32x4*)(YT + (size_t)tid * MTOK + m0);
#pragma unroll
        for (int i = 0; i < 8; ++i) { const u32x4 v = src[i];
#pragma unroll
            for (int j = 0; j < 4; ++j) { T2[(8 * i + 2 * j) * TP + tid] = (bf16_t)(v[j] & 0xffffu); T2[(8 * i + 2 * j + 1) * TP + tid] = (bf16_t)(v[j] >> 16); } }
    }
#define P4_ROWS8(LOADV, GAIN, DSTCOL) do { const float* gw_ = (GAIN) + 8 * lane; const f32x4 g0 = *(const f32x4*)gw_, g1 = *(const f32x4*)(gw_ + 4); \
        u32x4 v_[8]; float ss_[8]; \
        _Pragma("unroll") for (int r = 0; r < 8; ++r) v_[r] = LOADV(r); \
        _Pragma("unroll") for (int r = 0; r < 8; ++r) { float a_ = 0.f; _Pragma("unroll") for (int j = 0; j < 4; ++j) { const float lo_ = bf2f(v_[r][j] & 0xffffu), hi_ = bf2f(v_[r][j] >> 16); a_ += lo_ * lo_ + hi_ * hi_; } ss_[r] = a_; } \
        _Pragma("unroll") for (int o = 1; o < 64; o <<= 1) { _Pragma("unroll") for (int r = 0; r < 8; ++r) ss_[r] += __shfl_xor(ss_[r], o); } \
        _Pragma("unroll") for (int r = 0; r < 8; ++r) { const float rs = rsqrtf(ss_[r] * (1.0f / 512.0f) + EPS); float e[8]; \
            _Pragma("unroll") for (int j = 0; j < 4; ++j) { e[2 * j] = bf2f(v_[r][j] & 0xffffu); e[2 * j + 1] = bf2f(v_[r][j] >> 16); } \
            u32x4 o; o.x = pk2(e[0] * rs * g0[0], e[1] * rs * g0[1]); o.y = pk2(e[2] * rs * g0[2], e[3] * rs * g0[3]); o.z = pk2(e[4] * rs * g1[0], e[5] * rs * g1[1]); o.w = pk2(e[6] * rs * g1[2], e[7] * rs * g1[3]); \
            *(u32x4*)(AY + (size_t)(m0 + wid * 8 + r) * DM + (DSTCOL) + 8 * lane) = o; } } while (0)
#define P4_LOAD_A(r) (*(const u32x4*)(A + (size_t)(m0 + wid * 8 + (r)) * AW + 8 * lane))
#define P4_LOAD_T(r) (*(const LAS u32x4*)(T2 + (wid * 8 + (r)) * TP + 8 * lane))
    P4_ROWS8(P4_LOAD_A, kin(I_AONW), 0);
    __syncthreads();
    P4_ROWS8(P4_LOAD_T, kin(I_HONW), 512);
#undef P4_ROWS8
#undef P4_LOAD_A
#undef P4_LOAD_T
    __syncthreads();
}


#define DPPF(x, ctrl) __builtin_bit_cast(float, __builtin_amdgcn_mov_dpp(__builtin_bit_cast(int, (x)), (ctrl), 0xf, 0xf, true))
#define DPPI(x, ctrl) __builtin_amdgcn_mov_dpp((x), (ctrl), 0xf, 0xf, true)
struct RouteSel { int ea, eb; unsigned wa, wb, la, lb; };
__device__ __forceinline__ void p8_route16(Frame& F, int t0, RouteSel& R, LAS unsigned* lcnt) {
    const int lane = F.lane; const int j = lane & 3; const int t = t0 + (lane >> 2);
    const f32x4* lg = (const f32x4*)(WSP(const float, WS_LOGIT) + (size_t)t * NE + 64 * j);
    const f32x4* rbp = (const f32x4*)(kin(I_RB) + 64 * j);
    float b[64];
#pragma unroll
    for (int i = 0; i < 16; ++i) { const f32x4 v = lg[i], rb = rbp[i];
#pragma unroll
        for (int c = 0; c < 4; ++c) b[4 * i + c] = __builtin_amdgcn_rcpf(1.0f + __builtin_amdgcn_exp2f(-1.4426950408889634f * v[c])) + rb[c]; }
    float gsc[2];
#pragma unroll
    for (int g = 0; g < 2; ++g) { float a1 = fmaxf(b[32 * g], b[32 * g + 1]), a2 = fminf(b[32 * g], b[32 * g + 1]);
#pragma unroll
        for (int i = 2; i < 32; ++i) { const float x = b[32 * g + i]; a2 = fmaxf(a2, fminf(a1, x)); a1 = fmaxf(a1, x); }
        gsc[g] = a1 + a2; }
    float G[8];
    G[0] = DPPF(gsc[0], 0x00); G[1] = DPPF(gsc[1], 0x00); G[2] = DPPF(gsc[0], 0x55); G[3] = DPPF(gsc[1], 0x55);
    G[4] = DPPF(gsc[0], 0xAA); G[5] = DPPF(gsc[1], 0xAA); G[6] = DPPF(gsc[0], 0xFF); G[7] = DPPF(gsc[1], 0xFF);
#pragma unroll
    for (int g = 0; g < 2; ++g) { const int gid = 2 * j + g; int rank = 0;
#pragma unroll
        for (int h = 0; h < 8; ++h) rank += (G[h] > gsc[g] || (G[h] == gsc[g] && h < gid)) ? 1 : 0;
        if (rank >= 4) {
#pragma unroll
            for (int i = 0; i < 32; ++i) b[32 * g + i] = -INFINITY; } }
    unsigned key[64];
#pragma unroll
    for (int i = 0; i < 64; ++i) key[i] = b[i] == -INFINITY ? 0u : ((__builtin_bit_cast(unsigned, b[i] + 2.0f) & ~63u) | (unsigned)(63 - i));
    float lv[8]; int li[8];
#pragma unroll
    for (int r = 0; r < 8; ++r) { unsigned mx = key[0];
#pragma unroll
        for (int i = 1; i < 64; i += 2) { const unsigned a_ = key[i], b_ = i + 1 < 64 ? key[i + 1] : 0u; const unsigned m_ = a_ > b_ ? a_ : b_; mx = mx > m_ ? mx : m_; }
        lv[r] = mx ? __builtin_bit_cast(float, mx & ~63u) - 2.0f : -INFINITY; li[r] = mx ? 64 * j + 63 - (int)(mx & 63u) : 0x7ffffff0 + j;
#pragma unroll
        for (int i = 0; i < 64; ++i) key[i] = key[i] == mx ? 0u : key[i]; }
    int se[8]; float sv[8];
#pragma unroll
    for (int r = 0; r < 8; ++r) { float hv = lv[0]; int hi = li[0];
        { const float ov = DPPF(hv, 0xB1); const int oi = DPPI(hi, 0xB1); if (ov > hv || (ov == hv && oi < hi)) { hv = ov; hi = oi; } }
        { const float ov = DPPF(hv, 0x4E); const int oi = DPPI(hi, 0x4E); if (ov > hv || (ov == hv && oi < hi)) { hv = ov; hi = oi; } }
        se[r] = hi; sv[r] = hv;
        if (hi == li[0]) {
#pragma unroll
            for (int k = 0; k < 7; ++k) { lv[k] = lv[k + 1]; li[k] = li[k + 1]; }
            lv[7] = -INFINITY; li[7] = 0x7fffffff; } }
    const float* rbias = kin(I_RB); float wsum = 0.f;
#pragma unroll
    for (int r = 0; r < 8; ++r) { sv[r] -= rbias[se[r]]; wsum += sv[r]; }
    const float inv = 2.5f / wsum;
    const int ea = j == 0 ? se[0] : j == 1 ? se[2] : j == 2 ? se[4] : se[6], eb = j == 0 ? se[1] : j == 1 ? se[3] : j == 2 ? se[5] : se[7];
    const float wa = (j == 0 ? sv[0] : j == 1 ? sv[2] : j == 2 ? sv[4] : sv[6]) * inv, wb = (j == 0 ? sv[1] : j == 1 ? sv[3] : j == 2 ? sv[5] : sv[7]) * inv;
    R.ea = ea; R.eb = eb; R.wa = f2bf(wa); R.wb = f2bf(wb);
    R.la = __hip_atomic_fetch_add(lcnt + ea, 1u, __ATOMIC_RELAXED, __HIP_MEMORY_SCOPE_WORKGROUP); R.lb = __hip_atomic_fetch_add(lcnt + eb, 1u, __ATOMIC_RELAXED, __HIP_MEMORY_SCOPE_WORKGROUP);
}
__device__ __forceinline__ void route_commit(Frame& F, int t0, const RouteSel& R, const LAS unsigned* lbase) {
    const int lane = F.lane; const int j = lane & 3; const int t = t0 + (lane >> 2);
    unsigned* list = WSP(unsigned, WS_LIST); unsigned* asg = WSP(unsigned, WS_ASSIGN) + (size_t)t * 8 + 2 * j;
    const unsigned ra = lbase[R.ea] + R.la, rb2 = lbase[R.eb] + R.lb;
    list[(size_t)R.ea * 65536 + ra] = ((unsigned)t << 16) | R.wa; list[(size_t)R.eb * 65536 + rb2] = ((unsigned)t << 16) | R.wb;
    asg[0] = ((unsigned)R.ea << 16) | ra; asg[1] = ((unsigned)R.eb << 16) | rb2;
    if (j == 0) list[(size_t)256 * 65536 + t] = ((unsigned)t << 16) | 0x3F80u;
}
#undef DPPF
#undef DPPI

__device__ __forceinline__ MoeTab moe_tables(Frame& F) {
    LAS int* tp = (LAS int*)(F.lds + AUX_OFF + AUX_TP); LAS int* cnt = (LAS int*)(F.lds + AUX_OFF + AUX_CNT); LAS unsigned short* t2e = (LAS unsigned short*)(F.lds + AUX_OFF + AUX_T2E);
    __syncthreads();
    if (F.tid < 257) cnt[F.tid] = F.tid < 256 ? (int)__hip_atomic_load(F.ctl + CW_CNT + 32 * F.tid, RLX_AGENT) : MTOK;
    __syncthreads();
    if (F.tid < 258) { int run = 0; for (int j = 0; j < F.tid && j < 257; ++j) run += (cnt[j] + 255) >> 8; tp[F.tid] = run; }
    __syncthreads();
    if (F.tid < 257) { const int t0 = tp[F.tid], t1 = tp[F.tid + 1]; for (int T = t0; T < t1; ++T) t2e[T] = (unsigned short)F.tid; }
    __syncthreads();
    MoeTab t; t.tp = tp; t.cnt = cnt; t.t2e = t2e; return t;
}

__device__ __forceinline__ void down_phase(Frame& F, const MoeTab& tab) {
    using namespace pg8;
    int tid_ = F.wave * 64 + lane_id(); asm volatile("" : "+v"(tid_));
    const int tid = tid_, wid = F.wave, lane = tid & 63, wq = wid, fr = lane & 15, fq = lane >> 4;
    LAS unsigned char* lds = F.lds + RING_OFF;
    const unsigned char* ACT = WSP(const unsigned char, WS_ACT); const unsigned char* WD = WSP(const unsigned char, WS_WD); const unsigned char* WSD = WSP(const unsigned char, WS_WSD);
    unsigned char* SLOT = WSP(unsigned char, WS_SLOT);
    unsigned voA[2], voB[2];
#pragma unroll
    for (int i = 0; i < 2; ++i) { int R, C; stage_rc(tid * 16 + i * 8192, R, C); const int rho = R & 63, ii = rho & 15, nn = rho >> 4; const int Rb = (R & ~63) + 16 * (ii >> 2) + 4 * nn + (ii & 3);
        voA[i] = (unsigned)(R * 256 + C * 2); voB[i] = (unsigned)(Rb * 256 + C * 2); }
    const unsigned ldsw = (unsigned)wid * 1024u;
#define DN_STAGE(buf, gptr, vo) do { _Pragma("unroll") for (int _i = 0; _i < 2; ++_i) \
        __builtin_amdgcn_global_load_lds((const unsigned*)((gptr) + (vo)[_i]), (LAS unsigned*)(lds + (buf) * HTB + ldsw + _i * 8192), 16, 0, 0); } while (0)
    const int arow = (wq & 3) * 32 + fr;
    const int aoff = lds_byte(arow, fq * 8), boff = lds_byte(fr, fq * 8);
    const int TT = __builtin_amdgcn_readfirstlane(tab.tp[257]);
#define DN_STAGE_A(Ag_) do { _Pragma("unroll") for (int ai = 0; ai < 2; ++ai) _Pragma("unroll") for (int kt = 0; kt < 2; ++kt) DN_STAGE(ai * 2 + kt, (Ag_) + (size_t)ai * (128 * 256) + kt * 128, voA); } while (0)
#define DN_STAGE_B(slot, Bg_, c_) do { _Pragma("unroll") for (int kt = 0; kt < 2; ++kt) DN_STAGE(4 + 2 * (slot) + kt, (Bg_) + (size_t)(c_) * (128 * 256) + kt * 128, voB); } while (0)
    int T = F.vcu;
    const unsigned char* Bg = WD;
    if (T < TT) { const int e0 = __builtin_amdgcn_readfirstlane((int)tab.t2e[T]); Bg = e0 < 256 ? WD + (size_t)e0 * (1024 * 256) : WSD;
        DN_STAGE_A(ACT + (size_t)T * (256 * 256)); DN_STAGE_B(0, Bg, 0); }
    for (; T < TT; T += F.G) {
        const int Tn = T + F.G; const bool hn = Tn < TT;
        const unsigned char* Bn = WD;
        if (hn) { const int en = __builtin_amdgcn_readfirstlane((int)tab.t2e[Tn]); Bn = en < 256 ? WD + (size_t)en * (1024 * 256) : WSD; }
        asm volatile("s_waitcnt vmcnt(0)" ::: "memory"); __builtin_amdgcn_s_barrier(); asm volatile("" ::: "memory");
        v8i Af[2][2];
#pragma unroll
        for (int m = 0; m < 2; ++m)
#pragma unroll
            for (int kt = 0; kt < 2; ++kt) { const LAS unsigned char* p = lds + ((wq >> 2) * 2 + kt) * HTB + aoff + m * 2048;
                Af[m][kt] = cat8(*(const LAS bf16x8*)p, *(const LAS bf16x8*)(p + 1024)); }
        asm volatile("s_waitcnt lgkmcnt(0)" ::: "memory");
#pragma unroll 1
        for (int c = 0; c < 8; ++c) {
            const int sb = c & 1;
            if (c > 0) { if (c == 3 && hn) asm volatile("s_waitcnt vmcnt(12)" ::: "memory"); else asm volatile("s_waitcnt vmcnt(4)" ::: "memory"); }
            __builtin_amdgcn_s_barrier(); asm volatile("" ::: "memory");
            if (c < 7) DN_STAGE_B(sb ^ 1, Bg, c + 1); else if (hn) DN_STAGE_B(0, Bn, 0);
            if (c == 2 && hn) DN_STAGE_A(ACT + (size_t)Tn * (256 * 256));
            f32x4 acc[2][8];
#pragma unroll
            for (int m = 0; m < 2; ++m)
#pragma unroll
                for (int n = 0; n < 8; ++n) { acc[m][n] = (f32x4){0.f, 0.f, 0.f, 0.f}; asm volatile("" : "+v"(acc[m][n])); }
#pragma unroll
            for (int g = 0; g < 2; ++g) {
                v8i Bf[4][2];
#pragma unroll
                for (int n = 0; n < 4; ++n)
#pragma unroll
                    for (int kt = 0; kt < 2; ++kt) { const LAS unsigned char* p = lds + (4 + 2 * sb + kt) * HTB + boff + (4 * g + n) * 2048;
                        Bf[n][kt] = cat8(*(const LAS bf16x8*)p, *(const LAS bf16x8*)(p + 1024)); }
                asm volatile("s_waitcnt lgkmcnt(0)\n\ts_nop 4" ::: "memory");
#pragma unroll
                for (int kt = 0; kt < 2; ++kt)
#pragma unroll
                    for (int m = 0; m < 2; ++m)
#pragma unroll
                        for (int n = 0; n < 4; ++n) mfma_fp8(acc[m][4 * g + n], Bf[n][kt], Af[m][kt]);
            }
            asm volatile("s_nop 15\n\ts_nop 15" : "+v"(acc[0][0]), "+v"(acc[0][1]), "+v"(acc[0][2]), "+v"(acc[0][3]), "+v"(acc[0][4]), "+v"(acc[0][5]), "+v"(acc[0][6]), "+v"(acc[0][7]),
                         "+v"(acc[1][0]), "+v"(acc[1][1]), "+v"(acc[1][2]), "+v"(acc[1][3]), "+v"(acc[1][4]), "+v"(acc[1][5]), "+v"(acc[1][6]), "+v"(acc[1][7]) :: "memory");
            unsigned char* orow = SLOT + (size_t)(T * 256 + (wq >> 2) * 128 + (wq & 3) * 32 + fr) * DM + c * 128 + 16 * fq;
#pragma unroll
            for (int m = 0; m < 2; ++m)
#pragma unroll
                for (int g = 0; g < 2; ++g) { u32x4 pk;
#pragma unroll
                    for (int n = 0; n < 4; ++n) { const f32x4 a = acc[m][4 * g + n] * 0.125f; pk[n] = pk4_fp8c(a[0], a[1], a[2], a[3]); }
                    *(u32x4*)(orow + (size_t)(16 * m) * DM + 64 * g) = pk; }
        }
        Bg = Bn;
    }
    asm volatile("s_waitcnt vmcnt(0) lgkmcnt(0)" ::: "memory"); __builtin_amdgcn_s_barrier(); asm volatile("" ::: "memory");
#undef DN_STAGE_A
#undef DN_STAGE_B
#undef DN_STAGE
}

__device__ __forceinline__ void combine_token(Frame& F, const MoeTab& tab, int t0) {
    const int lane = F.lane; const int b = t0 >> 12;
    const unsigned* asg = WSP(const unsigned, WS_ASSIGN) + (size_t)t0 * 8; const unsigned char* SLOT = WSP(const unsigned char, WS_SLOT);
    const size_t Rs = (size_t)tab.tp[256] * 256;
    u32x4 sv[2][9];
#pragma unroll
    for (int q = 0; q < 2; ++q) {
#pragma unroll
        for (int k = 0; k < 8; ++k) { const unsigned av = asg[q * 8 + k]; const int e = av >> 16, rk = av & 0xffffu; const size_t R = (size_t)tab.tp[e] * 256 + rk;
            sv[q][k] = *(const u32x4*)(SLOT + R * DM + 16 * lane); }
        sv[q][8] = *(const u32x4*)(SLOT + (Rs + t0 + q) * DM + 16 * lane); }
    const float* g2 = WSP(const float, WS_MODV) + (size_t)b * 6144 + 5 * 1024 + 16 * lane; const float* fw = kin(I_FNW) + 16 * lane;
    f32x4 x[2][4]; float ss[2];
#pragma unroll
    for (int q = 0; q < 2; ++q) { const float* xr = F.out + (size_t)(t0 + q) * DM + 16 * lane;
#pragma unroll
        for (int j = 0; j < 4; ++j) x[q][j] = *(const f32x4*)(xr + 4 * j); }
#pragma unroll
    for (int q = 0; q < 2; ++q) { float a[16];
#pragma unroll
        for (int j = 0; j < 16; ++j) a[j] = 0.f;
#pragma unroll
        for (int k = 0; k < 9; ++k)
#pragma unroll
            for (int j = 0; j < 4; ++j) { const f32x2 lo = __builtin_amdgcn_cvt_pk_f32_fp8((int)sv[q][k][j], false), hi = __builtin_amdgcn_cvt_pk_f32_fp8((int)sv[q][k][j], true);
                a[4 * j] += lo[0]; a[4 * j + 1] += lo[1]; a[4 * j + 2] += hi[0]; a[4 * j + 3] += hi[1]; }
        ss[q] = 0.f;
#pragma unroll
        for (int j = 0; j < 4; ++j) { const f32x4 g = *(const f32x4*)(g2 + 4 * j) * (1.0f / 16.0f);
            x[q][j] = x[q][j] + g * (f32x4){a[4 * j], a[4 * j + 1], a[4 * j + 2], a[4 * j + 3]};
            ss[q] += (x[q][j][0] * x[q][j][0] + x[q][j][1] * x[q][j][1]) + (x[q][j][2] * x[q][j][2] + x[q][j][3] * x[q][j][3]); } }
#pragma unroll
    for (int o = 1; o < 64; o <<= 1) { ss[0] += __shfl_xor(ss[0], o); ss[1] += __shfl_xor(ss[1], o); }
#pragma unroll
    for (int q = 0; q < 2; ++q) { const float rs = rsqrtf(ss[q] * (1.0f / DM) + EPS); float* orow = F.out + (size_t)(t0 + q) * DM + 16 * lane;
#pragma unroll
        for (int j = 0; j < 4; ++j) *(f32x4*)(orow + 4 * j) = x[q][j] * rs * *(const f32x4*)(fw + 4 * j); }
}

constexpr int N_LAUNCHES = MK_N_LAUNCHES;
static_assert(N_LAUNCHES == 1 || N_LAUNCHES == NPHASE, "MK_N_LAUNCHES must be 1 or 14");
struct Args { const float* in[N_IN]; float* out; unsigned char* ws; int ph_lo, ph_hi; };
__global__ void __launch_bounds__(NWAVES * 64, 2) fwd_kernel(Args args) {
    extern __shared__ __attribute__((aligned(16))) unsigned char lds[];
    Frame F;
    F.lds = (LAS unsigned char*)lds;
    F.MISC = (volatile LAS unsigned*)(F.lds + MISC_OFF);
    F.tid = threadIdx.x; F.lane = F.tid & 63; F.wave = __builtin_amdgcn_readfirstlane(F.tid >> 6);
    F.G = gridDim.x; { const int bx = blockIdx.x; F.vcu = (F.G % 8 == 0) ? (bx % 8) * (F.G / 8) + bx / 8 : bx; }
    F.out = args.out; F.ws = args.ws; F.ctl = (unsigned*)(args.ws + WS_CTL);
    if (F.tid < 128) ((LAS unsigned*)(F.lds + MISC_OFF))[F.tid] = 0u;
    __syncthreads();
    XcdBarrier bar; bar.wv = (unsigned)F.wave; bar.bar = F.ctl + CW_BAR; bar.x = 0; bar.st = nullptr;
    if (N_LAUNCHES == 1) bar = xcd_barrier_post(F.ctl + CW_BAR, F.MISC + 8);
#define GRID_BAR() do { if (N_LAUNCHES == 1) xcd_barrier(bar); } while (0)
    const int lo = args.ph_lo, hi = args.ph_hi;
#ifndef PHASE_MASK
#define PHASE_MASK 0x3fff
#endif
#define IN(k) ((((PHASE_MASK) >> (k)) & 1) && lo <= (k) && (k) < hi)
#ifndef PHASE_DUP
#define PHASE_DUP 0
#endif
#define REPS(k) ((((PHASE_DUP) >> (k)) & 1) ? 2 : 1)
#ifndef PROBE_K
#define PROBE_K (-1)
#endif
#ifndef PROBE_AMP
#define PROBE_AMP 8
#endif
    unsigned long long tA_ = 0, tB_ = 0;
#define STAMP(j) do { if (PROBE_K >= 0 && (j) == PROBE_K) tA_ = __builtin_amdgcn_s_memrealtime(); if (PROBE_K >= 0 && (j) == PROBE_K + 1) tB_ = __builtin_amdgcn_s_memrealtime(); } while (0)
#define SEAM(k) do { if (IN(k) && IN((k) + 1)) GRID_BAR(); STAMP((k) + 1); } while (0)
#define PHASE_ENTER() do { int t_ = F.wave * 64 + lane_id(); asm volatile("" : "+v"(t_)); F.tid = t_; F.lane = t_ & 63; GAS unsigned char* w_ = (GAS unsigned char*)args.ws; GAS float* o_ = (GAS float*)args.out; asm volatile("" : "+s"(w_), "+s"(o_)); F.ws = (unsigned char*)w_; F.out = (float*)o_; F.ctl = (unsigned*)(F.ws + WS_CTL); } while (0)
    const int gw = F.vcu * NWAVES + F.wave, NGW = F.G * NWAVES;
#define modv WSP(const float, WS_MODV)
    LAS unsigned char* ring = F.lds + RING_OFF;
    LAS unsigned* idxw = (LAS unsigned*)(F.lds + AUX_OFF + AUX_IDX + F.wave * 1024);

    STAMP(0);
    if (IN(0)) for (int rep_ = 0; rep_ < REPS(0); ++rep_) { PHASE_ENTER(); p0_prologue(F); }
    SEAM(0);
    if (IN(1)) for (int rep_ = 0; rep_ < REPS(1); ++rep_) { PHASE_ENTER();
        for (int rb = gw; rb < MTOK / 32; rb += NGW) { const int row0 = rb * 32; const int b = row0 >> 12;
            modulate_rows<true>(F, kin(I_X), WSP(bf16_t, WS_H), row0, 32, kin(I_NORM1), modv + (size_t)b * 6144 + 1024, modv + (size_t)b * 6144, WSP(unsigned char, WS_H8)); }
        for (int rb = gw; rb < MCTX / 2; rb += NGW)
            modulate_rows(F, kin(I_CTX), WSP(bf16_t, WS_HC), rb * 2, 2, kin(I_NORM1), modv + (size_t)16 * 6144 + 1024, modv + (size_t)16 * 6144);
    }
    SEAM(1);
    if (IN(2)) for (int rep_ = 0; rep_ < REPS(2); ++rep_) { PHASE_ENTER();
        { SchedQKV S{WSP(const bf16_t, WS_H), (long)WS_HC - (long)WS_H, WSP(const bf16_t, WS_WQKV), F.G, F.vcu};
          EpiQKV E{WSP(bf16_t, WS_Q), WSP(bf16_t, WS_K), WSP(bf16_t, WS_V), kin(I_QNW), kin(I_KNW), WSP(const f32x2, WS_ROPE)};
          pg8::gemm_phase<EpiQKV, SchedQKV, false, true>(ring, idxw, DM, S, E, F.wave); }
        { SchedDense S{WSP(const bf16_t, WS_WU), WSP(const bf16_t, WS_H8), DM / 2, 6, MTOK / 256, F.G, F.vcu, true};
          EpiPlainBf16 E{WSP(bf16_t, WS_UT), (size_t)MTOK, 1.0f / 256.0f};
          pg8::gemm_phase<EpiPlainBf16, SchedDense, false, true, true>(ring, idxw, DM / 2, S, E, F.wave); }
    }
    SEAM(2);
    if (IN(3)) for (int rep_ = 0; rep_ < REPS(3); ++rep_) { PHASE_ENTER();
        const attn_body::AttnTensors AT{WSP(const attn_body::bf16, WS_Q), WSP(const attn_body::bf16, WS_K), WSP(const attn_body::bf16, WS_V), WSP(attn_body::bf16, WS_AO)};
        const attn_body::StaticOrder S(F.vcu);
        for (int r2_ = 0; r2_ < REPS(14); ++r2_) attn_body::attn_phase<attn_body::StaticOrder>((char*)lds + RING_OFF, AT, S, F.wave);
        __syncthreads(); PHASE_ENTER();
        for (int r2_ = 0; r2_ < REPS(15); ++r2_) for (int c = F.vcu; c < HW; c += F.G) {
#if HYENA_FP8
            hyena_unit8(F, c);
#else
            hyena_unit(F, c);
#endif
        }
    }
    SEAM(3);
    if (IN(4)) for (int rep_ = 0; rep_ < REPS(4); ++rep_) { PHASE_ENTER();
        for (int pm = F.vcu; pm < MTOK / 256; pm += F.G) {
            for (int q4 = 0; q4 < 4; ++q4) p4_norm_tile(F, pm * 4 + q4);
            VM_WAIT(); __syncthreads(); PHASE_ENTER();
            { SchedDense S{WSP(const bf16_t, WS_AY) + (size_t)pm * 256 * DM, WSP(const bf16_t, WS_WO), DM, 1, 4, 1, 0, false};
              EpiOutProj E{kin(I_X), F.out, modv, pm};
              pg8::gemm_phase<EpiOutProj, SchedDense, false, true>(ring, idxw, DM, S, E, F.wave); }
            VM_WAIT(); __syncthreads(); PHASE_ENTER();
            { const int row0 = pm * 256 + F.wave * 32; const int b = row0 >> 12;
              modulate_rows<true>(F, F.out, WSP(bf16_t, WS_H), row0, 32, kin(I_NORM2), modv + (size_t)b * 6144 + 4 * 1024, modv + (size_t)b * 6144 + 3 * 1024, WSP(unsigned char, WS_H8)); }
            VM_WAIT(); __syncthreads(); PHASE_ENTER();
            { SchedDense S{WSP(const bf16_t, WS_H) + (size_t)pm * 256 * DM, WSP(const bf16_t, WS_WR), DM, 1, 1, 1, 0, false};
              EpiF32 E{WSP(float, WS_LOGIT) + (size_t)pm * 256 * NE, (size_t)NE};
              pg8::gemm_phase<EpiF32, SchedDense, false, true>(ring, idxw, DM, S, E, F.wave); }
            VM_WAIT(); __syncthreads(); PHASE_ENTER();
            {
                LAS unsigned* lcnt = (LAS unsigned*)(F.lds + AUX_OFF); LAS unsigned* lbase = lcnt + 256;
                if (F.tid < 256) lcnt[F.tid] = 0u;
                __syncthreads();
                RouteSel R0, R1;
                p8_route16(F, pm * 256 + F.wave * 32, R0, lcnt); p8_route16(F, pm * 256 + F.wave * 32 + 16, R1, lcnt);
                __syncthreads();
                if (F.tid < 256) { const unsigned c = lcnt[F.tid]; lbase[F.tid] = c ? __hip_atomic_fetch_add(F.ctl + CW_CNT + 32 * F.tid, c, RLX_AGENT) : 0u; }
                __syncthreads();
                route_commit(F, pm * 256 + F.wave * 32, R0, lbase); route_commit(F, pm * 256 + F.wave * 32 + 16, R1, lbase);
                __syncthreads();
            }
        }
    }
    SEAM(4); STAMP(6); STAMP(7); STAMP(8); STAMP(9);
    if (IN(9)) for (int rep_ = 0; rep_ < REPS(9); ++rep_) { PHASE_ENTER();
        const MoeTab tab = moe_tables(F);
        SchedGU S{WSP(const bf16_t, WS_H8), WSP(const bf16_t, WS_WGU), WSP(const bf16_t, WS_WSGU8), WSP(const unsigned, WS_LIST), tab, F.G, F.vcu};
        EpiGU E{WSP(unsigned char, WS_ACT), WSP(const unsigned, WS_LIST), tab};
        pg8::gemm_phase<EpiGU, SchedGU, true, true, true>(ring, idxw, DM / 2, S, E, F.wave);
    }
    SEAM(9);
    if (IN(10)) for (int rep_ = 0; rep_ < REPS(10); ++rep_) { PHASE_ENTER();
        const MoeTab tab = moe_tables(F);
        down_phase(F, tab);
    }
    SEAM(10);
    if (IN(11)) for (int rep_ = 0; rep_ < REPS(11); ++rep_) { PHASE_ENTER(); const MoeTab tab = moe_tables(F); for (int rb = gw; rb < MTOK / 32; rb += NGW) for (int r = 0; r < 32; r += 2) combine_token(F, tab, rb * 32 + r); }
    STAMP(12); STAMP(13); STAMP(14);
    if (PROBE_K >= 0 && blockIdx.x == 0) {
        const unsigned long long until = __builtin_amdgcn_s_memrealtime() + (unsigned long long)PROBE_AMP * (tB_ - tA_);
        while (__builtin_amdgcn_s_memrealtime() < until) __builtin_amdgcn_s_sleep(32);
    }
#undef modv
#undef PHASE_ENTER
#undef IN
#undef SEAM
#undef GRID_BAR
}

extern "C" void kernel_launch(void* const* d_in, const int* in_sizes, int n_in, void* d_out, int out_size, void* d_ws, size_t ws_size, hipStream_t stream) {
    static int grid = 0;
    if (grid == 0) {
        if (n_in != N_IN || in_sizes[0] != MTOK * DM || out_size != MTOK * DM || ws_size < WS_END) {
            fprintf(stderr, "kernel_launch: unexpected problem (n_in %d, in0 %d, out %d, ws %zu < %zu); nothing launched\n", n_in, n_in > 0 ? in_sizes[0] : -1, out_size, ws_size, (size_t)WS_END); grid = -1; return; }
        int dev = 0, cus = 0, per_cu = 0;
        if (hipGetDevice(&dev) != hipSuccess || hipDeviceGetAttribute(&cus, hipDeviceAttributeMultiprocessorCount, dev) != hipSuccess) { grid = -1; return; }
        if (hipFuncSetAttribute((const void*)fwd_kernel, hipFuncAttributeMaxDynamicSharedMemorySize, LDS_BYTES) != hipSuccess) { fprintf(stderr, "kernel_launch: hipFuncSetAttribute failed\n"); grid = -1; return; }
        if (hipOccupancyMaxActiveBlocksPerMultiprocessor(&per_cu, (const void*)fwd_kernel, NWAVES * 64, LDS_BYTES) != hipSuccess || per_cu < 1)
            fprintf(stderr, "kernel_launch: note: occupancy query reports %d workgroups per CU\n", per_cu);
        (void)hipGetLastError();
        grid = cus;
    }
    if (grid < 0) return;
    if (hipMemsetAsync((char*)d_ws + WS_CTL, 0, CTL_ZERO_BYTES, stream) != hipSuccess) return;
    Args a{};
    for (int i = 0; i < N_IN; ++i) a.in[i] = (const float*)d_in[i];
    a.out = (float*)d_out; a.ws = (unsigned char*)d_ws;
    for (int li = 0; li < N_LAUNCHES; ++li) {
        a.ph_lo = (N_LAUNCHES == 1) ? 0 : li; a.ph_hi = (N_LAUNCHES == 1) ? NPHASE : li + 1;
        hipLaunchKernelGGL(fwd_kernel, dim3(grid), dim3(NWAVES * 64), LDS_BYTES, stream, a);
        const hipError_t le = hipPeekAtLastError();
        if (le != hipSuccess) { fprintf(stderr, "kernel_launch: launch %d failed: %s\n", li, hipGetErrorName(le)); break; }
    }
}
```

```cpp
#include <hip/hip_runtime.h>
#include <cstdio>
#include <cstdint>
#include <cmath>

#ifndef HYENA_FP8
#define HYENA_FP8 1
#endif
#ifndef MK_N_LAUNCHES
#define MK_N_LAUNCHES 1
#endif

#define LAS __attribute__((address_space(3)))
#define GAS __attribute__((address_space(1)))
typedef unsigned short bf16_t;
typedef short bf16x8 __attribute__((ext_vector_type(8)));
typedef float f32x4 __attribute__((ext_vector_type(4)));
typedef float f32x2 __attribute__((ext_vector_type(2)));
typedef unsigned u32x4 __attribute__((ext_vector_type(4)));
typedef unsigned u32x2 __attribute__((ext_vector_type(2)));

constexpr int NB = 16, SEQ = 4096, DM = 1024, MTOK = NB * SEQ, CTXL = 256, MCTX = NB * CTXL;
constexpr int NH = 8, HD = 64, AW = 512, HW = 512, KVP = 128, KVLEN = CTXL + SEQ;
constexpr int NE = 256, TOPK = 8, FF = 256;
constexpr float EPS = 1e-6f;
constexpr int NPHASE = 14;

constexpr size_t MiB = 1u << 20;
constexpr size_t WS_CTL = 0, CTL_ZERO_BYTES = 128 * 1024;
constexpr size_t WS_MODV = 512 * 1024;
constexpr size_t WS_ROPE = 1 * MiB;
constexpr size_t WS_SS = 1 * MiB + 256 * 1024;
constexpr size_t WS_ASSIGN = 2 * MiB;
constexpr size_t WS_KR = 4 * MiB;
constexpr size_t WS_WQKV = 12 * MiB;
constexpr size_t WS_WU = 14 * MiB;
constexpr size_t WS_WO = 17 * MiB;
constexpr size_t WS_WR = 19 * MiB;
constexpr size_t WS_WSGU = 20 * MiB;
constexpr size_t WS_WSD = 21 * MiB;
constexpr size_t WS_WD = 22 * MiB;
constexpr size_t WS_ACT = 150 * MiB;
constexpr size_t WS_SLOT = 406 * MiB;
constexpr size_t WS_END = 1048 * MiB;
constexpr size_t WS_Q = 150 * MiB;
constexpr size_t WS_K = 214 * MiB;
constexpr size_t WS_V = 231 * MiB;
constexpr size_t WS_UT = 248 * MiB;
constexpr size_t WS_HC = 440 * MiB;
constexpr size_t WS_AY = 248 * MiB;
constexpr size_t WS_LOGIT = 150 * MiB;
constexpr size_t WS_WGU = 470 * MiB;
constexpr size_t WS_H8 = 598 * MiB;
constexpr size_t WS_WSGU8 = 662 * MiB;
constexpr size_t WS_H = 726 * MiB;
constexpr size_t WS_HYW = 726 * MiB;
constexpr size_t WS_HYX = 790 * MiB;
constexpr size_t WS_LIST = 854 * MiB;
constexpr size_t WS_YT = 919 * MiB;
constexpr size_t WS_AO = 983 * MiB;
static_assert(WS_LIST + (size_t)257 * 65536 * 4 <= WS_YT && WS_YT + 64 * MiB <= WS_AO && WS_AO + 64 * MiB <= WS_END, "ws map");
constexpr size_t MAXROWS_R = 524288 + 256 * 255;
static_assert(WS_SLOT + (MAXROWS_R + 65536) * 1024 <= WS_END && WS_ACT + (MAXROWS_R + 65536) * 256 <= WS_SLOT, "ws map 2");

constexpr int CW_TMO = 0, CW_CODE = 1, CW_TILEQ = 64;
constexpr int CW_BAR = 4096;
constexpr int CW_CNT = 16384;
static_assert((CW_CNT + 257 * 32) * 4 <= (int)CTL_ZERO_BYTES && (CW_BAR + 3456) * 4 <= (int)CTL_ZERO_BYTES, "control words inside the memset region");

constexpr int RING_OFF = 0, RING_BYTES = 131072;
constexpr int AUX_OFF = 131072, AUX_BYTES = 16384;
constexpr int MISC_OFF = AUX_OFF + AUX_BYTES;
constexpr int LDS_BYTES = MISC_OFF + 512;
constexpr int AUX_TP = 0, AUX_CNT = 1280, AUX_T2E = 2560, AUX_IDX = 8192;

constexpr int NWAVES = 8;
constexpr float C2 = 0.125f * 1.4426950408889634f;

__device__ __forceinline__ unsigned f2bf(float f) { unsigned u = __builtin_bit_cast(unsigned, f); return (u + 0x7fffu + ((u >> 16) & 1u)) >> 16; }
__device__ __forceinline__ unsigned pk2(float lo, float hi) { unsigned r; asm("v_cvt_pk_bf16_f32 %0, %1, %2" : "=v"(r) : "v"(lo), "v"(hi)); return r; }
__device__ __forceinline__ float bf2f(unsigned h) { return __builtin_bit_cast(float, h << 16); }
__device__ __forceinline__ unsigned cvt_pk_bf16(float lo, float hi) { unsigned r; asm volatile("v_cvt_pk_bf16_f32 %0, %1, %2" : "=v"(r) : "v"(lo), "v"(hi)); return r; }
__device__ __forceinline__ int lane_id() { return (int)__builtin_amdgcn_mbcnt_hi(~0u, __builtin_amdgcn_mbcnt_lo(~0u, 0u)); }
__device__ __forceinline__ float wave_sum(float v) {
#pragma unroll
    for (int o = 1; o < 64; o <<= 1) v += __shfl_xor(v, o);
    return v;
}

namespace pg8 {
constexpr int BM = 256, BK = 64, HALF = 128, HTB = HALF * BK * 2, STAGE_BYTES = 8 * HTB;
__host__ __device__ __forceinline__ int lds_byte(int r, int c) { const int st = (r >> 4) * 2 + (c >> 5), rr = r & 15, cc = c & 31, ob = rr * 64 + cc * 2; return st * 1024 + (ob ^ (((ob >> 9) & 1) << 5)); }
__host__ __device__ __forceinline__ void stage_rc(int b, int& R, int& C) { const int st = b / 1024, sb = b % 1024, swz = sb ^ (((sb >> 9) & 1) << 5); R = (st >> 1) * 16 + swz / 64; C = (st & 1) * 32 + (swz % 64) / 2; }
__host__ __device__ __forceinline__ int perm32(int rho) { const int n = rho >> 4, i = rho & 15; return 8 * (i >> 2) + 4 * n + (i & 3); }

struct Unit { int pm, pn, aux, aux2; };
typedef int v8i __attribute__((ext_vector_type(8)));
typedef int v4i __attribute__((ext_vector_type(4)));
__device__ __forceinline__ void mfma_fp8(f32x4& acc, v8i a, v8i b) { asm volatile("v_mfma_f32_16x16x128_f8f6f4 %0, %1, %2, %0" : "+v"(acc) : "v"(a), "v"(b)); }
__device__ __forceinline__ v8i cat8(bf16x8 lo, bf16x8 hi) { const v4i a = __builtin_bit_cast(v4i, lo), b = __builtin_bit_cast(v4i, hi); return __builtin_shufflevector(a, b, 0, 1, 2, 3, 4, 5, 6, 7); }

template <class Epi, class Sched, bool GATHER, bool ALIGN_EPI, bool FP8 = false>
__device__ __forceinline__ void gemm_phase(LAS unsigned char* lds, LAS unsigned* idxw, const int K, const Sched& S, const Epi& E, const int wave) {
    int tid_ = wave * 64 + lane_id(); asm volatile("" : "+v"(tid_));
    const int tid = tid_, wid = __builtin_amdgcn_readfirstlane(tid >> 6), lane = tid & 63, wr = wid >> 2, wc = wid & 3, fr = lane & 15, fq = lane >> 4;
    const int nt = K / BK;
    int Rr[2], Cc[2]; unsigned voffB[2];
#pragma unroll
    for (int i = 0; i < 2; ++i) { stage_rc(tid * 16 + i * 8192, Rr[i], Cc[i]); const int Rb = (Rr[i] & ~31) + perm32(Rr[i] & 31); voffB[i] = (unsigned)(Rb * K + Cc[i]) * 2u; }
    const unsigned kstep = (unsigned)(BK * 2);
    const unsigned hstep = (unsigned)HALF * (unsigned)K * 2u;
    const unsigned ldsw = (unsigned)wid * 1024u;
    const int aoff = lds_byte(wr * 64 + fr, fq * 8), boff = lds_byte(wc * 32 + fr, fq * 8);
#define PG8_SA(b, h) (((b) * 2 + (h)) * HTB)
#define PG8_SB(b, h) ((4 + (b) * 2 + (h)) * HTB)
#define PG8_STAGE_B(bufoff, gbase) do { _Pragma("unroll") for (int _i = 0; _i < 2; ++_i) \
        __builtin_amdgcn_global_load_lds((const unsigned*)((const char*)(gbase) + voffB[_i]), (LAS unsigned*)(lds + (bufoff) + ldsw + _i * 8192), 16, 0, 0); } while (0)
#define PG8_STAGE_A(bufoff, gbase, VV, h) do { _Pragma("unroll") for (int _i = 0; _i < 2; ++_i) \
        __builtin_amdgcn_global_load_lds((const unsigned*)((const char*)(gbase) + VV[h][_i]), (LAS unsigned*)(lds + (bufoff) + ldsw + _i * 8192), 16, 0, 0); } while (0)
#define PG8_LDA(dst, b, h) do { _Pragma("unroll") for (int m = 0; m < 4; ++m) _Pragma("unroll") for (int k = 0; k < 2; ++k) dst[m][k] = *(const LAS bf16x8*)(lds + PG8_SA(b, h) + aoff + m * 2048 + k * 1024); } while (0)
#define PG8_LDB(dst, b, h) do { _Pragma("unroll") for (int n = 0; n < 2; ++n) _Pragma("unroll") for (int k = 0; k < 2; ++k) dst[n][k] = *(const LAS bf16x8*)(lds + PG8_SB(b, h) + boff + n * 2048 + k * 1024); } while (0)
#define PG8_MMA(ai, bj, At, Bt) do { __builtin_amdgcn_s_setprio(1); _Pragma("unroll") for (int m = 0; m < 4; ++m) _Pragma("unroll") for (int n = 0; n < 2; ++n) { \
        if constexpr (FP8) { mfma_fp8(acc[ai][bj][m][n], cat8(Bt[n][0], Bt[n][1]), cat8(At[m][0], At[m][1])); } \
        else { _Pragma("unroll") for (int k = 0; k < 2; ++k) acc[ai][bj][m][n] = __builtin_amdgcn_mfma_f32_16x16x32_bf16(Bt[n][k], At[m][k], acc[ai][bj][m][n], 0, 0, 0); } } __builtin_amdgcn_s_setprio(0); } while (0)
#define PG8_WAIT_V(n) asm volatile("s_waitcnt vmcnt(" #n ")" ::: "memory")
#define PG8_WAIT_L(n) asm volatile("s_waitcnt lgkmcnt(" #n ")" ::: "memory")
#define PG8_BAR __builtin_amdgcn_s_barrier()
#define PG8_SCHED __builtin_amdgcn_sched_barrier(0)
    Unit cur, nxt; int ui = 0;
    if (!S.next(0, cur)) return;
    f32x4 acc[2][2][4][2];
#pragma unroll
    for (int a = 0; a < 2; ++a)
#pragma unroll
        for (int b = 0; b < 2; ++b)
#pragma unroll
            for (int m = 0; m < 4; ++m)
#pragma unroll
                for (int n = 0; n < 2; ++n) { acc[a][b][m][n] = (f32x4){0.f, 0.f, 0.f, 0.f}; if constexpr (FP8) asm volatile("" : "+v"(acc[a][b][m][n])); }
    bf16x8 At[4][2], B0[2][2], B1[2][2];
    unsigned va[2][2], vn[2][2];
    if constexpr (GATHER) {
        const unsigned* ip = S.idx_ptr(cur); const int nv = S.nvalid(cur);
#pragma unroll
        for (int h = 0; h < 2; ++h)
#pragma unroll
            for (int i = 0; i < 2; ++i) { const int r = Rr[i] + HALF * h; const unsigned e = ip[r]; const unsigned tok = r < nv ? (e >> 16) : 0u; va[h][i] = tok * (unsigned)K * 2u + (unsigned)Cc[i] * 2u; }
    } else {
#pragma unroll
        for (int h = 0; h < 2; ++h)
#pragma unroll
            for (int i = 0; i < 2; ++i) va[h][i] = (unsigned)((Rr[i] + HALF * h) * K + Cc[i]) * 2u;
    }
#pragma unroll
    for (int h = 0; h < 2; ++h)
#pragma unroll
        for (int i = 0; i < 2; ++i) vn[h][i] = va[h][i];
    const char* cA = S.a_base(cur); const char* cB = S.b_base(cur);
    PG8_STAGE_B(PG8_SB(0, 0), cB); PG8_STAGE_B(PG8_SB(0, 1), cB + hstep); PG8_STAGE_A(PG8_SA(0, 0), cA, va, 0); PG8_STAGE_A(PG8_SA(0, 1), cA, va, 1);
    if (wr == 1) PG8_BAR;
    PG8_WAIT_V(2); PG8_BAR;
    PG8_STAGE_B(PG8_SB(1, 0), cB + kstep); PG8_STAGE_A(PG8_SA(1, 0), cA + kstep, va, 0); PG8_STAGE_B(PG8_SB(1, 1), cB + hstep + kstep);
    PG8_WAIT_V(6); PG8_BAR;
    for (;;) {
        const bool has_next = S.next(ui + 1, nxt);
        const char* nA = has_next ? S.a_base(nxt) : cA; const char* nB = has_next ? S.b_base(nxt) : cB;
        int nvn = 0;
        if constexpr (GATHER) {
            if (has_next) { nvn = S.nvalid(nxt);
                __builtin_amdgcn_global_load_lds((const unsigned*)(S.idx_ptr(nxt) + lane * 4), (LAS unsigned*)idxw, 16, 0, 0); }
        }
#pragma unroll 1
        for (int t = 0; t < nt; t += 2) {
            const bool last = (t == nt - 2);
            if constexpr (GATHER) {
                if (last && has_next) {
                    asm volatile("" ::: "memory");
#pragma unroll
                    for (int h = 0; h < 2; ++h)
#pragma unroll
                        for (int i = 0; i < 2; ++i) { const int r = Rr[i] + HALF * h; const unsigned e = idxw[r]; const unsigned tok = r < nvn ? (e >> 16) : 0u; vn[h][i] = tok * (unsigned)K * 2u + (unsigned)Cc[i] * 2u; }
                }
            }
            unsigned v2[2][2];
#pragma unroll
            for (int h = 0; h < 2; ++h)
#pragma unroll
                for (int i = 0; i < 2; ++i) v2[h][i] = (GATHER && last) ? vn[h][i] : va[h][i];
            const char* a1 = cA + (size_t)(t + 1) * kstep;
            const char* a2 = last ? nA : cA + (size_t)(t + 2) * kstep; const char* b2 = last ? nB : cB + (size_t)(t + 2) * kstep;
            const char* a3 = a2 + kstep; const char* b3 = b2 + kstep;
            PG8_LDB(B0, 0, 0); PG8_LDB(B1, 0, 1); PG8_SCHED; PG8_LDA(At, 0, 0); PG8_STAGE_A(PG8_SA(1, 1), a1, va, 1);
            PG8_WAIT_V(8); PG8_WAIT_L(0); PG8_BAR; PG8_MMA(0, 0, At, B0); PG8_MMA(0, 1, At, B1); PG8_BAR; PG8_SCHED;
            PG8_LDA(At, 0, 1); PG8_STAGE_B(PG8_SB(0, 0), b2); PG8_STAGE_B(PG8_SB(0, 1), b2 + hstep); PG8_STAGE_A(PG8_SA(0, 0), a2, v2, 0);
            PG8_WAIT_V(8); PG8_WAIT_L(0); PG8_BAR; PG8_MMA(1, 0, At, B0); PG8_MMA(1, 1, At, B1); PG8_BAR; PG8_SCHED;
            PG8_LDB(B0, 1, 0); PG8_LDB(B1, 1, 1); PG8_SCHED; PG8_LDA(At, 1, 0); PG8_STAGE_A(PG8_SA(0, 1), a2, v2, 1);
            PG8_WAIT_V(8); PG8_WAIT_L(0); PG8_BAR; PG8_MMA(0, 0, At, B0); PG8_MMA(0, 1, At, B1); PG8_BAR; PG8_SCHED;
            PG8_LDA(At, 1, 1); PG8_STAGE_B(PG8_SB(1, 0), b3); PG8_STAGE_B(PG8_SB(1, 1), b3 + hstep); PG8_STAGE_A(PG8_SA(1, 0), a3, v2, 0);
            PG8_WAIT_V(8); PG8_WAIT_L(0); PG8_BAR; PG8_MMA(1, 0, At, B0); PG8_MMA(1, 1, At, B1); PG8_BAR; PG8_SCHED;
        }
        if constexpr (ALIGN_EPI) { if (wr == 0) PG8_BAR; }
        if constexpr (FP8) {
#define PG8_A4(a, b) "+v"(acc[a][b][0][0]), "+v"(acc[a][b][0][1]), "+v"(acc[a][b][1][0]), "+v"(acc[a][b][1][1]), "+v"(acc[a][b][2][0]), "+v"(acc[a][b][2][1]), "+v"(acc[a][b][3][0]), "+v"(acc[a][b][3][1])
            asm volatile("s_nop 15\n\ts_nop 15" : PG8_A4(0, 0), PG8_A4(0, 1) :: "memory");
            asm volatile("" : PG8_A4(1, 0), PG8_A4(1, 1) :: "memory");
#undef PG8_A4
        }
        E(acc, cur, wr, wc, fr, fq);
        if (!has_next) break;
#pragma unroll
        for (int a = 0; a < 2; ++a)
#pragma unroll
            for (int b = 0; b < 2; ++b)
#pragma unroll
                for (int m = 0; m < 4; ++m)
#pragma unroll
                    for (int n = 0; n < 2; ++n) { acc[a][b][m][n] = (f32x4){0.f, 0.f, 0.f, 0.f}; if constexpr (FP8) asm volatile("" : "+v"(acc[a][b][m][n])); }
        cur = nxt; cA = nA; cB = nB; ++ui;
#pragma unroll
        for (int h = 0; h < 2; ++h)
#pragma unroll
            for (int i = 0; i < 2; ++i) va[h][i] = vn[h][i];
        if constexpr (ALIGN_EPI) { if (wr == 1) PG8_BAR; }
    }
    PG8_WAIT_V(0);
    if constexpr (!ALIGN_EPI) { if (wr == 0) PG8_BAR; }
    PG8_BAR;
#undef PG8_SA
#undef PG8_SB
#undef PG8_STAGE_A
#undef PG8_STAGE_B
#undef PG8_LDA
#undef PG8_LDB
#undef PG8_MMA
#undef PG8_WAIT_V
#undef PG8_WAIT_L
#undef PG8_BAR
#undef PG8_SCHED
}
}

using pg8::Unit;
struct MoeTab { const LAS int* tp; const LAS int* cnt; const LAS unsigned short* t2e; };
__device__ __forceinline__ int moe_find(const LAS int* tp, int T) {
    int lo = 0, hi = 256;
    while (lo < hi) { const int mid = (lo + hi + 1) >> 1; if (tp[mid] <= T) lo = mid; else hi = mid - 1; }
    return lo;
}

struct SchedQKV {
    const bf16_t *H; long hc_delta; const bf16_t *W; int G, c;
    __device__ __forceinline__ bool next(int i, Unit& u) const {
        const int L = i * G + c; if (L >= 784) return false;
        if (L < 768) { u.pm = L / 3; u.pn = L % 3; u.aux = 0; } else { u.pm = L - 768; u.pn = 2; u.aux = 1; }
        u.aux2 = 0; return true;
    }
    __device__ __forceinline__ const char* a_base(const Unit& u) const { return (const char*)H + (u.aux ? hc_delta : 0L) + (size_t)u.pm * (256 * 1024 * 2); }
    __device__ __forceinline__ const char* b_base(const Unit& u) const { return (const char*)W + (size_t)u.pn * (256 * 1024 * 2); }
    __device__ __forceinline__ const unsigned* idx_ptr(const Unit&) const { return nullptr; }
    __device__ __forceinline__ int nvalid(const Unit&) const { return 256; }
};
struct SchedDense {
    const bf16_t *A, *Bt; int K, nM, nN, G, c; bool m_fast;
    __device__ __forceinline__ bool next(int i, Unit& u) const {
        const int L = i * G + c; if (L >= nM * nN) return false;
        if (m_fast) { u.pm = L % nM; u.pn = L / nM; } else { u.pm = L / nN; u.pn = L % nN; }
        u.aux = 0; u.aux2 = 0; return true;
    }
    __device__ __forceinline__ const char* a_base(const Unit& u) const { return (const char*)A + (size_t)u.pm * 512 * (size_t)K; }
    __device__ __forceinline__ const char* b_base(const Unit& u) const { return (const char*)Bt + (size_t)u.pn * 512 * (size_t)K; }
    __device__ __forceinline__ const unsigned* idx_ptr(const Unit&) const { return nullptr; }
    __device__ __forceinline__ int nvalid(const Unit&) const { return 256; }
};
struct TileDeal {
    int nT, NP, G, c;
    __device__ __forceinline__ bool get(int i, int& tile, int& slot) const {
        const int full = nT / G, rem = nT - full * G;
        if (i < full * NP) { tile = (i / NP) * G + c; slot = i % NP; return true; }
        const int j = i - full * NP;
        if (rem * NP <= G) { if (j > 0 || c >= rem * NP) return false; tile = full * G + c / NP; slot = c % NP; return true; }
        if (j >= NP || c >= rem) return false; tile = full * G + c; slot = j; return true;
    }
};
struct SchedGU {
    const bf16_t *H2, *WGU, *WSGU; const unsigned* LIST; MoeTab tab; int G, c;
    __device__ __forceinline__ bool next(int i, Unit& u) const {
        const int Ttot = __builtin_amdgcn_readfirstlane(tab.tp[257]); const int L = i * G + c; if (L >= 2 * Ttot) return false;
        const int T = L >> 1, half = L & 1;
        const int e = __builtin_amdgcn_readfirstlane((int)tab.t2e[T]);
        u.pm = T; u.pn = half; u.aux = e; u.aux2 = __builtin_amdgcn_readfirstlane(T - tab.tp[e]); return true;
    }
    __device__ __forceinline__ const char* a_base(const Unit&) const { return (const char*)H2; }
    __device__ __forceinline__ const char* b_base(const Unit& u) const { return (u.aux < 256 ? (const char*)WGU + (size_t)u.aux * (512 * 1024) : (const char*)WSGU) + (size_t)u.pn * (256 * 1024); }
    __device__ __forceinline__ const unsigned* idx_ptr(const Unit& u) const { return LIST + (size_t)u.aux * 65536 + (size_t)u.aux2 * 256; }
    __device__ __forceinline__ int nvalid(const Unit& u) const { const int r = __builtin_amdgcn_readfirstlane(tab.cnt[u.aux]) - u.aux2 * 256; return r < 256 ? r : 256; }
};
struct SchedDown {
    const bf16_t *ACT, *WD, *WSD; MoeTab tab; int G, c;
    __device__ __forceinline__ bool next(int i, Unit& u) const {
        const int TT = __builtin_amdgcn_readfirstlane(tab.tp[257]);
        const int L = i * G + c; if (L >= 4 * TT) return false;
        u.pm = L >> 2; u.pn = L & 3;
        u.aux = __builtin_amdgcn_readfirstlane((int)tab.t2e[u.pm]); u.aux2 = 0; return true;
    }
    __device__ __forceinline__ const char* a_base(const Unit& u) const { return (const char*)ACT + (size_t)u.pm * (256 * 256); }
    __device__ __forceinline__ const char* b_base(const Unit& u) const { return (u.aux < 256 ? (const char*)WD + (size_t)u.aux * (1024 * 256) : (const char*)WSD) + (size_t)u.pn * (256 * 256); }
    __device__ __forceinline__ const unsigned* idx_ptr(const Unit&) const { return nullptr; }
    __device__ __forceinline__ int nvalid(const Unit&) const { return 256; }
};

#define EPI_ARGS const f32x4 (&acc)[2][2][4][2], const Unit& u, int wr, int wc, int fr_, int fq_
#define EPI_PIN int fr = fr_, fq = fq_; asm volatile("" : "+v"(fr), "+v"(fq))
__device__ __forceinline__ u32x4 pack8(const f32x4& a, const f32x4& b) { u32x4 o; o.x = cvt_pk_bf16(a[0], a[1]); o.y = cvt_pk_bf16(a[2], a[3]); o.z = cvt_pk_bf16(b[0], b[1]); o.w = cvt_pk_bf16(b[2], b[3]); return o; }

__device__ __forceinline__ unsigned pk4_fp8c(float a, float b, float c, float d) {
    a = __builtin_amdgcn_fmed3f(a, -440.f, 440.f); b = __builtin_amdgcn_fmed3f(b, -440.f, 440.f); c = __builtin_amdgcn_fmed3f(c, -440.f, 440.f); d = __builtin_amdgcn_fmed3f(d, -440.f, 440.f);
    int w = __builtin_amdgcn_cvt_pk_fp8_f32(a, b, 0, false); w = __builtin_amdgcn_cvt_pk_fp8_f32(c, d, w, true); return (unsigned)w; }
struct EpiQKV {
    bf16_t *Q, *Kb, *Vb; const float *qnw, *knw; const f32x2* rope;
    __device__ __forceinline__ void operator()(EPI_ARGS) const {
        EPI_PIN;
        const bool ctx = u.aux != 0;
        const int kind = (u.pn < 2) ? 0 : (wc < 2 ? 1 : 2);
        f32x4 w[2][2];
#pragma unroll
        for (int bj = 0; bj < 2; ++bj)
#pragma unroll
            for (int n = 0; n < 2; ++n) w[bj][n] = (kind == 2) ? (f32x4){1.f, 1.f, 1.f, 1.f} : *(const f32x4*)((kind == 0 ? qnw : knw) + 32 * bj + 8 * fq + 4 * n);
        f32x4 rrow[2][2], rcol[4][2];
        if (kind != 2 && !ctx) {
#pragma unroll
            for (int ai = 0; ai < 2; ++ai)
#pragma unroll
                for (int n = 0; n < 2; ++n) rrow[ai][n] = ((const f32x4*)(rope + (((u.pm * 4 + 2 * ai + wr) & 63) * 16) + 4 * fq))[n];
#pragma unroll
            for (int m = 0; m < 4; ++m)
#pragma unroll
                for (int n = 0; n < 2; ++n) rcol[m][n] = ((const f32x4*)(rope + (16 * m + fr) * 16 + 4 * fq))[n];
        }
#pragma unroll
        for (int ai = 0; ai < 2; ++ai)
#pragma unroll
            for (int m = 0; m < 4; ++m) {
                const int rl = ai * 128 + wr * 64 + m * 16 + fr; const int row = u.pm * 256 + rl;
                f32x4 v[2][2];
#pragma unroll
                for (int bj = 0; bj < 2; ++bj)
#pragma unroll
                    for (int n = 0; n < 2; ++n) v[bj][n] = acc[ai][bj][m][n];
                if (kind != 2) {
                    float ss = 0.f;
#pragma unroll
                    for (int bj = 0; bj < 2; ++bj)
#pragma unroll
                        for (int n = 0; n < 2; ++n) ss += (v[bj][n][0] * v[bj][n][0] + v[bj][n][1] * v[bj][n][1]) + (v[bj][n][2] * v[bj][n][2] + v[bj][n][3] * v[bj][n][3]);
                    ss += __shfl_xor(ss, 16); ss += __shfl_xor(ss, 32);
                    const float rs = rsqrtf(ss * (1.f / 64.f) + EPS);
#pragma unroll
                    for (int bj = 0; bj < 2; ++bj)
#pragma unroll
                        for (int n = 0; n < 2; ++n) v[bj][n] = v[bj][n] * rs * w[bj][n];
                    if (!ctx) {
#pragma unroll
                        for (int bj = 0; bj < 2; ++bj)
#pragma unroll
                            for (int n = 0; n < 2; ++n) { const f32x4 cs = bj == 0 ? rrow[ai][n] : rcol[m][n]; const f32x4 x = v[bj][n];
                                v[bj][n] = (f32x4){x[0] * cs[0] - x[1] * cs[1], x[0] * cs[1] + x[1] * cs[0], x[2] * cs[2] - x[3] * cs[3], x[2] * cs[3] + x[3] * cs[2]}; }
                    }
                    if (kind == 0) {
#pragma unroll
                        for (int bj = 0; bj < 2; ++bj)
#pragma unroll
                            for (int n = 0; n < 2; ++n) v[bj][n] = v[bj][n] * C2;
                    }
                }
                bf16_t* dst;
                if (kind == 0) dst = Q + (size_t)row * AW + 64 * (4 * u.pn + wc) + 8 * fq;
                else { const int kvrow = ctx ? (row >> 8) * KVLEN + (row & 255) : (row >> 12) * KVLEN + CTXL + (row & (SEQ - 1));
                       dst = (kind == 1 ? Kb : Vb) + (size_t)kvrow * KVP + 64 * (wc & 1) + 8 * fq; }
#pragma unroll
                for (int bj = 0; bj < 2; ++bj) *(u32x4*)(dst + 32 * bj) = pack8(v[bj][0], v[bj][1]);
            }
    }
};
struct EpiPlainBf16 {
    bf16_t* O; size_t ldc; float scale;
    __device__ __forceinline__ void operator()(EPI_ARGS) const {
        EPI_PIN;
#pragma unroll
        for (int ai = 0; ai < 2; ++ai)
#pragma unroll
            for (int m = 0; m < 4; ++m) { bf16_t* rowp = O + (size_t)(u.pm * 256 + ai * 128 + wr * 64 + m * 16 + fr) * ldc + u.pn * 256 + wc * 32 + 8 * fq;
#pragma unroll
                for (int bj = 0; bj < 2; ++bj) *(u32x4*)(rowp + bj * 128) = pack8(acc[ai][bj][m][0] * scale, acc[ai][bj][m][1] * scale); }
    }
};
struct EpiOutProj {
    const float* x; float* out; const float* modv; int pm0;
    __device__ __forceinline__ void operator()(EPI_ARGS) const {
        EPI_PIN;
        const int pmt = pm0 + u.pm;
        const float* g1 = modv + (size_t)(pmt >> 4) * 6144 + 2 * 1024; const int col0 = u.pn * 256 + wc * 32 + 8 * fq;
        f32x4 gv[2][2];
#pragma unroll
        for (int bj = 0; bj < 2; ++bj)
#pragma unroll
            for (int n = 0; n < 2; ++n) gv[bj][n] = *(const f32x4*)(g1 + col0 + bj * 128 + 4 * n);
#pragma unroll
        for (int ai = 0; ai < 2; ++ai)
#pragma unroll
            for (int m = 0; m < 4; ++m) { const size_t off = (size_t)(pmt * 256 + ai * 128 + wr * 64 + m * 16 + fr) * DM + col0;
#pragma unroll
                for (int bj = 0; bj < 2; ++bj)
#pragma unroll
                    for (int n = 0; n < 2; ++n) { const f32x4 xv = *(const f32x4*)(x + off + bj * 128 + 4 * n); *(f32x4*)(out + off + bj * 128 + 4 * n) = xv + gv[bj][n] * acc[ai][bj][m][n]; }
                if (m & 1) asm volatile("" ::: "memory"); }
    }
};
struct EpiF32 {
    float* O; size_t ldc;
    __device__ __forceinline__ void operator()(EPI_ARGS) const {
        EPI_PIN;
#pragma unroll
        for (int ai = 0; ai < 2; ++ai)
#pragma unroll
            for (int m = 0; m < 4; ++m) { float* rowp = O + (size_t)(u.pm * 256 + ai * 128 + wr * 64 + m * 16 + fr) * ldc + u.pn * 256 + wc * 32 + 8 * fq;
#pragma unroll
                for (int bj = 0; bj < 2; ++bj)
#pragma unroll
                    for (int n = 0; n < 2; ++n) *(f32x4*)(rowp + bj * 128 + 4 * n) = acc[ai][bj][m][n]; }
    }
};
struct EpiGU {
    unsigned char* ACT; const unsigned* LIST; MoeTab tab;
    __device__ __forceinline__ void operator()(EPI_ARGS) const {
        EPI_PIN;
        const int e = u.aux, tile = u.aux2; int nv = __builtin_amdgcn_readfirstlane(tab.cnt[e]) - tile * 256; nv = nv < 256 ? nv : 256;
        const unsigned* ip = LIST + (size_t)e * 65536 + (size_t)tile * 256;
        constexpr float C1 = -1.4426950408889634f / 256.0f;
#pragma unroll
        for (int ai = 0; ai < 2; ++ai)
#pragma unroll
            for (int m = 0; m < 4; ++m) { const int rl = ai * 128 + wr * 64 + m * 16 + fr;
                const float ws = rl < nv ? bf2f(ip[rl] & 0xffffu) * (4.0f / 65536.0f) : 0.f;
                unsigned pk[2];
#pragma unroll
                for (int n = 0; n < 2; ++n) { const f32x4 g = acc[ai][0][m][n], up = acc[ai][1][m][n]; f32x2 r[2];
#pragma unroll
                    for (int h = 0; h < 2; ++h) { const f32x2 gg = {g[2 * h], g[2 * h + 1]}, uu = {up[2 * h], up[2 * h + 1]};
                        const f32x2 ea = gg * C1; f32x2 d; d.x = __builtin_amdgcn_exp2f(ea.x); d.y = __builtin_amdgcn_exp2f(ea.y); d = d + 1.0f;
                        f32x2 q; q.x = __builtin_amdgcn_rcpf(d.x); q.y = __builtin_amdgcn_rcpf(d.y);
                        f32x2 p = (gg * uu) * (q * ws);
                        p.x = __builtin_amdgcn_fmed3f(p.x, -440.f, 440.f); p.y = __builtin_amdgcn_fmed3f(p.y, -440.f, 440.f); r[h] = p; }
                    int w = __builtin_amdgcn_cvt_pk_fp8_f32(r[0].x, r[0].y, 0, false); w = __builtin_amdgcn_cvt_pk_fp8_f32(r[1].x, r[1].y, w, true); pk[n] = (unsigned)w; }
                u32x2 o; o.x = pk[0]; o.y = pk[1];
                *(u32x2*)(ACT + (size_t)(u.pm * 256 + rl) * FF + u.pn * 128 + wc * 32 + 8 * fq) = o; }
    }
};
struct EpiDown {
    unsigned char* SLOT;
    __device__ __forceinline__ void operator()(EPI_ARGS) const {
        EPI_PIN;
#pragma unroll
        for (int ai = 0; ai < 2; ++ai)
#pragma unroll
            for (int m = 0; m < 4; ++m) { unsigned char* rowp = SLOT + (size_t)(u.pm * 256 + ai * 128 + wr * 64 + m * 16 + fr) * DM + u.pn * 256 + wc * 32 + 8 * fq;
#pragma unroll
                for (int bj = 0; bj < 2; ++bj) { const f32x4 a = acc[ai][bj][m][0] * 0.125f, b = acc[ai][bj][m][1] * 0.125f;
                    u32x2 pk; pk.x = pk4_fp8c(a[0], a[1], a[2], a[3]); pk.y = pk4_fp8c(b[0], b[1], b[2], b[3]); *(u32x2*)(rowp + bj * 128) = pk; } }
    }
};
#include <hip/hip_bf16.h>
#include <cmath>
namespace attn_body {
using bf16=__hip_bfloat16;
using bf16x8=__attribute__((ext_vector_type(8)))short;
using s16x4=__attribute__((ext_vector_type(4)))short;
using f32x16=__attribute__((ext_vector_type(16)))float;
using u32x4=__attribute__((ext_vector_type(4)))unsigned;
constexpr int SEQ=4096,D=64,QP=512,KVP=128,KVLEN=4352;
constexpr int NW=8,QBLK=32,QB=QBLK*NW,KVBLK=64,NQB=SEQ/QB;
constexpr int ATTN_UNIT_ROWS=QB;
__device__ __forceinline__ int crow(int r,int hi){return (r&3)+8*(r>>2)+4*hi;}
#define SBAR() __builtin_amdgcn_sched_barrier(0)

constexpr int NSLOT=3, SLOTB=8192;
constexpr int LDS_K=0, LDS_V=NSLOT*SLOTB, LDS_WS=2*NSLOT*SLOTB, LDS_OST=LDS_WS+NW*64*4, LDS_BYTES=LDS_OST+NW*4096;
constexpr float C2=0.125f*1.4426950408889634f;
__device__ __forceinline__ void glds16(const void*gsrc,unsigned lds_dst){unsigned keep;
  asm volatile("s_mov_b32 %0, m0\n\ts_mov_b32 m0, %2\n\ts_nop 0\n\tglobal_load_lds_dwordx4 %1, off\n\ts_mov_b32 m0, %0":"=&s"(keep):"v"(gsrc),"s"(lds_dst):"memory");}
__device__ __forceinline__ float max3f(float a,float b,float c){float r;asm("v_max3_f32 %0, %1, %2, %3":"=v"(r):"v"(a),"v"(b),"v"(c));return r;}
__device__ __forceinline__ float max2f(float a,float b){float r;asm("v_max_f32_e32 %0, %1, %2":"=v"(r):"v"(a),"v"(b));return r;}
__device__ __forceinline__ float fadd_s(float a,float b){float r;asm("v_add_f32_e32 %0, %1, %2":"=v"(r):"v"(a),"v"(b));return r;}
__device__ __forceinline__ float fsub_s(float a,float b){float r;asm("v_sub_f32_e32 %0, %1, %2":"=v"(r):"v"(a),"v"(b));return r;}
typedef float f32x2_t __attribute__((ext_vector_type(2))); typedef __bf16 bf16x2_t __attribute__((ext_vector_type(2)));
__device__ __forceinline__ unsigned cvtpk_s(float lo,float hi){f32x2_t v={lo,hi};bf16x2_t b=__builtin_convertvector(v,bf16x2_t);return __builtin_bit_cast(unsigned,b);}
#define WAIT_BAR(N) asm volatile("s_waitcnt vmcnt(" #N ") lgkmcnt(0)\n\ts_barrier":::"memory")

__device__ __forceinline__ void qkt(f32x16&p0,f32x16&p1,const char*Kslot,const bf16x8*qr,const f32x16&negm,int r32,int hi){
  const char*kb=Kslot+hi*1024+r32*16;
  #pragma unroll
  for(int d0=0;d0<4;++d0){
    const bf16x8 b0=*reinterpret_cast<const bf16x8*>(kb+d0*2048);
    const bf16x8 b1=*reinterpret_cast<const bf16x8*>(kb+d0*2048+512);
    if(d0==0){p0=__builtin_amdgcn_mfma_f32_32x32x16_bf16(b0,qr[0],negm,0,0,0);p1=__builtin_amdgcn_mfma_f32_32x32x16_bf16(b1,qr[0],negm,0,0,0);}
    else{p0=__builtin_amdgcn_mfma_f32_32x32x16_bf16(b0,qr[d0],p0,0,0,0);p1=__builtin_amdgcn_mfma_f32_32x32x16_bf16(b1,qr[d0],p1,0,0,0);}}
}
typedef __attribute__((address_space(3))) const char* lds_cptr;
typedef short v4i16_t __attribute__((ext_vector_type(4)));
__device__ __forceinline__ void kload8(bf16x8*kf,lds_cptr kp){
  kf[0]=*(const __attribute__((address_space(3))) bf16x8*)(kp);      kf[1]=*(const __attribute__((address_space(3))) bf16x8*)(kp+512);
  kf[2]=*(const __attribute__((address_space(3))) bf16x8*)(kp+2048); kf[3]=*(const __attribute__((address_space(3))) bf16x8*)(kp+2560);
  kf[4]=*(const __attribute__((address_space(3))) bf16x8*)(kp+4096); kf[5]=*(const __attribute__((address_space(3))) bf16x8*)(kp+4608);
  kf[6]=*(const __attribute__((address_space(3))) bf16x8*)(kp+6144); kf[7]=*(const __attribute__((address_space(3))) bf16x8*)(kp+6656);
}
__device__ __forceinline__ void kload2(bf16x8*kf,lds_cptr kp,int j){ kf[2*j]=*(const __attribute__((address_space(3))) bf16x8*)(kp+j*2048); kf[2*j+1]=*(const __attribute__((address_space(3))) bf16x8*)(kp+j*2048+512); }
__device__ __forceinline__ s16x4 vtr(lds_cptr p){ return __builtin_bit_cast(s16x4,__builtin_amdgcn_ds_read_tr16_b64_v4i16((__attribute__((address_space(3))) v4i16_t*)p)); }
__device__ __forceinline__ float rowmax(const f32x16&p0,const f32x16&p1){
  float a=max3f(p0[0],p0[1],p1[0]),b=max3f(p0[2],p0[3],p1[1]);a=max3f(a,p1[2],p1[3]);
  #pragma unroll
  for(int r=4;r<16;r+=4){a=max3f(a,p0[r],p0[r+1]);b=max3f(b,p0[r+2],p0[r+3]);a=max3f(a,p1[r],p1[r+1]);b=max3f(b,p1[r+2],p1[r+3]);}
  const float m=max2f(a,b);
  auto rr=__builtin_amdgcn_permlane32_swap(__float_as_uint(m),__float_as_uint(m),false,false);
  return max2f(__uint_as_float(rr[0]),__uint_as_float(rr[1]));
}
__device__ __forceinline__ void pv(f32x16*o,int vb,bf16x8 pa0,bf16x8 pa1,bf16x8 pa2,bf16x8 pa3){
  #pragma unroll
  for(int d0=0;d0<2;++d0){s16x4 lo[4],hi[4];
    #pragma unroll
    for(int ks=0;ks<4;++ks){
      asm volatile("ds_read_b64_tr_b16 %0,%1 offset:%c2":"=&v"(lo[ks]):"v"(vb),"i"(d0*4096+ks*1024):"memory");
      asm volatile("ds_read_b64_tr_b16 %0,%1 offset:%c2":"=&v"(hi[ks]):"v"(vb),"i"(d0*4096+ks*1024+512):"memory");}
    asm volatile("s_waitcnt lgkmcnt(0)":::"memory");SBAR();
    #define PK(k) (bf16x8){lo[k][0],lo[k][1],lo[k][2],lo[k][3],hi[k][0],hi[k][1],hi[k][2],hi[k][3]}
    o[d0]=__builtin_amdgcn_mfma_f32_32x32x16_bf16(pa0,PK(0),o[d0],0,0,0);
    o[d0]=__builtin_amdgcn_mfma_f32_32x32x16_bf16(pa1,PK(1),o[d0],0,0,0);
    o[d0]=__builtin_amdgcn_mfma_f32_32x32x16_bf16(pa2,PK(2),o[d0],0,0,0);
    o[d0]=__builtin_amdgcn_mfma_f32_32x32x16_bf16(pa3,PK(3),o[d0],0,0,0);
    #undef PK
  }
}

#ifndef ATTN_STORE16
#define ATTN_STORE16(p,v) (*(u32x4*)(p)=(v))
#endif
template<int THRL> __device__ __forceinline__ void attn_unit(int b,int h,int qb,const bf16*Q,const bf16*__restrict__ K,const bf16*__restrict__ V,bf16*O,char*shm,int wave_){
  const int lane=::lane_id(),tid=wave_*64+lane,r32=lane&31,hi=lane>>5; const int wid=wave_;
  const int q0=qb*QB; const long qrow0=(long)b*SEQ+q0+wid*QBLK;
  const bf16*Qw=Q+qrow0*QP+h*D;
  const bf16*Kh=K+(long)b*KVLEN*KVP+(h>>2)*D,*Vh=V+(long)b*KVLEN*KVP+(h>>2)*D;
  const unsigned lds0=(unsigned)(uintptr_t)shm;
  float*wsf=(float*)(shm+LDS_WS)+wid*64;
  const bf16*ksrc=Kh+(long)lane*KVP+wid*8;
  const bf16*vsrc=Vh+(long)(16*(wid&3)+(lane>>2))*KVP+(wid>>2)*32+(lane&3)*8;
  const unsigned kdst=lds0+LDS_K+wid*1024, vdst=lds0+LDS_V+wid*1024;
  #define DMA_K(t,slot) glds16(ksrc+(long)(t)*KVBLK*KVP,(unsigned)__builtin_amdgcn_readfirstlane(kdst+(slot)))
  #define DMA_V(t,slot) glds16(vsrc+(long)(t)*KVBLK*KVP,(unsigned)__builtin_amdgcn_readfirstlane(vdst+(slot)))
  const int vb0=(int)(lds0+LDS_V)+((lane>>4)&1)*32+(lane&3)*8+(4*hi+((lane&15)>>2))*64;
  const char*Kbase=shm+LDS_K; bf16x8 kf[8];
  const lds_cptr shm3=(lds_cptr)shm; const lds_cptr kp0=shm3+LDS_K+hi*1024+r32*16; const lds_cptr vp0=shm3+LDS_V+((lane>>4)&1)*32+(lane&3)*8+(4*hi+((lane&15)>>2))*64;
  constexpr int NT=KVLEN/KVBLK;
  DMA_K(0,0);DMA_V(0,0);DMA_K(1,SLOTB);
  bf16x8 qr[4];
  #pragma unroll
  for(int d0=0;d0<4;++d0)qr[d0]=*reinterpret_cast<const bf16x8*>(&Qw[(long)r32*QP+d0*16+hi*8]);
  float mhat=0.f,l_reg=0.f;f32x16 o[2];o[0]=f32x16{};o[1]=f32x16{};f32x16 negm=f32x16{};asm volatile("":"+v"(negm));
  #define CMASK(P0,P1,t) do{}while(0)
  bool resc=false;
  #define START(P0,P1) do{ const float rm=rowmax(P0,P1); resc=false; \
    { const float dl=rm; mhat=fadd_s(mhat,dl); \
      _Pragma("unroll") for(int r=0;r<16;++r){P0[r]=fsub_s(P0[r],dl);P1[r]=fsub_s(P1[r],dl);} \
      _Pragma("unroll") for(int r=0;r<16;++r)negm[r]=-mhat; asm volatile("":"+v"(negm)); } \
    _Pragma("unroll") for(int r=0;r<16;++r)P0[r]=__builtin_amdgcn_exp2f(P0[r]); }while(0)
  #define RESC() do{ if(resc){ asm volatile("s_waitcnt lgkmcnt(0)":::"memory"); \
      _Pragma("unroll") for(int d_=0;d_<2;++d_) _Pragma("unroll") for(int r=0;r<16;++r)o[d_][r]*=wsf[crow(r,hi)]; } }while(0)
  f32x16 pA0,pA1,pB0,pB1;
  int sl_prev=0,sl_cur=0,sl_next=SLOTB;
  #define ROT() do{sl_prev=sl_cur;sl_cur=sl_next;sl_next=(sl_next==(NSLOT-1)*SLOTB)?0:sl_next+SLOTB;}while(0)
  DMA_K(2,2*SLOTB);
  WAIT_BAR(3);
  qkt(pA0,pA1,Kbase,qr,negm,r32,hi);asm volatile("s_nop 15\n\ts_nop 7":"+v"(pA0),"+v"(pA1));CMASK(pA0,pA1,0);
  START(pA0,pA1);
  _Pragma("unroll") for(int r=0;r<16;++r)pA1[r]=__builtin_amdgcn_exp2f(pA1[r]);
  WAIT_BAR(0);
  DMA_K(3,0);DMA_V(1,SLOTB);
  ROT();
  kload8(kf,kp0+sl_cur);
  WAIT_BAR(2);
  s16x4 vlo[8],vhi[8]; u32x4 pw0,pw1,pw2,pw3;
  #define PKW(P,B) cvtpk_s(P[B],P[B+1])
  #define PAF(k) __builtin_bit_cast(bf16x8,pw##k)
  #define VFR(i) (bf16x8){vlo[i][0],vlo[i][1],vlo[i][2],vlo[i][3],vhi[i][0],vhi[i][1],vhi[i][2],vhi[i][3]}
  #define PIN(x) asm volatile("":"+v"(x))
  #define MX3(a,b,c) __builtin_fmaxf(__builtin_fmaxf((a),(b)),(c))
  #define GAPA(MF,A0,A1,A2,A3,W0,W1,PW) do{ MF; sacc+=A0; sacc+=A1; sacc+=A2; sacc+=A3; PIN(sacc); W0; W1; PIN(PW); SBAR(); }while(0)
  #define EX(v) __builtin_amdgcn_exp2f(v)
  #define GAPB(MF,X,B) do{ MF; X[B]=EX(X[B]); X[B+1]=EX(X[B+1]); X[B+2]=EX(X[B+2]); X[B+3]=EX(X[B+3]); PIN(X); SBAR(); }while(0)
  #define VRD(i) do{ vlo[i]=vtr(vp_+(((i)>>2)*4096+((i)&3)*1024)); vhi[i]=vtr(vp_+(((i)>>2)*4096+((i)&3)*1024+512)); }while(0)
  #define KRD(G,j) do{ if(G){ kload2(kf,kp0+sl_next,j); SBAR(); } }while(0)
  #define STEP(C0,C1,P0,P1,t,GK,GV,GL) do{ SBAR(); \
    const lds_cptr vp_=vp0+sl_prev; \
    VRD(0); SBAR(); float sacc=(P0[0]+P0[1]); \
    GAPA(C0=__builtin_amdgcn_mfma_f32_32x32x16_bf16(kf[0],qr[0],negm,0,0,0), P0[2],P0[3],P0[4],P0[5],     pw0[0]=PKW(P0,0), pw0[1]=PKW(P0,2), pw0); \
    VRD(4); SBAR(); GAPA(C1=__builtin_amdgcn_mfma_f32_32x32x16_bf16(kf[1],qr[0],negm,0,0,0), P0[6],P0[7],P0[8],P0[9],     pw0[2]=PKW(P0,4), pw0[3]=PKW(P0,6), pw0); \
    VRD(1); SBAR(); GAPA(C0=__builtin_amdgcn_mfma_f32_32x32x16_bf16(kf[2],qr[1],C0,0,0,0),   P0[10],P0[11],P0[12],P0[13], pw1[0]=PKW(P0,8), pw1[1]=PKW(P0,10), pw1); \
    VRD(5); SBAR(); GAPA(C1=__builtin_amdgcn_mfma_f32_32x32x16_bf16(kf[3],qr[1],C1,0,0,0),   P0[14],P0[15],P1[0],P1[1],   pw1[2]=PKW(P0,12),pw1[3]=PKW(P0,14), pw1); \
    VRD(2); SBAR(); GAPA(C0=__builtin_amdgcn_mfma_f32_32x32x16_bf16(kf[4],qr[2],C0,0,0,0),   P1[2],P1[3],P1[4],P1[5],     pw2[0]=PKW(P1,0), pw2[1]=PKW(P1,2), pw2); \
    VRD(6); SBAR(); GAPA(C1=__builtin_amdgcn_mfma_f32_32x32x16_bf16(kf[5],qr[2],C1,0,0,0),   P1[6],P1[7],P1[8],P1[9],     pw2[2]=PKW(P1,4), pw2[3]=PKW(P1,6), pw2); \
    VRD(3); SBAR(); GAPA(C0=__builtin_amdgcn_mfma_f32_32x32x16_bf16(kf[6],qr[3],C0,0,0,0),   P1[10],P1[11],P1[12],P1[13], pw3[0]=PKW(P1,8), pw3[1]=PKW(P1,10), pw3); \
    VRD(7); SBAR(); GAPA(C1=__builtin_amdgcn_mfma_f32_32x32x16_bf16(kf[7],qr[3],C1,0,0,0),   P1[14],P1[15],0.f,0.f,       pw3[2]=PKW(P1,12),pw3[3]=PKW(P1,14), pw3); \
    l_reg+=sacc; \
    if(GK){DMA_K((t)+3,sl_cur);} if(GV){DMA_V((t)+1,sl_next);} \
    CMASK(C0,C1,t); \
    { float a=MX3(C0[0],C0[1],C1[0]),b=MX3(C0[2],C0[3],C1[1]); a=MX3(a,C1[2],C1[3]); \
      _Pragma("unroll") for(int r=4;r<16;r+=4){a=MX3(a,C0[r],C0[r+1]);b=MX3(b,C0[r+2],C0[r+3]);a=MX3(a,C1[r],C1[r+1]);b=MX3(b,C1[r+2],C1[r+3]);} \
      float rm=__builtin_fmaxf(a,b); { auto rr=__builtin_amdgcn_permlane32_swap(__float_as_uint(rm),__float_as_uint(rm),false,false); rm=__builtin_fmaxf(__uint_as_float(rr[0]),__uint_as_float(rr[1])); } \
      resc=false; \
      if(__builtin_expect(__any(rm>(float)THRL),0)){ const float dl=__builtin_fmaxf(rm,0.f); mhat+=dl; \
        _Pragma("unroll") for(int r=0;r<16;++r){C0[r]-=dl;C1[r]-=dl;} \
        _Pragma("unroll") for(int r=0;r<16;++r)negm[r]=-mhat; asm volatile("":"+v"(negm)); \
        const float f=__builtin_amdgcn_exp2f(-dl); l_reg*=f; if(hi==0)wsf[r32]=f; resc=true; } } \
    SBAR(); \
    GAPB(o[0]=__builtin_amdgcn_mfma_f32_32x32x16_bf16(PAF(0),VFR(0),o[0],0,0,0), C0,0); \
    GAPB(o[1]=__builtin_amdgcn_mfma_f32_32x32x16_bf16(PAF(0),VFR(4),o[1],0,0,0), C0,4); \
    KRD(GL,0); GAPB(o[0]=__builtin_amdgcn_mfma_f32_32x32x16_bf16(PAF(1),VFR(1),o[0],0,0,0), C0,8); \
    KRD(GL,1); GAPB(o[1]=__builtin_amdgcn_mfma_f32_32x32x16_bf16(PAF(1),VFR(5),o[1],0,0,0), C0,12); \
    KRD(GL,2); GAPB(o[0]=__builtin_amdgcn_mfma_f32_32x32x16_bf16(PAF(2),VFR(2),o[0],0,0,0), C1,0); \
    KRD(GL,3); GAPB(o[1]=__builtin_amdgcn_mfma_f32_32x32x16_bf16(PAF(2),VFR(6),o[1],0,0,0), C1,4); \
    GAPB(o[0]=__builtin_amdgcn_mfma_f32_32x32x16_bf16(PAF(3),VFR(3),o[0],0,0,0), C1,8); \
    GAPB(o[1]=__builtin_amdgcn_mfma_f32_32x32x16_bf16(PAF(3),VFR(7),o[1],0,0,0), C1,12); \
    }while(0)
  int t=1;
  #undef CMASK
  #define CMASK(P0,P1,t) do{}while(0)
  for(;t+5<NT;t+=2){
    STEP(pB0,pB1,pA0,pA1,t,true,true,true);     WAIT_BAR(2); RESC(); ROT();
    STEP(pA0,pA1,pB0,pB1,t+1,true,true,true);   WAIT_BAR(2); RESC(); ROT();
  }
  #undef CMASK
  #define CMASK(P0,P1,t) do{}while(0)
  #define ENDW(tt) do{ if((tt)+3<NT){WAIT_BAR(2);} else if((tt)+2<NT){WAIT_BAR(1);} else {WAIT_BAR(0);} }while(0)
  for(;t+1<NT;t+=2){
    STEP(pB0,pB1,pA0,pA1,t,(t+3<NT),(t+1<NT),(t+1<NT));       ENDW(t);   RESC(); ROT();
    STEP(pA0,pA1,pB0,pB1,t+1,(t+4<NT),(t+2<NT),(t+2<NT));     ENDW(t+1); RESC(); ROT();
  }
  STEP(pB0,pB1,pA0,pA1,NT-1,false,false,false); RESC();
  { float sacc=pB0[0]+pB0[1]; _Pragma("unroll") for(int r=2;r<16;++r)sacc+=pB0[r]; _Pragma("unroll") for(int r=0;r<16;++r)sacc+=pB1[r]; l_reg+=sacc;
    pw0=(u32x4){PKW(pB0,0),PKW(pB0,2),PKW(pB0,4),PKW(pB0,6)};pw1=(u32x4){PKW(pB0,8),PKW(pB0,10),PKW(pB0,12),PKW(pB0,14)};pw2=(u32x4){PKW(pB1,0),PKW(pB1,2),PKW(pB1,4),PKW(pB1,6)};pw3=(u32x4){PKW(pB1,8),PKW(pB1,10),PKW(pB1,12),PKW(pB1,14)};
    SBAR(); pv(o,vb0+sl_cur,PAF(0),PAF(1),PAF(2),PAF(3)); }
  #undef PKW
  #undef PAF
  #undef VFR
  #undef PIN
  #undef MX3
  #undef GAPA
  #undef GAPB
  #undef EX
  #undef VRD
  #undef KRD
  #undef STEP
  #undef ENDW
  {auto rr=__builtin_amdgcn_permlane32_swap(__float_as_uint(l_reg),__float_as_uint(l_reg),false,false);l_reg=__uint_as_float(rr[0])+__uint_as_float(rr[1]);}
  if(hi==0)wsf[32+r32]=l_reg;asm volatile("s_waitcnt lgkmcnt(0)":::"memory");
  float rli[16];
  #pragma unroll
  for(int r=0;r<16;++r)rli[r]=__builtin_amdgcn_rcpf(wsf[32+crow(r,hi)]);
  bf16*Ow=O+qrow0*QP+h*D;
  { bf16*stg=(bf16*)(shm+LDS_OST)+wid*2048;
    #pragma unroll
    for(int r=0;r<16;++r){const int orow=crow(r,hi);
      #pragma unroll
      for(int d0=0;d0<2;++d0)stg[orow*64+d0*32+r32]=__float2bfloat16(o[d0][r]*rli[r]);}
    asm volatile("s_waitcnt lgkmcnt(0)":::"memory");
    #pragma unroll
    for(int i=0;i<4;++i){const int row=i*8+(lane>>3),ch=lane&7; const u32x4 v=*(const u32x4*)(stg+row*64+ch*8); ATTN_STORE16(Ow+(long)row*QP+ch*8,v);} }
  asm volatile("s_waitcnt lgkmcnt(0)\n\ts_barrier":::"memory");
  #undef DMA_K
  #undef DMA_V
  #undef CMASK
  #undef START
  #undef RESC
  #undef ROT
}
constexpr int ATTN_LDS_BYTES=LDS_BYTES;
struct AttnTensors { const bf16* Q; const bf16* K; const bf16* V; bf16* O; };
struct AttnUnit { int b; int h; int qb; };
struct StaticOrder {
  int vcu;
  __device__ __forceinline__ explicit StaticOrder(int v):vcu(v){}
  __device__ __forceinline__ bool next(int i,AttnUnit&u)const{ if(i>=8)return false; const int xcd=vcu>>5,lc=vcu&31; const int grp=xcd*4+(i>>1); const int idx=(i&1)*32+lc;
    u.b=grp>>1; u.h=(grp&1)*4+(idx>>4); u.qb=idx&15; return true; }
};
struct StaticOrderR {
  int vcu,i0,i1;
  __device__ __forceinline__ StaticOrderR(int v,int a,int b):vcu(v),i0(a),i1(b){}
  __device__ __forceinline__ bool next(int j,AttnUnit&u)const{ const int i=i0+j; if(i>=i1)return false; const int xcd=vcu>>5,lc=vcu&31; const int grp=xcd*4+(i>>1); const int idx=(i&1)*32+lc;
    u.b=grp>>1; u.h=(grp&1)*4+(idx>>4); u.qb=idx&15; return true; }
};
template<class Sched,int THRL=8> __device__ __forceinline__ void attn_phase(char*lds,const AttnTensors&T,const Sched&S,int wave_){
  AttnUnit u;
  for(int i=0;S.next(i,u);++i){ attn_unit<THRL>(u.b,u.h,u.qb,T.Q,T.K,T.V,T.O,lds,wave_); }
}
#undef SBAR
#undef WAIT_BAR
}
#define XB_TMO      128
#define XB_XCNT(j)  (256  + 64 * (j))
#define XB_XSUB(j)  (1280 + 64 * (j))
#define XB_XGEN(j)  (2304 + 64 * (j))
#define XB_TOP      3328
#define XB_TOPGEN   3392
#define XCD_BAR_WORDS 3456
#define XB_SPIN_CAP (1u << 18)

__device__ __forceinline__ unsigned xb_ld(unsigned* p)              { return __hip_atomic_load(p, __ATOMIC_RELAXED, __HIP_MEMORY_SCOPE_AGENT); }
__device__ __forceinline__ unsigned xb_add(unsigned* p, unsigned v) { return __hip_atomic_fetch_add(p, v, __ATOMIC_RELAXED, __HIP_MEMORY_SCOPE_AGENT); }
__device__ __forceinline__ unsigned xb_xcc_id() { return (unsigned)__builtin_amdgcn_s_getreg((3 << 11) | 20) & 0xFu; }
#define XB_SPIN(cond, bar) do { unsigned _sp = 0; while (cond) { __builtin_amdgcn_s_sleep(1); \
    if ((++_sp & 255u) == 0u) { if (xb_ld(&(bar)[XB_TMO])) break; if (_sp > XB_SPIN_CAP) { atomicAdd(&(bar)[XB_TMO], 1u); break; } } } } while (0)

struct XcdBarrier {
    unsigned wv; unsigned* bar; unsigned x;
    volatile LAS unsigned* st;
};

__device__ __forceinline__ XcdBarrier xcd_barrier_post(unsigned* bar, volatile LAS unsigned* st) {
    XcdBarrier b; b.bar = bar; b.x = xb_xcc_id(); b.st = st;
    if (threadIdx.x == 0) (void)xb_add(&bar[XB_XCNT(b.x)], 1u);
    b.wv = (unsigned)__builtin_amdgcn_readfirstlane((int)(threadIdx.x >> 6));
    return b;
}
__device__ __forceinline__ void xcd_barrier_complete(unsigned* bar, unsigned x, unsigned& nloc, unsigned& nx) {
    const unsigned G = gridDim.x * gridDim.y * gridDim.z;
    unsigned sum, cnt, mine, sp = 0u;
    for (;;) {
        sum = 0u; cnt = 0u; mine = 0u;
#pragma unroll
        for (unsigned j = 0; j < 16; ++j) { const unsigned c = xb_ld(&bar[XB_XCNT(j)]); sum += c; cnt += (c > 0u) ? 1u : 0u; mine = (j == x) ? c : mine; }
        if (sum == G) break;
        __builtin_amdgcn_s_sleep(1);
        if ((++sp & 255u) == 0u) { if (xb_ld(&bar[XB_TMO])) break; if (sp > XB_SPIN_CAP) { atomicAdd(&bar[XB_TMO], 1u); break; } }
    }
    nloc = mine > 0u ? mine : 1u; nx = cnt > 0u ? cnt : 1u;
}

__device__ __forceinline__ void xcd_barrier(const XcdBarrier& b) {
    asm volatile("s_waitcnt vmcnt(0)" ::: "memory");
    __syncthreads();
    if (b.wv == 0u && lane_id() == 0) {
        unsigned* bar = b.bar;
        __builtin_amdgcn_s_waitcnt(0);
        unsigned nloc = b.st[0], nx = b.st[1];
        if (nloc == 0u) { xcd_barrier_complete(bar, b.x, nloc, nx); b.st[0] = nloc; b.st[1] = nx; }
        const unsigned old = xb_add(&bar[XB_XSUB(b.x)], 1u);
        const unsigned gen = old / nloc;
        if (old + 1u == (gen + 1u) * nloc) {
            __builtin_amdgcn_fence(__ATOMIC_RELEASE, "agent");
            asm volatile("s_waitcnt vmcnt(0)" ::: "memory");
            const unsigned og = xb_add(&bar[XB_TOP], 1u);
            const unsigned tg = og / nx;
            if (og + 1u == (tg + 1u) * nx) xb_add(&bar[XB_TOPGEN], 1u);
            else XB_SPIN(xb_ld(&bar[XB_TOPGEN]) == tg, bar);
            __builtin_amdgcn_fence(__ATOMIC_ACQUIRE, "agent");
            xb_add(&bar[XB_XGEN(b.x)], 1u);
            asm volatile("s_waitcnt vmcnt(0)" ::: "memory");
        } else {
            XB_SPIN(xb_ld(&bar[XB_XGEN(b.x)]) == gen, bar);
            __builtin_amdgcn_fence(__ATOMIC_ACQUIRE, "agent");
            asm volatile("s_waitcnt vmcnt(0)" ::: "memory");
        }
    }
    __syncthreads();
}


typedef GAS unsigned gu32;
#define RLX_AGENT __ATOMIC_RELAXED, __HIP_MEMORY_SCOPE_AGENT
#define LDS_WAIT() asm volatile("s_waitcnt lgkmcnt(0)" ::: "memory")
#define VM_WAIT() asm volatile("s_waitcnt vmcnt(0)" ::: "memory")
constexpr int N_IN = 34;
enum { I_X = 0, I_C, I_CTX, I_CCTX, I_MODW, I_MODB, I_NORM1, I_WIN, I_QNW, I_KNW, I_CONVW, I_CONVB, I_FW1, I_FB1, I_FW2, I_FB2, I_FW3, I_FB3, I_FW4, I_FFREQ,
       I_HBIAS, I_AONW, I_HONW, I_WOUT, I_NORM2, I_RW, I_RB, I_EG, I_EU, I_ED, I_SG, I_SU, I_SD, I_FNW };
struct Frame {
    LAS unsigned char* lds;
    volatile LAS unsigned* MISC;
    unsigned* ctl;
    int tid, lane, wave, vcu, G;
    float* out; unsigned char* ws;
};
typedef const __attribute__((address_space(4))) char* kargp_t;
__device__ __forceinline__ const float* kin(int i) { kargp_t p = (kargp_t)__builtin_amdgcn_kernarg_segment_ptr(); asm volatile("" : "+s"(p)); return (const float*)*(const GAS float* const __attribute__((address_space(4)))*)(p + 8 * i); }
#define WSP(T, off) ((T*)(F.ws + (off)))

__device__ __forceinline__ void tr_item(const float* W, int ldw, int k0, int n0, bf16_t* WT, int Kd, int drow0, LAS float* scr, int lane) {
#pragma unroll 8
    for (int i = 0; i < 32; ++i) { const int kk = 2 * i + (lane >> 5); scr[kk * 33 + (lane & 31)] = W[(size_t)(k0 + kk) * ldw + n0 + (lane & 31)]; }
    LDS_WAIT(); asm volatile("" ::: "memory");
    const int c = lane & 7;
#pragma unroll
    for (int j = 0; j < 4; ++j) { const int n = (lane >> 3) + 8 * j; const LAS float* s = scr + (8 * c) * 33 + n;
        u32x4 o; o.x = pk2(s[0 * 33], s[1 * 33]); o.y = pk2(s[2 * 33], s[3 * 33]); o.z = pk2(s[4 * 33], s[5 * 33]); o.w = pk2(s[6 * 33], s[7 * 33]);
        *(u32x4*)(WT + (size_t)(drow0 + n) * Kd + k0 + 8 * c) = o; }
    LDS_WAIT(); asm volatile("" ::: "memory");
}
__device__ __forceinline__ unsigned pk4_fp8(float a, float b, float c, float d) { int w = __builtin_amdgcn_cvt_pk_fp8_f32(a, b, 0, false); w = __builtin_amdgcn_cvt_pk_fp8_f32(c, d, w, true); return (unsigned)w; }
__device__ __forceinline__ void tr_item8(const float* W, int ldw, int k0, int n0, unsigned char* WT, int Kd, int drow0, float scl, LAS float* scr, int lane) {
#pragma unroll 8
    for (int i = 0; i < 32; ++i) { const int kk = 2 * i + (lane >> 5); scr[kk * 33 + (lane & 31)] = W[(size_t)(k0 + kk) * ldw + n0 + (lane & 31)]; }
    LDS_WAIT(); asm volatile("" ::: "memory");
    const int c = lane & 7;
#pragma unroll
    for (int j = 0; j < 4; ++j) { const int n = (lane >> 3) + 8 * j; const LAS float* s = scr + (8 * c) * 33 + n;
        u32x2 o; o.x = pk4_fp8(s[0 * 33] * scl, s[1 * 33] * scl, s[2 * 33] * scl, s[3 * 33] * scl); o.y = pk4_fp8(s[4 * 33] * scl, s[5 * 33] * scl, s[6 * 33] * scl, s[7 * 33] * scl);
        *(u32x2*)(WT + (size_t)(drow0 + n) * Kd + k0 + 8 * c) = o; }
    LDS_WAIT(); asm volatile("" ::: "memory");
}
constexpr int IT_FILT = 2048, IT_MODV = 0, IT_ROPE = 1, IT_QKV = 384, IT_WU = 768, IT_WO = 512, IT_WR = 128, IT_SGU = 256, IT_SD = 128, IT_EXP = 256 * 384;
constexpr int IT_TILES = IT_QKV + IT_WU + IT_WO + IT_WR + IT_SGU + IT_SD;
constexpr int XP_TILES = 256 * 48;

template <int NT_> __device__ __forceinline__ void p0_filter_item(Frame& F, int item, LAS float* hsc) {
    const int lane = F.lane; const int t0 = NT_ * item;
    const float* w1 = kin(I_FW1); const float* b1 = kin(I_FB1); const float* w2 = kin(I_FW2); const float* b2 = kin(I_FB2);
    const float* w3 = kin(I_FW3); const float* b3 = kin(I_FB3); const float* w4 = kin(I_FW4); const float fr = kin(I_FFREQ)[lane];
    float h[NT_], a[NT_];
#pragma unroll
    for (int tt = 0; tt < NT_; ++tt) { const int t = t0 + tt; float v = 0.f;
        if (lane == 0) v = (float)t * (1.0f / 4095.0f);
        else if (lane < 33) { const int m = (lane - 1) & 15; const float f = 1e-4f + (float)m * ((15.0f - 1e-4f) / 15.0f);
            float rev = f * ((float)t * (1.0f / 4096.0f)); rev -= floorf(rev); const float ang = 6.283185307179586f * rev;
            v = lane <= 16 ? cosf(ang) : -sinf(ang); }
        h[tt] = v; }
#pragma unroll
    for (int l = 0; l < 3; ++l) { const float* ww = l == 0 ? w1 : l == 1 ? w2 : w3; const float bb = (l == 0 ? b1 : l == 1 ? b2 : b3)[lane];
        float wc[64];
#pragma unroll
        for (int i = 0; i < 64; ++i) wc[i] = (l == 0 && i >= 33) ? 0.f : ww[i * 64 + lane];
#pragma unroll
        for (int tt = 0; tt < NT_; ++tt) a[tt] = bb;
#pragma unroll
        for (int i = 0; i < 64; ++i) { if (l == 0 && i >= 33) break;
#pragma unroll
            for (int tt = 0; tt < NT_; ++tt) a[tt] += __shfl(h[tt], i) * wc[i]; }
#pragma unroll
        for (int tt = 0; tt < NT_; ++tt) h[tt] = sinf(fr * a[tt]); }
#pragma unroll
    for (int tt = 0; tt < NT_; ++tt) hsc[tt * 64 + lane] = h[tt];
    LDS_WAIT(); asm volatile("" ::: "memory");
    bf16_t* KR = WSP(bf16_t, WS_KR);
    const float dmin = logf(1e-2f) / 0.3f, dmax = logf(1e-2f) / 1.5f;
#pragma unroll 1
    for (int q = 0; q < 16; ++q) {
        const int n = lane + 64 * q; float wc[64];
#pragma unroll
        for (int i = 0; i < 64; ++i) wc[i] = w4[i * 1024 + n];
        float o[NT_];
#pragma unroll
        for (int tt = 0; tt < NT_; ++tt) o[tt] = 0.f;
#pragma unroll
        for (int i4 = 0; i4 < 16; ++i4)
#pragma unroll
            for (int tt = 0; tt < NT_; ++tt) { const f32x4 hv = *(const LAS f32x4*)(hsc + tt * 64 + 4 * i4);
                o[tt] += (hv[0] * wc[4 * i4] + hv[1] * wc[4 * i4 + 1]) + (hv[2] * wc[4 * i4 + 2] + hv[3] * wc[4 * i4 + 3]); }
        const int c = n & 511; const bool bwd = n >= 512;
        const float delta = fabsf(dmin + (float)c * ((dmax - dmin) / 511.0f));
#pragma unroll
        for (int tt = 0; tt < NT_; ++tt) { const int t = t0 + tt; const float tl = (float)t * (1.0f / 4095.0f);
            const float val = o[tt] * expf(-tl * delta);
            if (!(bwd && t == 0)) {
#if HYENA_FP8
                ((unsigned char*)KR)[(size_t)c * 8192 + (bwd ? 4096 + t : 4096 - t)] = (unsigned char)(pk4_fp8c(val * 64.0f, 0.f, 0.f, 0.f) & 0xffu);
#else
                KR[(size_t)c * 8192 + (bwd ? 4096 + t : 4096 - t)] = (bf16_t)f2bf(val);
#endif
            } }
    }
}
__device__ __forceinline__ void p0_modv_block(Frame& F, int chunk) {
    const int lane = F.lane, kc = F.wave; const int n0 = 64 * chunk, k0 = 128 * kc;
    LAS float* sv = (LAS float*)(F.lds + RING_OFF + F.wave * 8704);
    LAS float* part = (LAS float*)(F.lds + RING_OFF + 8 * 8704);
    for (int r = 0; r < 17; ++r)
#pragma unroll
        for (int hh = 0; hh < 2; ++hh) { const int kk = lane + 64 * hh; const float v = r < 16 ? kin(I_C)[r * 1024 + k0 + kk] : kin(I_CCTX)[k0 + kk];
            sv[r * 128 + kk] = v / (1.0f + expf(-v)); }
    LDS_WAIT(); asm volatile("" ::: "memory");
    float acc[17];
#pragma unroll
    for (int r = 0; r < 17; ++r) acc[r] = 0.f;
    const float* W = kin(I_MODW) + (size_t)k0 * 6144 + n0 + lane;
    for (int k4 = 0; k4 < 32; ++k4) {
        const float w0 = W[(size_t)(4 * k4 + 0) * 6144], w1 = W[(size_t)(4 * k4 + 1) * 6144], w2 = W[(size_t)(4 * k4 + 2) * 6144], w3 = W[(size_t)(4 * k4 + 3) * 6144];
#pragma unroll
        for (int r = 0; r < 17; ++r) { const f32x4 s = *(const LAS f32x4*)(sv + r * 128 + 4 * k4); acc[r] += (s[0] * w0 + s[1] * w1) + (s[2] * w2 + s[3] * w3); }
    }
#pragma unroll
    for (int r = 0; r < 17; ++r) part[(kc * 17 + r) * 64 + lane] = acc[r];
    __syncthreads();
    if (F.wave == 0) { float* mv = WSP(float, WS_MODV); const float bb = kin(I_MODB)[n0 + lane];
#pragma unroll
        for (int r = 0; r < 17; ++r) { float s = bb;
#pragma unroll
            for (int k = 0; k < 8; ++k) s += part[(k * 17 + r) * 64 + lane];
            mv[r * 6144 + n0 + lane] = s; } }
    __syncthreads();
}
struct XpT { const float* src; unsigned char* dst; int ldw, Kd, which; };
__device__ __forceinline__ XpT xp_params(Frame& F, int ti) {
    XpT p; const int e = ti / 48, q = ti % 48;
    if (q < 32) { const int which = q >> 4, kb = q & 15; p.src = kin(which ? I_EU : I_EG) + (size_t)e * (1024 * 256) + (size_t)(64 * kb) * 256; p.ldw = 256;
        p.dst = WSP(unsigned char, WS_WGU) + (size_t)e * (512 * 1024) + 64 * kb; p.Kd = 1024; p.which = which; }
    else { const int r = q - 32, kb = r & 3, cb = r >> 2; p.src = kin(I_ED) + (size_t)e * (256 * 1024) + (size_t)(64 * kb) * 1024 + 256 * cb; p.ldw = 1024;
        p.dst = WSP(unsigned char, WS_WD) + (size_t)e * (1024 * 256) + (size_t)(256 * cb) * 256 + 64 * kb; p.Kd = 256; p.which = -1; }
    return p;
}
__device__ __forceinline__ void xp_load(const XpT& p, f32x4 (&v)[8], int tid) {
#pragma unroll
    for (int i = 0; i < 8; ++i) { const int g = tid + 512 * i; v[i] = *(const f32x4*)(p.src + (size_t)(g >> 6) * p.ldw + 4 * (g & 63)); }
}
__device__ __forceinline__ void xp_tiles(Frame& F, int quota) {
    constexpr int PK = 65, PLANE = 64 * PK + 2, BUF = 4 * PLANE;
    LAS float* L0 = (LAS float*)(F.lds + RING_OFF);
    const int tid = F.tid;
    f32x4 va[8], vb[8], vc[8]; XpT pa, pb, pc;
    volatile LAS int* qw = (volatile LAS int*)(F.MISC + 16);
    if (tid == 0) { qw[0] = (int)__hip_atomic_fetch_add(F.ctl + CW_TILEQ, 1u, RLX_AGENT); qw[1] = (int)__hip_atomic_fetch_add(F.ctl + CW_TILEQ, 1u, RLX_AGENT); qw[2] = (int)__hip_atomic_fetch_add(F.ctl + CW_TILEQ, 1u, RLX_AGENT); }
    LDS_WAIT(); __syncthreads();
    int ti = qw[0], tn = qw[1], t2 = qw[2], par = 0, ng = 3;
    __syncthreads();
    if (ti < XP_TILES) { pa = xp_params(F, ti); xp_load(pa, va, tid); }
    if (tn < XP_TILES) { pb = xp_params(F, tn); xp_load(pb, vb, tid); }
    while (ti < XP_TILES) {
        const bool hn = tn < XP_TILES, h2 = t2 < XP_TILES;
        if (h2) { pc = xp_params(F, t2); xp_load(pc, vc, tid); }
        if (tid == 0) qw[4 + par] = (h2 && ng < quota) ? (int)__hip_atomic_fetch_add(F.ctl + CW_TILEQ, 1u, RLX_AGENT) : XP_TILES;
        ++ng;
        LAS float* buf = L0 + par * BUF;
#pragma unroll
        for (int i = 0; i < 8; ++i) { const int g = tid + 512 * i; LAS float* d = buf + (g >> 6) * PK + (g & 63);
            d[0] = va[i][0]; d[PLANE] = va[i][1]; d[2 * PLANE] = va[i][2]; d[3 * PLANE] = va[i][3]; }
        LDS_WAIT(); __syncthreads();
        const int t3 = qw[4 + par];
#pragma unroll
        for (int i = 0; i < 4; ++i) { const int pr = tid + 512 * i; const int kc = pr & 7, n = pr >> 3;
            const LAS float* s = buf + (n & 3) * PLANE + (8 * kc) * PK + (n >> 2);
            u32x2 o; o.x = pk4_fp8(s[0] * 32.f, s[PK] * 32.f, s[2 * PK] * 32.f, s[3 * PK] * 32.f); o.y = pk4_fp8(s[4 * PK] * 32.f, s[5 * PK] * 32.f, s[6 * PK] * 32.f, s[7 * PK] * 32.f);
            const int row = pa.which < 0 ? n : 256 * (n >> 7) + 128 * pa.which + (n & 127);
            *(u32x2*)(pa.dst + (size_t)row * pa.Kd + 8 * kc) = o; }
        if (hn) { pa = pb; pb = pc;
#pragma unroll
            for (int i = 0; i < 8; ++i) { va[i] = vb[i]; vb[i] = vc[i]; } }
        ti = tn; tn = t2; t2 = t3; par ^= 1;
    }
    LDS_WAIT(); __syncthreads();
}
__device__ __forceinline__ void p0_prologue(Frame& F) {
    LAS float* scr = (LAS float*)(F.lds + RING_OFF + F.wave * 16384);
    const int gw = F.vcu * NWAVES + F.wave, NGW = F.G * NWAVES; const int lane = F.lane;
    __syncthreads();
    for (int ch = F.vcu; ch < 96; ch += F.G) p0_modv_block(F, ch);
    for (int it = gw; it < IT_FILT; it += NGW) { p0_filter_item<2>(F, it, scr); LDS_WAIT(); }
    if (gw == NGW - 1) { f32x2* rope = WSP(f32x2, WS_ROPE);
        for (int idx = lane; idx < 1024; idx += 64) { const int pos = idx >> 4, f = idx & 15; const float inv = powf(10000.0f, -(float)f / 16.0f); const float ang = (float)pos * inv;
            rope[idx] = (f32x2){cosf(ang), sinf(ang)}; } }
    for (int it = gw; it < IT_TILES; it += NGW) {
        int r = it;
        if (r < IT_QKV) { const int cb = r >> 4, kb = r & 15, n0 = 32 * cb; const int pn = n0 >> 8, hl = (n0 & 255) >> 6, dh = (n0 & 63) >> 5;
            tr_item(kin(I_WIN), 2304, 64 * kb, n0, WSP(bf16_t, WS_WQKV), 1024, 256 * pn + 128 * dh + 32 * hl, scr, lane); continue; } r -= IT_QKV;
        if (r < IT_WU) { const int cb = r >> 4, kb = r & 15; tr_item8(kin(I_WIN), 2304, 64 * kb, 768 + 32 * cb, WSP(unsigned char, WS_WU), 1024, 32 * cb, 32.0f, scr, lane); continue; } r -= IT_WU;
        if (r < IT_WO) { const int cb = r >> 4, kb = r & 15; tr_item(kin(I_WOUT), 1024, 64 * kb, 32 * cb, WSP(bf16_t, WS_WO), 1024, 32 * cb, scr, lane); continue; } r -= IT_WO;
        if (r < IT_WR) { const int cb = r >> 4, kb = r & 15; tr_item(kin(I_RW), 256, 64 * kb, 32 * cb, WSP(bf16_t, WS_WR), 1024, 32 * cb, scr, lane); continue; } r -= IT_WR;
        if (r < IT_SGU) { const int which = r >> 7, rr = r & 127, cb = rr >> 4, kb = rr & 15, j0 = 32 * cb;
            tr_item8(kin(which ? I_SU : I_SG), 256, 64 * kb, j0, WSP(unsigned char, WS_WSGU8), 1024, 256 * (j0 >> 7) + 128 * which + (j0 & 127), 32.0f, scr, lane); continue; } r -= IT_SGU;
        if (r < IT_SD) { const int kb = r & 3, cb = r >> 2; tr_item8(kin(I_SD), 1024, 64 * kb, 32 * cb, WSP(unsigned char, WS_WSD), 256, 32 * cb, 32.0f, scr, lane); continue; } r -= IT_SD;
    }
    __syncthreads();
}

template <int NR, bool F8> __device__ __forceinline__ void modulate_group(Frame& F, const float* src, bf16_t* dst, unsigned char* dst8, int row, const f32x4 (&A)[4], const f32x4 (&Bv)[4]) {
    const f32x4* xr = (const f32x4*)(src + (size_t)row * DM) + F.lane;
    f32x4 v[NR][4]; float ss[NR];
#pragma unroll
    for (int q = 0; q < NR; ++q)
#pragma unroll
        for (int j = 0; j < 4; ++j) v[q][j] = xr[q * (DM / 4) + 64 * j];
#pragma unroll
    for (int q = 0; q < NR; ++q) { float a = 0.f;
#pragma unroll
        for (int j = 0; j < 4; ++j) a += (v[q][j][0] * v[q][j][0] + v[q][j][1] * v[q][j][1]) + (v[q][j][2] * v[q][j][2] + v[q][j][3] * v[q][j][3]);
        ss[q] = a; }
#pragma unroll
    for (int o = 1; o < 64; o <<= 1) {
#pragma unroll
        for (int q = 0; q < NR; ++q) ss[q] += __shfl_xor(ss[q], o); }
#pragma unroll
    for (int q = 0; q < NR; ++q) { const float rs = rsqrtf(ss[q] * (1.0f / DM) + EPS);
        u32x2* o8 = (u32x2*)(dst + (size_t)(row + q) * DM) + F.lane;
#pragma unroll
        for (int j = 0; j < 4; ++j) { const f32x4 o = v[q][j] * rs * A[j] + Bv[j]; u32x2 w; w.x = pk2(o[0], o[1]); w.y = pk2(o[2], o[3]); o8[64 * j] = w;
            if (F8) ((unsigned*)(dst8 + (size_t)(row + q) * DM))[F.lane + 64 * j] = pk4_fp8c(o[0] * 8.0f, o[1] * 8.0f, o[2] * 8.0f, o[3] * 8.0f); } }
}
template <bool F8 = false> __device__ __forceinline__ void modulate_rows(Frame& F, const float* src, bf16_t* dst, int row0, int nrows, const float* nw, const float* sc, const float* sh, unsigned char* dst8 = nullptr) {
    f32x4 A[4], Bv[4];
#pragma unroll
    for (int j = 0; j < 4; ++j) { const int c = 4 * F.lane + 256 * j; const f32x4 n4 = *(const f32x4*)(nw + c), s4 = *(const f32x4*)(sc + c); A[j] = n4 * (s4 + 1.0f); Bv[j] = *(const f32x4*)(sh + c); }
    int r = 0;
    for (; r + 4 <= nrows; r += 4) modulate_group<4, F8>(F, src, dst, dst8, row0 + r, A, Bv);
    if (r + 2 <= nrows) modulate_group<2, F8>(F, src, dst, dst8, row0 + r, A, Bv);
}

constexpr unsigned HY_SK_PACKED = 0xCB885410u;
__device__ __forceinline__ void hyena_unit(Frame& F, int c) {
    const int tid = F.tid, lane = F.lane, wid = F.wave;
    LAS unsigned char* Lc = F.lds + RING_OFF;
    const bf16_t* UT = WSP(const bf16_t, WS_UT);
    bf16_t* Wg = WSP(bf16_t, WS_HYW) + (size_t)c * MTOK;
    bf16_t* Xg = WSP(bf16_t, WS_HYX) + (size_t)c * MTOK;
    {
        const u32x4* src = (const u32x4*)(WSP(const bf16_t, WS_KR) + (size_t)c * 8192);
#pragma unroll
        for (int i = 0; i < 2; ++i) { const int jc = tid + 512 * i; const u32x4 lo = src[jc]; const u32x4 hi = jc < 1023 ? src[jc + 1] : (u32x4){0u, 0u, 0u, 0u};
            const unsigned w[8] = {lo.x, lo.y, lo.z, lo.w, hi.x, hi.y, hi.z, hi.w};
#pragma unroll
            for (int cc = 0; cc < 8; ++cc) { u32x4 o;
#pragma unroll
                for (int k = 0; k < 4; ++k) { const int idx = (cc >> 1) + k; o[k] = (cc & 1) ? __builtin_amdgcn_alignbyte(w[idx + 1], w[idx], 2u) : w[idx]; }
                *(LAS u32x4*)(Lc + cc * 16384 + 16 * ((HY_SK_PACKED >> (4 * cc)) & 15u) + 16 * jc) = o; } }
    }
    const float* cw = kin(I_CONVW); const float* cb = kin(I_CONVB);
    {
        const bf16_t* vrow = UT + (size_t)(1024 + c) * MTOK; const bf16_t* x1row = UT + (size_t)(512 + c) * MTOK; const bf16_t* x0row = UT + (size_t)c * MTOK;
        const float v0 = cw[1024 + c], v1 = cw[1536 + 1024 + c], v2 = cw[3072 + 1024 + c], vb = cb[1024 + c];
        const float a0 = cw[512 + c], a1 = cw[1536 + 512 + c], a2 = cw[3072 + 512 + c], ab = cb[512 + c];
        const float g0 = cw[c], g1 = cw[1536 + c], g2 = cw[3072 + c], gb = cb[c];
        const int s0 = tid * 8;
#pragma unroll 4
        for (int it = 0; it < 16; ++it) {
            const size_t base = (size_t)it * SEQ + s0;
            const u32x4 vv = *(const u32x4*)(vrow + base), xx = *(const u32x4*)(x1row + base), gg = *(const u32x4*)(x0row + base);
            float ve[10], xe[10], ge[10];
            ve[0] = s0 > 0 ? bf2f(vrow[base - 1]) : 0.f; xe[0] = s0 > 0 ? bf2f(x1row[base - 1]) : 0.f; ge[0] = s0 > 0 ? bf2f(x0row[base - 1]) : 0.f;
            ve[9] = s0 + 8 < SEQ ? bf2f(vrow[base + 8]) : 0.f; xe[9] = s0 + 8 < SEQ ? bf2f(x1row[base + 8]) : 0.f; ge[9] = s0 + 8 < SEQ ? bf2f(x0row[base + 8]) : 0.f;
#pragma unroll
            for (int j = 0; j < 4; ++j) { ve[1 + 2 * j] = bf2f(vv[j] & 0xffffu); ve[2 + 2 * j] = bf2f(vv[j] >> 16); xe[1 + 2 * j] = bf2f(xx[j] & 0xffffu); xe[2 + 2 * j] = bf2f(xx[j] >> 16);
                ge[1 + 2 * j] = bf2f(gg[j] & 0xffffu); ge[2 + 2 * j] = bf2f(gg[j] >> 16); }
            float w[8], g[8];
#pragma unroll
            for (int j = 0; j < 8; ++j) { w[j] = (v0 * ve[j] + v1 * ve[j + 1] + v2 * ve[j + 2] + vb) * (a0 * xe[j] + a1 * xe[j + 1] + a2 * xe[j + 2] + ab); g[j] = g0 * ge[j] + g1 * ge[j + 1] + g2 * ge[j + 2] + gb; }
            u32x4 o; o.x = pk2(w[0], w[1]); o.y = pk2(w[2], w[3]); o.z = pk2(w[4], w[5]); o.w = pk2(w[6], w[7]);
            *(u32x4*)(Wg + (size_t)(tid * 16 + it) * 8) = o;
            u32x4 p; p.x = pk2(g[0], g[1]); p.y = pk2(g[2], g[3]); p.z = pk2(g[4], g[5]); p.w = pk2(g[6], g[7]);
            *(u32x4*)(Xg + base) = p;
        }
    }
    VM_WAIT(); __syncthreads();
    const float hb = kin(I_HBIAS)[c];
    bf16_t* yrow = WSP(bf16_t, WS_YT) + (size_t)c * MTOK;
    const int li = lane & 15, lg = lane >> 4;
#pragma unroll 1
    for (int pass = 0; pass < 2; ++pass) {
        const int T0 = (pass * 8 + wid) * 256;
        f32x4 acc[16]; bf16x8 AF[16], Bf[8];
#pragma unroll
        for (int q = 0; q < 16; ++q) acc[q] = (f32x4){0.f, 0.f, 0.f, 0.f};
        const int xbase = 4096 - T0 - li + 8 * lg; const int cl = xbase & 7;
        const LAS unsigned char* pA = Lc + cl * 16384 + 16 * (int)((HY_SK_PACKED >> (4 * cl)) & 15u) + 2 * (xbase - cl);
        const bf16x8* Bg = (const bf16x8*)Wg + lg * 16 + li;
#define HY_LOADA(dst, q) dst = *(const LAS bf16x8*)(pA - 32 * (q))
#pragma unroll
        for (int q = 0; q < 16; ++q) HY_LOADA(AF[q], q);
#pragma unroll
        for (int v = 0; v < 8; ++v) Bf[v] = Bg[64 * v];
#pragma unroll 1
        for (int S8 = 0; S8 < 128; S8 += 8) {
#pragma unroll
            for (int v = 0; v < 8; ++v) { const int S = S8 + v;
#pragma unroll
                for (int tau = 15; tau >= 0; --tau) acc[tau] = __builtin_amdgcn_mfma_f32_16x16x32_bf16(AF[(tau - 2 * v) & 15], Bf[v], acc[tau], 0, 0, 0);
                if (S + 8 < 128) Bf[v] = Bg[64 * (S + 8)];
                if (S + 1 < 128) { HY_LOADA(AF[(-2 * (v + 1)) & 15], -2 * (S + 1)); HY_LOADA(AF[(-2 * (v + 1) + 1) & 15], -2 * (S + 1) + 1); }
            }
        }
#undef HY_LOADA
        u32x2 wv[16], xv[16];
#pragma unroll
        for (int tau = 0; tau < 16; ++tau) { const int t = T0 + 16 * tau + 4 * lg;
            wv[tau] = *(const u32x2*)(Wg + (size_t)((t >> 3) * 16 + li) * 8 + (t & 7)); xv[tau] = *(const u32x2*)(Xg + (size_t)li * SEQ + t); }
#pragma unroll
        for (int tau = 0; tau < 16; ++tau) { const int t = T0 + 16 * tau + 4 * lg;
            const float we[4] = {bf2f(wv[tau].x & 0xffffu), bf2f(wv[tau].x >> 16), bf2f(wv[tau].y & 0xffffu), bf2f(wv[tau].y >> 16)};
            const float xe[4] = {bf2f(xv[tau].x & 0xffffu), bf2f(xv[tau].x >> 16), bf2f(xv[tau].y & 0xffffu), bf2f(xv[tau].y >> 16)};
            float z[4];
#pragma unroll
            for (int j = 0; j < 4; ++j) z[j] = (acc[tau][j] + hb * we[j]) * xe[j];
            u32x2 o; o.x = pk2(z[0], z[1]); o.y = pk2(z[2], z[3]); *(u32x2*)(yrow + (size_t)li * SEQ + t) = o; }
    }
    __syncthreads();
}

constexpr unsigned long long HY8_SK = 0xea6eda965212d950ull; constexpr int HY8_STR = 8448;
__device__ __forceinline__ void hyena_unit8(Frame& F, int c) {
    int tid_ = F.tid; asm volatile("" : "+v"(tid_));
    const int tid = tid_, lane = tid & 63, wid = F.wave;
    LAS unsigned char* Lc = F.lds + RING_OFF;
    const bf16_t* UT = WSP(const bf16_t, WS_UT);
    unsigned char* W8 = WSP(unsigned char, WS_HYW) + (size_t)c * MTOK;
    bf16_t* Xg = WSP(bf16_t, WS_HYX) + (size_t)c * MTOK;
    {
        const u32x4* src = (const u32x4*)(WSP(const unsigned char, WS_KR) + (size_t)c * 8192);
        const u32x4 lo = src[tid]; const u32x4 hi = tid < 511 ? src[tid + 1] : (u32x4){0u, 0u, 0u, 0u};
        const unsigned w[8] = {lo.x, lo.y, lo.z, lo.w, hi.x, hi.y, hi.z, hi.w};
#pragma unroll
        for (int sh = 0; sh < 16; ++sh) { u32x4 o;
#pragma unroll
            for (int k = 0; k < 4; ++k) { const int idx = (sh >> 2) + k; o[k] = (sh & 3) ? __builtin_amdgcn_alignbyte(w[idx + 1], w[idx], (unsigned)(sh & 3)) : w[idx]; }
            *(LAS u32x4*)(Lc + sh * HY8_STR + 16 * (int)((HY8_SK >> (4 * sh)) & 15ull) + 16 * tid) = o; }
    }
    const float* cw = kin(I_CONVW); const float* cb = kin(I_CONVB);
    {
        const bf16_t* vrow = UT + (size_t)(1024 + c) * MTOK; const bf16_t* x1row = UT + (size_t)(512 + c) * MTOK; const bf16_t* x0row = UT + (size_t)c * MTOK;
        const float v0 = cw[1024 + c], v1 = cw[1536 + 1024 + c], v2 = cw[3072 + 1024 + c], vb = cb[1024 + c];
        const float a0 = cw[512 + c], a1 = cw[1536 + 512 + c], a2 = cw[3072 + 512 + c], ab = cb[512 + c];
        const float g0 = cw[c], g1 = cw[1536 + c], g2 = cw[3072 + c], gb = cb[c];
        const int s0 = tid * 8;
#pragma unroll 4
        for (int it = 0; it < 16; ++it) {
            const size_t base = (size_t)it * SEQ + s0;
            const u32x4 vv = *(const u32x4*)(vrow + base), xx = *(const u32x4*)(x1row + base), gg = *(const u32x4*)(x0row + base);
            float ve[10], xe[10], ge[10];
            ve[0] = s0 > 0 ? bf2f(vrow[base - 1]) : 0.f; xe[0] = s0 > 0 ? bf2f(x1row[base - 1]) : 0.f; ge[0] = s0 > 0 ? bf2f(x0row[base - 1]) : 0.f;
            ve[9] = s0 + 8 < SEQ ? bf2f(vrow[base + 8]) : 0.f; xe[9] = s0 + 8 < SEQ ? bf2f(x1row[base + 8]) : 0.f; ge[9] = s0 + 8 < SEQ ? bf2f(x0row[base + 8]) : 0.f;
#pragma unroll
            for (int j = 0; j < 4; ++j) { ve[1 + 2 * j] = bf2f(vv[j] & 0xffffu); ve[2 + 2 * j] = bf2f(vv[j] >> 16); xe[1 + 2 * j] = bf2f(xx[j] & 0xffffu); xe[2 + 2 * j] = bf2f(xx[j] >> 16);
                ge[1 + 2 * j] = bf2f(gg[j] & 0xffffu); ge[2 + 2 * j] = bf2f(gg[j] >> 16); }
            float w[8], g[8];
#pragma unroll
            for (int j = 0; j < 8; ++j) { w[j] = 8.0f * (v0 * ve[j] + v1 * ve[j + 1] + v2 * ve[j + 2] + vb) * (a0 * xe[j] + a1 * xe[j + 1] + a2 * xe[j + 2] + ab); g[j] = g0 * ge[j] + g1 * ge[j + 1] + g2 * ge[j + 2] + gb; }
            u32x2 o; o.x = pk4_fp8c(w[0], w[1], w[2], w[3]); o.y = pk4_fp8c(w[4], w[5], w[6], w[7]);
            *(u32x2*)(W8 + (size_t)((tid >> 2) * 16 + it) * 32 + (tid & 3) * 8) = o;
            u32x4 p; p.x = pk2(g[0], g[1]); p.y = pk2(g[2], g[3]); p.z = pk2(g[4], g[5]); p.w = pk2(g[6], g[7]);
            *(u32x4*)(Xg + base) = p;
        }
    }
    VM_WAIT(); __syncthreads();
    const float hb = kin(I_HBIAS)[c];
    bf16_t* yrow = WSP(bf16_t, WS_YT) + (size_t)c * MTOK;
    const int li = lane & 15, lg = lane >> 4;
#pragma unroll 1
    for (int pass = 0; pass < 2; ++pass) {
        const int T0 = (pass * 8 + wid) * 256;
        f32x4 acc[16]; pg8::v8i AF[16], Bf[2];
#pragma unroll
        for (int q = 0; q < 16; ++q) { acc[q] = (f32x4){0.f, 0.f, 0.f, 0.f}; asm volatile("" : "+v"(acc[q])); }
        const int x00 = 4096 - T0 - li + 32 * lg; const int cl = x00 & 15;
        const LAS unsigned char* pA = Lc + cl * HY8_STR + 16 * (int)((HY8_SK >> (4 * cl)) & 15ull) + (x00 - cl);
        const u32x4* Bg = (const u32x4*)W8 + (lg * 16 + li) * 2;
#define HY8_LOADA(dst, q) do { const LAS unsigned char* p_ = pA - 16 * (q); dst = pg8::cat8(*(const LAS bf16x8*)p_, *(const LAS bf16x8*)(p_ + 16)); } while (0)
#define HY8_LOADB(dst, S_) do { const u32x4 b0_ = Bg[128 * (S_)], b1_ = Bg[128 * (S_) + 1]; dst = pg8::cat8(__builtin_bit_cast(bf16x8, b0_), __builtin_bit_cast(bf16x8, b1_)); } while (0)
#pragma unroll
        for (int q = 0; q < 16; ++q) HY8_LOADA(AF[q], q);
#pragma unroll
        for (int v = 0; v < 2; ++v) HY8_LOADB(Bf[v], v);
#pragma unroll 1
        for (int S4 = 0; S4 < 32; S4 += 2) {
#pragma unroll
            for (int v = 0; v < 2; ++v) { const int S = S4 + v; const int p = v & 1;
                asm volatile("s_waitcnt lgkmcnt(0)\n\ts_nop 4" ::: "memory");
#pragma unroll
                for (int tau = 15; tau >= 0; --tau) pg8::mfma_fp8(acc[tau], AF[(tau - 8 * p) & 15], Bf[v]);
                if (S + 2 < 32) HY8_LOADB(Bf[v], S + 2);
                if (S + 1 < 32) {
#pragma unroll
                    for (int i = 0; i < 8; ++i) HY8_LOADA(AF[(i + 8 * (1 - p)) & 15], i - 8 * (S + 1)); }
            }
            asm volatile("s_nop 15\n\ts_nop 7" : "+v"(acc[0]), "+v"(acc[1]), "+v"(acc[2]), "+v"(acc[3]), "+v"(acc[4]), "+v"(acc[5]), "+v"(acc[6]), "+v"(acc[7]),
                         "+v"(acc[8]), "+v"(acc[9]), "+v"(acc[10]), "+v"(acc[11]), "+v"(acc[12]), "+v"(acc[13]), "+v"(acc[14]), "+v"(acc[15]));
        }
#undef HY8_LOADA
#undef HY8_LOADB
        asm volatile("s_nop 15\n\ts_nop 15" : "+v"(acc[0]), "+v"(acc[1]), "+v"(acc[2]), "+v"(acc[3]), "+v"(acc[4]), "+v"(acc[5]), "+v"(acc[6]), "+v"(acc[7]),
                     "+v"(acc[8]), "+v"(acc[9]), "+v"(acc[10]), "+v"(acc[11]), "+v"(acc[12]), "+v"(acc[13]), "+v"(acc[14]), "+v"(acc[15]) :: "memory");
        unsigned wv[16]; u32x2 xv[16];
#pragma unroll
        for (int tau = 0; tau < 16; ++tau) { const int t = T0 + 16 * tau + 4 * lg;
            wv[tau] = *(const unsigned*)(W8 + (size_t)((t >> 5) * 16 + li) * 32 + (t & 31)); xv[tau] = *(const u32x2*)(Xg + (size_t)li * SEQ + t); }
#pragma unroll
        for (int tau = 0; tau < 16; ++tau) { const int t = T0 + 16 * tau + 4 * lg;
            const f32x2 wlo = __builtin_amdgcn_cvt_pk_f32_fp8((int)wv[tau], false), whi = __builtin_amdgcn_cvt_pk_f32_fp8((int)wv[tau], true);
            const float we[4] = {wlo[0] * 0.125f, wlo[1] * 0.125f, whi[0] * 0.125f, whi[1] * 0.125f};
            const float xe[4] = {bf2f(xv[tau].x & 0xffffu), bf2f(xv[tau].x >> 16), bf2f(xv[tau].y & 0xffffu), bf2f(xv[tau].y >> 16)};
            float z[4];
#pragma unroll
            for (int j = 0; j < 4; ++j) z[j] = (acc[tau][j] * (1.0f / 512.0f) + hb * we[j]) * xe[j];
            u32x2 o; o.x = pk2(z[0], z[1]); o.y = pk2(z[2], z[3]); *(u32x2*)(yrow + (size_t)li * SEQ + t) = o; }
    }
    __syncthreads();
}

__device__ __forceinline__ void p4_norm_tile(Frame& F, int it) {
    const int lane = F.lane, wid = F.wave, tid = F.tid; const int m0 = it * 64;
    bf16_t* AY = WSP(bf16_t, WS_AY); const bf16_t* A = WSP(const bf16_t, WS_AO); const bf16_t* YT = WSP(const bf16_t, WS_YT);
    constexpr int TP = 520;
    LAS bf16_t* T2 = (LAS bf16_t*)(F.lds + RING_OFF);
    {
        const u32x4* src = (const u32x4*)(YT + (size_t)tid * MTOK + m0);
#pragma unroll
        for (int i = 0; i < 8; ++i) { const u32x4 v = src[i];
#pragma unroll
            for (int j = 0; j < 4; ++j) { T2[(8 * i + 2 * j) * TP + tid] = (bf16_t)(v[j] & 0xffffu); T2[(8 * i + 2 * j + 1) * TP + tid] = (bf16_t)(v[j] >> 16); } }
    }
#define P4_ROWS8(LOADV, GAIN, DSTCOL) do { const float* gw_ = (GAIN) + 8 * lane; const f32x4 g0 = *(const f32x4*)gw_, g1 = *(const f32x4*)(gw_ + 4); \
        u32x4 v_[8]; float ss_[8]; \
        _Pragma("unroll") for (int r = 0; r < 8; ++r) v_[r] = LOADV(r); \
        _Pragma("unroll") for (int r = 0; r < 8; ++r) { float a_ = 0.f; _Pragma("unroll") for (int j = 0; j < 4; ++j) { const float lo_ = bf2f(v_[r][j] & 0xffffu), hi_ = bf2f(v_[r][j] >> 16); a_ += lo_ * lo_ + hi_ * hi_; } ss_[r] = a_; } \
        _Pragma("unroll") for (int o = 1; o < 64; o <<= 1) { _Pragma("unroll") for (int r = 0; r < 8; ++r) ss_[r] += __shfl_xor(ss_[r], o); } \
        _Pragma("unroll") for (int r = 0; r < 8; ++r) { const float rs = rsqrtf(ss_[r] * (1.0f / 512.0f) + EPS); float e[8]; \
            _Pragma("unroll") for (int j = 0; j < 4; ++j) { e[2 * j] = bf2f(v_[r][j] & 0xffffu); e[2 * j + 1] = bf2f(v_[r][j] >> 16); } \
            u32x4 o; o.x = pk2(e[0] * rs * g0[0], e[1] * rs * g0[1]); o.y = pk2(e[2] * rs * g0[2], e[3] * rs * g0[3]); o.z = pk2(e[4] * rs * g1[0], e[5] * rs * g1[1]); o.w = pk2(e[6] * rs * g1[2], e[7] * rs * g1[3]); \
            *(u32x4*)(AY + (size_t)(m0 + wid * 8 + r) * DM + (DSTCOL) + 8 * lane) = o; } } while (0)
#define P4_LOAD_A(r) (*(const u32x4*)(A + (size_t)(m0 + wid * 8 + (r)) * AW + 8 * lane))
#define P4_LOAD_T(r) (*(const LAS u32x4*)(T2 + (wid * 8 + (r)) * TP + 8 * lane))
    P4_ROWS8(P4_LOAD_A, kin(I_AONW), 0);
    __syncthreads();
    P4_ROWS8(P4_LOAD_T, kin(I_HONW), 512);
#undef P4_ROWS8
#undef P4_LOAD_A
#undef P4_LOAD_T
    __syncthreads();
}


#define DPPF(x, ctrl) __builtin_bit_cast(float, __builtin_amdgcn_mov_dpp(__builtin_bit_cast(int, (x)), (ctrl), 0xf, 0xf, true))
#define DPPI(x, ctrl) __builtin_amdgcn_mov_dpp((x), (ctrl), 0xf, 0xf, true)
struct RouteSel { int ea, eb; unsigned wa, wb, la, lb; };
__device__ __forceinline__ void p8_route16(Frame& F, int t0, RouteSel& R, LAS unsigned* lcnt) {
    const int lane = F.lane; const int j = lane & 3; const int t = t0 + (lane >> 2);
    const f32x4* lg = (const f32x4*)(WSP(const float, WS_LOGIT) + (size_t)t * NE + 64 * j);
    const f32x4* rbp = (const f32x4*)(kin(I_RB) + 64 * j);
    float b[64];
#pragma unroll
    for (int i = 0; i < 16; ++i) { const f32x4 v = lg[i], rb = rbp[i];
#pragma unroll
        for (int c = 0; c < 4; ++c) b[4 * i + c] = __builtin_amdgcn_rcpf(1.0f + __builtin_amdgcn_exp2f(-1.4426950408889634f * v[c])) + rb[c]; }
    float gsc[2];
#pragma unroll
    for (int g = 0; g < 2; ++g) { float a1 = fmaxf(b[32 * g], b[32 * g + 1]), a2 = fminf(b[32 * g], b[32 * g + 1]);
#pragma unroll
        for (int i = 2; i < 32; ++i) { const float x = b[32 * g + i]; a2 = fmaxf(a2, fminf(a1, x)); a1 = fmaxf(a1, x); }
        gsc[g] = a1 + a2; }
    float G[8];
    G[0] = DPPF(gsc[0], 0x00); G[1] = DPPF(gsc[1], 0x00); G[2] = DPPF(gsc[0], 0x55); G[3] = DPPF(gsc[1], 0x55);
    G[4] = DPPF(gsc[0], 0xAA); G[5] = DPPF(gsc[1], 0xAA); G[6] = DPPF(gsc[0], 0xFF); G[7] = DPPF(gsc[1], 0xFF);
#pragma unroll
    for (int g = 0; g < 2; ++g) { const int gid = 2 * j + g; int rank = 0;
#pragma unroll
        for (int h = 0; h < 8; ++h) rank += (G[h] > gsc[g] || (G[h] == gsc[g] && h < gid)) ? 1 : 0;
        if (rank >= 4) {
#pragma unroll
            for (int i = 0; i < 32; ++i) b[32 * g + i] = -INFINITY; } }
    unsigned key[64];
#pragma unroll
    for (int i = 0; i < 64; ++i) key[i] = b[i] == -INFINITY ? 0u : ((__builtin_bit_cast(unsigned, b[i] + 2.0f) & ~63u) | (unsigned)(63 - i));
    float lv[8]; int li[8];
#pragma unroll
    for (int r = 0; r < 8; ++r) { unsigned mx = key[0];
#pragma unroll
        for (int i = 1; i < 64; i += 2) { const unsigned a_ = key[i], b_ = i + 1 < 64 ? key[i + 1] : 0u; const unsigned m_ = a_ > b_ ? a_ : b_; mx = mx > m_ ? mx : m_; }
        lv[r] = mx ? __builtin_bit_cast(float, mx & ~63u) - 2.0f : -INFINITY; li[r] = mx ? 64 * j + 63 - (int)(mx & 63u) : 0x7ffffff0 + j;
#pragma unroll
        for (int i = 0; i < 64; ++i) key[i] = key[i] == mx ? 0u : key[i]; }
    int se[8]; float sv[8];
#pragma unroll
    for (int r = 0; r < 8; ++r) { float hv = lv[0]; int hi = li[0];
        { const float ov = DPPF(hv, 0xB1); const int oi = DPPI(hi, 0xB1); if (ov > hv || (ov == hv && oi < hi)) { hv = ov; hi = oi; } }
        { const float ov = DPPF(hv, 0x4E); const int oi = DPPI(hi, 0x4E); if (ov > hv || (ov == hv && oi < hi)) { hv = ov; hi = oi; } }
        se[r] = hi; sv[r] = hv;
        if (hi == li[0]) {
#pragma unroll
            for (int k = 0; k < 7; ++k) { lv[k] = lv[k + 1]; li[k] = li[k + 1]; }
            lv[7] = -INFINITY; li[7] = 0x7fffffff; } }
    const float* rbias = kin(I_RB); float wsum = 0.f;
#pragma unroll
    for (int r = 0; r < 8; ++r) { sv[r] -= rbias[se[r]]; wsum += sv[r]; }
    const float inv = 2.5f / wsum;
    const int ea = j == 0 ? se[0] : j == 1 ? se[2] : j == 2 ? se[4] : se[6], eb = j == 0 ? se[1] : j == 1 ? se[3] : j == 2 ? se[5] : se[7];
    const float wa = (j == 0 ? sv[0] : j == 1 ? sv[2] : j == 2 ? sv[4] : sv[6]) * inv, wb = (j == 0 ? sv[1] : j == 1 ? sv[3] : j == 2 ? sv[5] : sv[7]) * inv;
    R.ea = ea; R.eb = eb; R.wa = f2bf(wa); R.wb = f2bf(wb);
    R.la = __hip_atomic_fetch_add(lcnt + ea, 1u, __ATOMIC_RELAXED, __HIP_MEMORY_SCOPE_WORKGROUP); R.lb = __hip_atomic_fetch_add(lcnt + eb, 1u, __ATOMIC_RELAXED, __HIP_MEMORY_SCOPE_WORKGROUP);
}
__device__ __forceinline__ void route_commit(Frame& F, int t0, const RouteSel& R, const LAS unsigned* lbase) {
    const int lane = F.lane; const int j = lane & 3; const int t = t0 + (lane >> 2);
    unsigned* list = WSP(unsigned, WS_LIST); unsigned* asg = WSP(unsigned, WS_ASSIGN) + (size_t)t * 8 + 2 * j;
    const unsigned ra = lbase[R.ea] + R.la, rb2 = lbase[R.eb] + R.lb;
    list[(size_t)R.ea * 65536 + ra] = ((unsigned)t << 16) | R.wa; list[(size_t)R.eb * 65536 + rb2] = ((unsigned)t << 16) | R.wb;
    asg[0] = ((unsigned)R.ea << 16) | ra; asg[1] = ((unsigned)R.eb << 16) | rb2;
    if (j == 0) list[(size_t)256 * 65536 + t] = ((unsigned)t << 16) | 0x3F80u;
}
#undef DPPF
#undef DPPI

__device__ __forceinline__ MoeTab moe_tables(Frame& F) {
    LAS int* tp = (LAS int*)(F.lds + AUX_OFF + AUX_TP); LAS int* cnt = (LAS int*)(F.lds + AUX_OFF + AUX_CNT); LAS unsigned short* t2e = (LAS unsigned short*)(F.lds + AUX_OFF + AUX_T2E);
    __syncthreads();
    if (F.tid < 257) cnt[F.tid] = F.tid < 256 ? (int)__hip_atomic_load(F.ctl + CW_CNT + 32 * F.tid, RLX_AGENT) : MTOK;
    __syncthreads();
    if (F.tid < 258) { int run = 0; for (int j = 0; j < F.tid && j < 257; ++j) run += (cnt[j] + 255) >> 8; tp[F.tid] = run; }
    __syncthreads();
    if (F.tid < 257) { const int t0 = tp[F.tid], t1 = tp[F.tid + 1]; for (int T = t0; T < t1; ++T) t2e[T] = (unsigned short)F.tid; }
    __syncthreads();
    MoeTab t; t.tp = tp; t.cnt = cnt; t.t2e = t2e; return t;
}

__device__ __forceinline__ void down_phase(Frame& F, const MoeTab& tab) {
    using namespace pg8;
    int tid_ = F.wave * 64 + lane_id(); asm volatile("" : "+v"(tid_));
    const int tid = tid_, wid = F.wave, lane = tid & 63, wq = wid, fr = lane & 15, fq = lane >> 4;
    LAS unsigned char* lds = F.lds + RING_OFF;
    const unsigned char* ACT = WSP(const unsigned char, WS_ACT); const unsigned char* WD = WSP(const unsigned char, WS_WD); const unsigned char* WSD = WSP(const unsigned char, WS_WSD);
    unsigned char* SLOT = WSP(unsigned char, WS_SLOT);
    unsigned voA[2], voB[2];
#pragma unroll
    for (int i = 0; i < 2; ++i) { int R, C; stage_rc(tid * 16 + i * 8192, R, C); const int rho = R & 63, ii = rho & 15, nn = rho >> 4; const int Rb = (R & ~63) + 16 * (ii >> 2) + 4 * nn + (ii & 3);
        voA[i] = (unsigned)(R * 256 + C * 2); voB[i] = (unsigned)(Rb * 256 + C * 2); }
    const unsigned ldsw = (unsigned)wid * 1024u;
#define DN_STAGE(buf, gptr, vo) do { _Pragma("unroll") for (int _i = 0; _i < 2; ++_i) \
        __builtin_amdgcn_global_load_lds((const unsigned*)((gptr) + (vo)[_i]), (LAS unsigned*)(lds + (buf) * HTB + ldsw + _i * 8192), 16, 0, 0); } while (0)
    const int arow = (wq & 3) * 32 + fr;
    const int aoff = lds_byte(arow, fq * 8), boff = lds_byte(fr, fq * 8);
    const int TT = __builtin_amdgcn_readfirstlane(tab.tp[257]);
#define DN_STAGE_A(Ag_) do { _Pragma("unroll") for (int ai = 0; ai < 2; ++ai) _Pragma("unroll") for (int kt = 0; kt < 2; ++kt) DN_STAGE(ai * 2 + kt, (Ag_) + (size_t)ai * (128 * 256) + kt * 128, voA); } while (0)
#define DN_STAGE_B(slot, Bg_, c_) do { _Pragma("unroll") for (int kt = 0; kt < 2; ++kt) DN_STAGE(4 + 2 * (slot) + kt, (Bg_) + (size_t)(c_) * (128 * 256) + kt * 128, voB); } while (0)
    int T = F.vcu;
    const unsigned char* Bg = WD;
    if (T < TT) { const int e0 = __builtin_amdgcn_readfirstlane((int)tab.t2e[T]); Bg = e0 < 256 ? WD + (size_t)e0 * (1024 * 256) : WSD;
        DN_STAGE_A(ACT + (size_t)T * (256 * 256)); DN_STAGE_B(0, Bg, 0); }
    for (; T < TT; T += F.G) {
        const int Tn = T + F.G; const bool hn = Tn < TT;
        const unsigned char* Bn = WD;
        if (hn) { const int en = __builtin_amdgcn_readfirstlane((int)tab.t2e[Tn]); Bn = en < 256 ? WD + (size_t)en * (1024 * 256) : WSD; }
        asm volatile("s_waitcnt vmcnt(0)" ::: "memory"); __builtin_amdgcn_s_barrier(); asm volatile("" ::: "memory");
        v8i Af[2][2];
#pragma unroll
        for (int m = 0; m < 2; ++m)
#pragma unroll
            for (int kt = 0; kt < 2; ++kt) { const LAS unsigned char* p = lds + ((wq >> 2) * 2 + kt) * HTB + aoff + m * 2048;
                Af[m][kt] = cat8(*(const LAS bf16x8*)p, *(const LAS bf16x8*)(p + 1024)); }
        asm volatile("s_waitcnt lgkmcnt(0)" ::: "memory");
#pragma unroll 1
        for (int c = 0; c < 8; ++c) {
            const int sb = c & 1;
            if (c > 0) { if (c == 3 && hn) asm volatile("s_waitcnt vmcnt(12)" ::: "memory"); else asm volatile("s_waitcnt vmcnt(4)" ::: "memory"); }
            __builtin_amdgcn_s_barrier(); asm volatile("" ::: "memory");
            if (c < 7) DN_STAGE_B(sb ^ 1, Bg, c + 1); else if (hn) DN_STAGE_B(0, Bn, 0);
            if (c == 2 && hn) DN_STAGE_A(ACT + (size_t)Tn * (256 * 256));
            f32x4 acc[2][8];
#pragma unroll
            for (int m = 0; m < 2; ++m)
#pragma unroll
                for (int n = 0; n < 8; ++n) { acc[m][n] = (f32x4){0.f, 0.f, 0.f, 0.f}; asm volatile("" : "+v"(acc[m][n])); }
#pragma unroll
            for (int g = 0; g < 2; ++g) {
                v8i Bf[4][2];
#pragma unroll
                for (int n = 0; n < 4; ++n)
#pragma unroll
                    for (int kt = 0; kt < 2; ++kt) { const LAS unsigned char* p = lds + (4 + 2 * sb + kt) * HTB + boff + (4 * g + n) * 2048;
                        Bf[n][kt] = cat8(*(const LAS bf16x8*)p, *(const LAS bf16x8*)(p + 1024)); }
                asm volatile("s_waitcnt lgkmcnt(0)\n\ts_nop 4" ::: "memory");
#pragma unroll
                for (int kt = 0; kt < 2; ++kt)
#pragma unroll
                    for (int m = 0; m < 2; ++m)
#pragma unroll
                        for (int n = 0; n < 4; ++n) mfma_fp8(acc[m][4 * g + n], Bf[n][kt], Af[m][kt]);
            }
            asm volatile("s_nop 15\n\ts_nop 15" : "+v"(acc[0][0]), "+v"(acc[0][1]), "+v"(acc[0][2]), "+v"(acc[0][3]), "+v"(acc[0][4]), "+v"(acc[0][5]), "+v"(acc[0][6]), "+v"(acc[0][7]),
                         "+v"(acc[1][0]), "+v"(acc[1][1]), "+v"(acc[1][2]), "+v"(acc[1][3]), "+v"(acc[1][4]), "+v"(acc[1][5]), "+v"(acc[1][6]), "+v"(acc[1][7]) :: "memory");
            unsigned char* orow = SLOT + (size_t)(T * 256 + (wq >> 2) * 128 + (wq & 3) * 32 + fr) * DM + c * 128 + 16 * fq;
#pragma unroll
            for (int m = 0; m < 2; ++m)
#pragma unroll
                for (int g = 0; g < 2; ++g) { u32x4 pk;
#pragma unroll
                    for (int n = 0; n < 4; ++n) { const f32x4 a = acc[m][4 * g + n] * 0.125f; pk[n] = pk4_fp8c(a[0], a[1], a[2], a[3]); }
                    *(u32x4*)(orow + (size_t)(16 * m) * DM + 64 * g) = pk; }
        }
        Bg = Bn;
    }
    asm volatile("s_waitcnt vmcnt(0) lgkmcnt(0)" ::: "memory"); __builtin_amdgcn_s_barrier(); asm volatile("" ::: "memory");
#undef DN_STAGE_A
#undef DN_STAGE_B
#undef DN_STAGE
}

__device__ __forceinline__ void combine_token(Frame& F, const MoeTab& tab, int t0) {
    const int lane = F.lane; const int b = t0 >> 12;
    const unsigned* asg = WSP(const unsigned, WS_ASSIGN) + (size_t)t0 * 8; const unsigned char* SLOT = WSP(const unsigned char, WS_SLOT);
    const size_t Rs = (size_t)tab.tp[256] * 256;
    u32x4 sv[2][9];
#pragma unroll
    for (int q = 0; q < 2; ++q) {
#pragma unroll
        for (int k = 0; k < 8; ++k) { const unsigned av = asg[q * 8 + k]; const int e = av >> 16, rk = av & 0xffffu; const size_t R = (size_t)tab.tp[e] * 256 + rk;
            sv[q][k] = *(const u32x4*)(SLOT + R * DM + 16 * lane); }
        sv[q][8] = *(const u32x4*)(SLOT + (Rs + t0 + q) * DM + 16 * lane); }
    const float* g2 = WSP(const float, WS_MODV) + (size_t)b * 6144 + 5 * 1024 + 16 * lane; const float* fw = kin(I_FNW) + 16 * lane;
    f32x4 x[2][4]; float ss[2];
#pragma unroll
    for (int q = 0; q < 2; ++q) { const float* xr = F.out + (size_t)(t0 + q) * DM + 16 * lane;
#pragma unroll
        for (int j = 0; j < 4; ++j) x[q][j] = *(const f32x4*)(xr + 4 * j); }
#pragma unroll
    for (int q = 0; q < 2; ++q) { float a[16];
#pragma unroll
        for (int j = 0; j < 16; ++j) a[j] = 0.f;
#pragma unroll
        for (int k = 0; k < 9; ++k)
#pragma unroll
            for (int j = 0; j < 4; ++j) { const f32x2 lo = __builtin_amdgcn_cvt_pk_f32_fp8((int)sv[q][k][j], false), hi = __builtin_amdgcn_cvt_pk_f32_fp8((int)sv[q][k][j], true);
                a[4 * j] += lo[0]; a[4 * j + 1] += lo[1]; a[4 * j + 2] += hi[0]; a[4 * j + 3] += hi[1]; }
        ss[q] = 0.f;
#pragma unroll
        for (int j = 0; j < 4; ++j) { const f32x4 g = *(const f32x4*)(g2 + 4 * j) * (1.0f / 16.0f);
            x[q][j] = x[q][j] + g * (f32x4){a[4 * j], a[4 * j + 1], a[4 * j + 2], a[4 * j + 3]};
            ss[q] += (x[q][j][0] * x[q][j][0] + x[q][j][1] * x[q][j][1]) + (x[q][j][2] * x[q][j][2] + x[q][j][3] * x[q][j][3]); } }
#pragma unroll
    for (int o = 1; o < 64; o <<= 1) { ss[0] += __shfl_xor(ss[0], o); ss[1] += __shfl_xor(ss[1], o); }
#pragma unroll
    for (int q = 0; q < 2; ++q) { const float rs = rsqrtf(ss[q] * (1.0f / DM) + EPS); float* orow = F.out + (size_t)(t0 + q) * DM + 16 * lane;
#pragma unroll
        for (int j = 0; j < 4; ++j) *(f32x4*)(orow + 4 * j) = x[q][j] * rs * *(const f32x4*)(fw + 4 * j); }
}

constexpr int N_LAUNCHES = MK_N_LAUNCHES;
static_assert(N_LAUNCHES == 1 || N_LAUNCHES == NPHASE, "MK_N_LAUNCHES must be 1 or 14");
struct Args { const float* in[N_IN]; float* out; unsigned char* ws; int ph_lo, ph_hi; };
__global__ void __launch_bounds__(NWAVES * 64, 2) fwd_kernel(Args args) {
    extern __shared__ __attribute__((aligned(16))) unsigned char lds[];
    Frame F;
    F.lds = (LAS unsigned char*)lds;
    F.MISC = (volatile LAS unsigned*)(F.lds + MISC_OFF);
    F.tid = threadIdx.x; F.lane = F.tid & 63; F.wave = __builtin_amdgcn_readfirstlane(F.tid >> 6);
    F.G = gridDim.x; { const int bx = blockIdx.x; F.vcu = (F.G % 8 == 0) ? (bx % 8) * (F.G / 8) + bx / 8 : bx; }
    F.out = args.out; F.ws = args.ws; F.ctl = (unsigned*)(args.ws + WS_CTL);
    if (F.tid < 128) ((LAS unsigned*)(F.lds + MISC_OFF))[F.tid] = 0u;
    __syncthreads();
    XcdBarrier bar; bar.wv = (unsigned)F.wave; bar.bar = F.ctl + CW_BAR; bar.x = 0; bar.st = nullptr;
    if (N_LAUNCHES == 1) bar = xcd_barrier_post(F.ctl + CW_BAR, F.MISC + 8);
#define GRID_BAR() do { if (N_LAUNCHES == 1) xcd_barrier(bar); } while (0)
    const int lo = args.ph_lo, hi = args.ph_hi;
#ifndef PHASE_MASK
#define PHASE_MASK 0x3fff
#endif
#define IN(k) ((((PHASE_MASK) >> (k)) & 1) && lo <= (k) && (k) < hi)
#ifndef PHASE_DUP
#define PHASE_DUP 0
#endif
#define REPS(k) ((((PHASE_DUP) >> (k)) & 1) ? 2 : 1)
#ifndef PROBE_K
#define PROBE_K (-1)
#endif
#ifndef PROBE_AMP
#define PROBE_AMP 8
#endif
    unsigned long long tA_ = 0, tB_ = 0;
#define STAMP(j) do { if (PROBE_K >= 0 && (j) == PROBE_K) tA_ = __builtin_amdgcn_s_memrealtime(); if (PROBE_K >= 0 && (j) == PROBE_K + 1) tB_ = __builtin_amdgcn_s_memrealtime(); } while (0)
#define SEAM(k) do { if (IN(k) && IN((k) + 1)) GRID_BAR(); STAMP((k) + 1); } while (0)
#define PHASE_ENTER() do { int t_ = F.wave * 64 + lane_id(); asm volatile("" : "+v"(t_)); F.tid = t_; F.lane = t_ & 63; GAS unsigned char* w_ = (GAS unsigned char*)args.ws; GAS float* o_ = (GAS float*)args.out; asm volatile("" : "+s"(w_), "+s"(o_)); F.ws = (unsigned char*)w_; F.out = (float*)o_; F.ctl = (unsigned*)(F.ws + WS_CTL); } while (0)
#define PHASE_ENTER_V() do { int l_; asm volatile("v_mbcnt_lo_u32_b32 %0, -1, 0\n\tv_mbcnt_hi_u32_b32 %0, -1, %0" : "=v"(l_)); int t_ = F.wave * 64 + l_; asm volatile("" : "+v"(t_)); F.tid = t_; F.lane = t_ & 63; GAS unsigned char* w_ = (GAS unsigned char*)args.ws; GAS float* o_ = (GAS float*)args.out; asm volatile("" : "+s"(w_), "+s"(o_)); F.ws = (unsigned char*)w_; F.out = (float*)o_; F.ctl = (unsigned*)(F.ws + WS_CTL); } while (0)
    const int gw = F.vcu * NWAVES + F.wave, NGW = F.G * NWAVES;
#define modv WSP(const float, WS_MODV)
    LAS unsigned char* ring = F.lds + RING_OFF;
    LAS unsigned* idxw = (LAS unsigned*)(F.lds + AUX_OFF + AUX_IDX + F.wave * 1024);

    STAMP(0);
    if (IN(0)) for (int rep_ = 0; rep_ < REPS(0); ++rep_) { PHASE_ENTER(); p0_prologue(F); }
    SEAM(0);
    if (IN(1)) for (int rep_ = 0; rep_ < REPS(1); ++rep_) { PHASE_ENTER();
        for (int rb = gw; rb < MTOK / 32; rb += NGW) { const int row0 = rb * 32; const int b = row0 >> 12;
            modulate_rows<true>(F, kin(I_X), WSP(bf16_t, WS_H), row0, 32, kin(I_NORM1), modv + (size_t)b * 6144 + 1024, modv + (size_t)b * 6144, WSP(unsigned char, WS_H8)); }
        for (int rb = gw; rb < MCTX / 2; rb += NGW)
            modulate_rows(F, kin(I_CTX), WSP(bf16_t, WS_HC), rb * 2, 2, kin(I_NORM1), modv + (size_t)16 * 6144 + 1024, modv + (size_t)16 * 6144);
    }
    SEAM(1);
    if (IN(2)) for (int rep_ = 0; rep_ < REPS(2); ++rep_) { PHASE_ENTER();
        { SchedQKV S{WSP(const bf16_t, WS_H), (long)WS_HC - (long)WS_H, WSP(const bf16_t, WS_WQKV), F.G, F.vcu};
          EpiQKV E{WSP(bf16_t, WS_Q), WSP(bf16_t, WS_K), WSP(bf16_t, WS_V), kin(I_QNW), kin(I_KNW), WSP(const f32x2, WS_ROPE)};
          pg8::gemm_phase<EpiQKV, SchedQKV, false, true>(ring, idxw, DM, S, E, F.wave); }
        { SchedDense S{WSP(const bf16_t, WS_WU), WSP(const bf16_t, WS_H8), DM / 2, 6, MTOK / 256, F.G, F.vcu, true};
          EpiPlainBf16 E{WSP(bf16_t, WS_UT), (size_t)MTOK, 1.0f / 256.0f};
          pg8::gemm_phase<EpiPlainBf16, SchedDense, false, true, true>(ring, idxw, DM / 2, S, E, F.wave); }
    }
    SEAM(2);
    if (IN(3)) for (int rep_ = 0; rep_ < REPS(3); ++rep_) { PHASE_ENTER();
        const int xq = (XP_TILES + F.G - 1) / F.G;
        if ((F.vcu & 3) == 0) { xp_tiles(F, xq); PHASE_ENTER_V(); }
        { const attn_body::AttnTensors AT{WSP(const attn_body::bf16, WS_Q), WSP(const attn_body::bf16, WS_K), WSP(const attn_body::bf16, WS_V), WSP(attn_body::bf16, WS_AO)};
          const attn_body::StaticOrderR S(F.vcu, 0, 4);
          for (int r2_ = 0; r2_ < REPS(14); ++r2_) attn_body::attn_phase<attn_body::StaticOrderR>((char*)lds + RING_OFF, AT, S, F.wave); }
        __syncthreads(); PHASE_ENTER_V();
        if ((F.vcu & 3) == 1) { xp_tiles(F, xq); PHASE_ENTER_V(); }
        { const attn_body::AttnTensors AT{WSP(const attn_body::bf16, WS_Q), WSP(const attn_body::bf16, WS_K), WSP(const attn_body::bf16, WS_V), WSP(attn_body::bf16, WS_AO)};
          const attn_body::StaticOrderR S(F.vcu, 4, 8);
          for (int r2_ = 0; r2_ < REPS(14); ++r2_) attn_body::attn_phase<attn_body::StaticOrderR>((char*)lds + RING_OFF, AT, S, F.wave); }
        __syncthreads(); PHASE_ENTER_V();
        if ((F.vcu & 3) == 2) { xp_tiles(F, xq); PHASE_ENTER_V(); }
        for (int r2_ = 0; r2_ < REPS(15); ++r2_) for (int c = F.vcu; c < HW; c += F.G) {
#if HYENA_FP8
            hyena_unit8(F, c);
#else
            hyena_unit(F, c);
#endif
        }
        __syncthreads(); PHASE_ENTER_V();
        if ((F.vcu & 3) == 3) xp_tiles(F, 1 << 30);
    }
    SEAM(3);
    if (IN(4)) for (int rep_ = 0; rep_ < REPS(4); ++rep_) { PHASE_ENTER();
        for (int pm = F.vcu; pm < MTOK / 256; pm += F.G) {
            for (int q4 = 0; q4 < 4; ++q4) p4_norm_tile(F, pm * 4 + q4);
            VM_WAIT(); __syncthreads(); PHASE_ENTER();
            { SchedDense S{WSP(const bf16_t, WS_AY) + (size_t)pm * 256 * DM, WSP(const bf16_t, WS_WO), DM, 1, 4, 1, 0, false};
              EpiOutProj E{kin(I_X), F.out, modv, pm};
              pg8::gemm_phase<EpiOutProj, SchedDense, false, true>(ring, idxw, DM, S, E, F.wave); }
            VM_WAIT(); __syncthreads(); PHASE_ENTER();
            { const int row0 = pm * 256 + F.wave * 32; const int b = row0 >> 12;
              modulate_rows<true>(F, F.out, WSP(bf16_t, WS_H), row0, 32, kin(I_NORM2), modv + (size_t)b * 6144 + 4 * 1024, modv + (size_t)b * 6144 + 3 * 1024, WSP(unsigned char, WS_H8)); }
            VM_WAIT(); __syncthreads(); PHASE_ENTER();
            { SchedDense S{WSP(const bf16_t, WS_H) + (size_t)pm * 256 * DM, WSP(const bf16_t, WS_WR), DM, 1, 1, 1, 0, false};
              EpiF32 E{WSP(float, WS_LOGIT) + (size_t)pm * 256 * NE, (size_t)NE};
              pg8::gemm_phase<EpiF32, SchedDense, false, true>(ring, idxw, DM, S, E, F.wave); }
            VM_WAIT(); __syncthreads(); PHASE_ENTER();
            {
                LAS unsigned* lcnt = (LAS unsigned*)(F.lds + AUX_OFF); LAS unsigned* lbase = lcnt + 256;
                if (F.tid < 256) lcnt[F.tid] = 0u;
                __syncthreads();
                RouteSel R0, R1;
                p8_route16(F, pm * 256 + F.wave * 32, R0, lcnt); p8_route16(F, pm * 256 + F.wave * 32 + 16, R1, lcnt);
                __syncthreads();
                if (F.tid < 256) { const unsigned c = lcnt[F.tid]; lbase[F.tid] = c ? __hip_atomic_fetch_add(F.ctl + CW_CNT + 32 * F.tid, c, RLX_AGENT) : 0u; }
                __syncthreads();
                route_commit(F, pm * 256 + F.wave * 32, R0, lbase); route_commit(F, pm * 256 + F.wave * 32 + 16, R1, lbase);
                __syncthreads();
            }
        }
    }
    SEAM(4); STAMP(6); STAMP(7); STAMP(8); STAMP(9);
    if (IN(9)) for (int rep_ = 0; rep_ < REPS(9); ++rep_) { PHASE_ENTER();
        const MoeTab tab = moe_tables(F);
        SchedGU S{WSP(const bf16_t, WS_H8), WSP(const bf16_t, WS_WGU), WSP(const bf16_t, WS_WSGU8), WSP(const unsigned, WS_LIST), tab, F.G, F.vcu};
        EpiGU E{WSP(unsigned char, WS_ACT), WSP(const unsigned, WS_LIST), tab};
        pg8::gemm_phase<EpiGU, SchedGU, true, true, true>(ring, idxw, DM / 2, S, E, F.wave);
    }
    SEAM(9);
    if (IN(10)) for (int rep_ = 0; rep_ < REPS(10); ++rep_) { PHASE_ENTER();
        const MoeTab tab = moe_tables(F);
        down_phase(F, tab);
    }
    SEAM(10);
    if (IN(11)) for (int rep_ = 0; rep_ < REPS(11); ++rep_) { PHASE_ENTER(); const MoeTab tab = moe_tables(F); for (int rb = gw; rb < MTOK / 32; rb += NGW) for (int r = 0; r < 32; r += 2) combine_token(F, tab, rb * 32 + r); }
    STAMP(12); STAMP(13); STAMP(14);
    if (PROBE_K >= 0 && blockIdx.x == 0) {
        const unsigned long long until = __builtin_amdgcn_s_memrealtime() + (unsigned long long)PROBE_AMP * (tB_ - tA_);
        while (__builtin_amdgcn_s_memrealtime() < until) __builtin_amdgcn_s_sleep(32);
    }
#undef modv
#undef PHASE_ENTER
#undef PHASE_ENTER_V
#undef IN
#undef SEAM
#undef GRID_BAR
}

extern "C" void kernel_launch(void* const* d_in, const int* in_sizes, int n_in, void* d_out, int out_size, void* d_ws, size_t ws_size, hipStream_t stream) {
    static int grid = 0;
    if (grid == 0) {
        if (n_in != N_IN || in_sizes[0] != MTOK * DM || out_size != MTOK * DM || ws_size < WS_END) {
            fprintf(stderr, "kernel_launch: unexpected problem (n_in %d, in0 %d, out %d, ws %zu < %zu); nothing launched\n", n_in, n_in > 0 ? in_sizes[0] : -1, out_size, ws_size, (size_t)WS_END); grid = -1; return; }
        int dev = 0, cus = 0, per_cu = 0;
        if (hipGetDevice(&dev) != hipSuccess || hipDeviceGetAttribute(&cus, hipDeviceAttributeMultiprocessorCount, dev) != hipSuccess) { grid = -1; return; }
        if (hipFuncSetAttribute((const void*)fwd_kernel, hipFuncAttributeMaxDynamicSharedMemorySize, LDS_BYTES) != hipSuccess) { fprintf(stderr, "kernel_launch: hipFuncSetAttribute failed\n"); grid = -1; return; }
        if (hipOccupancyMaxActiveBlocksPerMultiprocessor(&per_cu, (const void*)fwd_kernel, NWAVES * 64, LDS_BYTES) != hipSuccess || per_cu < 1)
            fprintf(stderr, "kernel_launch: note: occupancy query reports %d workgroups per CU\n", per_cu);
        (void)hipGetLastError();
        grid = cus;
    }
    if (grid < 0) return;
    if (hipMemsetAsync((char*)d_ws + WS_CTL, 0, CTL_ZERO_BYTES, stream) != hipSuccess) return;
    Args a{};
    for (int i = 0; i < N_IN; ++i) a.in[i] = (const float*)d_in[i];
    a.out = (float*)d_out; a.ws = (unsigned char*)d_ws;
    for (int li = 0; li < N_LAUNCHES; ++li) {
        a.ph_lo = (N_LAUNCHES == 1) ? 0 : li; a.ph_hi = (N_LAUNCHES == 1) ? NPHASE : li + 1;
        hipLaunchKernelGGL(fwd_kernel, dim3(grid), dim3(NWAVES * 64), LDS_BYTES, stream, a);
        const hipError_t le = hipPeekAtLastError();
        if (le != hipSuccess) { fprintf(stderr, "kernel_launch: launch %d failed: %s\n", li, hipGetErrorName(le)); break; }
    }
}
```

```cpp
#include <hip/hip_runtime.h>
#include <cstdio>
#include <cstdint>
#include <cmath>

#ifndef HYENA_FP8
#define HYENA_FP8 1
#endif
#ifndef MK_N_LAUNCHES
#define MK_N_LAUNCHES 1
#endif

#define LAS __attribute__((address_space(3)))
#define GAS __attribute__((address_space(1)))
typedef unsigned short bf16_t;
typedef short bf16x8 __attribute__((ext_vector_type(8)));
typedef float f32x4 __attribute__((ext_vector_type(4)));
typedef float f32x2 __attribute__((ext_vector_type(2)));
typedef unsigned u32x4 __attribute__((ext_vector_type(4)));
typedef unsigned u32x2 __attribute__((ext_vector_type(2)));

constexpr int NB = 16, SEQ = 4096, DM = 1024, MTOK = NB * SEQ, CTXL = 256, MCTX = NB * CTXL;
constexpr int NH = 8, HD = 64, AW = 512, HW = 512, KVP = 128, KVLEN = CTXL + SEQ;
constexpr int NE = 256, TOPK = 8, FF = 256;
constexpr float EPS = 1e-6f;
constexpr int NPHASE = 14;

constexpr size_t MiB = 1u << 20;
constexpr size_t WS_CTL = 0, CTL_ZERO_BYTES = 128 * 1024;
constexpr size_t WS_MODV = 512 * 1024;
constexpr size_t WS_ROPE = 1 * MiB;
constexpr size_t WS_SS = 1 * MiB + 256 * 1024;
constexpr size_t WS_ASSIGN = 2 * MiB;
constexpr size_t WS_KR = 4 * MiB;
constexpr size_t WS_WQKV = 12 * MiB;
constexpr size_t WS_WU = 14 * MiB;
constexpr size_t WS_WO = 17 * MiB;
constexpr size_t WS_WR = 19 * MiB;
constexpr size_t WS_WSGU = 20 * MiB;
constexpr size_t WS_WSD = 21 * MiB;
constexpr size_t WS_WD = 22 * MiB;
constexpr size_t WS_ACT = 150 * MiB;
constexpr size_t WS_SLOT = 406 * MiB;
constexpr size_t WS_END = 1048 * MiB;
constexpr size_t WS_Q = 150 * MiB;
constexpr size_t WS_K = 214 * MiB;
constexpr size_t WS_V = 231 * MiB;
constexpr size_t WS_UT = 248 * MiB;
constexpr size_t WS_HC = 440 * MiB;
constexpr size_t WS_AY = 248 * MiB;
constexpr size_t WS_LOGIT = 150 * MiB;
constexpr size_t WS_WGU = 470 * MiB;
constexpr size_t WS_H8 = 598 * MiB;
constexpr size_t WS_WSGU8 = 662 * MiB;
constexpr size_t WS_H = 726 * MiB;
constexpr size_t WS_HYW = 726 * MiB;
constexpr size_t WS_HYX = 790 * MiB;
constexpr size_t WS_LIST = 854 * MiB;
constexpr size_t WS_YT = 919 * MiB;
constexpr size_t WS_AO = 983 * MiB;
static_assert(WS_LIST + (size_t)257 * 65536 * 4 <= WS_YT && WS_YT + 64 * MiB <= WS_AO && WS_AO + 64 * MiB <= WS_END, "ws map");
constexpr size_t MAXROWS_R = 524288 + 256 * 255;
static_assert(WS_SLOT + (MAXROWS_R + 65536) * 1024 <= WS_END && WS_ACT + (MAXROWS_R + 65536) * 256 <= WS_SLOT, "ws map 2");

constexpr int CW_TMO = 0, CW_CODE = 1, CW_TILEQ = 64;
constexpr int CW_BAR = 4096;
constexpr int CW_CNT = 16384;
static_assert((CW_CNT + 257 * 32) * 4 <= (int)CTL_ZERO_BYTES && (CW_BAR + 3456) * 4 <= (int)CTL_ZERO_BYTES, "control words inside the memset region");

constexpr int RING_OFF = 0, RING_BYTES = 131072;
constexpr int AUX_OFF = 131072, AUX_BYTES = 16384;
constexpr int MISC_OFF = AUX_OFF + AUX_BYTES;
constexpr int LDS_BYTES = MISC_OFF + 512;
constexpr int AUX_TP = 0, AUX_CNT = 1280, AUX_T2E = 2560, AUX_IDX = 8192;

constexpr int NWAVES = 8;
constexpr float C2 = 0.125f * 1.4426950408889634f;

__device__ __forceinline__ unsigned f2bf(float f) { unsigned u = __builtin_bit_cast(unsigned, f); return (u + 0x7fffu + ((u >> 16) & 1u)) >> 16; }
__device__ __forceinline__ unsigned pk2(float lo, float hi) { unsigned r; asm("v_cvt_pk_bf16_f32 %0, %1, %2" : "=v"(r) : "v"(lo), "v"(hi)); return r; }
__device__ __forceinline__ float bf2f(unsigned h) { return __builtin_bit_cast(float, h << 16); }
__device__ __forceinline__ unsigned cvt_pk_bf16(float lo, float hi) { unsigned r; asm volatile("v_cvt_pk_bf16_f32 %0, %1, %2" : "=v"(r) : "v"(lo), "v"(hi)); return r; }
__device__ __forceinline__ int lane_id() { return (int)__builtin_amdgcn_mbcnt_hi(~0u, __builtin_amdgcn_mbcnt_lo(~0u, 0u)); }
__device__ __forceinline__ float wave_sum(float v) {
#pragma unroll
    for (int o = 1; o < 64; o <<= 1) v += __shfl_xor(v, o);
    return v;
}

namespace pg8 {
constexpr int BM = 256, BK = 64, HALF = 128, HTB = HALF * BK * 2, STAGE_BYTES = 8 * HTB;
__host__ __device__ __forceinline__ int lds_byte(int r, int c) { const int st = (r >> 4) * 2 + (c >> 5), rr = r & 15, cc = c & 31, ob = rr * 64 + cc * 2; return st * 1024 + (ob ^ (((ob >> 9) & 1) << 5)); }
__host__ __device__ __forceinline__ void stage_rc(int b, int& R, int& C) { const int st = b / 1024, sb = b % 1024, swz = sb ^ (((sb >> 9) & 1) << 5); R = (st >> 1) * 16 + swz / 64; C = (st & 1) * 32 + (swz % 64) / 2; }
__host__ __device__ __forceinline__ int perm32(int rho) { const int n = rho >> 4, i = rho & 15; return 8 * (i >> 2) + 4 * n + (i & 3); }

struct Unit { int pm, pn, aux, aux2; };
typedef int v8i __attribute__((ext_vector_type(8)));
typedef int v4i __attribute__((ext_vector_type(4)));
__device__ __forceinline__ void mfma_fp8(f32x4& acc, v8i a, v8i b) { asm volatile("v_mfma_f32_16x16x128_f8f6f4 %0, %1, %2, %0" : "+v"(acc) : "v"(a), "v"(b)); }
__device__ __forceinline__ v8i cat8(bf16x8 lo, bf16x8 hi) { const v4i a = __builtin_bit_cast(v4i, lo), b = __builtin_bit_cast(v4i, hi); return __builtin_shufflevector(a, b, 0, 1, 2, 3, 4, 5, 6, 7); }

template <class Epi, class Sched, bool GATHER, bool ALIGN_EPI, bool FP8 = false>
__device__ __forceinline__ void gemm_phase(LAS unsigned char* lds, LAS unsigned* idxw, const int K, const Sched& S, const Epi& E, const int wave) {
    int tid_ = wave * 64 + lane_id(); asm volatile("" : "+v"(tid_));
    const int tid = tid_, wid = __builtin_amdgcn_readfirstlane(tid >> 6), lane = tid & 63, wr = wid >> 2, wc = wid & 3, fr = lane & 15, fq = lane >> 4;
    const int nt = K / BK;
    int Rr[2], Cc[2]; unsigned voffB[2];
#pragma unroll
    for (int i = 0; i < 2; ++i) { stage_rc(tid * 16 + i * 8192, Rr[i], Cc[i]); const int Rb = (Rr[i] & ~31) + perm32(Rr[i] & 31); voffB[i] = (unsigned)(Rb * K + Cc[i]) * 2u; }
    const unsigned kstep = (unsigned)(BK * 2);
    const unsigned hstep = (unsigned)HALF * (unsigned)K * 2u;
    const unsigned ldsw = (unsigned)wid * 1024u;
    const int aoff = lds_byte(wr * 64 + fr, fq * 8), boff = lds_byte(wc * 32 + fr, fq * 8);
#define PG8_SA(b, h) (((b) * 2 + (h)) * HTB)
#define PG8_SB(b, h) ((4 + (b) * 2 + (h)) * HTB)
#define PG8_STAGE_B(bufoff, gbase) do { _Pragma("unroll") for (int _i = 0; _i < 2; ++_i) \
        __builtin_amdgcn_global_load_lds((const unsigned*)((const char*)(gbase) + voffB[_i]), (LAS unsigned*)(lds + (bufoff) + ldsw + _i * 8192), 16, 0, 0); } while (0)
#define PG8_STAGE_A(bufoff, gbase, VV, h) do { _Pragma("unroll") for (int _i = 0; _i < 2; ++_i) \
        __builtin_amdgcn_global_load_lds((const unsigned*)((const char*)(gbase) + VV[h][_i]), (LAS unsigned*)(lds + (bufoff) + ldsw + _i * 8192), 16, 0, 0); } while (0)
#define PG8_LDA(dst, b, h) do { _Pragma("unroll") for (int m = 0; m < 4; ++m) _Pragma("unroll") for (int k = 0; k < 2; ++k) dst[m][k] = *(const LAS bf16x8*)(lds + PG8_SA(b, h) + aoff + m * 2048 + k * 1024); } while (0)
#define PG8_LDB(dst, b, h) do { _Pragma("unroll") for (int n = 0; n < 2; ++n) _Pragma("unroll") for (int k = 0; k < 2; ++k) dst[n][k] = *(const LAS bf16x8*)(lds + PG8_SB(b, h) + boff + n * 2048 + k * 1024); } while (0)
#define PG8_MMA(ai, bj, At, Bt) do { __builtin_amdgcn_s_setprio(1); _Pragma("unroll") for (int m = 0; m < 4; ++m) _Pragma("unroll") for (int n = 0; n < 2; ++n) { \
        if constexpr (FP8) { mfma_fp8(acc[ai][bj][m][n], cat8(Bt[n][0], Bt[n][1]), cat8(At[m][0], At[m][1])); } \
        else { _Pragma("unroll") for (int k = 0; k < 2; ++k) acc[ai][bj][m][n] = __builtin_amdgcn_mfma_f32_16x16x32_bf16(Bt[n][k], At[m][k], acc[ai][bj][m][n], 0, 0, 0); } } __builtin_amdgcn_s_setprio(0); } while (0)
#define PG8_WAIT_V(n) asm volatile("s_waitcnt vmcnt(" #n ")" ::: "memory")
#define PG8_WAIT_L(n) asm volatile("s_waitcnt lgkmcnt(" #n ")" ::: "memory")
#define PG8_BAR __builtin_amdgcn_s_barrier()
#define PG8_SCHED __builtin_amdgcn_sched_barrier(0)
    Unit cur, nxt; int ui = 0;
    if (!S.next(0, cur)) return;
    f32x4 acc[2][2][4][2];
#pragma unroll
    for (int a = 0; a < 2; ++a)
#pragma unroll
        for (int b = 0; b < 2; ++b)
#pragma unroll
            for (int m = 0; m < 4; ++m)
#pragma unroll
                for (int n = 0; n < 2; ++n) { acc[a][b][m][n] = (f32x4){0.f, 0.f, 0.f, 0.f}; if constexpr (FP8) asm volatile("" : "+v"(acc[a][b][m][n])); }
    bf16x8 At[4][2], B0[2][2], B1[2][2];
    unsigned va[2][2], vn[2][2];
    if constexpr (GATHER) {
        const unsigned* ip = S.idx_ptr(cur); const int nv = S.nvalid(cur);
#pragma unroll
        for (int h = 0; h < 2; ++h)
#pragma unroll
            for (int i = 0; i < 2; ++i) { const int r = Rr[i] + HALF * h; const unsigned e = ip[r]; const unsigned tok = r < nv ? (e >> 16) : 0u; va[h][i] = tok * (unsigned)K * 2u + (unsigned)Cc[i] * 2u; }
    } else {
#pragma unroll
        for (int h = 0; h < 2; ++h)
#pragma unroll
            for (int i = 0; i < 2; ++i) va[h][i] = (unsigned)((Rr[i] + HALF * h) * K + Cc[i]) * 2u;
    }
#pragma unroll
    for (int h = 0; h < 2; ++h)
#pragma unroll
        for (int i = 0; i < 2; ++i) vn[h][i] = va[h][i];
    const char* cA = S.a_base(cur); const char* cB = S.b_base(cur);
    PG8_STAGE_B(PG8_SB(0, 0), cB); PG8_STAGE_B(PG8_SB(0, 1), cB + hstep); PG8_STAGE_A(PG8_SA(0, 0), cA, va, 0); PG8_STAGE_A(PG8_SA(0, 1), cA, va, 1);
    if (wr == 1) PG8_BAR;
    PG8_WAIT_V(2); PG8_BAR;
    PG8_STAGE_B(PG8_SB(1, 0), cB + kstep); PG8_STAGE_A(PG8_SA(1, 0), cA + kstep, va, 0); PG8_STAGE_B(PG8_SB(1, 1), cB + hstep + kstep);
    PG8_WAIT_V(6); PG8_BAR;
    for (;;) {
        const bool has_next = S.next(ui + 1, nxt);
        const char* nA = has_next ? S.a_base(nxt) : cA; const char* nB = has_next ? S.b_base(nxt) : cB;
        int nvn = 0;
        if constexpr (GATHER) {
            if (has_next) { nvn = S.nvalid(nxt);
                __builtin_amdgcn_global_load_lds((const unsigned*)(S.idx_ptr(nxt) + lane * 4), (LAS unsigned*)idxw, 16, 0, 0); }
        }
#pragma unroll 1
        for (int t = 0; t < nt; t += 2) {
            const bool last = (t == nt - 2);
            if constexpr (GATHER) {
                if (last && has_next) {
                    asm volatile("" ::: "memory");
#pragma unroll
                    for (int h = 0; h < 2; ++h)
#pragma unroll
                        for (int i = 0; i < 2; ++i) { const int r = Rr[i] + HALF * h; const unsigned e = idxw[r]; const unsigned tok = r < nvn ? (e >> 16) : 0u; vn[h][i] = tok * (unsigned)K * 2u + (unsigned)Cc[i] * 2u; }
                }
            }
            unsigned v2[2][2];
#pragma unroll
            for (int h = 0; h < 2; ++h)
#pragma unroll
                for (int i = 0; i < 2; ++i) v2[h][i] = (GATHER && last) ? vn[h][i] : va[h][i];
            const char* a1 = cA + (size_t)(t + 1) * kstep;
            const char* a2 = last ? nA : cA + (size_t)(t + 2) * kstep; const char* b2 = last ? nB : cB + (size_t)(t + 2) * kstep;
            const char* a3 = a2 + kstep; const char* b3 = b2 + kstep;
            PG8_LDB(B0, 0, 0); PG8_LDB(B1, 0, 1); PG8_SCHED; PG8_LDA(At, 0, 0); PG8_STAGE_A(PG8_SA(1, 1), a1, va, 1);
            PG8_WAIT_V(8); PG8_WAIT_L(0); PG8_BAR; PG8_MMA(0, 0, At, B0); PG8_MMA(0, 1, At, B1); PG8_BAR; PG8_SCHED;
            PG8_LDA(At, 0, 1); PG8_STAGE_B(PG8_SB(0, 0), b2); PG8_STAGE_B(PG8_SB(0, 1), b2 + hstep); PG8_STAGE_A(PG8_SA(0, 0), a2, v2, 0);
            PG8_WAIT_V(8); PG8_WAIT_L(0); PG8_BAR; PG8_MMA(1, 0, At, B0); PG8_MMA(1, 1, At, B1); PG8_BAR; PG8_SCHED;
            PG8_LDB(B0, 1, 0); PG8_LDB(B1, 1, 1); PG8_SCHED; PG8_LDA(At, 1, 0); PG8_STAGE_A(PG8_SA(0, 1), a2, v2, 1);
            PG8_WAIT_V(8); PG8_WAIT_L(0); PG8_BAR; PG8_MMA(0, 0, At, B0); PG8_MMA(0, 1, At, B1); PG8_BAR; PG8_SCHED;
            PG8_LDA(At, 1, 1); PG8_STAGE_B(PG8_SB(1, 0), b3); PG8_STAGE_B(PG8_SB(1, 1), b3 + hstep); PG8_STAGE_A(PG8_SA(1, 0), a3, v2, 0);
            PG8_WAIT_V(8); PG8_WAIT_L(0); PG8_BAR; PG8_MMA(1, 0, At, B0); PG8_MMA(1, 1, At, B1); PG8_BAR; PG8_SCHED;
        }
        if constexpr (ALIGN_EPI) { if (wr == 0) PG8_BAR; }
        if constexpr (FP8) {
#define PG8_A4(a, b) "+v"(acc[a][b][0][0]), "+v"(acc[a][b][0][1]), "+v"(acc[a][b][1][0]), "+v"(acc[a][b][1][1]), "+v"(acc[a][b][2][0]), "+v"(acc[a][b][2][1]), "+v"(acc[a][b][3][0]), "+v"(acc[a][b][3][1])
            asm volatile("s_nop 15\n\ts_nop 15" : PG8_A4(0, 0), PG8_A4(0, 1) :: "memory");
            asm volatile("" : PG8_A4(1, 0), PG8_A4(1, 1) :: "memory");
#undef PG8_A4
        }
        E(acc, cur, wr, wc, fr, fq);
        if (!has_next) break;
#pragma unroll
        for (int a = 0; a < 2; ++a)
#pragma unroll
            for (int b = 0; b < 2; ++b)
#pragma unroll
                for (int m = 0; m < 4; ++m)
#pragma unroll
                    for (int n = 0; n < 2; ++n) { acc[a][b][m][n] = (f32x4){0.f, 0.f, 0.f, 0.f}; if constexpr (FP8) asm volatile("" : "+v"(acc[a][b][m][n])); }
        cur = nxt; cA = nA; cB = nB; ++ui;
#pragma unroll
        for (int h = 0; h < 2; ++h)
#pragma unroll
            for (int i = 0; i < 2; ++i) va[h][i] = vn[h][i];
        if constexpr (ALIGN_EPI) { if (wr == 1) PG8_BAR; }
    }
    PG8_WAIT_V(0);
    if constexpr (!ALIGN_EPI) { if (wr == 0) PG8_BAR; }
    PG8_BAR;
#undef PG8_SA
#undef PG8_SB
#undef PG8_STAGE_A
#undef PG8_STAGE_B
#undef PG8_LDA
#undef PG8_LDB
#undef PG8_MMA
#undef PG8_WAIT_V
#undef PG8_WAIT_L
#undef PG8_BAR
#undef PG8_SCHED
}
}

using pg8::Unit;
struct MoeTab { const LAS int* tp; const LAS int* cnt; const LAS unsigned short* t2e; };
__device__ __forceinline__ int moe_find(const LAS int* tp, int T) {
    int lo = 0, hi = 256;
    while (lo < hi) { const int mid = (lo + hi + 1) >> 1; if (tp[mid] <= T) lo = mid; else hi = mid - 1; }
    return lo;
}

struct SchedQKV {
    const bf16_t *H; long hc_delta; const bf16_t *W; int G, c;
    __device__ __forceinline__ bool next(int i, Unit& u) const {
        const int L = i * G + c; if (L >= 784) return false;
        if (L < 768) { u.pm = L / 3; u.pn = L % 3; u.aux = 0; } else { u.pm = L - 768; u.pn = 2; u.aux = 1; }
        u.aux2 = 0; return true;
    }
    __device__ __forceinline__ const char* a_base(const Unit& u) const { return (const char*)H + (u.aux ? hc_delta : 0L) + (size_t)u.pm * (256 * 1024 * 2); }
    __device__ __forceinline__ const char* b_base(const Unit& u) const { return (const char*)W + (size_t)u.pn * (256 * 1024 * 2); }
    __device__ __forceinline__ const unsigned* idx_ptr(const Unit&) const { return nullptr; }
    __device__ __forceinline__ int nvalid(const Unit&) const { return 256; }
};
struct SchedDense {
    const bf16_t *A, *Bt; int K, nM, nN, G, c; bool m_fast;
    __device__ __forceinline__ bool next(int i, Unit& u) const {
        const int L = i * G + c; if (L >= nM * nN) return false;
        if (m_fast) { u.pm = L % nM; u.pn = L / nM; } else { u.pm = L / nN; u.pn = L % nN; }
        u.aux = 0; u.aux2 = 0; return true;
    }
    __device__ __forceinline__ const char* a_base(const Unit& u) const { return (const char*)A + (size_t)u.pm * 512 * (size_t)K; }
    __device__ __forceinline__ const char* b_base(const Unit& u) const { return (const char*)Bt + (size_t)u.pn * 512 * (size_t)K; }
    __device__ __forceinline__ const unsigned* idx_ptr(const Unit&) const { return nullptr; }
    __device__ __forceinline__ int nvalid(const Unit&) const { return 256; }
};
struct TileDeal {
    int nT, NP, G, c;
    __device__ __forceinline__ bool get(int i, int& tile, int& slot) const {
        const int full = nT / G, rem = nT - full * G;
        if (i < full * NP) { tile = (i / NP) * G + c; slot = i % NP; return true; }
        const int j = i - full * NP;
        if (rem * NP <= G) { if (j > 0 || c >= rem * NP) return false; tile = full * G + c / NP; slot = c % NP; return true; }
        if (j >= NP || c >= rem) return false; tile = full * G + c; slot = j; return true;
    }
};
struct SchedGU {
    const bf16_t *H2, *WGU, *WSGU; const unsigned* LIST; MoeTab tab; int G, c;
    __device__ __forceinline__ bool next(int i, Unit& u) const {
        const int Ttot = __builtin_amdgcn_readfirstlane(tab.tp[257]); const int L = i * G + c; if (L >= 2 * Ttot) return false;
        const int T = L >> 1, half = L & 1;
        const int e = __builtin_amdgcn_readfirstlane((int)tab.t2e[T]);
        u.pm = T; u.pn = half; u.aux = e; u.aux2 = __builtin_amdgcn_readfirstlane(T - tab.tp[e]); return true;
    }
    __device__ __forceinline__ const char* a_base(const Unit&) const { return (const char*)H2; }
    __device__ __forceinline__ const char* b_base(const Unit& u) const { return (u.aux < 256 ? (const char*)WGU + (size_t)u.aux * (512 * 1024) : (const char*)WSGU) + (size_t)u.pn * (256 * 1024); }
    __device__ __forceinline__ const unsigned* idx_ptr(const Unit& u) const { return LIST + (size_t)u.aux * 65536 + (size_t)u.aux2 * 256; }
    __device__ __forceinline__ int nvalid(const Unit& u) const { const int r = __builtin_amdgcn_readfirstlane(tab.cnt[u.aux]) - u.aux2 * 256; return r < 256 ? r : 256; }
};
struct SchedDown {
    const bf16_t *ACT, *WD, *WSD; MoeTab tab; int G, c;
    __device__ __forceinline__ bool next(int i, Unit& u) const {
        const int TT = __builtin_amdgcn_readfirstlane(tab.tp[257]);
        const int L = i * G + c; if (L >= 4 * TT) return false;
        u.pm = L >> 2; u.pn = L & 3;
        u.aux = __builtin_amdgcn_readfirstlane((int)tab.t2e[u.pm]); u.aux2 = 0; return true;
    }
    __device__ __forceinline__ const char* a_base(const Unit& u) const { return (const char*)ACT + (size_t)u.pm * (256 * 256); }
    __device__ __forceinline__ const char* b_base(const Unit& u) const { return (u.aux < 256 ? (const char*)WD + (size_t)u.aux * (1024 * 256) : (const char*)WSD) + (size_t)u.pn * (256 * 256); }
    __device__ __forceinline__ const unsigned* idx_ptr(const Unit&) const { return nullptr; }
    __device__ __forceinline__ int nvalid(const Unit&) const { return 256; }
};

#define EPI_ARGS const f32x4 (&acc)[2][2][4][2], const Unit& u, int wr, int wc, int fr_, int fq_
#define EPI_PIN int fr = fr_, fq = fq_; asm volatile("" : "+v"(fr), "+v"(fq))
__device__ __forceinline__ u32x4 pack8(const f32x4& a, const f32x4& b) { u32x4 o; o.x = cvt_pk_bf16(a[0], a[1]); o.y = cvt_pk_bf16(a[2], a[3]); o.z = cvt_pk_bf16(b[0], b[1]); o.w = cvt_pk_bf16(b[2], b[3]); return o; }

__device__ __forceinline__ unsigned pk4_fp8c(float a, float b, float c, float d) {
    a = __builtin_amdgcn_fmed3f(a, -440.f, 440.f); b = __builtin_amdgcn_fmed3f(b, -440.f, 440.f); c = __builtin_amdgcn_fmed3f(c, -440.f, 440.f); d = __builtin_amdgcn_fmed3f(d, -440.f, 440.f);
    int w = __builtin_amdgcn_cvt_pk_fp8_f32(a, b, 0, false); w = __builtin_amdgcn_cvt_pk_fp8_f32(c, d, w, true); return (unsigned)w; }
struct EpiQKV {
    bf16_t *Q, *Kb, *Vb; const float *qnw, *knw; const f32x2* rope;
    __device__ __forceinline__ void operator()(EPI_ARGS) const {
        EPI_PIN;
        const bool ctx = u.aux != 0;
        const int kind = (u.pn < 2) ? 0 : (wc < 2 ? 1 : 2);
        f32x4 w[2][2];
#pragma unroll
        for (int bj = 0; bj < 2; ++bj)
#pragma unroll
            for (int n = 0; n < 2; ++n) w[bj][n] = (kind == 2) ? (f32x4){1.f, 1.f, 1.f, 1.f} : *(const f32x4*)((kind == 0 ? qnw : knw) + 32 * bj + 8 * fq + 4 * n);
        f32x4 rrow[2][2], rcol[4][2];
        if (kind != 2 && !ctx) {
#pragma unroll
            for (int ai = 0; ai < 2; ++ai)
#pragma unroll
                for (int n = 0; n < 2; ++n) rrow[ai][n] = ((const f32x4*)(rope + (((u.pm * 4 + 2 * ai + wr) & 63) * 16) + 4 * fq))[n];
#pragma unroll
            for (int m = 0; m < 4; ++m)
#pragma unroll
                for (int n = 0; n < 2; ++n) rcol[m][n] = ((const f32x4*)(rope + (16 * m + fr) * 16 + 4 * fq))[n];
        }
#pragma unroll
        for (int ai = 0; ai < 2; ++ai)
#pragma unroll
            for (int m = 0; m < 4; ++m) {
                const int rl = ai * 128 + wr * 64 + m * 16 + fr; const int row = u.pm * 256 + rl;
                f32x4 v[2][2];
#pragma unroll
                for (int bj = 0; bj < 2; ++bj)
#pragma unroll
                    for (int n = 0; n < 2; ++n) v[bj][n] = acc[ai][bj][m][n];
                if (kind != 2) {
                    float ss = 0.f;
#pragma unroll
                    for (int bj = 0; bj < 2; ++bj)
#pragma unroll
                        for (int n = 0; n < 2; ++n) ss += (v[bj][n][0] * v[bj][n][0] + v[bj][n][1] * v[bj][n][1]) + (v[bj][n][2] * v[bj][n][2] + v[bj][n][3] * v[bj][n][3]);
                    ss += __shfl_xor(ss, 16); ss += __shfl_xor(ss, 32);
                    const float rs = rsqrtf(ss * (1.f / 64.f) + EPS);
#pragma unroll
                    for (int bj = 0; bj < 2; ++bj)
#pragma unroll
                        for (int n = 0; n < 2; ++n) v[bj][n] = v[bj][n] * rs * w[bj][n];
                    if (!ctx) {
#pragma unroll
                        for (int bj = 0; bj < 2; ++bj)
#pragma unroll
                            for (int n = 0; n < 2; ++n) { const f32x4 cs = bj == 0 ? rrow[ai][n] : rcol[m][n]; const f32x4 x = v[bj][n];
                                v[bj][n] = (f32x4){x[0] * cs[0] - x[1] * cs[1], x[0] * cs[1] + x[1] * cs[0], x[2] * cs[2] - x[3] * cs[3], x[2] * cs[3] + x[3] * cs[2]}; }
                    }
                    if (kind == 0) {
#pragma unroll
                        for (int bj = 0; bj < 2; ++bj)
#pragma unroll
                            for (int n = 0; n < 2; ++n) v[bj][n] = v[bj][n] * C2;
                    }
                }
                bf16_t* dst;
                if (kind == 0) dst = Q + (size_t)row * AW + 64 * (4 * u.pn + wc) + 8 * fq;
                else { const int kvrow = ctx ? (row >> 8) * KVLEN + (row & 255) : (row >> 12) * KVLEN + CTXL + (row & (SEQ - 1));
                       dst = (kind == 1 ? Kb : Vb) + (size_t)kvrow * KVP + 64 * (wc & 1) + 8 * fq; }
#pragma unroll
                for (int bj = 0; bj < 2; ++bj) *(u32x4*)(dst + 32 * bj) = pack8(v[bj][0], v[bj][1]);
            }
    }
};
struct EpiPlainBf16 {
    bf16_t* O; size_t ldc; float scale;
    __device__ __forceinline__ void operator()(EPI_ARGS) const {
        EPI_PIN;
#pragma unroll
        for (int ai = 0; ai < 2; ++ai)
#pragma unroll
            for (int m = 0; m < 4; ++m) { bf16_t* rowp = O + (size_t)(u.pm * 256 + ai * 128 + wr * 64 + m * 16 + fr) * ldc + u.pn * 256 + wc * 32 + 8 * fq;
#pragma unroll
                for (int bj = 0; bj < 2; ++bj) *(u32x4*)(rowp + bj * 128) = pack8(acc[ai][bj][m][0] * scale, acc[ai][bj][m][1] * scale); }
    }
};
struct EpiOutProj {
    const float* x; float* out; const float* modv; int pm0;
    __device__ __forceinline__ void operator()(EPI_ARGS) const {
        EPI_PIN;
        const int pmt = pm0 + u.pm;
        const float* g1 = modv + (size_t)(pmt >> 4) * 6144 + 2 * 1024; const int col0 = u.pn * 256 + wc * 32 + 8 * fq;
        f32x4 gv[2][2];
#pragma unroll
        for (int bj = 0; bj < 2; ++bj)
#pragma unroll
            for (int n = 0; n < 2; ++n) gv[bj][n] = *(const f32x4*)(g1 + col0 + bj * 128 + 4 * n);
#pragma unroll
        for (int ai = 0; ai < 2; ++ai)
#pragma unroll
            for (int m = 0; m < 4; ++m) { const size_t off = (size_t)(pmt * 256 + ai * 128 + wr * 64 + m * 16 + fr) * DM + col0;
#pragma unroll
                for (int bj = 0; bj < 2; ++bj)
#pragma unroll
                    for (int n = 0; n < 2; ++n) { const f32x4 xv = *(const f32x4*)(x + off + bj * 128 + 4 * n); *(f32x4*)(out + off + bj * 128 + 4 * n) = xv + gv[bj][n] * acc[ai][bj][m][n]; }
                if (m & 1) asm volatile("" ::: "memory"); }
    }
};
struct EpiF32 {
    float* O; size_t ldc;
    __device__ __forceinline__ void operator()(EPI_ARGS) const {
        EPI_PIN;
#pragma unroll
        for (int ai = 0; ai < 2; ++ai)
#pragma unroll
            for (int m = 0; m < 4; ++m) { float* rowp = O + (size_t)(u.pm * 256 + ai * 128 + wr * 64 + m * 16 + fr) * ldc + u.pn * 256 + wc * 32 + 8 * fq;
#pragma unroll
                for (int bj = 0; bj < 2; ++bj)
#pragma unroll
                    for (int n = 0; n < 2; ++n) *(f32x4*)(rowp + bj * 128 + 4 * n) = acc[ai][bj][m][n]; }
    }
};
struct EpiGU {
    unsigned char* ACT; const unsigned* LIST; MoeTab tab;
    __device__ __forceinline__ void operator()(EPI_ARGS) const {
        EPI_PIN;
        const int e = u.aux, tile = u.aux2; int nv = __builtin_amdgcn_readfirstlane(tab.cnt[e]) - tile * 256; nv = nv < 256 ? nv : 256;
        const unsigned* ip = LIST + (size_t)e * 65536 + (size_t)tile * 256;
        constexpr float C1 = -1.4426950408889634f / 256.0f;
#pragma unroll
        for (int ai = 0; ai < 2; ++ai)
#pragma unroll
            for (int m = 0; m < 4; ++m) { const int rl = ai * 128 + wr * 64 + m * 16 + fr;
                const float ws = rl < nv ? bf2f(ip[rl] & 0xffffu) * (4.0f / 65536.0f) : 0.f;
                unsigned pk[2];
#pragma unroll
                for (int n = 0; n < 2; ++n) { const f32x4 g = acc[ai][0][m][n], up = acc[ai][1][m][n]; f32x2 r[2];
#pragma unroll
                    for (int h = 0; h < 2; ++h) { const f32x2 gg = {g[2 * h], g[2 * h + 1]}, uu = {up[2 * h], up[2 * h + 1]};
                        const f32x2 ea = gg * C1; f32x2 d; d.x = __builtin_amdgcn_exp2f(ea.x); d.y = __builtin_amdgcn_exp2f(ea.y); d = d + 1.0f;
                        f32x2 q; q.x = __builtin_amdgcn_rcpf(d.x); q.y = __builtin_amdgcn_rcpf(d.y);
                        f32x2 p = (gg * uu) * (q * ws);
                        p.x = __builtin_amdgcn_fmed3f(p.x, -440.f, 440.f); p.y = __builtin_amdgcn_fmed3f(p.y, -440.f, 440.f); r[h] = p; }
                    int w = __builtin_amdgcn_cvt_pk_fp8_f32(r[0].x, r[0].y, 0, false); w = __builtin_amdgcn_cvt_pk_fp8_f32(r[1].x, r[1].y, w, true); pk[n] = (unsigned)w; }
                u32x2 o; o.x = pk[0]; o.y = pk[1];
                *(u32x2*)(ACT + (size_t)(u.pm * 256 + rl) * FF + u.pn * 128 + wc * 32 + 8 * fq) = o; }
    }
};
struct EpiDown {
    unsigned char* SLOT;
    __device__ __forceinline__ void operator()(EPI_ARGS) const {
        EPI_PIN;
#pragma unroll
        for (int ai = 0; ai < 2; ++ai)
#pragma unroll
            for (int m = 0; m < 4; ++m) { unsigned char* rowp = SLOT + (size_t)(u.pm * 256 + ai * 128 + wr * 64 + m * 16 + fr) * DM + u.pn * 256 + wc * 32 + 8 * fq;
#pragma unroll
                for (int bj = 0; bj < 2; ++bj) { const f32x4 a = acc[ai][bj][m][0] * 0.125f, b = acc[ai][bj][m][1] * 0.125f;
                    u32x2 pk; pk.x = pk4_fp8c(a[0], a[1], a[2], a[3]); pk.y = pk4_fp8c(b[0], b[1], b[2], b[3]); *(u32x2*)(rowp + bj * 128) = pk; } }
    }
};
#include <hip/hip_bf16.h>
#include <cmath>
namespace attn_body {
using bf16=__hip_bfloat16;
using bf16x8=__attribute__((ext_vector_type(8)))short;
using s16x4=__attribute__((ext_vector_type(4)))short;
using f32x16=__attribute__((ext_vector_type(16)))float;
using u32x4=__attribute__((ext_vector_type(4)))unsigned;
constexpr int SEQ=4096,D=64,QP=512,KVP=128,KVLEN=4352;
constexpr int NW=8,QBLK=32,QB=QBLK*NW,KVBLK=64,NQB=SEQ/QB;
constexpr int ATTN_UNIT_ROWS=QB;
__device__ __forceinline__ int crow(int r,int hi){return (r&3)+8*(r>>2)+4*hi;}
#define SBAR() __builtin_amdgcn_sched_barrier(0)

constexpr int NSLOT=3, SLOTB=8192;
constexpr int LDS_K=0, LDS_V=NSLOT*SLOTB, LDS_WS=2*NSLOT*SLOTB, LDS_OST=LDS_WS+NW*64*4, LDS_BYTES=LDS_OST+NW*4096;
constexpr float C2=0.125f*1.4426950408889634f;
__device__ __forceinline__ void glds16(const void*gsrc,unsigned lds_dst){unsigned keep;
  asm volatile("s_mov_b32 %0, m0\n\ts_mov_b32 m0, %2\n\ts_nop 0\n\tglobal_load_lds_dwordx4 %1, off\n\ts_mov_b32 m0, %0":"=&s"(keep):"v"(gsrc),"s"(lds_dst):"memory");}
__device__ __forceinline__ float max3f(float a,float b,float c){float r;asm("v_max3_f32 %0, %1, %2, %3":"=v"(r):"v"(a),"v"(b),"v"(c));return r;}
__device__ __forceinline__ float max2f(float a,float b){float r;asm("v_max_f32_e32 %0, %1, %2":"=v"(r):"v"(a),"v"(b));return r;}
__device__ __forceinline__ float fadd_s(float a,float b){float r;asm("v_add_f32_e32 %0, %1, %2":"=v"(r):"v"(a),"v"(b));return r;}
__device__ __forceinline__ float fsub_s(float a,float b){float r;asm("v_sub_f32_e32 %0, %1, %2":"=v"(r):"v"(a),"v"(b));return r;}
typedef float f32x2_t __attribute__((ext_vector_type(2))); typedef __bf16 bf16x2_t __attribute__((ext_vector_type(2)));
__device__ __forceinline__ unsigned cvtpk_s(float lo,float hi){f32x2_t v={lo,hi};bf16x2_t b=__builtin_convertvector(v,bf16x2_t);return __builtin_bit_cast(unsigned,b);}
#define WAIT_BAR(N) asm volatile("s_waitcnt vmcnt(" #N ") lgkmcnt(0)\n\ts_barrier":::"memory")

__device__ __forceinline__ void qkt(f32x16&p0,f32x16&p1,const char*Kslot,const bf16x8*qr,const f32x16&negm,int r32,int hi){
  const char*kb=Kslot+hi*1024+r32*16;
  #pragma unroll
  for(int d0=0;d0<4;++d0){
    const bf16x8 b0=*reinterpret_cast<const bf16x8*>(kb+d0*2048);
    const bf16x8 b1=*reinterpret_cast<const bf16x8*>(kb+d0*2048+512);
    if(d0==0){p0=__builtin_amdgcn_mfma_f32_32x32x16_bf16(b0,qr[0],negm,0,0,0);p1=__builtin_amdgcn_mfma_f32_32x32x16_bf16(b1,qr[0],negm,0,0,0);}
    else{p0=__builtin_amdgcn_mfma_f32_32x32x16_bf16(b0,qr[d0],p0,0,0,0);p1=__builtin_amdgcn_mfma_f32_32x32x16_bf16(b1,qr[d0],p1,0,0,0);}}
}
typedef __attribute__((address_space(3))) const char* lds_cptr;
typedef short v4i16_t __attribute__((ext_vector_type(4)));
__device__ __forceinline__ void kload8(bf16x8*kf,lds_cptr kp){
  kf[0]=*(const __attribute__((address_space(3))) bf16x8*)(kp);      kf[1]=*(const __attribute__((address_space(3))) bf16x8*)(kp+512);
  kf[2]=*(const __attribute__((address_space(3))) bf16x8*)(kp+2048); kf[3]=*(const __attribute__((address_space(3))) bf16x8*)(kp+2560);
  kf[4]=*(const __attribute__((address_space(3))) bf16x8*)(kp+4096); kf[5]=*(const __attribute__((address_space(3))) bf16x8*)(kp+4608);
  kf[6]=*(const __attribute__((address_space(3))) bf16x8*)(kp+6144); kf[7]=*(const __attribute__((address_space(3))) bf16x8*)(kp+6656);
}
__device__ __forceinline__ void kload2(bf16x8*kf,lds_cptr kp,int j){ kf[2*j]=*(const __attribute__((address_space(3))) bf16x8*)(kp+j*2048); kf[2*j+1]=*(const __attribute__((address_space(3))) bf16x8*)(kp+j*2048+512); }
__device__ __forceinline__ s16x4 vtr(lds_cptr p){ return __builtin_bit_cast(s16x4,__builtin_amdgcn_ds_read_tr16_b64_v4i16((__attribute__((address_space(3))) v4i16_t*)p)); }
__device__ __forceinline__ float rowmax(const f32x16&p0,const f32x16&p1){
  float a=max3f(p0[0],p0[1],p1[0]),b=max3f(p0[2],p0[3],p1[1]);a=max3f(a,p1[2],p1[3]);
  #pragma unroll
  for(int r=4;r<16;r+=4){a=max3f(a,p0[r],p0[r+1]);b=max3f(b,p0[r+2],p0[r+3]);a=max3f(a,p1[r],p1[r+1]);b=max3f(b,p1[r+2],p1[r+3]);}
  const float m=max2f(a,b);
  auto rr=__builtin_amdgcn_permlane32_swap(__float_as_uint(m),__float_as_uint(m),false,false);
  return max2f(__uint_as_float(rr[0]),__uint_as_float(rr[1]));
}
__device__ __forceinline__ void pv(f32x16*o,int vb,bf16x8 pa0,bf16x8 pa1,bf16x8 pa2,bf16x8 pa3){
  #pragma unroll
  for(int d0=0;d0<2;++d0){s16x4 lo[4],hi[4];
    #pragma unroll
    for(int ks=0;ks<4;++ks){
      asm volatile("ds_read_b64_tr_b16 %0,%1 offset:%c2":"=&v"(lo[ks]):"v"(vb),"i"(d0*4096+ks*1024):"memory");
      asm volatile("ds_read_b64_tr_b16 %0,%1 offset:%c2":"=&v"(hi[ks]):"v"(vb),"i"(d0*4096+ks*1024+512):"memory");}
    asm volatile("s_waitcnt lgkmcnt(0)":::"memory");SBAR();
    #define PK(k) (bf16x8){lo[k][0],lo[k][1],lo[k][2],lo[k][3],hi[k][0],hi[k][1],hi[k][2],hi[k][3]}
    o[d0]=__builtin_amdgcn_mfma_f32_32x32x16_bf16(pa0,PK(0),o[d0],0,0,0);
    o[d0]=__builtin_amdgcn_mfma_f32_32x32x16_bf16(pa1,PK(1),o[d0],0,0,0);
    o[d0]=__builtin_amdgcn_mfma_f32_32x32x16_bf16(pa2,PK(2),o[d0],0,0,0);
    o[d0]=__builtin_amdgcn_mfma_f32_32x32x16_bf16(pa3,PK(3),o[d0],0,0,0);
    #undef PK
  }
}

#ifndef ATTN_STORE16
#define ATTN_STORE16(p,v) (*(u32x4*)(p)=(v))
#endif
template<int THRL> __device__ __forceinline__ void attn_unit(int b,int h,int qb,const bf16*Q,const bf16*__restrict__ K,const bf16*__restrict__ V,bf16*O,char*shm,int wave_){
  const int lane=::lane_id(),tid=wave_*64+lane,r32=lane&31,hi=lane>>5; const int wid=wave_;
  const int q0=qb*QB; const long qrow0=(long)b*SEQ+q0+wid*QBLK;
  const bf16*Qw=Q+qrow0*QP+h*D;
  const bf16*Kh=K+(long)b*KVLEN*KVP+(h>>2)*D,*Vh=V+(long)b*KVLEN*KVP+(h>>2)*D;
  const unsigned lds0=(unsigned)(uintptr_t)shm;
  float*wsf=(float*)(shm+LDS_WS)+wid*64;
  const bf16*ksrc=Kh+(long)lane*KVP+wid*8;
  const bf16*vsrc=Vh+(long)(16*(wid&3)+(lane>>2))*KVP+(wid>>2)*32+(lane&3)*8;
  const unsigned kdst=lds0+LDS_K+wid*1024, vdst=lds0+LDS_V+wid*1024;
  #define DMA_K(t,slot) glds16(ksrc+(long)(t)*KVBLK*KVP,(unsigned)__builtin_amdgcn_readfirstlane(kdst+(slot)))
  #define DMA_V(t,slot) glds16(vsrc+(long)(t)*KVBLK*KVP,(unsigned)__builtin_amdgcn_readfirstlane(vdst+(slot)))
  const int vb0=(int)(lds0+LDS_V)+((lane>>4)&1)*32+(lane&3)*8+(4*hi+((lane&15)>>2))*64;
  const char*Kbase=shm+LDS_K; bf16x8 kf[8];
  const lds_cptr shm3=(lds_cptr)shm; const lds_cptr kp0=shm3+LDS_K+hi*1024+r32*16; const lds_cptr vp0=shm3+LDS_V+((lane>>4)&1)*32+(lane&3)*8+(4*hi+((lane&15)>>2))*64;
  constexpr int NT=KVLEN/KVBLK;
  DMA_K(0,0);DMA_V(0,0);DMA_K(1,SLOTB);
  bf16x8 qr[4];
  #pragma unroll
  for(int d0=0;d0<4;++d0)qr[d0]=*reinterpret_cast<const bf16x8*>(&Qw[(long)r32*QP+d0*16+hi*8]);
  float mhat=0.f,l_reg=0.f;f32x16 o[2];o[0]=f32x16{};o[1]=f32x16{};f32x16 negm=f32x16{};asm volatile("":"+v"(negm));
  #define CMASK(P0,P1,t) do{}while(0)
  bool resc=false;
  #define START(P0,P1) do{ const float rm=rowmax(P0,P1); resc=false; \
    { const float dl=rm; mhat=fadd_s(mhat,dl); \
      _Pragma("unroll") for(int r=0;r<16;++r){P0[r]=fsub_s(P0[r],dl);P1[r]=fsub_s(P1[r],dl);} \
      _Pragma("unroll") for(int r=0;r<16;++r)negm[r]=-mhat; asm volatile("":"+v"(negm)); } \
    _Pragma("unroll") for(int r=0;r<16;++r)P0[r]=__builtin_amdgcn_exp2f(P0[r]); }while(0)
  #define RESC() do{ if(resc){ asm volatile("s_waitcnt lgkmcnt(0)":::"memory"); \
      _Pragma("unroll") for(int d_=0;d_<2;++d_) _Pragma("unroll") for(int r=0;r<16;++r)o[d_][r]*=wsf[crow(r,hi)]; } }while(0)
  f32x16 pA0,pA1,pB0,pB1;
  int sl_prev=0,sl_cur=0,sl_next=SLOTB;
  #define ROT() do{sl_prev=sl_cur;sl_cur=sl_next;sl_next=(sl_next==(NSLOT-1)*SLOTB)?0:sl_next+SLOTB;}while(0)
  DMA_K(2,2*SLOTB);
  WAIT_BAR(3);
  qkt(pA0,pA1,Kbase,qr,negm,r32,hi);asm volatile("s_nop 15\n\ts_nop 7":"+v"(pA0),"+v"(pA1));CMASK(pA0,pA1,0);
  START(pA0,pA1);
  _Pragma("unroll") for(int r=0;r<16;++r)pA1[r]=__builtin_amdgcn_exp2f(pA1[r]);
  WAIT_BAR(0);
  DMA_K(3,0);DMA_V(1,SLOTB);
  ROT();
  kload8(kf,kp0+sl_cur);
  WAIT_BAR(2);
  s16x4 vlo[8],vhi[8]; u32x4 pw0,pw1,pw2,pw3;
  #define PKW(P,B) cvtpk_s(P[B],P[B+1])
  #define PAF(k) __builtin_bit_cast(bf16x8,pw##k)
  #define VFR(i) (bf16x8){vlo[i][0],vlo[i][1],vlo[i][2],vlo[i][3],vhi[i][0],vhi[i][1],vhi[i][2],vhi[i][3]}
  #define PIN(x) asm volatile("":"+v"(x))
  #define MX3(a,b,c) __builtin_fmaxf(__builtin_fmaxf((a),(b)),(c))
  #define GAPA(MF,A0,A1,A2,A3,W0,W1,PW) do{ MF; sacc+=A0; sacc+=A1; sacc+=A2; sacc+=A3; PIN(sacc); W0; W1; PIN(PW); SBAR(); }while(0)
  #define EX(v) __builtin_amdgcn_exp2f(v)
  #define GAPB(MF,X,B) do{ MF; X[B]=EX(X[B]); X[B+1]=EX(X[B+1]); X[B+2]=EX(X[B+2]); X[B+3]=EX(X[B+3]); PIN(X); SBAR(); }while(0)
  #define VRD(i) do{ vlo[i]=vtr(vp_+(((i)>>2)*4096+((i)&3)*1024)); vhi[i]=vtr(vp_+(((i)>>2)*4096+((i)&3)*1024+512)); }while(0)
  #define KRD(G,j) do{ if(G){ kload2(kf,kp0+sl_next,j); SBAR(); } }while(0)
  #define STEP(C0,C1,P0,P1,t,GK,GV,GL) do{ SBAR(); \
    const lds_cptr vp_=vp0+sl_prev; \
    VRD(0); SBAR(); float sacc=(P0[0]+P0[1]); \
    GAPA(C0=__builtin_amdgcn_mfma_f32_32x32x16_bf16(kf[0],qr[0],negm,0,0,0), P0[2],P0[3],P0[4],P0[5],     pw0[0]=PKW(P0,0), pw0[1]=PKW(P0,2), pw0); \
    VRD(4); SBAR(); GAPA(C1=__builtin_amdgcn_mfma_f32_32x32x16_bf16(kf[1],qr[0],negm,0,0,0), P0[6],P0[7],P0[8],P0[9],     pw0[2]=PKW(P0,4), pw0[3]=PKW(P0,6), pw0); \
    VRD(1); SBAR(); GAPA(C0=__builtin_amdgcn_mfma_f32_32x32x16_bf16(kf[2],qr[1],C0,0,0,0),   P0[10],P0[11],P0[12],P0[13], pw1[0]=PKW(P0,8), pw1[1]=PKW(P0,10), pw1); \
    VRD(5); SBAR(); GAPA(C1=__builtin_amdgcn_mfma_f32_32x32x16_bf16(kf[3],qr[1],C1,0,0,0),   P0[14],P0[15],P1[0],P1[1],   pw1[2]=PKW(P0,12),pw1[3]=PKW(P0,14), pw1); \
    VRD(2); SBAR(); GAPA(C0=__builtin_amdgcn_mfma_f32_32x32x16_bf16(kf[4],qr[2],C0,0,0,0),   P1[2],P1[3],P1[4],P1[5],     pw2[0]=PKW(P1,0), pw2[1]=PKW(P1,2), pw2); \
    VRD(6); SBAR(); GAPA(C1=__builtin_amdgcn_mfma_f32_32x32x16_bf16(kf[5],qr[2],C1,0,0,0),   P1[6],P1[7],P1[8],P1[9],     pw2[2]=PKW(P1,4), pw2[3]=PKW(P1,6), pw2); \
    VRD(3); SBAR(); GAPA(C0=__builtin_amdgcn_mfma_f32_32x32x16_bf16(kf[6],qr[3],C0,0,0,0),   P1[10],P1[11],P1[12],P1[13], pw3[0]=PKW(P1,8), pw3[1]=PKW(P1,10), pw3); \
    VRD(7); SBAR(); GAPA(C1=__builtin_amdgcn_mfma_f32_32x32x16_bf16(kf[7],qr[3],C1,0,0,0),   P1[14],P1[15],0.f,0.f,       pw3[2]=PKW(P1,12),pw3[3]=PKW(P1,14), pw3); \
    l_reg+=sacc; \
    if(GK){DMA_K((t)+3,sl_cur);} if(GV){DMA_V((t)+1,sl_next);} \
    CMASK(C0,C1,t); \
    { float a=MX3(C0[0],C0[1],C1[0]),b=MX3(C0[2],C0[3],C1[1]); a=MX3(a,C1[2],C1[3]); \
      _Pragma("unroll") for(int r=4;r<16;r+=4){a=MX3(a,C0[r],C0[r+1]);b=MX3(b,C0[r+2],C0[r+3]);a=MX3(a,C1[r],C1[r+1]);b=MX3(b,C1[r+2],C1[r+3]);} \
      float rm=__builtin_fmaxf(a,b); { auto rr=__builtin_amdgcn_permlane32_swap(__float_as_uint(rm),__float_as_uint(rm),false,false); rm=__builtin_fmaxf(__uint_as_float(rr[0]),__uint_as_float(rr[1])); } \
      resc=false; \
      if(__builtin_expect(__any(rm>(float)THRL),0)){ const float dl=__builtin_fmaxf(rm,0.f); mhat+=dl; \
        _Pragma("unroll") for(int r=0;r<16;++r){C0[r]-=dl;C1[r]-=dl;} \
        _Pragma("unroll") for(int r=0;r<16;++r)negm[r]=-mhat; asm volatile("":"+v"(negm)); \
        const float f=__builtin_amdgcn_exp2f(-dl); l_reg*=f; if(hi==0)wsf[r32]=f; resc=true; } } \
    SBAR(); \
    GAPB(o[0]=__builtin_amdgcn_mfma_f32_32x32x16_bf16(PAF(0),VFR(0),o[0],0,0,0), C0,0); \
    GAPB(o[1]=__builtin_amdgcn_mfma_f32_32x32x16_bf16(PAF(0),VFR(4),o[1],0,0,0), C0,4); \
    KRD(GL,0); GAPB(o[0]=__builtin_amdgcn_mfma_f32_32x32x16_bf16(PAF(1),VFR(1),o[0],0,0,0), C0,8); \
    KRD(GL,1); GAPB(o[1]=__builtin_amdgcn_mfma_f32_32x32x16_bf16(PAF(1),VFR(5),o[1],0,0,0), C0,12); \
    KRD(GL,2); GAPB(o[0]=__builtin_amdgcn_mfma_f32_32x32x16_bf16(PAF(2),VFR(2),o[0],0,0,0), C1,0); \
    KRD(GL,3); GAPB(o[1]=__builtin_amdgcn_mfma_f32_32x32x16_bf16(PAF(2),VFR(6),o[1],0,0,0), C1,4); \
    GAPB(o[0]=__builtin_amdgcn_mfma_f32_32x32x16_bf16(PAF(3),VFR(3),o[0],0,0,0), C1,8); \
    GAPB(o[1]=__builtin_amdgcn_mfma_f32_32x32x16_bf16(PAF(3),VFR(7),o[1],0,0,0), C1,12); \
    }while(0)
  int t=1;
  #undef CMASK
  #define CMASK(P0,P1,t) do{}while(0)
  for(;t+5<NT;t+=2){
    STEP(pB0,pB1,pA0,pA1,t,true,true,true);     WAIT_BAR(2); RESC(); ROT();
    STEP(pA0,pA1,pB0,pB1,t+1,true,true,true);   WAIT_BAR(2); RESC(); ROT();
  }
  #undef CMASK
  #define CMASK(P0,P1,t) do{}while(0)
  #define ENDW(tt) do{ if((tt)+3<NT){WAIT_BAR(2);} else if((tt)+2<NT){WAIT_BAR(1);} else {WAIT_BAR(0);} }while(0)
  for(;t+1<NT;t+=2){
    STEP(pB0,pB1,pA0,pA1,t,(t+3<NT),(t+1<NT),(t+1<NT));       ENDW(t);   RESC(); ROT();
    STEP(pA0,pA1,pB0,pB1,t+1,(t+4<NT),(t+2<NT),(t+2<NT));     ENDW(t+1); RESC(); ROT();
  }
  STEP(pB0,pB1,pA0,pA1,NT-1,false,false,false); RESC();
  { float sacc=pB0[0]+pB0[1]; _Pragma("unroll") for(int r=2;r<16;++r)sacc+=pB0[r]; _Pragma("unroll") for(int r=0;r<16;++r)sacc+=pB1[r]; l_reg+=sacc;
    pw0=(u32x4){PKW(pB0,0),PKW(pB0,2),PKW(pB0,4),PKW(pB0,6)};pw1=(u32x4){PKW(pB0,8),PKW(pB0,10),PKW(pB0,12),PKW(pB0,14)};pw2=(u32x4){PKW(pB1,0),PKW(pB1,2),PKW(pB1,4),PKW(pB1,6)};pw3=(u32x4){PKW(pB1,8),PKW(pB1,10),PKW(pB1,12),PKW(pB1,14)};
    SBAR(); pv(o,vb0+sl_cur,PAF(0),PAF(1),PAF(2),PAF(3)); }
  #undef PKW
  #undef PAF
  #undef VFR
  #undef PIN
  #undef MX3
  #undef GAPA
  #undef GAPB
  #undef EX
  #undef VRD
  #undef KRD
  #undef STEP
  #undef ENDW
  {auto rr=__builtin_amdgcn_permlane32_swap(__float_as_uint(l_reg),__float_as_uint(l_reg),false,false);l_reg=__uint_as_float(rr[0])+__uint_as_float(rr[1]);}
  if(hi==0)wsf[32+r32]=l_reg;asm volatile("s_waitcnt lgkmcnt(0)":::"memory");
  float rli[16];
  #pragma unroll
  for(int r=0;r<16;++r)rli[r]=__builtin_amdgcn_rcpf(wsf[32+crow(r,hi)]);
  bf16*Ow=O+qrow0*QP+h*D;
  { bf16*stg=(bf16*)(shm+LDS_OST)+wid*2048;
    #pragma unroll
    for(int r=0;r<16;++r){const int orow=crow(r,hi);
      #pragma unroll
      for(int d0=0;d0<2;++d0)stg[orow*64+d0*32+r32]=__float2bfloat16(o[d0][r]*rli[r]);}
    asm volatile("s_waitcnt lgkmcnt(0)":::"memory");
    #pragma unroll
    for(int i=0;i<4;++i){const int row=i*8+(lane>>3),ch=lane&7; const u32x4 v=*(const u32x4*)(stg+row*64+ch*8); ATTN_STORE16(Ow+(long)row*QP+ch*8,v);} }
  asm volatile("s_waitcnt lgkmcnt(0)\n\ts_barrier":::"memory");
  #undef DMA_K
  #undef DMA_V
  #undef CMASK
  #undef START
  #undef RESC
  #undef ROT
}
constexpr int ATTN_LDS_BYTES=LDS_BYTES;
struct AttnTensors { const bf16* Q; const bf16* K; const bf16* V; bf16* O; };
struct AttnUnit { int b; int h; int qb; };
struct StaticOrder {
  int vcu;
  __device__ __forceinline__ explicit StaticOrder(int v):vcu(v){}
  __device__ __forceinline__ bool next(int i,AttnUnit&u)const{ if(i>=8)return false; const int xcd=vcu>>5,lc=vcu&31; const int grp=xcd*4+(i>>1); const int idx=(i&1)*32+lc;
    u.b=grp>>1; u.h=(grp&1)*4+(idx>>4); u.qb=idx&15; return true; }
};
struct StaticOrderR {
  int vcu,i0,i1;
  __device__ __forceinline__ StaticOrderR(int v,int a,int b):vcu(v),i0(a),i1(b){}
  __device__ __forceinline__ bool next(int j,AttnUnit&u)const{ const int i=i0+j; if(i>=i1)return false; const int xcd=vcu>>5,lc=vcu&31; const int grp=xcd*4+(i>>1); const int idx=(i&1)*32+lc;
    u.b=grp>>1; u.h=(grp&1)*4+(idx>>4); u.qb=idx&15; return true; }
};
template<class Sched,int THRL=8> __device__ __forceinline__ void attn_phase(char*lds,const AttnTensors&T,const Sched&S,int wave_){
  AttnUnit u;
  for(int i=0;S.next(i,u);++i){ attn_unit<THRL>(u.b,u.h,u.qb,T.Q,T.K,T.V,T.O,lds,wave_); }
}
#undef SBAR
#undef WAIT_BAR
}
#define XB_TMO      128
#define XB_XCNT(j)  (256  + 64 * (j))
#define XB_XSUB(j)  (1280 + 64 * (j))
#define XB_XGEN(j)  (2304 + 64 * (j))
#define XB_TOP      3328
#define XB_TOPGEN   3392
#define XCD_BAR_WORDS 3456
#define XB_SPIN_CAP (1u << 18)

__device__ __forceinline__ unsigned xb_ld(unsigned* p)              { return __hip_atomic_load(p, __ATOMIC_RELAXED, __HIP_MEMORY_SCOPE_AGENT); }
__device__ __forceinline__ unsigned xb_add(unsigned* p, unsigned v) { return __hip_atomic_fetch_add(p, v, __ATOMIC_RELAXED, __HIP_MEMORY_SCOPE_AGENT); }
__device__ __forceinline__ unsigned xb_xcc_id() { return (unsigned)__builtin_amdgcn_s_getreg((3 << 11) | 20) & 0xFu; }
#define XB_SPIN(cond, bar) do { unsigned _sp = 0; while (cond) { __builtin_amdgcn_s_sleep(1); \
    if ((++_sp & 255u) == 0u) { if (xb_ld(&(bar)[XB_TMO])) break; if (_sp > XB_SPIN_CAP) { atomicAdd(&(bar)[XB_TMO], 1u); break; } } } } while (0)

struct XcdBarrier {
    unsigned wv; unsigned* bar; unsigned x;
    volatile LAS unsigned* st;
};

__device__ __forceinline__ XcdBarrier xcd_barrier_post(unsigned* bar, volatile LAS unsigned* st) {
    XcdBarrier b; b.bar = bar; b.x = xb_xcc_id(); b.st = st;
    if (threadIdx.x == 0) (void)xb_add(&bar[XB_XCNT(b.x)], 1u);
    b.wv = (unsigned)__builtin_amdgcn_readfirstlane((int)(threadIdx.x >> 6));
    return b;
}
__device__ __forceinline__ void xcd_barrier_complete(unsigned* bar, unsigned x, unsigned& nloc, unsigned& nx) {
    const unsigned G = gridDim.x * gridDim.y * gridDim.z;
    unsigned sum, cnt, mine, sp = 0u;
    for (;;) {
        sum = 0u; cnt = 0u; mine = 0u;
#pragma unroll
        for (unsigned j = 0; j < 16; ++j) { const unsigned c = xb_ld(&bar[XB_XCNT(j)]); sum += c; cnt += (c > 0u) ? 1u : 0u; mine = (j == x) ? c : mine; }
        if (sum == G) break;
        __builtin_amdgcn_s_sleep(1);
        if ((++sp & 255u) == 0u) { if (xb_ld(&bar[XB_TMO])) break; if (sp > XB_SPIN_CAP) { atomicAdd(&bar[XB_TMO], 1u); break; } }
    }
    nloc = mine > 0u ? mine : 1u; nx = cnt > 0u ? cnt : 1u;
}

__device__ __forceinline__ void xcd_barrier(const XcdBarrier& b) {
    asm volatile("s_waitcnt vmcnt(0)" ::: "memory");
    __syncthreads();
    if (b.wv == 0u && lane_id() == 0) {
        unsigned* bar = b.bar;
        __builtin_amdgcn_s_waitcnt(0);
        unsigned nloc = b.st[0], nx = b.st[1];
        if (nloc == 0u) { xcd_barrier_complete(bar, b.x, nloc, nx); b.st[0] = nloc; b.st[1] = nx; }
        const unsigned old = xb_add(&bar[XB_XSUB(b.x)], 1u);
        const unsigned gen = old / nloc;
        if (old + 1u == (gen + 1u) * nloc) {
            __builtin_amdgcn_fence(__ATOMIC_RELEASE, "agent");
            asm volatile("s_waitcnt vmcnt(0)" ::: "memory");
            const unsigned og = xb_add(&bar[XB_TOP], 1u);
            const unsigned tg = og / nx;
            if (og + 1u == (tg + 1u) * nx) xb_add(&bar[XB_TOPGEN], 1u);
            else XB_SPIN(xb_ld(&bar[XB_TOPGEN]) == tg, bar);
            __builtin_amdgcn_fence(__ATOMIC_ACQUIRE, "agent");
            xb_add(&bar[XB_XGEN(b.x)], 1u);
            asm volatile("s_waitcnt vmcnt(0)" ::: "memory");
        } else {
            XB_SPIN(xb_ld(&bar[XB_XGEN(b.x)]) == gen, bar);
            __builtin_amdgcn_fence(__ATOMIC_ACQUIRE, "agent");
            asm volatile("s_waitcnt vmcnt(0)" ::: "memory");
        }
    }
    __syncthreads();
}


typedef GAS unsigned gu32;
#define RLX_AGENT __ATOMIC_RELAXED, __HIP_MEMORY_SCOPE_AGENT
#define LDS_WAIT() asm volatile("s_waitcnt lgkmcnt(0)" ::: "memory")
#define VM_WAIT() asm volatile("s_waitcnt vmcnt(0)" ::: "memory")
constexpr int N_IN = 34;
enum { I_X = 0, I_C, I_CTX, I_CCTX, I_MODW, I_MODB, I_NORM1, I_WIN, I_QNW, I_KNW, I_CONVW, I_CONVB, I_FW1, I_FB1, I_FW2, I_FB2, I_FW3, I_FB3, I_FW4, I_FFREQ,
       I_HBIAS, I_AONW, I_HONW, I_WOUT, I_NORM2, I_RW, I_RB, I_EG, I_EU, I_ED, I_SG, I_SU, I_SD, I_FNW };
struct Frame {
    LAS unsigned char* lds;
    volatile LAS unsigned* MISC;
    unsigned* ctl;
    int tid, lane, wave, vcu, G;
    float* out; unsigned char* ws;
};
typedef const __attribute__((address_space(4))) char* kargp_t;
__device__ __forceinline__ const float* kin(int i) { kargp_t p = (kargp_t)__builtin_amdgcn_kernarg_segment_ptr(); asm volatile("" : "+s"(p)); return (const float*)*(const GAS float* const __attribute__((address_space(4)))*)(p + 8 * i); }
#define WSP(T, off) ((T*)(F.ws + (off)))

__device__ __forceinline__ void tr_item(const float* W, int ldw, int k0, int n0, bf16_t* WT, int Kd, int drow0, LAS float* scr, int lane) {
#pragma unroll 8
    for (int i = 0; i < 32; ++i) { const int kk = 2 * i + (lane >> 5); scr[kk * 33 + (lane & 31)] = W[(size_t)(k0 + kk) * ldw + n0 + (lane & 31)]; }
    LDS_WAIT(); asm volatile("" ::: "memory");
    const int c = lane & 7;
#pragma unroll
    for (int j = 0; j < 4; ++j) { const int n = (lane >> 3) + 8 * j; const LAS float* s = scr + (8 * c) * 33 + n;
        u32x4 o; o.x = pk2(s[0 * 33], s[1 * 33]); o.y = pk2(s[2 * 33], s[3 * 33]); o.z = pk2(s[4 * 33], s[5 * 33]); o.w = pk2(s[6 * 33], s[7 * 33]);
        *(u32x4*)(WT + (size_t)(drow0 + n) * Kd + k0 + 8 * c) = o; }
    LDS_WAIT(); asm volatile("" ::: "memory");
}
__device__ __forceinline__ unsigned pk4_fp8(float a, float b, float c, float d) { int w = __builtin_amdgcn_cvt_pk_fp8_f32(a, b, 0, false); w = __builtin_amdgcn_cvt_pk_fp8_f32(c, d, w, true); return (unsigned)w; }
__device__ __forceinline__ void tr_item8(const float* W, int ldw, int k0, int n0, unsigned char* WT, int Kd, int drow0, float scl, LAS float* scr, int lane) {
#pragma unroll 8
    for (int i = 0; i < 32; ++i) { const int kk = 2 * i + (lane >> 5); scr[kk * 33 + (lane & 31)] = W[(size_t)(k0 + kk) * ldw + n0 + (lane & 31)]; }
    LDS_WAIT(); asm volatile("" ::: "memory");
    const int c = lane & 7;
#pragma unroll
    for (int j = 0; j < 4; ++j) { const int n = (lane >> 3) + 8 * j; const LAS float* s = scr + (8 * c) * 33 + n;
        u32x2 o; o.x = pk4_fp8(s[0 * 33] * scl, s[1 * 33] * scl, s[2 * 33] * scl, s[3 * 33] * scl); o.y = pk4_fp8(s[4 * 33] * scl, s[5 * 33] * scl, s[6 * 33] * scl, s[7 * 33] * scl);
        *(u32x2*)(WT + (size_t)(drow0 + n) * Kd + k0 + 8 * c) = o; }
    LDS_WAIT(); asm volatile("" ::: "memory");
}
constexpr int IT_FILT = 2048, IT_MODV = 0, IT_ROPE = 1, IT_QKV = 384, IT_WU = 768, IT_WO = 512, IT_WR = 128, IT_SGU = 256, IT_SD = 128, IT_EXP = 256 * 384;
constexpr int IT_TILES = IT_QKV + IT_WU + IT_WO + IT_WR + IT_SGU + IT_SD;
constexpr int XP_TILES = 256 * 48;

template <int NT_> __device__ __forceinline__ void p0_filter_item(Frame& F, int item, LAS float* hsc) {
    const int lane = F.lane; const int t0 = NT_ * item;
    const float* w1 = kin(I_FW1); const float* b1 = kin(I_FB1); const float* w2 = kin(I_FW2); const float* b2 = kin(I_FB2);
    const float* w3 = kin(I_FW3); const float* b3 = kin(I_FB3); const float* w4 = kin(I_FW4); const float fr = kin(I_FFREQ)[lane];
    float h[NT_], a[NT_];
#pragma unroll
    for (int tt = 0; tt < NT_; ++tt) { const int t = t0 + tt; float v = 0.f;
        if (lane == 0) v = (float)t * (1.0f / 4095.0f);
        else if (lane < 33) { const int m = (lane - 1) & 15; const float f = 1e-4f + (float)m * ((15.0f - 1e-4f) / 15.0f);
            float rev = f * ((float)t * (1.0f / 4096.0f)); rev -= floorf(rev); const float ang = 6.283185307179586f * rev;
            v = lane <= 16 ? cosf(ang) : -sinf(ang); }
        h[tt] = v; }
#pragma unroll
    for (int l = 0; l < 3; ++l) { const float* ww = l == 0 ? w1 : l == 1 ? w2 : w3; const float bb = (l == 0 ? b1 : l == 1 ? b2 : b3)[lane];
        float wc[64];
#pragma unroll
        for (int i = 0; i < 64; ++i) wc[i] = (l == 0 && i >= 33) ? 0.f : ww[i * 64 + lane];
#pragma unroll
        for (int tt = 0; tt < NT_; ++tt) a[tt] = bb;
#pragma unroll
        for (int i = 0; i < 64; ++i) { if (l == 0 && i >= 33) break;
#pragma unroll
            for (int tt = 0; tt < NT_; ++tt) a[tt] += __shfl(h[tt], i) * wc[i]; }
#pragma unroll
        for (int tt = 0; tt < NT_; ++tt) h[tt] = sinf(fr * a[tt]); }
#pragma unroll
    for (int tt = 0; tt < NT_; ++tt) hsc[tt * 64 + lane] = h[tt];
    LDS_WAIT(); asm volatile("" ::: "memory");
    bf16_t* KR = WSP(bf16_t, WS_KR);
    const float dmin = logf(1e-2f) / 0.3f, dmax = logf(1e-2f) / 1.5f;
#pragma unroll 1
    for (int q = 0; q < 16; ++q) {
        const int n = lane + 64 * q; float wc[64];
#pragma unroll
        for (int i = 0; i < 64; ++i) wc[i] = w4[i * 1024 + n];
        float o[NT_];
#pragma unroll
        for (int tt = 0; tt < NT_; ++tt) o[tt] = 0.f;
#pragma unroll
        for (int i4 = 0; i4 < 16; ++i4)
#pragma unroll
            for (int tt = 0; tt < NT_; ++tt) { const f32x4 hv = *(const LAS f32x4*)(hsc + tt * 64 + 4 * i4);
                o[tt] += (hv[0] * wc[4 * i4] + hv[1] * wc[4 * i4 + 1]) + (hv[2] * wc[4 * i4 + 2] + hv[3] * wc[4 * i4 + 3]); }
        const int c = n & 511; const bool bwd = n >= 512;
        const float delta = fabsf(dmin + (float)c * ((dmax - dmin) / 511.0f));
#pragma unroll
        for (int tt = 0; tt < NT_; ++tt) { const int t = t0 + tt; const float tl = (float)t * (1.0f / 4095.0f);
            const float val = o[tt] * expf(-tl * delta);
            if (!(bwd && t == 0)) {
#if HYENA_FP8
                ((unsigned char*)KR)[(size_t)c * 8192 + (bwd ? 4096 + t : 4096 - t)] = (unsigned char)(pk4_fp8c(val * 64.0f, 0.f, 0.f, 0.f) & 0xffu);
#else
                KR[(size_t)c * 8192 + (bwd ? 4096 + t : 4096 - t)] = (bf16_t)f2bf(val);
#endif
            } }
    }
}
__device__ __forceinline__ void p0_modv_block(Frame& F, int chunk) {
    const int lane = F.lane, kc = F.wave; const int n0 = 64 * chunk, k0 = 128 * kc;
    LAS float* sv = (LAS float*)(F.lds + RING_OFF + F.wave * 8704);
    LAS float* part = (LAS float*)(F.lds + RING_OFF + 8 * 8704);
    for (int r = 0; r < 17; ++r)
#pragma unroll
        for (int hh = 0; hh < 2; ++hh) { const int kk = lane + 64 * hh; const float v = r < 16 ? kin(I_C)[r * 1024 + k0 + kk] : kin(I_CCTX)[k0 + kk];
            sv[r * 128 + kk] = v / (1.0f + expf(-v)); }
    LDS_WAIT(); asm volatile("" ::: "memory");
    float acc[17];
#pragma unroll
    for (int r = 0; r < 17; ++r) acc[r] = 0.f;
    const float* W = kin(I_MODW) + (size_t)k0 * 6144 + n0 + lane;
    for (int k4 = 0; k4 < 32; ++k4) {
        const float w0 = W[(size_t)(4 * k4 + 0) * 6144], w1 = W[(size_t)(4 * k4 + 1) * 6144], w2 = W[(size_t)(4 * k4 + 2) * 6144], w3 = W[(size_t)(4 * k4 + 3) * 6144];
#pragma unroll
        for (int r = 0; r < 17; ++r) { const f32x4 s = *(const LAS f32x4*)(sv + r * 128 + 4 * k4); acc[r] += (s[0] * w0 + s[1] * w1) + (s[2] * w2 + s[3] * w3); }
    }
#pragma unroll
    for (int r = 0; r < 17; ++r) part[(kc * 17 + r) * 64 + lane] = acc[r];
    __syncthreads();
    if (F.wave == 0) { float* mv = WSP(float, WS_MODV); const float bb = kin(I_MODB)[n0 + lane];
#pragma unroll
        for (int r = 0; r < 17; ++r) { float s = bb;
#pragma unroll
            for (int k = 0; k < 8; ++k) s += part[(k * 17 + r) * 64 + lane];
            mv[r * 6144 + n0 + lane] = s; } }
    __syncthreads();
}
struct XpT { const float* src; unsigned char* dst; int ldw, Kd, which; };
__device__ __forceinline__ XpT xp_params(Frame& F, int ti) {
    XpT p; const int e = ti / 48, q = ti % 48;
    if (q < 32) { const int which = q >> 4, kb = q & 15; p.src = kin(which ? I_EU : I_EG) + (size_t)e * (1024 * 256) + (size_t)(64 * kb) * 256; p.ldw = 256;
        p.dst = WSP(unsigned char, WS_WGU) + (size_t)e * (512 * 1024) + 64 * kb; p.Kd = 1024; p.which = which; }
    else { const int r = q - 32, kb = r & 3, cb = r >> 2; p.src = kin(I_ED) + (size_t)e * (256 * 1024) + (size_t)(64 * kb) * 1024 + 256 * cb; p.ldw = 1024;
        p.dst = WSP(unsigned char, WS_WD) + (size_t)e * (1024 * 256) + (size_t)(256 * cb) * 256 + 64 * kb; p.Kd = 256; p.which = -1; }
    return p;
}
__device__ __forceinline__ void xp_load(const XpT& p, f32x4 (&v)[8], int tid) {
#pragma unroll
    for (int i = 0; i < 8; ++i) { const int g = tid + 512 * i; v[i] = *(const f32x4*)(p.src + (size_t)(g >> 6) * p.ldw + 4 * (g & 63)); }
}
__device__ __forceinline__ void xp_tiles(Frame& F, int quota) {
    constexpr int PK = 65, PLANE = 64 * PK + 2, BUF = 4 * PLANE;
    LAS float* L0 = (LAS float*)(F.lds + RING_OFF);
    const int tid = F.tid;
    volatile LAS int* qw = (volatile LAS int*)(F.MISC + 16);
    if (tid == 0) {
#pragma unroll
        for (int k = 0; k < 5; ++k) qw[k] = (int)__hip_atomic_fetch_add(F.ctl + CW_TILEQ, 1u, RLX_AGENT); }
    LDS_WAIT(); __syncthreads();
    int t0 = qw[0], t1 = qw[1], t2 = qw[2], t3 = qw[3], t4 = qw[4], par = 0, ng = 5;
    __syncthreads();
    f32x4 v0[8], v1[8], v2[8], v3[8];
    if (t0 < XP_TILES) { const XpT p = xp_params(F, t0); xp_load(p, v0, tid); }
    if (t1 < XP_TILES) { const XpT p = xp_params(F, t1); xp_load(p, v1, tid); }
    if (t2 < XP_TILES) { const XpT p = xp_params(F, t2); xp_load(p, v2, tid); }
    if (t3 < XP_TILES) { const XpT p = xp_params(F, t3); xp_load(p, v3, tid); }
#define XP_STEP(V) { if (t0 >= XP_TILES) break; \
        if (tid == 0) qw[6 + par] = (t4 < XP_TILES && ng < quota) ? (int)__hip_atomic_fetch_add(F.ctl + CW_TILEQ, 1u, RLX_AGENT) : XP_TILES;     \
        ++ng; \
        LAS float* buf = L0 + par * BUF; \
        _Pragma("unroll") for (int i = 0; i < 8; ++i) { const int g = tid + 512 * i; LAS float* d = buf + (g >> 6) * PK + (g & 63); \
            d[0] = V[i][0]; d[PLANE] = V[i][1]; d[2 * PLANE] = V[i][2]; d[3 * PLANE] = V[i][3]; } \
        if (t4 < XP_TILES) { const XpT p = xp_params(F, t4); xp_load(p, V, tid); } \
        LDS_WAIT(); __syncthreads(); \
        const int t5 = qw[6 + par]; \
        const XpT pa = xp_params(F, t0); \
        _Pragma("unroll") for (int i = 0; i < 4; ++i) { const int pr = tid + 512 * i; const int kc = pr & 7, n = pr >> 3; \
            const LAS float* s_ = buf + (n & 3) * PLANE + (8 * kc) * PK + (n >> 2); \
            u32x2 o; o.x = pk4_fp8(s_[0] * 32.f, s_[PK] * 32.f, s_[2 * PK] * 32.f, s_[3 * PK] * 32.f); o.y = pk4_fp8(s_[4 * PK] * 32.f, s_[5 * PK] * 32.f, s_[6 * PK] * 32.f, s_[7 * PK] * 32.f); \
            const int row = pa.which < 0 ? n : 256 * (n >> 7) + 128 * pa.which + (n & 127); \
            *(u32x2*)(pa.dst + (size_t)row * pa.Kd + 8 * kc) = o; } \
        t0 = t1; t1 = t2; t2 = t3; t3 = t4; t4 = t5; par ^= 1; }
    for (;;) { XP_STEP(v0) XP_STEP(v1) XP_STEP(v2) XP_STEP(v3) }
#undef XP_STEP
    LDS_WAIT(); __syncthreads();
}
__device__ __forceinline__ void p0_prologue(Frame& F) {
    LAS float* scr = (LAS float*)(F.lds + RING_OFF + F.wave * 16384);
    const int gw = F.vcu * NWAVES + F.wave, NGW = F.G * NWAVES; const int lane = F.lane;
    __syncthreads();
    for (int ch = F.vcu; ch < 96; ch += F.G) p0_modv_block(F, ch);
    for (int it = gw; it < IT_FILT; it += NGW) { p0_filter_item<2>(F, it, scr); LDS_WAIT(); }
    if (gw == NGW - 1) { f32x2* rope = WSP(f32x2, WS_ROPE);
        for (int idx = lane; idx < 1024; idx += 64) { const int pos = idx >> 4, f = idx & 15; const float inv = powf(10000.0f, -(float)f / 16.0f); const float ang = (float)pos * inv;
            rope[idx] = (f32x2){cosf(ang), sinf(ang)}; } }
    for (int it = gw; it < IT_TILES; it += NGW) {
        int r = it;
        if (r < IT_QKV) { const int cb = r >> 4, kb = r & 15, n0 = 32 * cb; const int pn = n0 >> 8, hl = (n0 & 255) >> 6, dh = (n0 & 63) >> 5;
            tr_item(kin(I_WIN), 2304, 64 * kb, n0, WSP(bf16_t, WS_WQKV), 1024, 256 * pn + 128 * dh + 32 * hl, scr, lane); continue; } r -= IT_QKV;
        if (r < IT_WU) { const int cb = r >> 4, kb = r & 15; tr_item8(kin(I_WIN), 2304, 64 * kb, 768 + 32 * cb, WSP(unsigned char, WS_WU), 1024, 32 * cb, 32.0f, scr, lane); continue; } r -= IT_WU;
        if (r < IT_WO) { const int cb = r >> 4, kb = r & 15; tr_item(kin(I_WOUT), 1024, 64 * kb, 32 * cb, WSP(bf16_t, WS_WO), 1024, 32 * cb, scr, lane); continue; } r -= IT_WO;
        if (r < IT_WR) { const int cb = r >> 4, kb = r & 15; tr_item(kin(I_RW), 256, 64 * kb, 32 * cb, WSP(bf16_t, WS_WR), 1024, 32 * cb, scr, lane); continue; } r -= IT_WR;
        if (r < IT_SGU) { const int which = r >> 7, rr = r & 127, cb = rr >> 4, kb = rr & 15, j0 = 32 * cb;
            tr_item8(kin(which ? I_SU : I_SG), 256, 64 * kb, j0, WSP(unsigned char, WS_WSGU8), 1024, 256 * (j0 >> 7) + 128 * which + (j0 & 127), 32.0f, scr, lane); continue; } r -= IT_SGU;
        if (r < IT_SD) { const int kb = r & 3, cb = r >> 2; tr_item8(kin(I_SD), 1024, 64 * kb, 32 * cb, WSP(unsigned char, WS_WSD), 256, 32 * cb, 32.0f, scr, lane); continue; } r -= IT_SD;
    }
    __syncthreads();
}

template <int NR, bool F8> __device__ __forceinline__ void modulate_group(Frame& F, const float* src, bf16_t* dst, unsigned char* dst8, int row, const f32x4 (&A)[4], const f32x4 (&Bv)[4]) {
    const f32x4* xr = (const f32x4*)(src + (size_t)row * DM) + F.lane;
    f32x4 v[NR][4]; float ss[NR];
#pragma unroll
    for (int q = 0; q < NR; ++q)
#pragma unroll
        for (int j = 0; j < 4; ++j) v[q][j] = xr[q * (DM / 4) + 64 * j];
#pragma unroll
    for (int q = 0; q < NR; ++q) { float a = 0.f;
#pragma unroll
        for (int j = 0; j < 4; ++j) a += (v[q][j][0] * v[q][j][0] + v[q][j][1] * v[q][j][1]) + (v[q][j][2] * v[q][j][2] + v[q][j][3] * v[q][j][3]);
        ss[q] = a; }
#pragma unroll
    for (int o = 1; o < 64; o <<= 1) {
#pragma unroll
        for (int q = 0; q < NR; ++q) ss[q] += __shfl_xor(ss[q], o); }
#pragma unroll
    for (int q = 0; q < NR; ++q) { const float rs = rsqrtf(ss[q] * (1.0f / DM) + EPS);
        u32x2* o8 = (u32x2*)(dst + (size_t)(row + q) * DM) + F.lane;
#pragma unroll
        for (int j = 0; j < 4; ++j) { const f32x4 o = v[q][j] * rs * A[j] + Bv[j]; u32x2 w; w.x = pk2(o[0], o[1]); w.y = pk2(o[2], o[3]); o8[64 * j] = w;
            if (F8) ((unsigned*)(dst8 + (size_t)(row + q) * DM))[F.lane + 64 * j] = pk4_fp8c(o[0] * 8.0f, o[1] * 8.0f, o[2] * 8.0f, o[3] * 8.0f); } }
}
template <bool F8 = false> __device__ __forceinline__ void modulate_rows(Frame& F, const float* src, bf16_t* dst, int row0, int nrows, const float* nw, const float* sc, const float* sh, unsigned char* dst8 = nullptr) {
    f32x4 A[4], Bv[4];
#pragma unroll
    for (int j = 0; j < 4; ++j) { const int c = 4 * F.lane + 256 * j; const f32x4 n4 = *(const f32x4*)(nw + c), s4 = *(const f32x4*)(sc + c); A[j] = n4 * (s4 + 1.0f); Bv[j] = *(const f32x4*)(sh + c); }
    int r = 0;
    for (; r + 4 <= nrows; r += 4) modulate_group<4, F8>(F, src, dst, dst8, row0 + r, A, Bv);
    if (r + 2 <= nrows) modulate_group<2, F8>(F, src, dst, dst8, row0 + r, A, Bv);
}

constexpr unsigned HY_SK_PACKED = 0xCB885410u;
__device__ __forceinline__ void hyena_unit(Frame& F, int c) {
    const int tid = F.tid, lane = F.lane, wid = F.wave;
    LAS unsigned char* Lc = F.lds + RING_OFF;
    const bf16_t* UT = WSP(const bf16_t, WS_UT);
    bf16_t* Wg = WSP(bf16_t, WS_HYW) + (size_t)c * MTOK;
    bf16_t* Xg = WSP(bf16_t, WS_HYX) + (size_t)c * MTOK;
    {
        const u32x4* src = (const u32x4*)(WSP(const bf16_t, WS_KR) + (size_t)c * 8192);
#pragma unroll
        for (int i = 0; i < 2; ++i) { const int jc = tid + 512 * i; const u32x4 lo = src[jc]; const u32x4 hi = jc < 1023 ? src[jc + 1] : (u32x4){0u, 0u, 0u, 0u};
            const unsigned w[8] = {lo.x, lo.y, lo.z, lo.w, hi.x, hi.y, hi.z, hi.w};
#pragma unroll
            for (int cc = 0; cc < 8; ++cc) { u32x4 o;
#pragma unroll
                for (int k = 0; k < 4; ++k) { const int idx = (cc >> 1) + k; o[k] = (cc & 1) ? __builtin_amdgcn_alignbyte(w[idx + 1], w[idx], 2u) : w[idx]; }
                *(LAS u32x4*)(Lc + cc * 16384 + 16 * ((HY_SK_PACKED >> (4 * cc)) & 15u) + 16 * jc) = o; } }
    }
    const float* cw = kin(I_CONVW); const float* cb = kin(I_CONVB);
    {
        const bf16_t* vrow = UT + (size_t)(1024 + c) * MTOK; const bf16_t* x1row = UT + (size_t)(512 + c) * MTOK; const bf16_t* x0row = UT + (size_t)c * MTOK;
        const float v0 = cw[1024 + c], v1 = cw[1536 + 1024 + c], v2 = cw[3072 + 1024 + c], vb = cb[1024 + c];
        const float a0 = cw[512 + c], a1 = cw[1536 + 512 + c], a2 = cw[3072 + 512 + c], ab = cb[512 + c];
        const float g0 = cw[c], g1 = cw[1536 + c], g2 = cw[3072 + c], gb = cb[c];
        const int s0 = tid * 8;
#pragma unroll 4
        for (int it = 0; it < 16; ++it) {
            const size_t base = (size_t)it * SEQ + s0;
            const u32x4 vv = *(const u32x4*)(vrow + base), xx = *(const u32x4*)(x1row + base), gg = *(const u32x4*)(x0row + base);
            float ve[10], xe[10], ge[10];
            ve[0] = s0 > 0 ? bf2f(vrow[base - 1]) : 0.f; xe[0] = s0 > 0 ? bf2f(x1row[base - 1]) : 0.f; ge[0] = s0 > 0 ? bf2f(x0row[base - 1]) : 0.f;
            ve[9] = s0 + 8 < SEQ ? bf2f(vrow[base + 8]) : 0.f; xe[9] = s0 + 8 < SEQ ? bf2f(x1row[base + 8]) : 0.f; ge[9] = s0 + 8 < SEQ ? bf2f(x0row[base + 8]) : 0.f;
#pragma unroll
            for (int j = 0; j < 4; ++j) { ve[1 + 2 * j] = bf2f(vv[j] & 0xffffu); ve[2 + 2 * j] = bf2f(vv[j] >> 16); xe[1 + 2 * j] = bf2f(xx[j] & 0xffffu); xe[2 + 2 * j] = bf2f(xx[j] >> 16);
                ge[1 + 2 * j] = bf2f(gg[j] & 0xffffu); ge[2 + 2 * j] = bf2f(gg[j] >> 16); }
            float w[8], g[8];
#pragma unroll
            for (int j = 0; j < 8; ++j) { w[j] = (v0 * ve[j] + v1 * ve[j + 1] + v2 * ve[j + 2] + vb) * (a0 * xe[j] + a1 * xe[j + 1] + a2 * xe[j + 2] + ab); g[j] = g0 * ge[j] + g1 * ge[j + 1] + g2 * ge[j + 2] + gb; }
            u32x4 o; o.x = pk2(w[0], w[1]); o.y = pk2(w[2], w[3]); o.z = pk2(w[4], w[5]); o.w = pk2(w[6], w[7]);
            *(u32x4*)(Wg + (size_t)(tid * 16 + it) * 8) = o;
            u32x4 p; p.x = pk2(g[0], g[1]); p.y = pk2(g[2], g[3]); p.z = pk2(g[4], g[5]); p.w = pk2(g[6], g[7]);
            *(u32x4*)(Xg + base) = p;
        }
    }
    VM_WAIT(); __syncthreads();
    const float hb = kin(I_HBIAS)[c];
    bf16_t* yrow = WSP(bf16_t, WS_YT) + (size_t)c * MTOK;
    const int li = lane & 15, lg = lane >> 4;
#pragma unroll 1
    for (int pass = 0; pass < 2; ++pass) {
        const int T0 = (pass * 8 + wid) * 256;
        f32x4 acc[16]; bf16x8 AF[16], Bf[8];
#pragma unroll
        for (int q = 0; q < 16; ++q) acc[q] = (f32x4){0.f, 0.f, 0.f, 0.f};
        const int xbase = 4096 - T0 - li + 8 * lg; const int cl = xbase & 7;
        const LAS unsigned char* pA = Lc + cl * 16384 + 16 * (int)((HY_SK_PACKED >> (4 * cl)) & 15u) + 2 * (xbase - cl);
        const bf16x8* Bg = (const bf16x8*)Wg + lg * 16 + li;
#define HY_LOADA(dst, q) dst = *(const LAS bf16x8*)(pA - 32 * (q))
#pragma unroll
        for (int q = 0; q < 16; ++q) HY_LOADA(AF[q], q);
#pragma unroll
        for (int v = 0; v < 8; ++v) Bf[v] = Bg[64 * v];
#pragma unroll 1
        for (int S8 = 0; S8 < 128; S8 += 8) {
#pragma unroll
            for (int v = 0; v < 8; ++v) { const int S = S8 + v;
#pragma unroll
                for (int tau = 15; tau >= 0; --tau) acc[tau] = __builtin_amdgcn_mfma_f32_16x16x32_bf16(AF[(tau - 2 * v) & 15], Bf[v], acc[tau], 0, 0, 0);
                if (S + 8 < 128) Bf[v] = Bg[64 * (S + 8)];
                if (S + 1 < 128) { HY_LOADA(AF[(-2 * (v + 1)) & 15], -2 * (S + 1)); HY_LOADA(AF[(-2 * (v + 1) + 1) & 15], -2 * (S + 1) + 1); }
            }
        }
#undef HY_LOADA
        u32x2 wv[16], xv[16];
#pragma unroll
        for (int tau = 0; tau < 16; ++tau) { const int t = T0 + 16 * tau + 4 * lg;
            wv[tau] = *(const u32x2*)(Wg + (size_t)((t >> 3) * 16 + li) * 8 + (t & 7)); xv[tau] = *(const u32x2*)(Xg + (size_t)li * SEQ + t); }
#pragma unroll
        for (int tau = 0; tau < 16; ++tau) { const int t = T0 + 16 * tau + 4 * lg;
            const float we[4] = {bf2f(wv[tau].x & 0xffffu), bf2f(wv[tau].x >> 16), bf2f(wv[tau].y & 0xffffu), bf2f(wv[tau].y >> 16)};
            const float xe[4] = {bf2f(xv[tau].x & 0xffffu), bf2f(xv[tau].x >> 16), bf2f(xv[tau].y & 0xffffu), bf2f(xv[tau].y >> 16)};
            float z[4];
#pragma unroll
            for (int j = 0; j < 4; ++j) z[j] = (acc[tau][j] + hb * we[j]) * xe[j];
            u32x2 o; o.x = pk2(z[0], z[1]); o.y = pk2(z[2], z[3]); *(u32x2*)(yrow + (size_t)li * SEQ + t) = o; }
    }
    __syncthreads();
}

constexpr unsigned long long HY8_SK = 0xea6eda965212d950ull; constexpr int HY8_STR = 8448;
__device__ __forceinline__ void hyena_unit8(Frame& F, int c) {
    int tid_ = F.tid; asm volatile("" : "+v"(tid_));
    const int tid = tid_, lane = tid & 63, wid = F.wave;
    LAS unsigned char* Lc = F.lds + RING_OFF;
    const bf16_t* UT = WSP(const bf16_t, WS_UT);
    unsigned char* W8 = WSP(unsigned char, WS_HYW) + (size_t)c * MTOK;
    bf16_t* Xg = WSP(bf16_t, WS_HYX) + (size_t)c * MTOK;
    {
        const u32x4* src = (const u32x4*)(WSP(const unsigned char, WS_KR) + (size_t)c * 8192);
        const u32x4 lo = src[tid]; const u32x4 hi = tid < 511 ? src[tid + 1] : (u32x4){0u, 0u, 0u, 0u};
        const unsigned w[8] = {lo.x, lo.y, lo.z, lo.w, hi.x, hi.y, hi.z, hi.w};
#pragma unroll
        for (int sh = 0; sh < 16; ++sh) { u32x4 o;
#pragma unroll
            for (int k = 0; k < 4; ++k) { const int idx = (sh >> 2) + k; o[k] = (sh & 3) ? __builtin_amdgcn_alignbyte(w[idx + 1], w[idx], (unsigned)(sh & 3)) : w[idx]; }
            *(LAS u32x4*)(Lc + sh * HY8_STR + 16 * (int)((HY8_SK >> (4 * sh)) & 15ull) + 16 * tid) = o; }
    }
    const float* cw = kin(I_CONVW); const float* cb = kin(I_CONVB);
    {
        const bf16_t* vrow = UT + (size_t)(1024 + c) * MTOK; const bf16_t* x1row = UT + (size_t)(512 + c) * MTOK; const bf16_t* x0row = UT + (size_t)c * MTOK;
        const float v0 = cw[1024 + c], v1 = cw[1536 + 1024 + c], v2 = cw[3072 + 1024 + c], vb = cb[1024 + c];
        const float a0 = cw[512 + c], a1 = cw[1536 + 512 + c], a2 = cw[3072 + 512 + c], ab = cb[512 + c];
        const float g0 = cw[c], g1 = cw[1536 + c], g2 = cw[3072 + c], gb = cb[c];
        const int s0 = tid * 8;
#pragma unroll 4
        for (int it = 0; it < 16; ++it) {
            const size_t base = (size_t)it * SEQ + s0;
            const u32x4 vv = *(const u32x4*)(vrow + base), xx = *(const u32x4*)(x1row + base), gg = *(const u32x4*)(x0row + base);
            float ve[10], xe[10], ge[10];
            ve[0] = s0 > 0 ? bf2f(vrow[base - 1]) : 0.f; xe[0] = s0 > 0 ? bf2f(x1row[base - 1]) : 0.f; ge[0] = s0 > 0 ? bf2f(x0row[base - 1]) : 0.f;
            ve[9] = s0 + 8 < SEQ ? bf2f(vrow[base + 8]) : 0.f; xe[9] = s0 + 8 < SEQ ? bf2f(x1row[base + 8]) : 0.f; ge[9] = s0 + 8 < SEQ ? bf2f(x0row[base + 8]) : 0.f;
#pragma unroll
            for (int j = 0; j < 4; ++j) { ve[1 + 2 * j] = bf2f(vv[j] & 0xffffu); ve[2 + 2 * j] = bf2f(vv[j] >> 16); xe[1 + 2 * j] = bf2f(xx[j] & 0xffffu); xe[2 + 2 * j] = bf2f(xx[j] >> 16);
                ge[1 + 2 * j] = bf2f(gg[j] & 0xffffu); ge[2 + 2 * j] = bf2f(gg[j] >> 16); }
            float w[8], g[8];
#pragma unroll
            for (int j = 0; j < 8; ++j) { w[j] = 8.0f * (v0 * ve[j] + v1 * ve[j + 1] + v2 * ve[j + 2] + vb) * (a0 * xe[j] + a1 * xe[j + 1] + a2 * xe[j + 2] + ab); g[j] = g0 * ge[j] + g1 * ge[j + 1] + g2 * ge[j + 2] + gb; }
            u32x2 o; o.x = pk4_fp8c(w[0], w[1], w[2], w[3]); o.y = pk4_fp8c(w[4], w[5], w[6], w[7]);
            *(u32x2*)(W8 + (size_t)((tid >> 2) * 16 + it) * 32 + (tid & 3) * 8) = o;
            u32x4 p; p.x = pk2(g[0], g[1]); p.y = pk2(g[2], g[3]); p.z = pk2(g[4], g[5]); p.w = pk2(g[6], g[7]);
            *(u32x4*)(Xg + base) = p;
        }
    }
    VM_WAIT(); __syncthreads();
    const float hb = kin(I_HBIAS)[c];
    bf16_t* yrow = WSP(bf16_t, WS_YT) + (size_t)c * MTOK;
    const int li = lane & 15, lg = lane >> 4;
#pragma unroll 1
    for (int pass = 0; pass < 2; ++pass) {
        const int T0 = (pass * 8 + wid) * 256;
        f32x4 acc[16]; pg8::v8i AF[16], Bf[2];
#pragma unroll
        for (int q = 0; q < 16; ++q) { acc[q] = (f32x4){0.f, 0.f, 0.f, 0.f}; asm volatile("" : "+v"(acc[q])); }
        const int x00 = 4096 - T0 - li + 32 * lg; const int cl = x00 & 15;
        const LAS unsigned char* pA = Lc + cl * HY8_STR + 16 * (int)((HY8_SK >> (4 * cl)) & 15ull) + (x00 - cl);
        const u32x4* Bg = (const u32x4*)W8 + (lg * 16 + li) * 2;
#define HY8_LOADA(dst, q) do { const LAS unsigned char* p_ = pA - 16 * (q); dst = pg8::cat8(*(const LAS bf16x8*)p_, *(const LAS bf16x8*)(p_ + 16)); } while (0)
#define HY8_LOADB(dst, S_) do { const u32x4 b0_ = Bg[128 * (S_)], b1_ = Bg[128 * (S_) + 1]; dst = pg8::cat8(__builtin_bit_cast(bf16x8, b0_), __builtin_bit_cast(bf16x8, b1_)); } while (0)
#pragma unroll
        for (int q = 0; q < 16; ++q) HY8_LOADA(AF[q], q);
#pragma unroll
        for (int v = 0; v < 2; ++v) HY8_LOADB(Bf[v], v);
#pragma unroll 1
        for (int S4 = 0; S4 < 32; S4 += 2) {
#pragma unroll
            for (int v = 0; v < 2; ++v) { const int S = S4 + v; const int p = v & 1;
                asm volatile("s_waitcnt lgkmcnt(0)\n\ts_nop 4" ::: "memory");
#pragma unroll
                for (int tau = 15; tau >= 0; --tau) pg8::mfma_fp8(acc[tau], AF[(tau - 8 * p) & 15], Bf[v]);
                if (S + 2 < 32) HY8_LOADB(Bf[v], S + 2);
                if (S + 1 < 32) {
#pragma unroll
                    for (int i = 0; i < 8; ++i) HY8_LOADA(AF[(i + 8 * (1 - p)) & 15], i - 8 * (S + 1)); }
            }
            asm volatile("s_nop 15\n\ts_nop 7" : "+v"(acc[0]), "+v"(acc[1]), "+v"(acc[2]), "+v"(acc[3]), "+v"(acc[4]), "+v"(acc[5]), "+v"(acc[6]), "+v"(acc[7]),
                         "+v"(acc[8]), "+v"(acc[9]), "+v"(acc[10]), "+v"(acc[11]), "+v"(acc[12]), "+v"(acc[13]), "+v"(acc[14]), "+v"(acc[15]));
        }
#undef HY8_LOADA
#undef HY8_LOADB
        asm volatile("s_nop 15\n\ts_nop 15" : "+v"(acc[0]), "+v"(acc[1]), "+v"(acc[2]), "+v"(acc[3]), "+v"(acc[4]), "+v"(acc[5]), "+v"(acc[6]), "+v"(acc[7]),
                     "+v"(acc[8]), "+v"(acc[9]), "+v"(acc[10]), "+v"(acc[11]), "+v"(acc[12]), "+v"(acc[13]), "+v"(acc[14]), "+v"(acc[15]) :: "memory");
        unsigned wv[16]; u32x2 xv[16];
#pragma unroll
        for (int tau = 0; tau < 16; ++tau) { const int t = T0 + 16 * tau + 4 * lg;
            wv[tau] = *(const unsigned*)(W8 + (size_t)((t >> 5) * 16 + li) * 32 + (t & 31)); xv[tau] = *(const u32x2*)(Xg + (size_t)li * SEQ + t); }
#pragma unroll
        for (int tau = 0; tau < 16; ++tau) { const int t = T0 + 16 * tau + 4 * lg;
            const f32x2 wlo = __builtin_amdgcn_cvt_pk_f32_fp8((int)wv[tau], false), whi = __builtin_amdgcn_cvt_pk_f32_fp8((int)wv[tau], true);
            const float we[4] = {wlo[0] * 0.125f, wlo[1] * 0.125f, whi[0] * 0.125f, whi[1] * 0.125f};
            const float xe[4] = {bf2f(xv[tau].x & 0xffffu), bf2f(xv[tau].x >> 16), bf2f(xv[tau].y & 0xffffu), bf2f(xv[tau].y >> 16)};
            float z[4];
#pragma unroll
            for (int j = 0; j < 4; ++j) z[j] = (acc[tau][j] * (1.0f / 512.0f) + hb * we[j]) * xe[j];
            u32x2 o; o.x = pk2(z[0], z[1]); o.y = pk2(z[2], z[3]); *(u32x2*)(yrow + (size_t)li * SEQ + t) = o; }
    }
    __syncthreads();
}

__device__ __forceinline__ void p4_norm_tile(Frame& F, int it) {
    const int lane = F.lane, wid = F.wave, tid = F.tid; const int m0 = it * 64;
    bf16_t* AY = WSP(bf16_t, WS_AY); const bf16_t* A = WSP(const bf16_t, WS_AO); const bf16_t* YT = WSP(const bf16_t, WS_YT);
    constexpr int TP = 520;
    LAS bf16_t* T2 = (LAS bf16_t*)(F.lds + RING_OFF);
    {
        const u32x4* src = (const u32x4*)(YT + (size_t)tid * MTOK + m0);
#pragma unroll
        for (int i = 0; i < 8; ++i) { const u32x4 v = src[i];
#pragma unroll
            for (int j = 0; j < 4; ++j) { T2[(8 * i + 2 * j) * TP + tid] = (bf16_t)(v[j] & 0xffffu); T2[(8 * i + 2 * j + 1) * TP + tid] = (bf16_t)(v[j] >> 16); } }
    }
#define P4_ROWS8(LOADV, GAIN, DSTCOL) do { const float* gw_ = (GAIN) + 8 * lane; const f32x4 g0 = *(const f32x4*)gw_, g1 = *(const f32x4*)(gw_ + 4); \
        u32x4 v_[8]; float ss_[8]; \
        _Pragma("unroll") for (int r = 0; r < 8; ++r) v_[r] = LOADV(r); \
        _Pragma("unroll") for (int r = 0; r < 8; ++r) { float a_ = 0.f; _Pragma("unroll") for (int j = 0; j < 4; ++j) { const float lo_ = bf2f(v_[r][j] & 0xffffu), hi_ = bf2f(v_[r][j] >> 16); a_ += lo_ * lo_ + hi_ * hi_; } ss_[r] = a_; } \
        _Pragma("unroll") for (int o = 1; o < 64; o <<= 1) { _Pragma("unroll") for (int r = 0; r < 8; ++r) ss_[r] += __shfl_xor(ss_[r], o); } \
        _Pragma("unroll") for (int r = 0; r < 8; ++r) { const float rs = rsqrtf(ss_[r] * (1.0f / 512.0f) + EPS); float e[8]; \
            _Pragma("unroll") for (int j = 0; j < 4; ++j) { e[2 * j] = bf2f(v_[r][j] & 0xffffu); e[2 * j + 1] = bf2f(v_[r][j] >> 16); } \
            u32x4 o; o.x = pk2(e[0] * rs * g0[0], e[1] * rs * g0[1]); o.y = pk2(e[2] * rs * g0[2], e[3] * rs * g0[3]); o.z = pk2(e[4] * rs * g1[0], e[5] * rs * g1[1]); o.w = pk2(e[6] * rs * g1[2], e[7] * rs * g1[3]); \
            *(u32x4*)(AY + (size_t)(m0 + wid * 8 + r) * DM + (DSTCOL) + 8 * lane) = o; } } while (0)
#define P4_LOAD_A(r) (*(const u32x4*)(A + (size_t)(m0 + wid * 8 + (r)) * AW + 8 * lane))
#define P4_LOAD_T(r) (*(const LAS u32x4*)(T2 + (wid * 8 + (r)) * TP + 8 * lane))
    P4_ROWS8(P4_LOAD_A, kin(I_AONW), 0);
    __syncthreads();
    P4_ROWS8(P4_LOAD_T, kin(I_HONW), 512);
#undef P4_ROWS8
#undef P4_LOAD_A
#undef P4_LOAD_T
    __syncthreads();
}


#define DPPF(x, ctrl) __builtin_bit_cast(float, __builtin_amdgcn_mov_dpp(__builtin_bit_cast(int, (x)), (ctrl), 0xf, 0xf, true))
#define DPPI(x, ctrl) __builtin_amdgcn_mov_dpp((x), (ctrl), 0xf, 0xf, true)
struct RouteSel { int ea, eb; unsigned wa, wb, la, lb; };
__device__ __forceinline__ void p8_route16(Frame& F, int t0, RouteSel& R, LAS unsigned* lcnt) {
    const int lane = F.lane; const int j = lane & 3; const int t = t0 + (lane >> 2);
    const f32x4* lg = (const f32x4*)(WSP(const float, WS_LOGIT) + (size_t)t * NE + 64 * j);
    const f32x4* rbp = (const f32x4*)(kin(I_RB) + 64 * j);
    float b[64];
#pragma unroll
    for (int i = 0; i < 16; ++i) { const f32x4 v = lg[i], rb = rbp[i];
#pragma unroll
        for (int c = 0; c < 4; ++c) b[4 * i + c] = __builtin_amdgcn_rcpf(1.0f + __builtin_amdgcn_exp2f(-1.4426950408889634f * v[c])) + rb[c]; }
    float gsc[2];
#pragma unroll
    for (int g = 0; g < 2; ++g) { float a1 = fmaxf(b[32 * g], b[32 * g + 1]), a2 = fminf(b[32 * g], b[32 * g + 1]);
#pragma unroll
        for (int i = 2; i < 32; ++i) { const float x = b[32 * g + i]; a2 = fmaxf(a2, fminf(a1, x)); a1 = fmaxf(a1, x); }
        gsc[g] = a1 + a2; }
    float G[8];
    G[0] = DPPF(gsc[0], 0x00); G[1] = DPPF(gsc[1], 0x00); G[2] = DPPF(gsc[0], 0x55); G[3] = DPPF(gsc[1], 0x55);
    G[4] = DPPF(gsc[0], 0xAA); G[5] = DPPF(gsc[1], 0xAA); G[6] = DPPF(gsc[0], 0xFF); G[7] = DPPF(gsc[1], 0xFF);
#pragma unroll
    for (int g = 0; g < 2; ++g) { const int gid = 2 * j + g; int rank = 0;
#pragma unroll
        for (int h = 0; h < 8; ++h) rank += (G[h] > gsc[g] || (G[h] == gsc[g] && h < gid)) ? 1 : 0;
        if (rank >= 4) {
#pragma unroll
            for (int i = 0; i < 32; ++i) b[32 * g + i] = -INFINITY; } }
    unsigned key[64];
#pragma unroll
    for (int i = 0; i < 64; ++i) key[i] = b[i] == -INFINITY ? 0u : ((__builtin_bit_cast(unsigned, b[i] + 2.0f) & ~63u) | (unsigned)(63 - i));
    float lv[8]; int li[8];
#pragma unroll
    for (int r = 0; r < 8; ++r) { unsigned mx = key[0];
#pragma unroll
        for (int i = 1; i < 64; i += 2) { const unsigned a_ = key[i], b_ = i + 1 < 64 ? key[i + 1] : 0u; const unsigned m_ = a_ > b_ ? a_ : b_; mx = mx > m_ ? mx : m_; }
        lv[r] = mx ? __builtin_bit_cast(float, mx & ~63u) - 2.0f : -INFINITY; li[r] = mx ? 64 * j + 63 - (int)(mx & 63u) : 0x7ffffff0 + j;
#pragma unroll
        for (int i = 0; i < 64; ++i) key[i] = key[i] == mx ? 0u : key[i]; }
    int se[8]; float sv[8];
#pragma unroll
    for (int r = 0; r < 8; ++r) { float hv = lv[0]; int hi = li[0];
        { const float ov = DPPF(hv, 0xB1); const int oi = DPPI(hi, 0xB1); if (ov > hv || (ov == hv && oi < hi)) { hv = ov; hi = oi; } }
        { const float ov = DPPF(hv, 0x4E); const int oi = DPPI(hi, 0x4E); if (ov > hv || (ov == hv && oi < hi)) { hv = ov; hi = oi; } }
        se[r] = hi; sv[r] = hv;
        if (hi == li[0]) {
#pragma unroll
            for (int k = 0; k < 7; ++k) { lv[k] = lv[k + 1]; li[k] = li[k + 1]; }
            lv[7] = -INFINITY; li[7] = 0x7fffffff; } }
    const float* rbias = kin(I_RB); float wsum = 0.f;
#pragma unroll
    for (int r = 0; r < 8; ++r) { sv[r] -= rbias[se[r]]; wsum += sv[r]; }
    const float inv = 2.5f / wsum;
    const int ea = j == 0 ? se[0] : j == 1 ? se[2] : j == 2 ? se[4] : se[6], eb = j == 0 ? se[1] : j == 1 ? se[3] : j == 2 ? se[5] : se[7];
    const float wa = (j == 0 ? sv[0] : j == 1 ? sv[2] : j == 2 ? sv[4] : sv[6]) * inv, wb = (j == 0 ? sv[1] : j == 1 ? sv[3] : j == 2 ? sv[5] : sv[7]) * inv;
    R.ea = ea; R.eb = eb; R.wa = f2bf(wa); R.wb = f2bf(wb);
    R.la = __hip_atomic_fetch_add(lcnt + ea, 1u, __ATOMIC_RELAXED, __HIP_MEMORY_SCOPE_WORKGROUP); R.lb = __hip_atomic_fetch_add(lcnt + eb, 1u, __ATOMIC_RELAXED, __HIP_MEMORY_SCOPE_WORKGROUP);
}
__device__ __forceinline__ void route_commit(Frame& F, int t0, const RouteSel& R, const LAS unsigned* lbase) {
    const int lane = F.lane; const int j = lane & 3; const int t = t0 + (lane >> 2);
    unsigned* list = WSP(unsigned, WS_LIST); unsigned* asg = WSP(unsigned, WS_ASSIGN) + (size_t)t * 8 + 2 * j;
    const unsigned ra = lbase[R.ea] + R.la, rb2 = lbase[R.eb] + R.lb;
    list[(size_t)R.ea * 65536 + ra] = ((unsigned)t << 16) | R.wa; list[(size_t)R.eb * 65536 + rb2] = ((unsigned)t << 16) | R.wb;
    asg[0] = ((unsigned)R.ea << 16) | ra; asg[1] = ((unsigned)R.eb << 16) | rb2;
    if (j == 0) list[(size_t)256 * 65536 + t] = ((unsigned)t << 16) | 0x3F80u;
}
#undef DPPF
#undef DPPI

__device__ __forceinline__ MoeTab moe_tables(Frame& F) {
    LAS int* tp = (LAS int*)(F.lds + AUX_OFF + AUX_TP); LAS int* cnt = (LAS int*)(F.lds + AUX_OFF + AUX_CNT); LAS unsigned short* t2e = (LAS unsigned short*)(F.lds + AUX_OFF + AUX_T2E);
    __syncthreads();
    if (F.tid < 257) cnt[F.tid] = F.tid < 256 ? (int)__hip_atomic_load(F.ctl + CW_CNT + 32 * F.tid, RLX_AGENT) : MTOK;
    __syncthreads();
    if (F.tid < 258) { int run = 0; for (int j = 0; j < F.tid && j < 257; ++j) run += (cnt[j] + 255) >> 8; tp[F.tid] = run; }
    __syncthreads();
    if (F.tid < 257) { const int t0 = tp[F.tid], t1 = tp[F.tid + 1]; for (int T = t0; T < t1; ++T) t2e[T] = (unsigned short)F.tid; }
    __syncthreads();
    MoeTab t; t.tp = tp; t.cnt = cnt; t.t2e = t2e; return t;
}

__device__ __forceinline__ void down_phase(Frame& F, const MoeTab& tab) {
    using namespace pg8;
    int tid_ = F.wave * 64 + lane_id(); asm volatile("" : "+v"(tid_));
    const int tid = tid_, wid = F.wave, lane = tid & 63, wq = wid, fr = lane & 15, fq = lane >> 4;
    LAS unsigned char* lds = F.lds + RING_OFF;
    const unsigned char* ACT = WSP(const unsigned char, WS_ACT); const unsigned char* WD = WSP(const unsigned char, WS_WD); const unsigned char* WSD = WSP(const unsigned char, WS_WSD);
    unsigned char* SLOT = WSP(unsigned char, WS_SLOT);
    unsigned voA[2], voB[2];
#pragma unroll
    for (int i = 0; i < 2; ++i) { int R, C; stage_rc(tid * 16 + i * 8192, R, C); const int rho = R & 63, ii = rho & 15, nn = rho >> 4; const int Rb = (R & ~63) + 16 * (ii >> 2) + 4 * nn + (ii & 3);
        voA[i] = (unsigned)(R * 256 + C * 2); voB[i] = (unsigned)(Rb * 256 + C * 2); }
    const unsigned ldsw = (unsigned)wid * 1024u;
#define DN_STAGE(buf, gptr, vo) do { _Pragma("unroll") for (int _i = 0; _i < 2; ++_i) \
        __builtin_amdgcn_global_load_lds((const unsigned*)((gptr) + (vo)[_i]), (LAS unsigned*)(lds + (buf) * HTB + ldsw + _i * 8192), 16, 0, 0); } while (0)
    const int arow = (wq & 3) * 32 + fr;
    const int aoff = lds_byte(arow, fq * 8), boff = lds_byte(fr, fq * 8);
    const int TT = __builtin_amdgcn_readfirstlane(tab.tp[257]);
#define DN_STAGE_A(Ag_) do { _Pragma("unroll") for (int ai = 0; ai < 2; ++ai) _Pragma("unroll") for (int kt = 0; kt < 2; ++kt) DN_STAGE(ai * 2 + kt, (Ag_) + (size_t)ai * (128 * 256) + kt * 128, voA); } while (0)
#define DN_STAGE_B(slot, Bg_, c_) do { _Pragma("unroll") for (int kt = 0; kt < 2; ++kt) DN_STAGE(4 + 2 * (slot) + kt, (Bg_) + (size_t)(c_) * (128 * 256) + kt * 128, voB); } while (0)
    int T = F.vcu;
    const unsigned char* Bg = WD;
    if (T < TT) { const int e0 = __builtin_amdgcn_readfirstlane((int)tab.t2e[T]); Bg = e0 < 256 ? WD + (size_t)e0 * (1024 * 256) : WSD;
        DN_STAGE_A(ACT + (size_t)T * (256 * 256)); DN_STAGE_B(0, Bg, 0); }
    for (; T < TT; T += F.G) {
        const int Tn = T + F.G; const bool hn = Tn < TT;
        const unsigned char* Bn = WD;
        if (hn) { const int en = __builtin_amdgcn_readfirstlane((int)tab.t2e[Tn]); Bn = en < 256 ? WD + (size_t)en * (1024 * 256) : WSD; }
        asm volatile("s_waitcnt vmcnt(0)" ::: "memory"); __builtin_amdgcn_s_barrier(); asm volatile("" ::: "memory");
        v8i Af[2][2];
#pragma unroll
        for (int m = 0; m < 2; ++m)
#pragma unroll
            for (int kt = 0; kt < 2; ++kt) { const LAS unsigned char* p = lds + ((wq >> 2) * 2 + kt) * HTB + aoff + m * 2048;
                Af[m][kt] = cat8(*(const LAS bf16x8*)p, *(const LAS bf16x8*)(p + 1024)); }
        asm volatile("s_waitcnt lgkmcnt(0)" ::: "memory");
#pragma unroll 1
        for (int c = 0; c < 8; ++c) {
            const int sb = c & 1;
            if (c > 0) { if (c == 3 && hn) asm volatile("s_waitcnt vmcnt(12)" ::: "memory"); else asm volatile("s_waitcnt vmcnt(4)" ::: "memory"); }
            __builtin_amdgcn_s_barrier(); asm volatile("" ::: "memory");
            if (c < 7) DN_STAGE_B(sb ^ 1, Bg, c + 1); else if (hn) DN_STAGE_B(0, Bn, 0);
            if (c == 2 && hn) DN_STAGE_A(ACT + (size_t)Tn * (256 * 256));
            f32x4 acc[2][8];
#pragma unroll
            for (int m = 0; m < 2; ++m)
#pragma unroll
                for (int n = 0; n < 8; ++n) { acc[m][n] = (f32x4){0.f, 0.f, 0.f, 0.f}; asm volatile("" : "+v"(acc[m][n])); }
#pragma unroll
            for (int g = 0; g < 2; ++g) {
                v8i Bf[4][2];
#pragma unroll
                for (int n = 0; n < 4; ++n)
#pragma unroll
                    for (int kt = 0; kt < 2; ++kt) { const LAS unsigned char* p = lds + (4 + 2 * sb + kt) * HTB + boff + (4 * g + n) * 2048;
                        Bf[n][kt] = cat8(*(const LAS bf16x8*)p, *(const LAS bf16x8*)(p + 1024)); }
                asm volatile("s_waitcnt lgkmcnt(0)\n\ts_nop 4" ::: "memory");
#pragma unroll
                for (int kt = 0; kt < 2; ++kt)
#pragma unroll
                    for (int m = 0; m < 2; ++m)
#pragma unroll
                        for (int n = 0; n < 4; ++n) mfma_fp8(acc[m][4 * g + n], Bf[n][kt], Af[m][kt]);
            }
            asm volatile("s_nop 15\n\ts_nop 15" : "+v"(acc[0][0]), "+v"(acc[0][1]), "+v"(acc[0][2]), "+v"(acc[0][3]), "+v"(acc[0][4]), "+v"(acc[0][5]), "+v"(acc[0][6]), "+v"(acc[0][7]),
                         "+v"(acc[1][0]), "+v"(acc[1][1]), "+v"(acc[1][2]), "+v"(acc[1][3]), "+v"(acc[1][4]), "+v"(acc[1][5]), "+v"(acc[1][6]), "+v"(acc[1][7]) :: "memory");
            unsigned char* orow = SLOT + (size_t)(T * 256 + (wq >> 2) * 128 + (wq & 3) * 32 + fr) * DM + c * 128 + 16 * fq;
#pragma unroll
            for (int m = 0; m < 2; ++m)
#pragma unroll
                for (int g = 0; g < 2; ++g) { u32x4 pk;
#pragma unroll
                    for (int n = 0; n < 4; ++n) { const f32x4 a = acc[m][4 * g + n] * 0.125f; pk[n] = pk4_fp8c(a[0], a[1], a[2], a[3]); }
                    *(u32x4*)(orow + (size_t)(16 * m) * DM + 64 * g) = pk; }
        }
        Bg = Bn;
    }
    asm volatile("s_waitcnt vmcnt(0) lgkmcnt(0)" ::: "memory"); __builtin_amdgcn_s_barrier(); asm volatile("" ::: "memory");
#undef DN_STAGE_A
#undef DN_STAGE_B
#undef DN_STAGE
}

__device__ __forceinline__ void combine_token(Frame& F, const MoeTab& tab, int t0) {
    const int lane = F.lane; const int b = t0 >> 12;
    const unsigned* asg = WSP(const unsigned, WS_ASSIGN) + (size_t)t0 * 8; const unsigned char* SLOT = WSP(const unsigned char, WS_SLOT);
    const size_t Rs = (size_t)tab.tp[256] * 256;
    u32x4 sv[2][9];
#pragma unroll
    for (int q = 0; q < 2; ++q) {
#pragma unroll
        for (int k = 0; k < 8; ++k) { const unsigned av = asg[q * 8 + k]; const int e = av >> 16, rk = av & 0xffffu; const size_t R = (size_t)tab.tp[e] * 256 + rk;
            sv[q][k] = *(const u32x4*)(SLOT + R * DM + 16 * lane); }
        sv[q][8] = *(const u32x4*)(SLOT + (Rs + t0 + q) * DM + 16 * lane); }
    const float* g2 = WSP(const float, WS_MODV) + (size_t)b * 6144 + 5 * 1024 + 16 * lane; const float* fw = kin(I_FNW) + 16 * lane;
    f32x4 x[2][4]; float ss[2];
#pragma unroll
    for (int q = 0; q < 2; ++q) { const float* xr = F.out + (size_t)(t0 + q) * DM + 16 * lane;
#pragma unroll
        for (int j = 0; j < 4; ++j) x[q][j] = *(const f32x4*)(xr + 4 * j); }
#pragma unroll
    for (int q = 0; q < 2; ++q) { float a[16];
#pragma unroll
        for (int j = 0; j < 16; ++j) a[j] = 0.f;
#pragma unroll
        for (int k = 0; k < 9; ++k)
#pragma unroll
            for (int j = 0; j < 4; ++j) { const f32x2 lo = __builtin_amdgcn_cvt_pk_f32_fp8((int)sv[q][k][j], false), hi = __builtin_amdgcn_cvt_pk_f32_fp8((int)sv[q][k][j], true);
                a[4 * j] += lo[0]; a[4 * j + 1] += lo[1]; a[4 * j + 2] += hi[0]; a[4 * j + 3] += hi[1]; }
        ss[q] = 0.f;
#pragma unroll
        for (int j = 0; j < 4; ++j) { const f32x4 g = *(const f32x4*)(g2 + 4 * j) * (1.0f / 16.0f);
            x[q][j] = x[q][j] + g * (f32x4){a[4 * j], a[4 * j + 1], a[4 * j + 2], a[4 * j + 3]};
            ss[q] += (x[q][j][0] * x[q][j][0] + x[q][j][1] * x[q][j][1]) + (x[q][j][2] * x[q][j][2] + x[q][j][3] * x[q][j][3]); } }
#pragma unroll
    for (int o = 1; o < 64; o <<= 1) { ss[0] += __shfl_xor(ss[0], o); ss[1] += __shfl_xor(ss[1], o); }
#pragma unroll
    for (int q = 0; q < 2; ++q) { const float rs = rsqrtf(ss[q] * (1.0f / DM) + EPS); float* orow = F.out + (size_t)(t0 + q) * DM + 16 * lane;
#pragma unroll
        for (int j = 0; j < 4; ++j) *(f32x4*)(orow + 4 * j) = x[q][j] * rs * *(const f32x4*)(fw + 4 * j); }
}

constexpr int N_LAUNCHES = MK_N_LAUNCHES;
static_assert(N_LAUNCHES == 1 || N_LAUNCHES == NPHASE, "MK_N_LAUNCHES must be 1 or 14");
struct Args { const float* in[N_IN]; float* out; unsigned char* ws; int ph_lo, ph_hi; };
__global__ void __launch_bounds__(NWAVES * 64, 2) fwd_kernel(Args args) {
    extern __shared__ __attribute__((aligned(16))) unsigned char lds[];
    Frame F;
    F.lds = (LAS unsigned char*)lds;
    F.MISC = (volatile LAS unsigned*)(F.lds + MISC_OFF);
    F.tid = threadIdx.x; F.lane = F.tid & 63; F.wave = __builtin_amdgcn_readfirstlane(F.tid >> 6);
    F.G = gridDim.x; { const int bx = blockIdx.x; F.vcu = (F.G % 8 == 0) ? (bx % 8) * (F.G / 8) + bx / 8 : bx; }
    F.out = args.out; F.ws = args.ws; F.ctl = (unsigned*)(args.ws + WS_CTL);
    if (F.tid < 128) ((LAS unsigned*)(F.lds + MISC_OFF))[F.tid] = 0u;
    __syncthreads();
    XcdBarrier bar; bar.wv = (unsigned)F.wave; bar.bar = F.ctl + CW_BAR; bar.x = 0; bar.st = nullptr;
    if (N_LAUNCHES == 1) bar = xcd_barrier_post(F.ctl + CW_BAR, F.MISC + 8);
#define GRID_BAR() do { if (N_LAUNCHES == 1) xcd_barrier(bar); } while (0)
    const int lo = args.ph_lo, hi = args.ph_hi;
#ifndef PHASE_MASK
#define PHASE_MASK 0x3fff
#endif
#define IN(k) ((((PHASE_MASK) >> (k)) & 1) && lo <= (k) && (k) < hi)
#ifndef PHASE_DUP
#define PHASE_DUP 0
#endif
#define REPS(k) ((((PHASE_DUP) >> (k)) & 1) ? 2 : 1)
#ifndef PROBE_K
#define PROBE_K (-1)
#endif
#ifndef PROBE_AMP
#define PROBE_AMP 8
#endif
    unsigned long long tA_ = 0, tB_ = 0;
#define STAMP(j) do { if (PROBE_K >= 0 && (j) == PROBE_K) tA_ = __builtin_amdgcn_s_memrealtime(); if (PROBE_K >= 0 && (j) == PROBE_K + 1) tB_ = __builtin_amdgcn_s_memrealtime(); } while (0)
#define SEAM(k) do { if (IN(k) && IN((k) + 1)) GRID_BAR(); STAMP((k) + 1); } while (0)
#define PHASE_ENTER() do { int t_ = F.wave * 64 + lane_id(); asm volatile("" : "+v"(t_)); F.tid = t_; F.lane = t_ & 63; GAS unsigned char* w_ = (GAS unsigned char*)args.ws; GAS float* o_ = (GAS float*)args.out; asm volatile("" : "+s"(w_), "+s"(o_)); F.ws = (unsigned char*)w_; F.out = (float*)o_; F.ctl = (unsigned*)(F.ws + WS_CTL); } while (0)
#define PHASE_ENTER_V() do { int l_; asm volatile("v_mbcnt_lo_u32_b32 %0, -1, 0\n\tv_mbcnt_hi_u32_b32 %0, -1, %0" : "=v"(l_)); int t_ = F.wave * 64 + l_; asm volatile("" : "+v"(t_)); F.tid = t_; F.lane = t_ & 63; GAS unsigned char* w_ = (GAS unsigned char*)args.ws; GAS float* o_ = (GAS float*)args.out; asm volatile("" : "+s"(w_), "+s"(o_)); F.ws = (unsigned char*)w_; F.out = (float*)o_; F.ctl = (unsigned*)(F.ws + WS_CTL); } while (0)
    const int gw = F.vcu * NWAVES + F.wave, NGW = F.G * NWAVES;
#define modv WSP(const float, WS_MODV)
    LAS unsigned char* ring = F.lds + RING_OFF;
    LAS unsigned* idxw = (LAS unsigned*)(F.lds + AUX_OFF + AUX_IDX + F.wave * 1024);

    STAMP(0);
    if (IN(0)) for (int rep_ = 0; rep_ < REPS(0); ++rep_) { PHASE_ENTER(); p0_prologue(F); }
    SEAM(0);
    if (IN(1)) for (int rep_ = 0; rep_ < REPS(1); ++rep_) { PHASE_ENTER();
        for (int rb = gw; rb < MTOK / 32; rb += NGW) { const int row0 = rb * 32; const int b = row0 >> 12;
            modulate_rows<true>(F, kin(I_X), WSP(bf16_t, WS_H), row0, 32, kin(I_NORM1), modv + (size_t)b * 6144 + 1024, modv + (size_t)b * 6144, WSP(unsigned char, WS_H8)); }
        for (int rb = gw; rb < MCTX / 2; rb += NGW)
            modulate_rows(F, kin(I_CTX), WSP(bf16_t, WS_HC), rb * 2, 2, kin(I_NORM1), modv + (size_t)16 * 6144 + 1024, modv + (size_t)16 * 6144);
    }
    SEAM(1);
    if (IN(2)) for (int rep_ = 0; rep_ < REPS(2); ++rep_) { PHASE_ENTER();
        { SchedQKV S{WSP(const bf16_t, WS_H), (long)WS_HC - (long)WS_H, WSP(const bf16_t, WS_WQKV), F.G, F.vcu};
          EpiQKV E{WSP(bf16_t, WS_Q), WSP(bf16_t, WS_K), WSP(bf16_t, WS_V), kin(I_QNW), kin(I_KNW), WSP(const f32x2, WS_ROPE)};
          pg8::gemm_phase<EpiQKV, SchedQKV, false, true>(ring, idxw, DM, S, E, F.wave); }
        { SchedDense S{WSP(const bf16_t, WS_WU), WSP(const bf16_t, WS_H8), DM / 2, 6, MTOK / 256, F.G, F.vcu, true};
          EpiPlainBf16 E{WSP(bf16_t, WS_UT), (size_t)MTOK, 1.0f / 256.0f};
          pg8::gemm_phase<EpiPlainBf16, SchedDense, false, true, true>(ring, idxw, DM / 2, S, E, F.wave); }
    }
    SEAM(2);
    if (IN(3)) for (int rep_ = 0; rep_ < REPS(3); ++rep_) { PHASE_ENTER();
        const int xq = (XP_TILES + F.G - 1) / F.G;
        if ((F.vcu & 3) == 0) { xp_tiles(F, xq); PHASE_ENTER_V(); }
        { const attn_body::AttnTensors AT{WSP(const attn_body::bf16, WS_Q), WSP(const attn_body::bf16, WS_K), WSP(const attn_body::bf16, WS_V), WSP(attn_body::bf16, WS_AO)};
          const attn_body::StaticOrderR S(F.vcu, 0, 4);
          for (int r2_ = 0; r2_ < REPS(14); ++r2_) attn_body::attn_phase<attn_body::StaticOrderR>((char*)lds + RING_OFF, AT, S, F.wave); }
        __syncthreads(); PHASE_ENTER_V();
        if ((F.vcu & 3) == 1) { xp_tiles(F, xq); PHASE_ENTER_V(); }
        { const attn_body::AttnTensors AT{WSP(const attn_body::bf16, WS_Q), WSP(const attn_body::bf16, WS_K), WSP(const attn_body::bf16, WS_V), WSP(attn_body::bf16, WS_AO)};
          const attn_body::StaticOrderR S(F.vcu, 4, 8);
          for (int r2_ = 0; r2_ < REPS(14); ++r2_) attn_body::attn_phase<attn_body::StaticOrderR>((char*)lds + RING_OFF, AT, S, F.wave); }
        __syncthreads(); PHASE_ENTER_V();
        if ((F.vcu & 3) == 2) { xp_tiles(F, xq); PHASE_ENTER_V(); }
        for (int r2_ = 0; r2_ < REPS(15); ++r2_) for (int c = F.vcu; c < HW; c += F.G) {
#if HYENA_FP8
            hyena_unit8(F, c);
#else
            hyena_unit(F, c);
#endif
        }
        __syncthreads(); PHASE_ENTER_V();
        if ((F.vcu & 3) == 3) xp_tiles(F, 1 << 30);
    }
    SEAM(3);
    if (IN(4)) for (int rep_ = 0; rep_ < REPS(4); ++rep_) { PHASE_ENTER();
        for (int pm = F.vcu; pm < MTOK / 256; pm += F.G) {
            for (int q4 = 0; q4 < 4; ++q4) p4_norm_tile(F, pm * 4 + q4);
            VM_WAIT(); __syncthreads(); PHASE_ENTER();
            { SchedDense S{WSP(const bf16_t, WS_AY) + (size_t)pm * 256 * DM, WSP(const bf16_t, WS_WO), DM, 1, 4, 1, 0, false};
              EpiOutProj E{kin(I_X), F.out, modv, pm};
              pg8::gemm_phase<EpiOutProj, SchedDense, false, true>(ring, idxw, DM, S, E, F.wave); }
            VM_WAIT(); __syncthreads(); PHASE_ENTER();
            { const int row0 = pm * 256 + F.wave * 32; const int b = row0 >> 12;
              modulate_rows<true>(F, F.out, WSP(bf16_t, WS_H), row0, 32, kin(I_NORM2), modv + (size_t)b * 6144 + 4 * 1024, modv + (size_t)b * 6144 + 3 * 1024, WSP(unsigned char, WS_H8)); }
            VM_WAIT(); __syncthreads(); PHASE_ENTER();
            { SchedDense S{WSP(const bf16_t, WS_H) + (size_t)pm * 256 * DM, WSP(const bf16_t, WS_WR), DM, 1, 1, 1, 0, false};
              EpiF32 E{WSP(float, WS_LOGIT) + (size_t)pm * 256 * NE, (size_t)NE};
              pg8::gemm_phase<EpiF32, SchedDense, false, true>(ring, idxw, DM, S, E, F.wave); }
            VM_WAIT(); __syncthreads(); PHASE_ENTER();
            {
                LAS unsigned* lcnt = (LAS unsigned*)(F.lds + AUX_OFF); LAS unsigned* lbase = lcnt + 256;
                if (F.tid < 256) lcnt[F.tid] = 0u;
                __syncthreads();
                RouteSel R0, R1;
                p8_route16(F, pm * 256 + F.wave * 32, R0, lcnt); p8_route16(F, pm * 256 + F.wave * 32 + 16, R1, lcnt);
                __syncthreads();
                if (F.tid < 256) { const unsigned c = lcnt[F.tid]; lbase[F.tid] = c ? __hip_atomic_fetch_add(F.ctl + CW_CNT + 32 * F.tid, c, RLX_AGENT) : 0u; }
                __syncthreads();
                route_commit(F, pm * 256 + F.wave * 32, R0, lbase); route_commit(F, pm * 256 + F.wave * 32 + 16, R1, lbase);
                __syncthreads();
            }
        }
    }
    SEAM(4); STAMP(6); STAMP(7); STAMP(8); STAMP(9);
    if (IN(9)) for (int rep_ = 0; rep_ < REPS(9); ++rep_) { PHASE_ENTER();
        const MoeTab tab = moe_tables(F);
        SchedGU S{WSP(const bf16_t, WS_H8), WSP(const bf16_t, WS_WGU), WSP(const bf16_t, WS_WSGU8), WSP(const unsigned, WS_LIST), tab, F.G, F.vcu};
        EpiGU E{WSP(unsigned char, WS_ACT), WSP(const unsigned, WS_LIST), tab};
        pg8::gemm_phase<EpiGU, SchedGU, true, true, true>(ring, idxw, DM / 2, S, E, F.wave);
    }
    SEAM(9);
    if (IN(10)) for (int rep_ = 0; rep_ < REPS(10); ++rep_) { PHASE_ENTER();
        const MoeTab tab = moe_tables(F);
        down_phase(F, tab);
    }
    SEAM(10);
    if (IN(11)) for (int rep_ = 0; rep_ < REPS(11); ++rep_) { PHASE_ENTER(); const MoeTab tab = moe_tables(F); for (int rb = gw; rb < MTOK / 32; rb += NGW) for (int r = 0; r < 32; r += 2) combine_token(F, tab, rb * 32 + r); }
    STAMP(12); STAMP(13); STAMP(14);
    if (PROBE_K >= 0 && blockIdx.x == 0) {
        const unsigned long long until = __builtin_amdgcn_s_memrealtime() + (unsigned long long)PROBE_AMP * (tB_ - tA_);
        while (__builtin_amdgcn_s_memrealtime() < until) __builtin_amdgcn_s_sleep(32);
    }
#undef modv
#undef PHASE_ENTER
#undef PHASE_ENTER_V
#undef IN
#undef SEAM
#undef GRID_BAR
}

extern "C" void kernel_launch(void* const* d_in, const int* in_sizes, int n_in, void* d_out, int out_size, void* d_ws, size_t ws_size, hipStream_t stream) {
    static int grid = 0;
    if (grid == 0) {
        if (n_in != N_IN || in_sizes[0] != MTOK * DM || out_size != MTOK * DM || ws_size < WS_END) {
            fprintf(stderr, "kernel_launch: unexpected problem (n_in %d, in0 %d, out %d, ws %zu < %zu); nothing launched\n", n_in, n_in > 0 ? in_sizes[0] : -1, out_size, ws_size, (size_t)WS_END); grid = -1; return; }
        int dev = 0, cus = 0, per_cu = 0;
        if (hipGetDevice(&dev) != hipSuccess || hipDeviceGetAttribute(&cus, hipDeviceAttributeMultiprocessorCount, dev) != hipSuccess) { grid = -1; return; }
        if (hipFuncSetAttribute((const void*)fwd_kernel, hipFuncAttributeMaxDynamicSharedMemorySize, LDS_BYTES) != hipSuccess) { fprintf(stderr, "kernel_launch: hipFuncSetAttribute failed\n"); grid = -1; return; }
        if (hipOccupancyMaxActiveBlocksPerMultiprocessor(&per_cu, (const void*)fwd_kernel, NWAVES * 64, LDS_BYTES) != hipSuccess || per_cu < 1)
            fprintf(stderr, "kernel_launch: note: occupancy query reports %d workgroups per CU\n", per_cu);
        (void)hipGetLastError();
        grid = cus;
    }
    if (grid < 0) return;
    if (hipMemsetAsync((char*)d_ws + WS_CTL, 0, CTL_ZERO_BYTES, stream) != hipSuccess) return;
    Args a{};
    for (int i = 0; i < N_IN; ++i) a.in[i] = (const float*)d_in[i];
    a.out = (float*)d_out; a.ws = (unsigned char*)d_ws;
    for (int li = 0; li < N_LAUNCHES; ++li) {
        a.ph_lo = (N_LAUNCHES == 1) ? 0 : li; a.ph_hi = (N_LAUNCHES == 1) ? NPHASE : li + 1;
        hipLaunchKernelGGL(fwd_kernel, dim3(grid), dim3(NWAVES * 64), LDS_BYTES, stream, a);
        const hipError_t le = hipPeekAtLastError();
        if (le != hipSuccess) { fprintf(stderr, "kernel_launch: launch %d failed: %s\n", li, hipGetErrorName(le)); break; }
    }
}
```

```cpp
#include <hip/hip_runtime.h>
#include <cstdio>
#include <cstdint>
#include <cmath>

#ifndef HYENA_FP8
#define X1_BF16 1
#define HYENA_FP8 1
#endif
#ifndef MK_N_LAUNCHES
#define MK_N_LAUNCHES 1
#endif

#define LAS __attribute__((address_space(3)))
#define GAS __attribute__((address_space(1)))
typedef unsigned short bf16_t;
typedef short bf16x8 __attribute__((ext_vector_type(8)));
typedef float f32x4 __attribute__((ext_vector_type(4)));
typedef float f32x2 __attribute__((ext_vector_type(2)));
typedef unsigned u32x4 __attribute__((ext_vector_type(4)));
typedef unsigned u32x2 __attribute__((ext_vector_type(2)));

constexpr int NB = 16, SEQ = 4096, DM = 1024, MTOK = NB * SEQ, CTXL = 256, MCTX = NB * CTXL;
constexpr int NH = 8, HD = 64, AW = 512, HW = 512, KVP = 128, KVLEN = CTXL + SEQ;
constexpr int NE = 256, TOPK = 8, FF = 256;
constexpr float EPS = 1e-6f;
constexpr int NPHASE = 14;

constexpr size_t MiB = 1u << 20;
constexpr size_t WS_CTL = 0, CTL_ZERO_BYTES = 128 * 1024;
constexpr size_t WS_MODV = 512 * 1024;
constexpr size_t WS_ROPE = 1 * MiB;
constexpr size_t WS_SS = 1 * MiB + 256 * 1024;
constexpr size_t WS_ASSIGN = 2 * MiB;
constexpr size_t WS_KR = 4 * MiB;
constexpr size_t WS_WQKV = 12 * MiB;
constexpr size_t WS_WU = 14 * MiB;
constexpr size_t WS_WO = 17 * MiB;
constexpr size_t WS_WR = 19 * MiB;
constexpr size_t WS_WSGU = 20 * MiB;
constexpr size_t WS_WSD = 21 * MiB;
constexpr size_t WS_WD = 22 * MiB;
constexpr size_t WS_ACT = 150 * MiB;
constexpr size_t WS_SLOT = 406 * MiB;
constexpr size_t WS_END = 1048 * MiB;
constexpr size_t WS_Q = 150 * MiB;
constexpr size_t WS_K = 214 * MiB;
constexpr size_t WS_V = 231 * MiB;
constexpr size_t WS_UT = 248 * MiB;
constexpr size_t WS_HC = 440 * MiB;
constexpr size_t WS_AY = 248 * MiB;
constexpr size_t WS_LOGIT = 150 * MiB;
constexpr size_t WS_WGU = 470 * MiB;
constexpr size_t WS_H8 = 598 * MiB;
constexpr size_t WS_WSGU8 = 662 * MiB;
constexpr size_t WS_H = 726 * MiB;
constexpr size_t WS_HYW = 726 * MiB;
constexpr size_t WS_HYX = 790 * MiB;
constexpr size_t WS_LIST = 854 * MiB;
constexpr size_t WS_YT = 919 * MiB;
constexpr size_t WS_AO = 983 * MiB;
static_assert(WS_LIST + (size_t)257 * 65536 * 4 <= WS_YT && WS_YT + 64 * MiB <= WS_AO && WS_AO + 64 * MiB <= WS_END, "ws map");
constexpr size_t MAXROWS_R = 524288 + 256 * 255;
static_assert(WS_SLOT + (MAXROWS_R + 65536) * 1024 <= WS_END && WS_ACT + (MAXROWS_R + 65536) * 256 <= WS_SLOT, "ws map 2");

constexpr int CW_TMO = 0, CW_CODE = 1, CW_TILEQ = 64;
constexpr int CW_BAR = 4096;
constexpr int CW_CNT = 16384;
static_assert((CW_CNT + 257 * 32) * 4 <= (int)CTL_ZERO_BYTES && (CW_BAR + 3456) * 4 <= (int)CTL_ZERO_BYTES, "control words inside the memset region");

constexpr int RING_OFF = 0, RING_BYTES = 131072;
constexpr int AUX_OFF = 131072, AUX_BYTES = 16384;
constexpr int MISC_OFF = AUX_OFF + AUX_BYTES;
constexpr int LDS_BYTES = MISC_OFF + 512;
constexpr int AUX_TP = 0, AUX_CNT = 1280, AUX_T2E = 2560, AUX_IDX = 8192;

constexpr int NWAVES = 8;
constexpr float C2 = 0.125f * 1.4426950408889634f;

__device__ __forceinline__ unsigned f2bf(float f) { unsigned u = __builtin_bit_cast(unsigned, f); return (u + 0x7fffu + ((u >> 16) & 1u)) >> 16; }
__device__ __forceinline__ unsigned pk2(float lo, float hi) { unsigned r; asm("v_cvt_pk_bf16_f32 %0, %1, %2" : "=v"(r) : "v"(lo), "v"(hi)); return r; }
__device__ __forceinline__ float bf2f(unsigned h) { return __builtin_bit_cast(float, h << 16); }
__device__ __forceinline__ unsigned cvt_pk_bf16(float lo, float hi) { unsigned r; asm volatile("v_cvt_pk_bf16_f32 %0, %1, %2" : "=v"(r) : "v"(lo), "v"(hi)); return r; }
__device__ __forceinline__ int lane_id() { return (int)__builtin_amdgcn_mbcnt_hi(~0u, __builtin_amdgcn_mbcnt_lo(~0u, 0u)); }
__device__ __forceinline__ float wave_sum(float v) {
#pragma unroll
    for (int o = 1; o < 64; o <<= 1) v += __shfl_xor(v, o);
    return v;
}

namespace pg8 {
constexpr int BM = 256, BK = 64, HALF = 128, HTB = HALF * BK * 2, STAGE_BYTES = 8 * HTB;
__host__ __device__ __forceinline__ int lds_byte(int r, int c) { const int st = (r >> 4) * 2 + (c >> 5), rr = r & 15, cc = c & 31, ob = rr * 64 + cc * 2; return st * 1024 + (ob ^ (((ob >> 9) & 1) << 5)); }
__host__ __device__ __forceinline__ void stage_rc(int b, int& R, int& C) { const int st = b / 1024, sb = b % 1024, swz = sb ^ (((sb >> 9) & 1) << 5); R = (st >> 1) * 16 + swz / 64; C = (st & 1) * 32 + (swz % 64) / 2; }
__host__ __device__ __forceinline__ int perm32(int rho) { const int n = rho >> 4, i = rho & 15; return 8 * (i >> 2) + 4 * n + (i & 3); }

struct Unit { int pm, pn, aux, aux2; };
typedef int v8i __attribute__((ext_vector_type(8)));
typedef int v4i __attribute__((ext_vector_type(4)));
__device__ __forceinline__ void mfma_fp8(f32x4& acc, v8i a, v8i b) { asm volatile("v_mfma_f32_16x16x128_f8f6f4 %0, %1, %2, %0" : "+v"(acc) : "v"(a), "v"(b)); }
__device__ __forceinline__ v8i cat8(bf16x8 lo, bf16x8 hi) { const v4i a = __builtin_bit_cast(v4i, lo), b = __builtin_bit_cast(v4i, hi); return __builtin_shufflevector(a, b, 0, 1, 2, 3, 4, 5, 6, 7); }

template <class Epi, class Sched, bool GATHER, bool ALIGN_EPI, bool FP8 = false>
__device__ __forceinline__ void gemm_phase(LAS unsigned char* lds, LAS unsigned* idxw, const int K, const Sched& S, const Epi& E, const int wave) {
    int tid_ = wave * 64 + lane_id(); asm volatile("" : "+v"(tid_));
    const int tid = tid_, wid = __builtin_amdgcn_readfirstlane(tid >> 6), lane = tid & 63, wr = wid >> 2, wc = wid & 3, fr = lane & 15, fq = lane >> 4;
    const int nt = K / BK;
    int Rr[2], Cc[2]; unsigned voffB[2];
#pragma unroll
    for (int i = 0; i < 2; ++i) { stage_rc(tid * 16 + i * 8192, Rr[i], Cc[i]); const int Rb = (Rr[i] & ~31) + perm32(Rr[i] & 31); voffB[i] = (unsigned)(Rb * K + Cc[i]) * 2u; }
    const unsigned kstep = (unsigned)(BK * 2);
    const unsigned hstep = (unsigned)HALF * (unsigned)K * 2u;
    const unsigned ldsw = (unsigned)wid * 1024u;
    const int aoff = lds_byte(wr * 64 + fr, fq * 8), boff = lds_byte(wc * 32 + fr, fq * 8);
#define PG8_SA(b, h) (((b) * 2 + (h)) * HTB)
#define PG8_SB(b, h) ((4 + (b) * 2 + (h)) * HTB)
#define PG8_STAGE_B(bufoff, gbase) do { _Pragma("unroll") for (int _i = 0; _i < 2; ++_i) \
        __builtin_amdgcn_global_load_lds((const unsigned*)((const char*)(gbase) + voffB[_i]), (LAS unsigned*)(lds + (bufoff) + ldsw + _i * 8192), 16, 0, 0); } while (0)
#define PG8_STAGE_A(bufoff, gbase, VV, h) do { _Pragma("unroll") for (int _i = 0; _i < 2; ++_i) \
        __builtin_amdgcn_global_load_lds((const unsigned*)((const char*)(gbase) + VV[h][_i]), (LAS unsigned*)(lds + (bufoff) + ldsw + _i * 8192), 16, 0, 0); } while (0)
#define PG8_LDA(dst, b, h) do { _Pragma("unroll") for (int m = 0; m < 4; ++m) _Pragma("unroll") for (int k = 0; k < 2; ++k) dst[m][k] = *(const LAS bf16x8*)(lds + PG8_SA(b, h) + aoff + m * 2048 + k * 1024); } while (0)
#define PG8_LDB(dst, b, h) do { _Pragma("unroll") for (int n = 0; n < 2; ++n) _Pragma("unroll") for (int k = 0; k < 2; ++k) dst[n][k] = *(const LAS bf16x8*)(lds + PG8_SB(b, h) + boff + n * 2048 + k * 1024); } while (0)
#define PG8_MMA(ai, bj, At, Bt) do { __builtin_amdgcn_s_setprio(1); _Pragma("unroll") for (int m = 0; m < 4; ++m) _Pragma("unroll") for (int n = 0; n < 2; ++n) { \
        if constexpr (FP8) { mfma_fp8(acc[ai][bj][m][n], cat8(Bt[n][0], Bt[n][1]), cat8(At[m][0], At[m][1])); } \
        else { _Pragma("unroll") for (int k = 0; k < 2; ++k) acc[ai][bj][m][n] = __builtin_amdgcn_mfma_f32_16x16x32_bf16(Bt[n][k], At[m][k], acc[ai][bj][m][n], 0, 0, 0); } } __builtin_amdgcn_s_setprio(0); } while (0)
#define PG8_WAIT_V(n) asm volatile("s_waitcnt vmcnt(" #n ")" ::: "memory")
#define PG8_WAIT_L(n) asm volatile("s_waitcnt lgkmcnt(" #n ")" ::: "memory")
#define PG8_BAR __builtin_amdgcn_s_barrier()
#define PG8_SCHED __builtin_amdgcn_sched_barrier(0)
    Unit cur, nxt; int ui = 0;
    if (!S.next(0, cur)) return;
    f32x4 acc[2][2][4][2];
#pragma unroll
    for (int a = 0; a < 2; ++a)
#pragma unroll
        for (int b = 0; b < 2; ++b)
#pragma unroll
            for (int m = 0; m < 4; ++m)
#pragma unroll
                for (int n = 0; n < 2; ++n) { acc[a][b][m][n] = (f32x4){0.f, 0.f, 0.f, 0.f}; if constexpr (FP8) asm volatile("" : "+v"(acc[a][b][m][n])); }
    bf16x8 At[4][2], B0[2][2], B1[2][2];
    unsigned va[2][2], vn[2][2];
    if constexpr (GATHER) {
        const unsigned* ip = S.idx_ptr(cur); const int nv = S.nvalid(cur);
#pragma unroll
        for (int h = 0; h < 2; ++h)
#pragma unroll
            for (int i = 0; i < 2; ++i) { const int r = Rr[i] + HALF * h; const unsigned e = ip[r]; const unsigned tok = r < nv ? (e >> 16) : 0u; va[h][i] = tok * (unsigned)K * 2u + (unsigned)Cc[i] * 2u; }
    } else {
#pragma unroll
        for (int h = 0; h < 2; ++h)
#pragma unroll
            for (int i = 0; i < 2; ++i) va[h][i] = (unsigned)((Rr[i] + HALF * h) * K + Cc[i]) * 2u;
    }
#pragma unroll
    for (int h = 0; h < 2; ++h)
#pragma unroll
        for (int i = 0; i < 2; ++i) vn[h][i] = va[h][i];
    const char* cA = S.a_base(cur); const char* cB = S.b_base(cur);
    PG8_STAGE_B(PG8_SB(0, 0), cB); PG8_STAGE_B(PG8_SB(0, 1), cB + hstep); PG8_STAGE_A(PG8_SA(0, 0), cA, va, 0); PG8_STAGE_A(PG8_SA(0, 1), cA, va, 1);
    if (wr == 1) PG8_BAR;
    PG8_WAIT_V(2); PG8_BAR;
    PG8_STAGE_B(PG8_SB(1, 0), cB + kstep); PG8_STAGE_A(PG8_SA(1, 0), cA + kstep, va, 0); PG8_STAGE_B(PG8_SB(1, 1), cB + hstep + kstep);
    PG8_WAIT_V(6); PG8_BAR;
    for (;;) {
        const bool has_next = S.next(ui + 1, nxt);
        const char* nA = has_next ? S.a_base(nxt) : cA; const char* nB = has_next ? S.b_base(nxt) : cB;
        int nvn = 0;
        if constexpr (GATHER) {
            if (has_next) { nvn = S.nvalid(nxt);
                __builtin_amdgcn_global_load_lds((const unsigned*)(S.idx_ptr(nxt) + lane * 4), (LAS unsigned*)idxw, 16, 0, 0); }
        }
#pragma unroll 1
        for (int t = 0; t < nt; t += 2) {
            const bool last = (t == nt - 2);
            if constexpr (GATHER) {
                if (last && has_next) {
                    asm volatile("" ::: "memory");
#pragma unroll
                    for (int h = 0; h < 2; ++h)
#pragma unroll
                        for (int i = 0; i < 2; ++i) { const int r = Rr[i] + HALF * h; const unsigned e = idxw[r]; const unsigned tok = r < nvn ? (e >> 16) : 0u; vn[h][i] = tok * (unsigned)K * 2u + (unsigned)Cc[i] * 2u; }
                }
            }
            unsigned v2[2][2];
#pragma unroll
            for (int h = 0; h < 2; ++h)
#pragma unroll
                for (int i = 0; i < 2; ++i) v2[h][i] = (GATHER && last) ? vn[h][i] : va[h][i];
            const char* a1 = cA + (size_t)(t + 1) * kstep;
            const char* a2 = last ? nA : cA + (size_t)(t + 2) * kstep; const char* b2 = last ? nB : cB + (size_t)(t + 2) * kstep;
            const char* a3 = a2 + kstep; const char* b3 = b2 + kstep;
            PG8_LDB(B0, 0, 0); PG8_LDB(B1, 0, 1); PG8_SCHED; PG8_LDA(At, 0, 0); PG8_STAGE_A(PG8_SA(1, 1), a1, va, 1);
            PG8_WAIT_V(8); PG8_WAIT_L(0); PG8_BAR; PG8_MMA(0, 0, At, B0); PG8_MMA(0, 1, At, B1); PG8_BAR; PG8_SCHED;
            PG8_LDA(At, 0, 1); PG8_STAGE_B(PG8_SB(0, 0), b2); PG8_STAGE_B(PG8_SB(0, 1), b2 + hstep); PG8_STAGE_A(PG8_SA(0, 0), a2, v2, 0);
            PG8_WAIT_V(8); PG8_WAIT_L(0); PG8_BAR; PG8_MMA(1, 0, At, B0); PG8_MMA(1, 1, At, B1); PG8_BAR; PG8_SCHED;
            PG8_LDB(B0, 1, 0); PG8_LDB(B1, 1, 1); PG8_SCHED; PG8_LDA(At, 1, 0); PG8_STAGE_A(PG8_SA(0, 1), a2, v2, 1);
            PG8_WAIT_V(8); PG8_WAIT_L(0); PG8_BAR; PG8_MMA(0, 0, At, B0); PG8_MMA(0, 1, At, B1); PG8_BAR; PG8_SCHED;
            PG8_LDA(At, 1, 1); PG8_STAGE_B(PG8_SB(1, 0), b3); PG8_STAGE_B(PG8_SB(1, 1), b3 + hstep); PG8_STAGE_A(PG8_SA(1, 0), a3, v2, 0);
            PG8_WAIT_V(8); PG8_WAIT_L(0); PG8_BAR; PG8_MMA(1, 0, At, B0); PG8_MMA(1, 1, At, B1); PG8_BAR; PG8_SCHED;
        }
        if constexpr (ALIGN_EPI) { if (wr == 0) PG8_BAR; }
        if constexpr (FP8) {
#define PG8_A4(a, b) "+v"(acc[a][b][0][0]), "+v"(acc[a][b][0][1]), "+v"(acc[a][b][1][0]), "+v"(acc[a][b][1][1]), "+v"(acc[a][b][2][0]), "+v"(acc[a][b][2][1]), "+v"(acc[a][b][3][0]), "+v"(acc[a][b][3][1])
            asm volatile("s_nop 15\n\ts_nop 15" : PG8_A4(0, 0), PG8_A4(0, 1) :: "memory");
            asm volatile("" : PG8_A4(1, 0), PG8_A4(1, 1) :: "memory");
#undef PG8_A4
        }
        E(acc, cur, wr, wc, fr, fq);
        if (!has_next) break;
#pragma unroll
        for (int a = 0; a < 2; ++a)
#pragma unroll
            for (int b = 0; b < 2; ++b)
#pragma unroll
                for (int m = 0; m < 4; ++m)
#pragma unroll
                    for (int n = 0; n < 2; ++n) { acc[a][b][m][n] = (f32x4){0.f, 0.f, 0.f, 0.f}; if constexpr (FP8) asm volatile("" : "+v"(acc[a][b][m][n])); }
        cur = nxt; cA = nA; cB = nB; ++ui;
#pragma unroll
        for (int h = 0; h < 2; ++h)
#pragma unroll
            for (int i = 0; i < 2; ++i) va[h][i] = vn[h][i];
        if constexpr (ALIGN_EPI) { if (wr == 1) PG8_BAR; }
    }
    PG8_WAIT_V(0);
    if constexpr (!ALIGN_EPI) { if (wr == 0) PG8_BAR; }
    PG8_BAR;
#undef PG8_SA
#undef PG8_SB
#undef PG8_STAGE_A
#undef PG8_STAGE_B
#undef PG8_LDA
#undef PG8_LDB
#undef PG8_MMA
#undef PG8_WAIT_V
#undef PG8_WAIT_L
#undef PG8_BAR
#undef PG8_SCHED
}
}

using pg8::Unit;
struct MoeTab { const LAS int* tp; const LAS int* cnt; const LAS unsigned short* t2e; };
__device__ __forceinline__ int moe_find(const LAS int* tp, int T) {
    int lo = 0, hi = 256;
    while (lo < hi) { const int mid = (lo + hi + 1) >> 1; if (tp[mid] <= T) lo = mid; else hi = mid - 1; }
    return lo;
}

struct SchedQKV {
    const bf16_t *H; long hc_delta; const bf16_t *W; int G, c;
    __device__ __forceinline__ bool next(int i, Unit& u) const {
        const int L = i * G + c; if (L >= 784) return false;
        if (L < 768) { u.pm = L / 3; u.pn = L % 3; u.aux = 0; } else { u.pm = L - 768; u.pn = 2; u.aux = 1; }
        u.aux2 = 0; return true;
    }
    __device__ __forceinline__ const char* a_base(const Unit& u) const { return (const char*)H + (u.aux ? hc_delta : 0L) + (size_t)u.pm * (256 * 1024 * 2); }
    __device__ __forceinline__ const char* b_base(const Unit& u) const { return (const char*)W + (size_t)u.pn * (256 * 1024 * 2); }
    __device__ __forceinline__ const unsigned* idx_ptr(const Unit&) const { return nullptr; }
    __device__ __forceinline__ int nvalid(const Unit&) const { return 256; }
};
struct SchedDense {
    const bf16_t *A, *Bt; int K, nM, nN, G, c; bool m_fast;
    __device__ __forceinline__ bool next(int i, Unit& u) const {
        const int L = i * G + c; if (L >= nM * nN) return false;
        if (m_fast) { u.pm = L % nM; u.pn = L / nM; } else { u.pm = L / nN; u.pn = L % nN; }
        u.aux = 0; u.aux2 = 0; return true;
    }
    __device__ __forceinline__ const char* a_base(const Unit& u) const { return (const char*)A + (size_t)u.pm * 512 * (size_t)K; }
    __device__ __forceinline__ const char* b_base(const Unit& u) const { return (const char*)Bt + (size_t)u.pn * 512 * (size_t)K; }
    __device__ __forceinline__ const unsigned* idx_ptr(const Unit&) const { return nullptr; }
    __device__ __forceinline__ int nvalid(const Unit&) const { return 256; }
};
struct TileDeal {
    int nT, NP, G, c;
    __device__ __forceinline__ bool get(int i, int& tile, int& slot) const {
        const int full = nT / G, rem = nT - full * G;
        if (i < full * NP) { tile = (i / NP) * G + c; slot = i % NP; return true; }
        const int j = i - full * NP;
        if (rem * NP <= G) { if (j > 0 || c >= rem * NP) return false; tile = full * G + c / NP; slot = c % NP; return true; }
        if (j >= NP || c >= rem) return false; tile = full * G + c; slot = j; return true;
    }
};
struct SchedGU {
    const bf16_t *H2, *WGU, *WSGU; const unsigned* LIST; MoeTab tab; int G, c;
    __device__ __forceinline__ bool next(int i, Unit& u) const {
        const int Ttot = __builtin_amdgcn_readfirstlane(tab.tp[257]); const int L = i * G + c; if (L >= 2 * Ttot) return false;
        const int T = L >> 1, half = L & 1;
        const int e = __builtin_amdgcn_readfirstlane((int)tab.t2e[T]);
        u.pm = T; u.pn = half; u.aux = e; u.aux2 = __builtin_amdgcn_readfirstlane(T - tab.tp[e]); return true;
    }
    __device__ __forceinline__ const char* a_base(const Unit&) const { return (const char*)H2; }
    __device__ __forceinline__ const char* b_base(const Unit& u) const { return (u.aux < 256 ? (const char*)WGU + (size_t)u.aux * (512 * 1024) : (const char*)WSGU) + (size_t)u.pn * (256 * 1024); }
    __device__ __forceinline__ const unsigned* idx_ptr(const Unit& u) const { return LIST + (size_t)u.aux * 65536 + (size_t)u.aux2 * 256; }
    __device__ __forceinline__ int nvalid(const Unit& u) const { const int r = __builtin_amdgcn_readfirstlane(tab.cnt[u.aux]) - u.aux2 * 256; return r < 256 ? r : 256; }
};
struct SchedDown {
    const bf16_t *ACT, *WD, *WSD; MoeTab tab; int G, c;
    __device__ __forceinline__ bool next(int i, Unit& u) const {
        const int TT = __builtin_amdgcn_readfirstlane(tab.tp[257]);
        const int L = i * G + c; if (L >= 4 * TT) return false;
        u.pm = L >> 2; u.pn = L & 3;
        u.aux = __builtin_amdgcn_readfirstlane((int)tab.t2e[u.pm]); u.aux2 = 0; return true;
    }
    __device__ __forceinline__ const char* a_base(const Unit& u) const { return (const char*)ACT + (size_t)u.pm * (256 * 256); }
    __device__ __forceinline__ const char* b_base(const Unit& u) const { return (u.aux < 256 ? (const char*)WD + (size_t)u.aux * (1024 * 256) : (const char*)WSD) + (size_t)u.pn * (256 * 256); }
    __device__ __forceinline__ const unsigned* idx_ptr(const Unit&) const { return nullptr; }
    __device__ __forceinline__ int nvalid(const Unit&) const { return 256; }
};

#define EPI_ARGS const f32x4 (&acc)[2][2][4][2], const Unit& u, int wr, int wc, int fr_, int fq_
#define EPI_PIN int fr = fr_, fq = fq_; asm volatile("" : "+v"(fr), "+v"(fq))
__device__ __forceinline__ u32x4 pack8(const f32x4& a, const f32x4& b) { u32x4 o; o.x = cvt_pk_bf16(a[0], a[1]); o.y = cvt_pk_bf16(a[2], a[3]); o.z = cvt_pk_bf16(b[0], b[1]); o.w = cvt_pk_bf16(b[2], b[3]); return o; }

__device__ __forceinline__ unsigned pk4_fp8c(float a, float b, float c, float d) {
    a = __builtin_amdgcn_fmed3f(a, -440.f, 440.f); b = __builtin_amdgcn_fmed3f(b, -440.f, 440.f); c = __builtin_amdgcn_fmed3f(c, -440.f, 440.f); d = __builtin_amdgcn_fmed3f(d, -440.f, 440.f);
    int w = __builtin_amdgcn_cvt_pk_fp8_f32(a, b, 0, false); w = __builtin_amdgcn_cvt_pk_fp8_f32(c, d, w, true); return (unsigned)w; }
struct EpiQKV {
    bf16_t *Q, *Kb, *Vb; const float *qnw, *knw; const f32x2* rope;
    __device__ __forceinline__ void operator()(EPI_ARGS) const {
        EPI_PIN;
        const bool ctx = u.aux != 0;
        const int kind = (u.pn < 2) ? 0 : (wc < 2 ? 1 : 2);
        f32x4 w[2][2];
#pragma unroll
        for (int bj = 0; bj < 2; ++bj)
#pragma unroll
            for (int n = 0; n < 2; ++n) w[bj][n] = (kind == 2) ? (f32x4){1.f, 1.f, 1.f, 1.f} : *(const f32x4*)((kind == 0 ? qnw : knw) + 32 * bj + 8 * fq + 4 * n);
        f32x4 rrow[2][2], rcol[4][2];
        if (kind != 2 && !ctx) {
#pragma unroll
            for (int ai = 0; ai < 2; ++ai)
#pragma unroll
                for (int n = 0; n < 2; ++n) rrow[ai][n] = ((const f32x4*)(rope + (((u.pm * 4 + 2 * ai + wr) & 63) * 16) + 4 * fq))[n];
#pragma unroll
            for (int m = 0; m < 4; ++m)
#pragma unroll
                for (int n = 0; n < 2; ++n) rcol[m][n] = ((const f32x4*)(rope + (16 * m + fr) * 16 + 4 * fq))[n];
        }
#pragma unroll
        for (int ai = 0; ai < 2; ++ai)
#pragma unroll
            for (int m = 0; m < 4; ++m) {
                const int rl = ai * 128 + wr * 64 + m * 16 + fr; const int row = u.pm * 256 + rl;
                f32x4 v[2][2];
#pragma unroll
                for (int bj = 0; bj < 2; ++bj)
#pragma unroll
                    for (int n = 0; n < 2; ++n) v[bj][n] = acc[ai][bj][m][n];
                if (kind != 2) {
                    float ss = 0.f;
#pragma unroll
                    for (int bj = 0; bj < 2; ++bj)
#pragma unroll
                        for (int n = 0; n < 2; ++n) ss += (v[bj][n][0] * v[bj][n][0] + v[bj][n][1] * v[bj][n][1]) + (v[bj][n][2] * v[bj][n][2] + v[bj][n][3] * v[bj][n][3]);
                    ss += __shfl_xor(ss, 16); ss += __shfl_xor(ss, 32);
                    const float rs = rsqrtf(ss * (1.f / 64.f) + EPS);
#pragma unroll
                    for (int bj = 0; bj < 2; ++bj)
#pragma unroll
                        for (int n = 0; n < 2; ++n) v[bj][n] = v[bj][n] * rs * w[bj][n];
                    if (!ctx) {
#pragma unroll
                        for (int bj = 0; bj < 2; ++bj)
#pragma unroll
                            for (int n = 0; n < 2; ++n) { const f32x4 cs = bj == 0 ? rrow[ai][n] : rcol[m][n]; const f32x4 x = v[bj][n];
                                v[bj][n] = (f32x4){x[0] * cs[0] - x[1] * cs[1], x[0] * cs[1] + x[1] * cs[0], x[2] * cs[2] - x[3] * cs[3], x[2] * cs[3] + x[3] * cs[2]}; }
                    }
                    if (kind == 0) {
#pragma unroll
                        for (int bj = 0; bj < 2; ++bj)
#pragma unroll
                            for (int n = 0; n < 2; ++n) v[bj][n] = v[bj][n] * C2;
                    }
                }
                bf16_t* dst;
                if (kind == 0) dst = Q + (size_t)row * AW + 64 * (4 * u.pn + wc) + 8 * fq;
                else { const int kvrow = ctx ? (row >> 8) * KVLEN + (row & 255) : (row >> 12) * KVLEN + CTXL + (row & (SEQ - 1));
                       dst = (kind == 1 ? Kb : Vb) + (size_t)kvrow * KVP + 64 * (wc & 1) + 8 * fq; }
#pragma unroll
                for (int bj = 0; bj < 2; ++bj) *(u32x4*)(dst + 32 * bj) = pack8(v[bj][0], v[bj][1]);
            }
    }
};
struct EpiPlainBf16 {
    bf16_t* O; size_t ldc; float scale;
    __device__ __forceinline__ void operator()(EPI_ARGS) const {
        EPI_PIN;
#pragma unroll
        for (int ai = 0; ai < 2; ++ai)
#pragma unroll
            for (int m = 0; m < 4; ++m) { bf16_t* rowp = O + (size_t)(u.pm * 256 + ai * 128 + wr * 64 + m * 16 + fr) * ldc + u.pn * 256 + wc * 32 + 8 * fq;
#pragma unroll
                for (int bj = 0; bj < 2; ++bj) *(u32x4*)(rowp + bj * 128) = pack8(acc[ai][bj][m][0] * scale, acc[ai][bj][m][1] * scale); }
    }
};
struct EpiOutProj {
    const float* x; float* out; const float* modv; int pm0;
    __device__ __forceinline__ void operator()(EPI_ARGS) const {
        EPI_PIN;
        const int pmt = pm0 + u.pm;
        const float* g1 = modv + (size_t)(pmt >> 4) * 6144 + 2 * 1024; const int col0 = u.pn * 256 + wc * 32 + 8 * fq;
        f32x4 gv[2][2];
#pragma unroll
        for (int bj = 0; bj < 2; ++bj)
#pragma unroll
            for (int n = 0; n < 2; ++n) gv[bj][n] = *(const f32x4*)(g1 + col0 + bj * 128 + 4 * n);
#pragma unroll
        for (int ai = 0; ai < 2; ++ai)
#pragma unroll
            for (int m = 0; m < 4; ++m) { const size_t off = (size_t)(pmt * 256 + ai * 128 + wr * 64 + m * 16 + fr) * DM + col0;
#pragma unroll
                for (int bj = 0; bj < 2; ++bj) {
#if X1_BF16
                    const f32x4 xa = *(const f32x4*)(x + off + bj * 128), xb = *(const f32x4*)(x + off + bj * 128 + 4);
                    const size_t rowoff = off - col0;
                    *(u32x4*)((bf16_t*)(out + rowoff) + col0 + bj * 128) = pack8(xa + gv[bj][0] * acc[ai][bj][m][0], xb + gv[bj][1] * acc[ai][bj][m][1]);
#else
#pragma unroll
                    for (int n = 0; n < 2; ++n) { const f32x4 xv = *(const f32x4*)(x + off + bj * 128 + 4 * n); *(f32x4*)(out + off + bj * 128 + 4 * n) = xv + gv[bj][n] * acc[ai][bj][m][n]; }
#endif
                }
                if (m & 1) asm volatile("" ::: "memory"); }
    }
};
struct EpiF32 {
    float* O; size_t ldc;
    __device__ __forceinline__ void operator()(EPI_ARGS) const {
        EPI_PIN;
#pragma unroll
        for (int ai = 0; ai < 2; ++ai)
#pragma unroll
            for (int m = 0; m < 4; ++m) { float* rowp = O + (size_t)(u.pm * 256 + ai * 128 + wr * 64 + m * 16 + fr) * ldc + u.pn * 256 + wc * 32 + 8 * fq;
#pragma unroll
                for (int bj = 0; bj < 2; ++bj)
#pragma unroll
                    for (int n = 0; n < 2; ++n) *(f32x4*)(rowp + bj * 128 + 4 * n) = acc[ai][bj][m][n]; }
    }
};
struct EpiGU {
    unsigned char* ACT; const unsigned* LIST; MoeTab tab;
    __device__ __forceinline__ void operator()(EPI_ARGS) const {
        EPI_PIN;
        const int e = u.aux, tile = u.aux2; int nv = __builtin_amdgcn_readfirstlane(tab.cnt[e]) - tile * 256; nv = nv < 256 ? nv : 256;
        const unsigned* ip = LIST + (size_t)e * 65536 + (size_t)tile * 256;
        constexpr float C1 = -1.4426950408889634f / 256.0f;
#pragma unroll
        for (int ai = 0; ai < 2; ++ai)
#pragma unroll
            for (int m = 0; m < 4; ++m) { const int rl = ai * 128 + wr * 64 + m * 16 + fr;
                const float ws = rl < nv ? bf2f(ip[rl] & 0xffffu) * (4.0f / 65536.0f) : 0.f;
                unsigned pk[2];
#pragma unroll
                for (int n = 0; n < 2; ++n) { const f32x4 g = acc[ai][0][m][n], up = acc[ai][1][m][n]; f32x2 r[2];
#pragma unroll
                    for (int h = 0; h < 2; ++h) { const f32x2 gg = {g[2 * h], g[2 * h + 1]}, uu = {up[2 * h], up[2 * h + 1]};
                        const f32x2 ea = gg * C1; f32x2 d; d.x = __builtin_amdgcn_exp2f(ea.x); d.y = __builtin_amdgcn_exp2f(ea.y); d = d + 1.0f;
                        f32x2 q; q.x = __builtin_amdgcn_rcpf(d.x); q.y = __builtin_amdgcn_rcpf(d.y);
                        f32x2 p = (gg * uu) * (q * ws);
                        p.x = __builtin_amdgcn_fmed3f(p.x, -440.f, 440.f); p.y = __builtin_amdgcn_fmed3f(p.y, -440.f, 440.f); r[h] = p; }
                    int w = __builtin_amdgcn_cvt_pk_fp8_f32(r[0].x, r[0].y, 0, false); w = __builtin_amdgcn_cvt_pk_fp8_f32(r[1].x, r[1].y, w, true); pk[n] = (unsigned)w; }
                u32x2 o; o.x = pk[0]; o.y = pk[1];
                *(u32x2*)(ACT + (size_t)(u.pm * 256 + rl) * FF + u.pn * 128 + wc * 32 + 8 * fq) = o; }
    }
};
struct EpiDown {
    unsigned char* SLOT;
    __device__ __forceinline__ void operator()(EPI_ARGS) const {
        EPI_PIN;
#pragma unroll
        for (int ai = 0; ai < 2; ++ai)
#pragma unroll
            for (int m = 0; m < 4; ++m) { unsigned char* rowp = SLOT + (size_t)(u.pm * 256 + ai * 128 + wr * 64 + m * 16 + fr) * DM + u.pn * 256 + wc * 32 + 8 * fq;
#pragma unroll
                for (int bj = 0; bj < 2; ++bj) { const f32x4 a = acc[ai][bj][m][0] * 0.125f, b = acc[ai][bj][m][1] * 0.125f;
                    u32x2 pk; pk.x = pk4_fp8c(a[0], a[1], a[2], a[3]); pk.y = pk4_fp8c(b[0], b[1], b[2], b[3]); *(u32x2*)(rowp + bj * 128) = pk; } }
    }
};
#include <hip/hip_bf16.h>
#include <cmath>
namespace attn_body {
using bf16=__hip_bfloat16;
using bf16x8=__attribute__((ext_vector_type(8)))short;
using s16x4=__attribute__((ext_vector_type(4)))short;
using f32x16=__attribute__((ext_vector_type(16)))float;
using u32x4=__attribute__((ext_vector_type(4)))unsigned;
constexpr int SEQ=4096,D=64,QP=512,KVP=128,KVLEN=4352;
constexpr int NW=8,QBLK=32,QB=QBLK*NW,KVBLK=64,NQB=SEQ/QB;
constexpr int ATTN_UNIT_ROWS=QB;
__device__ __forceinline__ int crow(int r,int hi){return (r&3)+8*(r>>2)+4*hi;}
#define SBAR() __builtin_amdgcn_sched_barrier(0)

constexpr int NSLOT=3, SLOTB=8192;
constexpr int LDS_K=0, LDS_V=NSLOT*SLOTB, LDS_WS=2*NSLOT*SLOTB, LDS_OST=LDS_WS+NW*64*4, LDS_BYTES=LDS_OST+NW*4096;
constexpr float C2=0.125f*1.4426950408889634f;
__device__ __forceinline__ void glds16(const void*gsrc,unsigned lds_dst){unsigned keep;
  asm volatile("s_mov_b32 %0, m0\n\ts_mov_b32 m0, %2\n\ts_nop 0\n\tglobal_load_lds_dwordx4 %1, off\n\ts_mov_b32 m0, %0":"=&s"(keep):"v"(gsrc),"s"(lds_dst):"memory");}
__device__ __forceinline__ float max3f(float a,float b,float c){float r;asm("v_max3_f32 %0, %1, %2, %3":"=v"(r):"v"(a),"v"(b),"v"(c));return r;}
__device__ __forceinline__ float max2f(float a,float b){float r;asm("v_max_f32_e32 %0, %1, %2":"=v"(r):"v"(a),"v"(b));return r;}
__device__ __forceinline__ float fadd_s(float a,float b){float r;asm("v_add_f32_e32 %0, %1, %2":"=v"(r):"v"(a),"v"(b));return r;}
__device__ __forceinline__ float fsub_s(float a,float b){float r;asm("v_sub_f32_e32 %0, %1, %2":"=v"(r):"v"(a),"v"(b));return r;}
typedef float f32x2_t __attribute__((ext_vector_type(2))); typedef __bf16 bf16x2_t __attribute__((ext_vector_type(2)));
__device__ __forceinline__ unsigned cvtpk_s(float lo,float hi){f32x2_t v={lo,hi};bf16x2_t b=__builtin_convertvector(v,bf16x2_t);return __builtin_bit_cast(unsigned,b);}
#define WAIT_BAR(N) asm volatile("s_waitcnt vmcnt(" #N ") lgkmcnt(0)\n\ts_barrier":::"memory")

__device__ __forceinline__ void qkt(f32x16&p0,f32x16&p1,const char*Kslot,const bf16x8*qr,const f32x16&negm,int r32,int hi){
  const char*kb=Kslot+hi*1024+r32*16;
  #pragma unroll
  for(int d0=0;d0<4;++d0){
    const bf16x8 b0=*reinterpret_cast<const bf16x8*>(kb+d0*2048);
    const bf16x8 b1=*reinterpret_cast<const bf16x8*>(kb+d0*2048+512);
    if(d0==0){p0=__builtin_amdgcn_mfma_f32_32x32x16_bf16(b0,qr[0],negm,0,0,0);p1=__builtin_amdgcn_mfma_f32_32x32x16_bf16(b1,qr[0],negm,0,0,0);}
    else{p0=__builtin_amdgcn_mfma_f32_32x32x16_bf16(b0,qr[d0],p0,0,0,0);p1=__builtin_amdgcn_mfma_f32_32x32x16_bf16(b1,qr[d0],p1,0,0,0);}}
}
typedef __attribute__((address_space(3))) const char* lds_cptr;
typedef short v4i16_t __attribute__((ext_vector_type(4)));
__device__ __forceinline__ void kload8(bf16x8*kf,lds_cptr kp){
  kf[0]=*(const __attribute__((address_space(3))) bf16x8*)(kp);      kf[1]=*(const __attribute__((address_space(3))) bf16x8*)(kp+512);
  kf[2]=*(const __attribute__((address_space(3))) bf16x8*)(kp+2048); kf[3]=*(const __attribute__((address_space(3))) bf16x8*)(kp+2560);
  kf[4]=*(const __attribute__((address_space(3))) bf16x8*)(kp+4096); kf[5]=*(const __attribute__((address_space(3))) bf16x8*)(kp+4608);
  kf[6]=*(const __attribute__((address_space(3))) bf16x8*)(kp+6144); kf[7]=*(const __attribute__((address_space(3))) bf16x8*)(kp+6656);
}
__device__ __forceinline__ void kload2(bf16x8*kf,lds_cptr kp,int j){ kf[2*j]=*(const __attribute__((address_space(3))) bf16x8*)(kp+j*2048); kf[2*j+1]=*(const __attribute__((address_space(3))) bf16x8*)(kp+j*2048+512); }
__device__ __forceinline__ s16x4 vtr(lds_cptr p){ return __builtin_bit_cast(s16x4,__builtin_amdgcn_ds_read_tr16_b64_v4i16((__attribute__((address_space(3))) v4i16_t*)p)); }
__device__ __forceinline__ float rowmax(const f32x16&p0,const f32x16&p1){
  float a=max3f(p0[0],p0[1],p1[0]),b=max3f(p0[2],p0[3],p1[1]);a=max3f(a,p1[2],p1[3]);
  #pragma unroll
  for(int r=4;r<16;r+=4){a=max3f(a,p0[r],p0[r+1]);b=max3f(b,p0[r+2],p0[r+3]);a=max3f(a,p1[r],p1[r+1]);b=max3f(b,p1[r+2],p1[r+3]);}
  const float m=max2f(a,b);
  auto rr=__builtin_amdgcn_permlane32_swap(__float_as_uint(m),__float_as_uint(m),false,false);
  return max2f(__uint_as_float(rr[0]),__uint_as_float(rr[1]));
}
__device__ __forceinline__ void pv(f32x16*o,int vb,bf16x8 pa0,bf16x8 pa1,bf16x8 pa2,bf16x8 pa3){
  #pragma unroll
  for(int d0=0;d0<2;++d0){s16x4 lo[4],hi[4];
    #pragma unroll
    for(int ks=0;ks<4;++ks){
      asm volatile("ds_read_b64_tr_b16 %0,%1 offset:%c2":"=&v"(lo[ks]):"v"(vb),"i"(d0*4096+ks*1024):"memory");
      asm volatile("ds_read_b64_tr_b16 %0,%1 offset:%c2":"=&v"(hi[ks]):"v"(vb),"i"(d0*4096+ks*1024+512):"memory");}
    asm volatile("s_waitcnt lgkmcnt(0)":::"memory");SBAR();
    #define PK(k) (bf16x8){lo[k][0],lo[k][1],lo[k][2],lo[k][3],hi[k][0],hi[k][1],hi[k][2],hi[k][3]}
    o[d0]=__builtin_amdgcn_mfma_f32_32x32x16_bf16(pa0,PK(0),o[d0],0,0,0);
    o[d0]=__builtin_amdgcn_mfma_f32_32x32x16_bf16(pa1,PK(1),o[d0],0,0,0);
    o[d0]=__builtin_amdgcn_mfma_f32_32x32x16_bf16(pa2,PK(2),o[d0],0,0,0);
    o[d0]=__builtin_amdgcn_mfma_f32_32x32x16_bf16(pa3,PK(3),o[d0],0,0,0);
    #undef PK
  }
}

#ifndef ATTN_STORE16
#define ATTN_STORE16(p,v) (*(u32x4*)(p)=(v))
#endif
template<int THRL> __device__ __forceinline__ void attn_unit(int b,int h,int qb,const bf16*Q,const bf16*__restrict__ K,const bf16*__restrict__ V,bf16*O,char*shm,int wave_){
  const int lane=::lane_id(),tid=wave_*64+lane,r32=lane&31,hi=lane>>5; const int wid=wave_;
  const int q0=qb*QB; const long qrow0=(long)b*SEQ+q0+wid*QBLK;
  const bf16*Qw=Q+qrow0*QP+h*D;
  const bf16*Kh=K+(long)b*KVLEN*KVP+(h>>2)*D,*Vh=V+(long)b*KVLEN*KVP+(h>>2)*D;
  const unsigned lds0=(unsigned)(uintptr_t)shm;
  float*wsf=(float*)(shm+LDS_WS)+wid*64;
  const bf16*ksrc=Kh+(long)lane*KVP+wid*8;
  const bf16*vsrc=Vh+(long)(16*(wid&3)+(lane>>2))*KVP+(wid>>2)*32+(lane&3)*8;
  const unsigned kdst=lds0+LDS_K+wid*1024, vdst=lds0+LDS_V+wid*1024;
  #define DMA_K(t,slot) glds16(ksrc+(long)(t)*KVBLK*KVP,(unsigned)__builtin_amdgcn_readfirstlane(kdst+(slot)))
  #define DMA_V(t,slot) glds16(vsrc+(long)(t)*KVBLK*KVP,(unsigned)__builtin_amdgcn_readfirstlane(vdst+(slot)))
  const int vb0=(int)(lds0+LDS_V)+((lane>>4)&1)*32+(lane&3)*8+(4*hi+((lane&15)>>2))*64;
  const char*Kbase=shm+LDS_K; bf16x8 kf[8];
  const lds_cptr shm3=(lds_cptr)shm; const lds_cptr kp0=shm3+LDS_K+hi*1024+r32*16; const lds_cptr vp0=shm3+LDS_V+((lane>>4)&1)*32+(lane&3)*8+(4*hi+((lane&15)>>2))*64;
  constexpr int NT=KVLEN/KVBLK;
  DMA_K(0,0);DMA_V(0,0);DMA_K(1,SLOTB);
  bf16x8 qr[4];
  #pragma unroll
  for(int d0=0;d0<4;++d0)qr[d0]=*reinterpret_cast<const bf16x8*>(&Qw[(long)r32*QP+d0*16+hi*8]);
  float mhat=0.f,l_reg=0.f;f32x16 o[2];o[0]=f32x16{};o[1]=f32x16{};f32x16 negm=f32x16{};asm volatile("":"+v"(negm));
  #define CMASK(P0,P1,t) do{}while(0)
  bool resc=false;
  #define START(P0,P1) do{ const float rm=rowmax(P0,P1); resc=false; \
    { const float dl=rm; mhat=fadd_s(mhat,dl); \
      _Pragma("unroll") for(int r=0;r<16;++r){P0[r]=fsub_s(P0[r],dl);P1[r]=fsub_s(P1[r],dl);} \
      _Pragma("unroll") for(int r=0;r<16;++r)negm[r]=-mhat; asm volatile("":"+v"(negm)); } \
    _Pragma("unroll") for(int r=0;r<16;++r)P0[r]=__builtin_amdgcn_exp2f(P0[r]); }while(0)
  #define RESC() do{ if(resc){ asm volatile("s_waitcnt lgkmcnt(0)":::"memory"); \
      _Pragma("unroll") for(int d_=0;d_<2;++d_) _Pragma("unroll") for(int r=0;r<16;++r)o[d_][r]*=wsf[crow(r,hi)]; } }while(0)
  f32x16 pA0,pA1,pB0,pB1;
  int sl_prev=0,sl_cur=0,sl_next=SLOTB;
  #define ROT() do{sl_prev=sl_cur;sl_cur=sl_next;sl_next=(sl_next==(NSLOT-1)*SLOTB)?0:sl_next+SLOTB;}while(0)
  DMA_K(2,2*SLOTB);
  WAIT_BAR(3);
  qkt(pA0,pA1,Kbase,qr,negm,r32,hi);asm volatile("s_nop 15\n\ts_nop 7":"+v"(pA0),"+v"(pA1));CMASK(pA0,pA1,0);
  START(pA0,pA1);
  _Pragma("unroll") for(int r=0;r<16;++r)pA1[r]=__builtin_amdgcn_exp2f(pA1[r]);
  WAIT_BAR(0);
  DMA_K(3,0);DMA_V(1,SLOTB);
  ROT();
  kload8(kf,kp0+sl_cur);
  WAIT_BAR(2);
  s16x4 vlo[8],vhi[8]; u32x4 pw0,pw1,pw2,pw3;
  #define PKW(P,B) cvtpk_s(P[B],P[B+1])
  #define PAF(k) __builtin_bit_cast(bf16x8,pw##k)
  #define VFR(i) (bf16x8){vlo[i][0],vlo[i][1],vlo[i][2],vlo[i][3],vhi[i][0],vhi[i][1],vhi[i][2],vhi[i][3]}
  #define PIN(x) asm volatile("":"+v"(x))
  #define MX3(a,b,c) __builtin_fmaxf(__builtin_fmaxf((a),(b)),(c))
  #define GAPA(MF,A0,A1,A2,A3,W0,W1,PW) do{ MF; sacc+=A0; sacc+=A1; sacc+=A2; sacc+=A3; PIN(sacc); W0; W1; PIN(PW); SBAR(); }while(0)
  #define EX(v) __builtin_amdgcn_exp2f(v)
  #define GAPB(MF,X,B) do{ MF; X[B]=EX(X[B]); X[B+1]=EX(X[B+1]); X[B+2]=EX(X[B+2]); X[B+3]=EX(X[B+3]); PIN(X); SBAR(); }while(0)
  #define VRD(i) do{ vlo[i]=vtr(vp_+(((i)>>2)*4096+((i)&3)*1024)); vhi[i]=vtr(vp_+(((i)>>2)*4096+((i)&3)*1024+512)); }while(0)
  #define KRD(G,j) do{ if(G){ kload2(kf,kp0+sl_next,j); SBAR(); } }while(0)
  #define STEP(C0,C1,P0,P1,t,GK,GV,GL) do{ SBAR(); \
    const lds_cptr vp_=vp0+sl_prev; \
    VRD(0); SBAR(); float sacc=(P0[0]+P0[1]); \
    GAPA(C0=__builtin_amdgcn_mfma_f32_32x32x16_bf16(kf[0],qr[0],negm,0,0,0), P0[2],P0[3],P0[4],P0[5],     pw0[0]=PKW(P0,0), pw0[1]=PKW(P0,2), pw0); \
    VRD(4); SBAR(); GAPA(C1=__builtin_amdgcn_mfma_f32_32x32x16_bf16(kf[1],qr[0],negm,0,0,0), P0[6],P0[7],P0[8],P0[9],     pw0[2]=PKW(P0,4), pw0[3]=PKW(P0,6), pw0); \
    VRD(1); SBAR(); GAPA(C0=__builtin_amdgcn_mfma_f32_32x32x16_bf16(kf[2],qr[1],C0,0,0,0),   P0[10],P0[11],P0[12],P0[13], pw1[0]=PKW(P0,8), pw1[1]=PKW(P0,10), pw1); \
    VRD(5); SBAR(); GAPA(C1=__builtin_amdgcn_mfma_f32_32x32x16_bf16(kf[3],qr[1],C1,0,0,0),   P0[14],P0[15],P1[0],P1[1],   pw1[2]=PKW(P0,12),pw1[3]=PKW(P0,14), pw1); \
    VRD(2); SBAR(); GAPA(C0=__builtin_amdgcn_mfma_f32_32x32x16_bf16(kf[4],qr[2],C0,0,0,0),   P1[2],P1[3],P1[4],P1[5],     pw2[0]=PKW(P1,0), pw2[1]=PKW(P1,2), pw2); \
    VRD(6); SBAR(); GAPA(C1=__builtin_amdgcn_mfma_f32_32x32x16_bf16(kf[5],qr[2],C1,0,0,0),   P1[6],P1[7],P1[8],P1[9],     pw2[2]=PKW(P1,4), pw2[3]=PKW(P1,6), pw2); \
    VRD(3); SBAR(); GAPA(C0=__builtin_amdgcn_mfma_f32_32x32x16_bf16(kf[6],qr[3],C0,0,0,0),   P1[10],P1[11],P1[12],P1[13], pw3[0]=PKW(P1,8), pw3[1]=PKW(P1,10), pw3); \
    VRD(7); SBAR(); GAPA(C1=__builtin_amdgcn_mfma_f32_32x32x16_bf16(kf[7],qr[3],C1,0,0,0),   P1[14],P1[15],0.f,0.f,       pw3[2]=PKW(P1,12),pw3[3]=PKW(P1,14), pw3); \
    l_reg+=sacc; \
    if(GK){DMA_K((t)+3,sl_cur);} if(GV){DMA_V((t)+1,sl_next);} \
    CMASK(C0,C1,t); \
    { float a=MX3(C0[0],C0[1],C1[0]),b=MX3(C0[2],C0[3],C1[1]); a=MX3(a,C1[2],C1[3]); \
      _Pragma("unroll") for(int r=4;r<16;r+=4){a=MX3(a,C0[r],C0[r+1]);b=MX3(b,C0[r+2],C0[r+3]);a=MX3(a,C1[r],C1[r+1]);b=MX3(b,C1[r+2],C1[r+3]);} \
      float rm=__builtin_fmaxf(a,b); { auto rr=__builtin_amdgcn_permlane32_swap(__float_as_uint(rm),__float_as_uint(rm),false,false); rm=__builtin_fmaxf(__uint_as_float(rr[0]),__uint_as_float(rr[1])); } \
      resc=false; \
      if(__builtin_expect(__any(rm>(float)THRL),0)){ const float dl=__builtin_fmaxf(rm,0.f); mhat+=dl; \
        _Pragma("unroll") for(int r=0;r<16;++r){C0[r]-=dl;C1[r]-=dl;} \
        _Pragma("unroll") for(int r=0;r<16;++r)negm[r]=-mhat; asm volatile("":"+v"(negm)); \
        const float f=__builtin_amdgcn_exp2f(-dl); l_reg*=f; if(hi==0)wsf[r32]=f; resc=true; } } \
    SBAR(); \
    GAPB(o[0]=__builtin_amdgcn_mfma_f32_32x32x16_bf16(PAF(0),VFR(0),o[0],0,0,0), C0,0); \
    GAPB(o[1]=__builtin_amdgcn_mfma_f32_32x32x16_bf16(PAF(0),VFR(4),o[1],0,0,0), C0,4); \
    KRD(GL,0); GAPB(o[0]=__builtin_amdgcn_mfma_f32_32x32x16_bf16(PAF(1),VFR(1),o[0],0,0,0), C0,8); \
    KRD(GL,1); GAPB(o[1]=__builtin_amdgcn_mfma_f32_32x32x16_bf16(PAF(1),VFR(5),o[1],0,0,0), C0,12); \
    KRD(GL,2); GAPB(o[0]=__builtin_amdgcn_mfma_f32_32x32x16_bf16(PAF(2),VFR(2),o[0],0,0,0), C1,0); \
    KRD(GL,3); GAPB(o[1]=__builtin_amdgcn_mfma_f32_32x32x16_bf16(PAF(2),VFR(6),o[1],0,0,0), C1,4); \
    GAPB(o[0]=__builtin_amdgcn_mfma_f32_32x32x16_bf16(PAF(3),VFR(3),o[0],0,0,0), C1,8); \
    GAPB(o[1]=__builtin_amdgcn_mfma_f32_32x32x16_bf16(PAF(3),VFR(7),o[1],0,0,0), C1,12); \
    }while(0)
  int t=1;
  #undef CMASK
  #define CMASK(P0,P1,t) do{}while(0)
  for(;t+5<NT;t+=2){
    STEP(pB0,pB1,pA0,pA1,t,true,true,true);     WAIT_BAR(2); RESC(); ROT();
    STEP(pA0,pA1,pB0,pB1,t+1,true,true,true);   WAIT_BAR(2); RESC(); ROT();
  }
  #undef CMASK
  #define CMASK(P0,P1,t) do{}while(0)
  #define ENDW(tt) do{ if((tt)+3<NT){WAIT_BAR(2);} else if((tt)+2<NT){WAIT_BAR(1);} else {WAIT_BAR(0);} }while(0)
  for(;t+1<NT;t+=2){
    STEP(pB0,pB1,pA0,pA1,t,(t+3<NT),(t+1<NT),(t+1<NT));       ENDW(t);   RESC(); ROT();
    STEP(pA0,pA1,pB0,pB1,t+1,(t+4<NT),(t+2<NT),(t+2<NT));     ENDW(t+1); RESC(); ROT();
  }
  STEP(pB0,pB1,pA0,pA1,NT-1,false,false,false); RESC();
  { float sacc=pB0[0]+pB0[1]; _Pragma("unroll") for(int r=2;r<16;++r)sacc+=pB0[r]; _Pragma("unroll") for(int r=0;r<16;++r)sacc+=pB1[r]; l_reg+=sacc;
    pw0=(u32x4){PKW(pB0,0),PKW(pB0,2),PKW(pB0,4),PKW(pB0,6)};pw1=(u32x4){PKW(pB0,8),PKW(pB0,10),PKW(pB0,12),PKW(pB0,14)};pw2=(u32x4){PKW(pB1,0),PKW(pB1,2),PKW(pB1,4),PKW(pB1,6)};pw3=(u32x4){PKW(pB1,8),PKW(pB1,10),PKW(pB1,12),PKW(pB1,14)};
    SBAR(); pv(o,vb0+sl_cur,PAF(0),PAF(1),PAF(2),PAF(3)); }
  #undef PKW
  #undef PAF
  #undef VFR
  #undef PIN
  #undef MX3
  #undef GAPA
  #undef GAPB
  #undef EX
  #undef VRD
  #undef KRD
  #undef STEP
  #undef ENDW
  {auto rr=__builtin_amdgcn_permlane32_swap(__float_as_uint(l_reg),__float_as_uint(l_reg),false,false);l_reg=__uint_as_float(rr[0])+__uint_as_float(rr[1]);}
  if(hi==0)wsf[32+r32]=l_reg;asm volatile("s_waitcnt lgkmcnt(0)":::"memory");
  float rli[16];
  #pragma unroll
  for(int r=0;r<16;++r)rli[r]=__builtin_amdgcn_rcpf(wsf[32+crow(r,hi)]);
  bf16*Ow=O+qrow0*QP+h*D;
  { bf16*stg=(bf16*)(shm+LDS_OST)+wid*2048;
    #pragma unroll
    for(int r=0;r<16;++r){const int orow=crow(r,hi);
      #pragma unroll
      for(int d0=0;d0<2;++d0)stg[orow*64+d0*32+r32]=__float2bfloat16(o[d0][r]*rli[r]);}
    asm volatile("s_waitcnt lgkmcnt(0)":::"memory");
    #pragma unroll
    for(int i=0;i<4;++i){const int row=i*8+(lane>>3),ch=lane&7; const u32x4 v=*(const u32x4*)(stg+row*64+ch*8); ATTN_STORE16(Ow+(long)row*QP+ch*8,v);} }
  asm volatile("s_waitcnt lgkmcnt(0)\n\ts_barrier":::"memory");
  #undef DMA_K
  #undef DMA_V
  #undef CMASK
  #undef START
  #undef RESC
  #undef ROT
}
constexpr int ATTN_LDS_BYTES=LDS_BYTES;
struct AttnTensors { const bf16* Q; const bf16* K; const bf16* V; bf16* O; };
struct AttnUnit { int b; int h; int qb; };
struct StaticOrder {
  int vcu;
  __device__ __forceinline__ explicit StaticOrder(int v):vcu(v){}
  __device__ __forceinline__ bool next(int i,AttnUnit&u)const{ if(i>=8)return false; const int xcd=vcu>>5,lc=vcu&31; const int grp=xcd*4+(i>>1); const int idx=(i&1)*32+lc;
    u.b=grp>>1; u.h=(grp&1)*4+(idx>>4); u.qb=idx&15; return true; }
};
struct StaticOrderR {
  int vcu,i0,i1;
  __device__ __forceinline__ StaticOrderR(int v,int a,int b):vcu(v),i0(a),i1(b){}
  __device__ __forceinline__ bool next(int j,AttnUnit&u)const{ const int i=i0+j; if(i>=i1)return false; const int xcd=vcu>>5,lc=vcu&31; const int grp=xcd*4+(i>>1); const int idx=(i&1)*32+lc;
    u.b=grp>>1; u.h=(grp&1)*4+(idx>>4); u.qb=idx&15; return true; }
};
template<class Sched,int THRL=8> __device__ __forceinline__ void attn_phase(char*lds,const AttnTensors&T,const Sched&S,int wave_){
  AttnUnit u;
  for(int i=0;S.next(i,u);++i){ attn_unit<THRL>(u.b,u.h,u.qb,T.Q,T.K,T.V,T.O,lds,wave_); }
}
#undef SBAR
#undef WAIT_BAR
}
#define XB_TMO      128
#define XB_XCNT(j)  (256  + 64 * (j))
#define XB_XSUB(j)  (1280 + 64 * (j))
#define XB_XGEN(j)  (2304 + 64 * (j))
#define XB_TOP      3328
#define XB_TOPGEN   3392
#define XCD_BAR_WORDS 3456
#define XB_SPIN_CAP (1u << 18)

__device__ __forceinline__ unsigned xb_ld(unsigned* p)              { return __hip_atomic_load(p, __ATOMIC_RELAXED, __HIP_MEMORY_SCOPE_AGENT); }
__device__ __forceinline__ unsigned xb_add(unsigned* p, unsigned v) { return __hip_atomic_fetch_add(p, v, __ATOMIC_RELAXED, __HIP_MEMORY_SCOPE_AGENT); }
__device__ __forceinline__ unsigned xb_xcc_id() { return (unsigned)__builtin_amdgcn_s_getreg((3 << 11) | 20) & 0xFu; }
#define XB_SPIN(cond, bar) do { unsigned _sp = 0; while (cond) { __builtin_amdgcn_s_sleep(1); \
    if ((++_sp & 255u) == 0u) { if (xb_ld(&(bar)[XB_TMO])) break; if (_sp > XB_SPIN_CAP) { atomicAdd(&(bar)[XB_TMO], 1u); break; } } } } while (0)

struct XcdBarrier {
    unsigned wv; unsigned* bar; unsigned x;
    volatile LAS unsigned* st;
};

__device__ __forceinline__ XcdBarrier xcd_barrier_post(unsigned* bar, volatile LAS unsigned* st) {
    XcdBarrier b; b.bar = bar; b.x = xb_xcc_id(); b.st = st;
    if (threadIdx.x == 0) (void)xb_add(&bar[XB_XCNT(b.x)], 1u);
    b.wv = (unsigned)__builtin_amdgcn_readfirstlane((int)(threadIdx.x >> 6));
    return b;
}
__device__ __forceinline__ void xcd_barrier_complete(unsigned* bar, unsigned x, unsigned& nloc, unsigned& nx) {
    const unsigned G = gridDim.x * gridDim.y * gridDim.z;
    unsigned sum, cnt, mine, sp = 0u;
    for (;;) {
        sum = 0u; cnt = 0u; mine = 0u;
#pragma unroll
        for (unsigned j = 0; j < 16; ++j) { const unsigned c = xb_ld(&bar[XB_XCNT(j)]); sum += c; cnt += (c > 0u) ? 1u : 0u; mine = (j == x) ? c : mine; }
        if (sum == G) break;
        __builtin_amdgcn_s_sleep(1);
        if ((++sp & 255u) == 0u) { if (xb_ld(&bar[XB_TMO])) break; if (sp > XB_SPIN_CAP) { atomicAdd(&bar[XB_TMO], 1u); break; } }
    }
    nloc = mine > 0u ? mine : 1u; nx = cnt > 0u ? cnt : 1u;
}

__device__ __forceinline__ void xcd_barrier(const XcdBarrier& b) {
    asm volatile("s_waitcnt vmcnt(0)" ::: "memory");
    __syncthreads();
    if (b.wv == 0u && lane_id() == 0) {
        unsigned* bar = b.bar;
        __builtin_amdgcn_s_waitcnt(0);
        unsigned nloc = b.st[0], nx = b.st[1];
        if (nloc == 0u) { xcd_barrier_complete(bar, b.x, nloc, nx); b.st[0] = nloc; b.st[1] = nx; }
        const unsigned old = xb_add(&bar[XB_XSUB(b.x)], 1u);
        const unsigned gen = old / nloc;
        if (old + 1u == (gen + 1u) * nloc) {
            __builtin_amdgcn_fence(__ATOMIC_RELEASE, "agent");
            asm volatile("s_waitcnt vmcnt(0)" ::: "memory");
            const unsigned og = xb_add(&bar[XB_TOP], 1u);
            const unsigned tg = og / nx;
            if (og + 1u == (tg + 1u) * nx) xb_add(&bar[XB_TOPGEN], 1u);
            else XB_SPIN(xb_ld(&bar[XB_TOPGEN]) == tg, bar);
            __builtin_amdgcn_fence(__ATOMIC_ACQUIRE, "agent");
            xb_add(&bar[XB_XGEN(b.x)], 1u);
            asm volatile("s_waitcnt vmcnt(0)" ::: "memory");
        } else {
            XB_SPIN(xb_ld(&bar[XB_XGEN(b.x)]) == gen, bar);
            __builtin_amdgcn_fence(__ATOMIC_ACQUIRE, "agent");
            asm volatile("s_waitcnt vmcnt(0)" ::: "memory");
        }
    }
    __syncthreads();
}


typedef GAS unsigned gu32;
#define RLX_AGENT __ATOMIC_RELAXED, __HIP_MEMORY_SCOPE_AGENT
#define LDS_WAIT() asm volatile("s_waitcnt lgkmcnt(0)" ::: "memory")
#define VM_WAIT() asm volatile("s_waitcnt vmcnt(0)" ::: "memory")
constexpr int N_IN = 34;
enum { I_X = 0, I_C, I_CTX, I_CCTX, I_MODW, I_MODB, I_NORM1, I_WIN, I_QNW, I_KNW, I_CONVW, I_CONVB, I_FW1, I_FB1, I_FW2, I_FB2, I_FW3, I_FB3, I_FW4, I_FFREQ,
       I_HBIAS, I_AONW, I_HONW, I_WOUT, I_NORM2, I_RW, I_RB, I_EG, I_EU, I_ED, I_SG, I_SU, I_SD, I_FNW };
struct Frame {
    LAS unsigned char* lds;
    volatile LAS unsigned* MISC;
    unsigned* ctl;
    int tid, lane, wave, vcu, G;
    float* out; unsigned char* ws;
};
typedef const __attribute__((address_space(4))) char* kargp_t;
__device__ __forceinline__ const float* kin(int i) { kargp_t p = (kargp_t)__builtin_amdgcn_kernarg_segment_ptr(); asm volatile("" : "+s"(p)); return (const float*)*(const GAS float* const __attribute__((address_space(4)))*)(p + 8 * i); }
#define WSP(T, off) ((T*)(F.ws + (off)))

__device__ __forceinline__ void tr_item(const float* W, int ldw, int k0, int n0, bf16_t* WT, int Kd, int drow0, LAS float* scr, int lane) {
#pragma unroll 8
    for (int i = 0; i < 32; ++i) { const int kk = 2 * i + (lane >> 5); scr[kk * 33 + (lane & 31)] = W[(size_t)(k0 + kk) * ldw + n0 + (lane & 31)]; }
    LDS_WAIT(); asm volatile("" ::: "memory");
    const int c = lane & 7;
#pragma unroll
    for (int j = 0; j < 4; ++j) { const int n = (lane >> 3) + 8 * j; const LAS float* s = scr + (8 * c) * 33 + n;
        u32x4 o; o.x = pk2(s[0 * 33], s[1 * 33]); o.y = pk2(s[2 * 33], s[3 * 33]); o.z = pk2(s[4 * 33], s[5 * 33]); o.w = pk2(s[6 * 33], s[7 * 33]);
        *(u32x4*)(WT + (size_t)(drow0 + n) * Kd + k0 + 8 * c) = o; }
    LDS_WAIT(); asm volatile("" ::: "memory");
}
__device__ __forceinline__ unsigned pk4_fp8(float a, float b, float c, float d) { int w = __builtin_amdgcn_cvt_pk_fp8_f32(a, b, 0, false); w = __builtin_amdgcn_cvt_pk_fp8_f32(c, d, w, true); return (unsigned)w; }
__device__ __forceinline__ void tr_item8(const float* W, int ldw, int k0, int n0, unsigned char* WT, int Kd, int drow0, float scl, LAS float* scr, int lane) {
#pragma unroll 8
    for (int i = 0; i < 32; ++i) { const int kk = 2 * i + (lane >> 5); scr[kk * 33 + (lane & 31)] = W[(size_t)(k0 + kk) * ldw + n0 + (lane & 31)]; }
    LDS_WAIT(); asm volatile("" ::: "memory");
    const int c = lane & 7;
#pragma unroll
    for (int j = 0; j < 4; ++j) { const int n = (lane >> 3) + 8 * j; const LAS float* s = scr + (8 * c) * 33 + n;
        u32x2 o; o.x = pk4_fp8(s[0 * 33] * scl, s[1 * 33] * scl, s[2 * 33] * scl, s[3 * 33] * scl); o.y = pk4_fp8(s[4 * 33] * scl, s[5 * 33] * scl, s[6 * 33] * scl, s[7 * 33] * scl);
        *(u32x2*)(WT + (size_t)(drow0 + n) * Kd + k0 + 8 * c) = o; }
    LDS_WAIT(); asm volatile("" ::: "memory");
}
constexpr int IT_FILT = 2048, IT_MODV = 0, IT_ROPE = 1, IT_QKV = 384, IT_WU = 768, IT_WO = 512, IT_WR = 128, IT_SGU = 256, IT_SD = 128, IT_EXP = 256 * 384;
constexpr int IT_TILES = IT_QKV + IT_WU + IT_WO + IT_WR + IT_SGU + IT_SD;
constexpr int XP_TILES = 256 * 48;

template <int NT_> __device__ __forceinline__ void p0_filter_item(Frame& F, int item, LAS float* hsc) {
    const int lane = F.lane; const int t0 = NT_ * item;
    const float* w1 = kin(I_FW1); const float* b1 = kin(I_FB1); const float* w2 = kin(I_FW2); const float* b2 = kin(I_FB2);
    const float* w3 = kin(I_FW3); const float* b3 = kin(I_FB3); const float* w4 = kin(I_FW4); const float fr = kin(I_FFREQ)[lane];
    float h[NT_], a[NT_];
#pragma unroll
    for (int tt = 0; tt < NT_; ++tt) { const int t = t0 + tt; float v = 0.f;
        if (lane == 0) v = (float)t * (1.0f / 4095.0f);
        else if (lane < 33) { const int m = (lane - 1) & 15; const float f = 1e-4f + (float)m * ((15.0f - 1e-4f) / 15.0f);
            float rev = f * ((float)t * (1.0f / 4096.0f)); rev -= floorf(rev); const float ang = 6.283185307179586f * rev;
            v = lane <= 16 ? cosf(ang) : -sinf(ang); }
        h[tt] = v; }
#pragma unroll
    for (int l = 0; l < 3; ++l) { const float* ww = l == 0 ? w1 : l == 1 ? w2 : w3; const float bb = (l == 0 ? b1 : l == 1 ? b2 : b3)[lane];
        float wc[64];
#pragma unroll
        for (int i = 0; i < 64; ++i) wc[i] = (l == 0 && i >= 33) ? 0.f : ww[i * 64 + lane];
#pragma unroll
        for (int tt = 0; tt < NT_; ++tt) a[tt] = bb;
#pragma unroll
        for (int i = 0; i < 64; ++i) { if (l == 0 && i >= 33) break;
#pragma unroll
            for (int tt = 0; tt < NT_; ++tt) a[tt] += __shfl(h[tt], i) * wc[i]; }
#pragma unroll
        for (int tt = 0; tt < NT_; ++tt) h[tt] = sinf(fr * a[tt]); }
#pragma unroll
    for (int tt = 0; tt < NT_; ++tt) hsc[tt * 64 + lane] = h[tt];
    LDS_WAIT(); asm volatile("" ::: "memory");
    bf16_t* KR = WSP(bf16_t, WS_KR);
    const float dmin = logf(1e-2f) / 0.3f, dmax = logf(1e-2f) / 1.5f;
#pragma unroll 1
    for (int q = 0; q < 16; ++q) {
        const int n = lane + 64 * q; float wc[64];
#pragma unroll
        for (int i = 0; i < 64; ++i) wc[i] = w4[i * 1024 + n];
        float o[NT_];
#pragma unroll
        for (int tt = 0; tt < NT_; ++tt) o[tt] = 0.f;
#pragma unroll
        for (int i4 = 0; i4 < 16; ++i4)
#pragma unroll
            for (int tt = 0; tt < NT_; ++tt) { const f32x4 hv = *(const LAS f32x4*)(hsc + tt * 64 + 4 * i4);
                o[tt] += (hv[0] * wc[4 * i4] + hv[1] * wc[4 * i4 + 1]) + (hv[2] * wc[4 * i4 + 2] + hv[3] * wc[4 * i4 + 3]); }
        const int c = n & 511; const bool bwd = n >= 512;
        const float delta = fabsf(dmin + (float)c * ((dmax - dmin) / 511.0f));
#pragma unroll
        for (int tt = 0; tt < NT_; ++tt) { const int t = t0 + tt; const float tl = (float)t * (1.0f / 4095.0f);
            const float val = o[tt] * expf(-tl * delta);
            if (!(bwd && t == 0)) {
#if HYENA_FP8
                ((unsigned char*)KR)[(size_t)c * 8192 + (bwd ? 4096 + t : 4096 - t)] = (unsigned char)(pk4_fp8c(val * 64.0f, 0.f, 0.f, 0.f) & 0xffu);
#else
                KR[(size_t)c * 8192 + (bwd ? 4096 + t : 4096 - t)] = (bf16_t)f2bf(val);
#endif
            } }
    }
}
__device__ __forceinline__ void p0_modv_block(Frame& F, int chunk) {
    const int lane = F.lane, kc = F.wave; const int n0 = 64 * chunk, k0 = 128 * kc;
    LAS float* sv = (LAS float*)(F.lds + RING_OFF + F.wave * 8704);
    LAS float* part = (LAS float*)(F.lds + RING_OFF + 8 * 8704);
    for (int r = 0; r < 17; ++r)
#pragma unroll
        for (int hh = 0; hh < 2; ++hh) { const int kk = lane + 64 * hh; const float v = r < 16 ? kin(I_C)[r * 1024 + k0 + kk] : kin(I_CCTX)[k0 + kk];
            sv[r * 128 + kk] = v / (1.0f + expf(-v)); }
    LDS_WAIT(); asm volatile("" ::: "memory");
    float acc[17];
#pragma unroll
    for (int r = 0; r < 17; ++r) acc[r] = 0.f;
    const float* W = kin(I_MODW) + (size_t)k0 * 6144 + n0 + lane;
    for (int k4 = 0; k4 < 32; ++k4) {
        const float w0 = W[(size_t)(4 * k4 + 0) * 6144], w1 = W[(size_t)(4 * k4 + 1) * 6144], w2 = W[(size_t)(4 * k4 + 2) * 6144], w3 = W[(size_t)(4 * k4 + 3) * 6144];
#pragma unroll
        for (int r = 0; r < 17; ++r) { const f32x4 s = *(const LAS f32x4*)(sv + r * 128 + 4 * k4); acc[r] += (s[0] * w0 + s[1] * w1) + (s[2] * w2 + s[3] * w3); }
    }
#pragma unroll
    for (int r = 0; r < 17; ++r) part[(kc * 17 + r) * 64 + lane] = acc[r];
    __syncthreads();
    if (F.wave == 0) { float* mv = WSP(float, WS_MODV); const float bb = kin(I_MODB)[n0 + lane];
#pragma unroll
        for (int r = 0; r < 17; ++r) { float s = bb;
#pragma unroll
            for (int k = 0; k < 8; ++k) s += part[(k * 17 + r) * 64 + lane];
            mv[r * 6144 + n0 + lane] = s; } }
    __syncthreads();
}
struct XpT { const float* src; unsigned char* dst; int ldw, Kd, which; };
__device__ __forceinline__ XpT xp_params(Frame& F, int ti) {
    XpT p; const int e = ti / 48, q = ti % 48;
    if (q < 32) { const int which = q >> 4, kb = q & 15; p.src = kin(which ? I_EU : I_EG) + (size_t)e * (1024 * 256) + (size_t)(64 * kb) * 256; p.ldw = 256;
        p.dst = WSP(unsigned char, WS_WGU) + (size_t)e * (512 * 1024) + 64 * kb; p.Kd = 1024; p.which = which; }
    else { const int r = q - 32, kb = r & 3, cb = r >> 2; p.src = kin(I_ED) + (size_t)e * (256 * 1024) + (size_t)(64 * kb) * 1024 + 256 * cb; p.ldw = 1024;
        p.dst = WSP(unsigned char, WS_WD) + (size_t)e * (1024 * 256) + (size_t)(256 * cb) * 256 + 64 * kb; p.Kd = 256; p.which = -1; }
    return p;
}
__device__ __forceinline__ void xp_load(const XpT& p, f32x4 (&v)[8], int tid) {
#pragma unroll
    for (int i = 0; i < 8; ++i) { const int g = tid + 512 * i; v[i] = *(const f32x4*)(p.src + (size_t)(g >> 6) * p.ldw + 4 * (g & 63)); }
}
__device__ __forceinline__ void xp_tiles(Frame& F, int quota) {
    constexpr int PK = 65, PLANE = 64 * PK + 2, BUF = 4 * PLANE;
    LAS float* L0 = (LAS float*)(F.lds + RING_OFF);
    const int tid = F.tid;
    volatile LAS int* qw = (volatile LAS int*)(F.MISC + 16);
    if (tid == 0) {
#pragma unroll
        for (int k = 0; k < 5; ++k) qw[k] = (int)__hip_atomic_fetch_add(F.ctl + CW_TILEQ, 1u, RLX_AGENT); }
    LDS_WAIT(); __syncthreads();
    int t0 = qw[0], t1 = qw[1], t2 = qw[2], t3 = qw[3], t4 = qw[4], par = 0, ng = 5;
    __syncthreads();
    f32x4 v0[8], v1[8], v2[8], v3[8];
    if (t0 < XP_TILES) { const XpT p = xp_params(F, t0); xp_load(p, v0, tid); }
    if (t1 < XP_TILES) { const XpT p = xp_params(F, t1); xp_load(p, v1, tid); }
    if (t2 < XP_TILES) { const XpT p = xp_params(F, t2); xp_load(p, v2, tid); }
    if (t3 < XP_TILES) { const XpT p = xp_params(F, t3); xp_load(p, v3, tid); }
#define XP_STEP(V) { if (t0 >= XP_TILES) break; \
        if (tid == 0) qw[6 + par] = (t4 < XP_TILES && ng < quota) ? (int)__hip_atomic_fetch_add(F.ctl + CW_TILEQ, 1u, RLX_AGENT) : XP_TILES;     \
        ++ng; \
        LAS float* buf = L0 + par * BUF; \
        _Pragma("unroll") for (int i = 0; i < 8; ++i) { const int g = tid + 512 * i; LAS float* d = buf + (g >> 6) * PK + (g & 63); \
            d[0] = V[i][0]; d[PLANE] = V[i][1]; d[2 * PLANE] = V[i][2]; d[3 * PLANE] = V[i][3]; } \
        if (t4 < XP_TILES) { const XpT p = xp_params(F, t4); xp_load(p, V, tid); } \
        LDS_WAIT(); __syncthreads(); \
        const int t5 = qw[6 + par]; \
        const XpT pa = xp_params(F, t0); \
        _Pragma("unroll") for (int i = 0; i < 4; ++i) { const int pr = tid + 512 * i; const int kc = pr & 7, n = pr >> 3; \
            const LAS float* s_ = buf + (n & 3) * PLANE + (8 * kc) * PK + (n >> 2); \
            u32x2 o; o.x = pk4_fp8(s_[0] * 32.f, s_[PK] * 32.f, s_[2 * PK] * 32.f, s_[3 * PK] * 32.f); o.y = pk4_fp8(s_[4 * PK] * 32.f, s_[5 * PK] * 32.f, s_[6 * PK] * 32.f, s_[7 * PK] * 32.f); \
            const int row = pa.which < 0 ? n : 256 * (n >> 7) + 128 * pa.which + (n & 127); \
            *(u32x2*)(pa.dst + (size_t)row * pa.Kd + 8 * kc) = o; } \
        t0 = t1; t1 = t2; t2 = t3; t3 = t4; t4 = t5; par ^= 1; }
    for (;;) { XP_STEP(v0) XP_STEP(v1) XP_STEP(v2) XP_STEP(v3) }
#undef XP_STEP
    LDS_WAIT(); __syncthreads();
}
__device__ __forceinline__ void p0_prologue(Frame& F) {
    LAS float* scr = (LAS float*)(F.lds + RING_OFF + F.wave * 16384);
    const int gw = F.vcu * NWAVES + F.wave, NGW = F.G * NWAVES; const int lane = F.lane;
    __syncthreads();
    for (int ch = F.vcu; ch < 96; ch += F.G) p0_modv_block(F, ch);
    for (int it = gw; it < IT_FILT; it += NGW) { p0_filter_item<2>(F, it, scr); LDS_WAIT(); }
    if (gw == NGW - 1) { f32x2* rope = WSP(f32x2, WS_ROPE);
        for (int idx = lane; idx < 1024; idx += 64) { const int pos = idx >> 4, f = idx & 15; const float inv = powf(10000.0f, -(float)f / 16.0f); const float ang = (float)pos * inv;
            rope[idx] = (f32x2){cosf(ang), sinf(ang)}; } }
    for (int it = gw; it < IT_TILES; it += NGW) {
        int r = it;
        if (r < IT_QKV) { const int cb = r >> 4, kb = r & 15, n0 = 32 * cb; const int pn = n0 >> 8, hl = (n0 & 255) >> 6, dh = (n0 & 63) >> 5;
            tr_item(kin(I_WIN), 2304, 64 * kb, n0, WSP(bf16_t, WS_WQKV), 1024, 256 * pn + 128 * dh + 32 * hl, scr, lane); continue; } r -= IT_QKV;
        if (r < IT_WU) { const int cb = r >> 4, kb = r & 15; tr_item8(kin(I_WIN), 2304, 64 * kb, 768 + 32 * cb, WSP(unsigned char, WS_WU), 1024, 32 * cb, 32.0f, scr, lane); continue; } r -= IT_WU;
        if (r < IT_WO) { const int cb = r >> 4, kb = r & 15; tr_item(kin(I_WOUT), 1024, 64 * kb, 32 * cb, WSP(bf16_t, WS_WO), 1024, 32 * cb, scr, lane); continue; } r -= IT_WO;
        if (r < IT_WR) { const int cb = r >> 4, kb = r & 15; tr_item(kin(I_RW), 256, 64 * kb, 32 * cb, WSP(bf16_t, WS_WR), 1024, 32 * cb, scr, lane); continue; } r -= IT_WR;
        if (r < IT_SGU) { const int which = r >> 7, rr = r & 127, cb = rr >> 4, kb = rr & 15, j0 = 32 * cb;
            tr_item8(kin(which ? I_SU : I_SG), 256, 64 * kb, j0, WSP(unsigned char, WS_WSGU8), 1024, 256 * (j0 >> 7) + 128 * which + (j0 & 127), 32.0f, scr, lane); continue; } r -= IT_SGU;
        if (r < IT_SD) { const int kb = r & 3, cb = r >> 2; tr_item8(kin(I_SD), 1024, 64 * kb, 32 * cb, WSP(unsigned char, WS_WSD), 256, 32 * cb, 32.0f, scr, lane); continue; } r -= IT_SD;
    }
    __syncthreads();
}

template <int NR, bool F8, bool SRC16 = false> __device__ __forceinline__ void modulate_group(Frame& F, const float* src, bf16_t* dst, unsigned char* dst8, int row, const f32x4 (&A)[4], const f32x4 (&Bv)[4]) {
    const f32x4* xr = (const f32x4*)(src + (size_t)row * DM) + F.lane;
    f32x4 v[NR][4]; float ss[NR];
    if (SRC16) {
        u32x2 raw[NR][4];
#pragma unroll
        for (int q = 0; q < NR; ++q)
#pragma unroll
            for (int j = 0; j < 4; ++j) raw[q][j] = ((const u32x2*)(src + (size_t)(row + q) * DM))[F.lane + 64 * j];
#pragma unroll
        for (int q = 0; q < NR; ++q)
#pragma unroll
            for (int j = 0; j < 4; ++j) v[q][j] = (f32x4){__uint_as_float(raw[q][j].x << 16), __uint_as_float(raw[q][j].x & 0xffff0000u), __uint_as_float(raw[q][j].y << 16), __uint_as_float(raw[q][j].y & 0xffff0000u)};
    } else {
#pragma unroll
    for (int q = 0; q < NR; ++q)
#pragma unroll
        for (int j = 0; j < 4; ++j) v[q][j] = xr[q * (DM / 4) + 64 * j];
    }
#pragma unroll
    for (int q = 0; q < NR; ++q) { float a = 0.f;
#pragma unroll
        for (int j = 0; j < 4; ++j) a += (v[q][j][0] * v[q][j][0] + v[q][j][1] * v[q][j][1]) + (v[q][j][2] * v[q][j][2] + v[q][j][3] * v[q][j][3]);
        ss[q] = a; }
#pragma unroll
    for (int o = 1; o < 64; o <<= 1) {
#pragma unroll
        for (int q = 0; q < NR; ++q) ss[q] += __shfl_xor(ss[q], o); }
#pragma unroll
    for (int q = 0; q < NR; ++q) { const float rs = rsqrtf(ss[q] * (1.0f / DM) + EPS);
        u32x2* o8 = (u32x2*)(dst + (size_t)(row + q) * DM) + F.lane;
#pragma unroll
        for (int j = 0; j < 4; ++j) { const f32x4 o = v[q][j] * rs * A[j] + Bv[j]; u32x2 w; w.x = pk2(o[0], o[1]); w.y = pk2(o[2], o[3]); o8[64 * j] = w;
            if (F8) ((unsigned*)(dst8 + (size_t)(row + q) * DM))[F.lane + 64 * j] = pk4_fp8c(o[0] * 8.0f, o[1] * 8.0f, o[2] * 8.0f, o[3] * 8.0f); } }
}
template <bool F8 = false, bool SRC16 = false> __device__ __forceinline__ void modulate_rows(Frame& F, const float* src, bf16_t* dst, int row0, int nrows, const float* nw, const float* sc, const float* sh, unsigned char* dst8 = nullptr) {
    f32x4 A[4], Bv[4];
#pragma unroll
    for (int j = 0; j < 4; ++j) { const int c = 4 * F.lane + 256 * j; const f32x4 n4 = *(const f32x4*)(nw + c), s4 = *(const f32x4*)(sc + c); A[j] = n4 * (s4 + 1.0f); Bv[j] = *(const f32x4*)(sh + c); }
    int r = 0;
    for (; r + 4 <= nrows; r += 4) modulate_group<4, F8, SRC16>(F, src, dst, dst8, row0 + r, A, Bv);
    if (r + 2 <= nrows) modulate_group<2, F8, SRC16>(F, src, dst, dst8, row0 + r, A, Bv);
}

constexpr unsigned HY_SK_PACKED = 0xCB885410u;
__device__ __forceinline__ void hyena_unit(Frame& F, int c) {
    const int tid = F.tid, lane = F.lane, wid = F.wave;
    LAS unsigned char* Lc = F.lds + RING_OFF;
    const bf16_t* UT = WSP(const bf16_t, WS_UT);
    bf16_t* Wg = WSP(bf16_t, WS_HYW) + (size_t)c * MTOK;
    bf16_t* Xg = WSP(bf16_t, WS_HYX) + (size_t)c * MTOK;
    {
        const u32x4* src = (const u32x4*)(WSP(const bf16_t, WS_KR) + (size_t)c * 8192);
#pragma unroll
        for (int i = 0; i < 2; ++i) { const int jc = tid + 512 * i; const u32x4 lo = src[jc]; const u32x4 hi = jc < 1023 ? src[jc + 1] : (u32x4){0u, 0u, 0u, 0u};
            const unsigned w[8] = {lo.x, lo.y, lo.z, lo.w, hi.x, hi.y, hi.z, hi.w};
#pragma unroll
            for (int cc = 0; cc < 8; ++cc) { u32x4 o;
#pragma unroll
                for (int k = 0; k < 4; ++k) { const int idx = (cc >> 1) + k; o[k] = (cc & 1) ? __builtin_amdgcn_alignbyte(w[idx + 1], w[idx], 2u) : w[idx]; }
                *(LAS u32x4*)(Lc + cc * 16384 + 16 * ((HY_SK_PACKED >> (4 * cc)) & 15u) + 16 * jc) = o; } }
    }
    const float* cw = kin(I_CONVW); const float* cb = kin(I_CONVB);
    {
        const bf16_t* vrow = UT + (size_t)(1024 + c) * MTOK; const bf16_t* x1row = UT + (size_t)(512 + c) * MTOK; const bf16_t* x0row = UT + (size_t)c * MTOK;
        const float v0 = cw[1024 + c], v1 = cw[1536 + 1024 + c], v2 = cw[3072 + 1024 + c], vb = cb[1024 + c];
        const float a0 = cw[512 + c], a1 = cw[1536 + 512 + c], a2 = cw[3072 + 512 + c], ab = cb[512 + c];
        const float g0 = cw[c], g1 = cw[1536 + c], g2 = cw[3072 + c], gb = cb[c];
        const int s0 = tid * 8;
#pragma unroll 4
        for (int it = 0; it < 16; ++it) {
            const size_t base = (size_t)it * SEQ + s0;
            const u32x4 vv = *(const u32x4*)(vrow + base), xx = *(const u32x4*)(x1row + base), gg = *(const u32x4*)(x0row + base);
            float ve[10], xe[10], ge[10];
            ve[0] = s0 > 0 ? bf2f(vrow[base - 1]) : 0.f; xe[0] = s0 > 0 ? bf2f(x1row[base - 1]) : 0.f; ge[0] = s0 > 0 ? bf2f(x0row[base - 1]) : 0.f;
            ve[9] = s0 + 8 < SEQ ? bf2f(vrow[base + 8]) : 0.f; xe[9] = s0 + 8 < SEQ ? bf2f(x1row[base + 8]) : 0.f; ge[9] = s0 + 8 < SEQ ? bf2f(x0row[base + 8]) : 0.f;
#pragma unroll
            for (int j = 0; j < 4; ++j) { ve[1 + 2 * j] = bf2f(vv[j] & 0xffffu); ve[2 + 2 * j] = bf2f(vv[j] >> 16); xe[1 + 2 * j] = bf2f(xx[j] & 0xffffu); xe[2 + 2 * j] = bf2f(xx[j] >> 16);
                ge[1 + 2 * j] = bf2f(gg[j] & 0xffffu); ge[2 + 2 * j] = bf2f(gg[j] >> 16); }
            float w[8], g[8];
#pragma unroll
            for (int j = 0; j < 8; ++j) { w[j] = (v0 * ve[j] + v1 * ve[j + 1] + v2 * ve[j + 2] + vb) * (a0 * xe[j] + a1 * xe[j + 1] + a2 * xe[j + 2] + ab); g[j] = g0 * ge[j] + g1 * ge[j + 1] + g2 * ge[j + 2] + gb; }
            u32x4 o; o.x = pk2(w[0], w[1]); o.y = pk2(w[2], w[3]); o.z = pk2(w[4], w[5]); o.w = pk2(w[6], w[7]);
            *(u32x4*)(Wg + (size_t)(tid * 16 + it) * 8) = o;
            u32x4 p; p.x = pk2(g[0], g[1]); p.y = pk2(g[2], g[3]); p.z = pk2(g[4], g[5]); p.w = pk2(g[6], g[7]);
            *(u32x4*)(Xg + base) = p;
        }
    }
    VM_WAIT(); __syncthreads();
    const float hb = kin(I_HBIAS)[c];
    bf16_t* yrow = WSP(bf16_t, WS_YT) + (size_t)c * MTOK;
    const int li = lane & 15, lg = lane >> 4;
#pragma unroll 1
    for (int pass = 0; pass < 2; ++pass) {
        const int T0 = (pass * 8 + wid) * 256;
        f32x4 acc[16]; bf16x8 AF[16], Bf[8];
#pragma unroll
        for (int q = 0; q < 16; ++q) acc[q] = (f32x4){0.f, 0.f, 0.f, 0.f};
        const int xbase = 4096 - T0 - li + 8 * lg; const int cl = xbase & 7;
        const LAS unsigned char* pA = Lc + cl * 16384 + 16 * (int)((HY_SK_PACKED >> (4 * cl)) & 15u) + 2 * (xbase - cl);
        const bf16x8* Bg = (const bf16x8*)Wg + lg * 16 + li;
#define HY_LOADA(dst, q) dst = *(const LAS bf16x8*)(pA - 32 * (q))
#pragma unroll
        for (int q = 0; q < 16; ++q) HY_LOADA(AF[q], q);
#pragma unroll
        for (int v = 0; v < 8; ++v) Bf[v] = Bg[64 * v];
#pragma unroll 1
        for (int S8 = 0; S8 < 128; S8 += 8) {
#pragma unroll
            for (int v = 0; v < 8; ++v) { const int S = S8 + v;
#pragma unroll
                for (int tau = 15; tau >= 0; --tau) acc[tau] = __builtin_amdgcn_mfma_f32_16x16x32_bf16(AF[(tau - 2 * v) & 15], Bf[v], acc[tau], 0, 0, 0);
                if (S + 8 < 128) Bf[v] = Bg[64 * (S + 8)];
                if (S + 1 < 128) { HY_LOADA(AF[(-2 * (v + 1)) & 15], -2 * (S + 1)); HY_LOADA(AF[(-2 * (v + 1) + 1) & 15], -2 * (S + 1) + 1); }
            }
        }
#undef HY_LOADA
        u32x2 wv[16], xv[16];
#pragma unroll
        for (int tau = 0; tau < 16; ++tau) { const int t = T0 + 16 * tau + 4 * lg;
            wv[tau] = *(const u32x2*)(Wg + (size_t)((t >> 3) * 16 + li) * 8 + (t & 7)); xv[tau] = *(const u32x2*)(Xg + (size_t)li * SEQ + t); }
#pragma unroll
        for (int tau = 0; tau < 16; ++tau) { const int t = T0 + 16 * tau + 4 * lg;
            const float we[4] = {bf2f(wv[tau].x & 0xffffu), bf2f(wv[tau].x >> 16), bf2f(wv[tau].y & 0xffffu), bf2f(wv[tau].y >> 16)};
            const float xe[4] = {bf2f(xv[tau].x & 0xffffu), bf2f(xv[tau].x >> 16), bf2f(xv[tau].y & 0xffffu), bf2f(xv[tau].y >> 16)};
            float z[4];
#pragma unroll
            for (int j = 0; j < 4; ++j) z[j] = (acc[tau][j] + hb * we[j]) * xe[j];
            u32x2 o; o.x = pk2(z[0], z[1]); o.y = pk2(z[2], z[3]); *(u32x2*)(yrow + (size_t)li * SEQ + t) = o; }
    }
    __syncthreads();
}

constexpr unsigned long long HY8_SK = 0xea6eda965212d950ull; constexpr int HY8_STR = 8448;
__device__ __forceinline__ void hyena_unit8(Frame& F, int c) {
    int tid_ = F.tid; asm volatile("" : "+v"(tid_));
    const int tid = tid_, lane = tid & 63, wid = F.wave;
    LAS unsigned char* Lc = F.lds + RING_OFF;
    const bf16_t* UT = WSP(const bf16_t, WS_UT);
    unsigned char* W8 = WSP(unsigned char, WS_HYW) + (size_t)c * MTOK;
    bf16_t* Xg = WSP(bf16_t, WS_HYX) + (size_t)c * MTOK;
    {
        const u32x4* src = (const u32x4*)(WSP(const unsigned char, WS_KR) + (size_t)c * 8192);
        const u32x4 lo = src[tid]; const u32x4 hi = tid < 511 ? src[tid + 1] : (u32x4){0u, 0u, 0u, 0u};
        const unsigned w[8] = {lo.x, lo.y, lo.z, lo.w, hi.x, hi.y, hi.z, hi.w};
#pragma unroll
        for (int sh = 0; sh < 16; ++sh) { u32x4 o;
#pragma unroll
            for (int k = 0; k < 4; ++k) { const int idx = (sh >> 2) + k; o[k] = (sh & 3) ? __builtin_amdgcn_alignbyte(w[idx + 1], w[idx], (unsigned)(sh & 3)) : w[idx]; }
            *(LAS u32x4*)(Lc + sh * HY8_STR + 16 * (int)((HY8_SK >> (4 * sh)) & 15ull) + 16 * tid) = o; }
    }
    const float* cw = kin(I_CONVW); const float* cb = kin(I_CONVB);
    {
        const bf16_t* vrow = UT + (size_t)(1024 + c) * MTOK; const bf16_t* x1row = UT + (size_t)(512 + c) * MTOK; const bf16_t* x0row = UT + (size_t)c * MTOK;
        const float v0 = cw[1024 + c], v1 = cw[1536 + 1024 + c], v2 = cw[3072 + 1024 + c], vb = cb[1024 + c];
        const float a0 = cw[512 + c], a1 = cw[1536 + 512 + c], a2 = cw[3072 + 512 + c], ab = cb[512 + c];
        const float g0 = cw[c], g1 = cw[1536 + c], g2 = cw[3072 + c], gb = cb[c];
        const int s0 = tid * 8;
#pragma unroll 4
        for (int it = 0; it < 16; ++it) {
            const size_t base = (size_t)it * SEQ + s0;
            const u32x4 vv = *(const u32x4*)(vrow + base), xx = *(const u32x4*)(x1row + base), gg = *(const u32x4*)(x0row + base);
            float ve[10], xe[10], ge[10];
            ve[0] = s0 > 0 ? bf2f(vrow[base - 1]) : 0.f; xe[0] = s0 > 0 ? bf2f(x1row[base - 1]) : 0.f; ge[0] = s0 > 0 ? bf2f(x0row[base - 1]) : 0.f;
            ve[9] = s0 + 8 < SEQ ? bf2f(vrow[base + 8]) : 0.f; xe[9] = s0 + 8 < SEQ ? bf2f(x1row[base + 8]) : 0.f; ge[9] = s0 + 8 < SEQ ? bf2f(x0row[base + 8]) : 0.f;
#pragma unroll
            for (int j = 0; j < 4; ++j) { ve[1 + 2 * j] = bf2f(vv[j] & 0xffffu); ve[2 + 2 * j] = bf2f(vv[j] >> 16); xe[1 + 2 * j] = bf2f(xx[j] & 0xffffu); xe[2 + 2 * j] = bf2f(xx[j] >> 16);
                ge[1 + 2 * j] = bf2f(gg[j] & 0xffffu); ge[2 + 2 * j] = bf2f(gg[j] >> 16); }
            float w[8], g[8];
#pragma unroll
            for (int j = 0; j < 8; ++j) { w[j] = 8.0f * (v0 * ve[j] + v1 * ve[j + 1] + v2 * ve[j + 2] + vb) * (a0 * xe[j] + a1 * xe[j + 1] + a2 * xe[j + 2] + ab); g[j] = g0 * ge[j] + g1 * ge[j + 1] + g2 * ge[j + 2] + gb; }
            u32x2 o; o.x = pk4_fp8c(w[0], w[1], w[2], w[3]); o.y = pk4_fp8c(w[4], w[5], w[6], w[7]);
            *(u32x2*)(W8 + (size_t)((tid >> 2) * 16 + it) * 32 + (tid & 3) * 8) = o;
            u32x4 p; p.x = pk2(g[0], g[1]); p.y = pk2(g[2], g[3]); p.z = pk2(g[4], g[5]); p.w = pk2(g[6], g[7]);
            *(u32x4*)(Xg + base) = p;
        }
    }
    VM_WAIT(); __syncthreads();
    const float hb = kin(I_HBIAS)[c];
    bf16_t* yrow = WSP(bf16_t, WS_YT) + (size_t)c * MTOK;
    const int li = lane & 15, lg = lane >> 4;
#pragma unroll 1
    for (int pass = 0; pass < 2; ++pass) {
        const int T0 = (pass * 8 + wid) * 256;
        f32x4 acc[16]; pg8::v8i AF[16], Bf[2];
#pragma unroll
        for (int q = 0; q < 16; ++q) { acc[q] = (f32x4){0.f, 0.f, 0.f, 0.f}; asm volatile("" : "+v"(acc[q])); }
        const int x00 = 4096 - T0 - li + 32 * lg; const int cl = x00 & 15;
        const LAS unsigned char* pA = Lc + cl * HY8_STR + 16 * (int)((HY8_SK >> (4 * cl)) & 15ull) + (x00 - cl);
        const u32x4* Bg = (const u32x4*)W8 + (lg * 16 + li) * 2;
#define HY8_LOADA(dst, q) do { const LAS unsigned char* p_ = pA - 16 * (q); dst = pg8::cat8(*(const LAS bf16x8*)p_, *(const LAS bf16x8*)(p_ + 16)); } while (0)
#define HY8_LOADB(dst, S_) do { const u32x4 b0_ = Bg[128 * (S_)], b1_ = Bg[128 * (S_) + 1]; dst = pg8::cat8(__builtin_bit_cast(bf16x8, b0_), __builtin_bit_cast(bf16x8, b1_)); } while (0)
#pragma unroll
        for (int q = 0; q < 16; ++q) HY8_LOADA(AF[q], q);
#pragma unroll
        for (int v = 0; v < 2; ++v) HY8_LOADB(Bf[v], v);
#pragma unroll 1
        for (int S4 = 0; S4 < 32; S4 += 2) {
#pragma unroll
            for (int v = 0; v < 2; ++v) { const int S = S4 + v; const int p = v & 1;
                asm volatile("s_waitcnt lgkmcnt(0)\n\ts_nop 4" ::: "memory");
#pragma unroll
                for (int tau = 15; tau >= 0; --tau) pg8::mfma_fp8(acc[tau], AF[(tau - 8 * p) & 15], Bf[v]);
                if (S + 2 < 32) HY8_LOADB(Bf[v], S + 2);
                if (S + 1 < 32) {
#pragma unroll
                    for (int i = 0; i < 8; ++i) HY8_LOADA(AF[(i + 8 * (1 - p)) & 15], i - 8 * (S + 1)); }
            }
            asm volatile("s_nop 15\n\ts_nop 7" : "+v"(acc[0]), "+v"(acc[1]), "+v"(acc[2]), "+v"(acc[3]), "+v"(acc[4]), "+v"(acc[5]), "+v"(acc[6]), "+v"(acc[7]),
                         "+v"(acc[8]), "+v"(acc[9]), "+v"(acc[10]), "+v"(acc[11]), "+v"(acc[12]), "+v"(acc[13]), "+v"(acc[14]), "+v"(acc[15]));
        }
#undef HY8_LOADA
#undef HY8_LOADB
        asm volatile("s_nop 15\n\ts_nop 15" : "+v"(acc[0]), "+v"(acc[1]), "+v"(acc[2]), "+v"(acc[3]), "+v"(acc[4]), "+v"(acc[5]), "+v"(acc[6]), "+v"(acc[7]),
                     "+v"(acc[8]), "+v"(acc[9]), "+v"(acc[10]), "+v"(acc[11]), "+v"(acc[12]), "+v"(acc[13]), "+v"(acc[14]), "+v"(acc[15]) :: "memory");
        unsigned wv[16]; u32x2 xv[16];
#pragma unroll
        for (int tau = 0; tau < 16; ++tau) { const int t = T0 + 16 * tau + 4 * lg;
            wv[tau] = *(const unsigned*)(W8 + (size_t)((t >> 5) * 16 + li) * 32 + (t & 31)); xv[tau] = *(const u32x2*)(Xg + (size_t)li * SEQ + t); }
#pragma unroll
        for (int tau = 0; tau < 16; ++tau) { const int t = T0 + 16 * tau + 4 * lg;
            const f32x2 wlo = __builtin_amdgcn_cvt_pk_f32_fp8((int)wv[tau], false), whi = __builtin_amdgcn_cvt_pk_f32_fp8((int)wv[tau], true);
            const float we[4] = {wlo[0] * 0.125f, wlo[1] * 0.125f, whi[0] * 0.125f, whi[1] * 0.125f};
            const float xe[4] = {bf2f(xv[tau].x & 0xffffu), bf2f(xv[tau].x >> 16), bf2f(xv[tau].y & 0xffffu), bf2f(xv[tau].y >> 16)};
            float z[4];
#pragma unroll
            for (int j = 0; j < 4; ++j) z[j] = (acc[tau][j] * (1.0f / 512.0f) + hb * we[j]) * xe[j];
            u32x2 o; o.x = pk2(z[0], z[1]); o.y = pk2(z[2], z[3]); *(u32x2*)(yrow + (size_t)li * SEQ + t) = o; }
    }
    __syncthreads();
}

__device__ __forceinline__ void p4_norm_tile(Frame& F, int it) {
    const int lane = F.lane, wid = F.wave, tid = F.tid; const int m0 = it * 64;
    bf16_t* AY = WSP(bf16_t, WS_AY); const bf16_t* A = WSP(const bf16_t, WS_AO); const bf16_t* YT = WSP(const bf16_t, WS_YT);
    constexpr int TP = 520;
    LAS bf16_t* T2 = (LAS bf16_t*)(F.lds + RING_OFF);
    {
        const u32x4* src = (const u32x4*)(YT + (size_t)tid * MTOK + m0);
#pragma unroll
        for (int i = 0; i < 8; ++i) { const u32x4 v = src[i];
#pragma unroll
            for (int j = 0; j < 4; ++j) { T2[(8 * i + 2 * j) * TP + tid] = (bf16_t)(v[j] & 0xffffu); T2[(8 * i + 2 * j + 1) * TP + tid] = (bf16_t)(v[j] >> 16); } }
    }
#define P4_ROWS8(LOADV, GAIN, DSTCOL) do { const float* gw_ = (GAIN) + 8 * lane; const f32x4 g0 = *(const f32x4*)gw_, g1 = *(const f32x4*)(gw_ + 4); \
        u32x4 v_[8]; float ss_[8]; \
        _Pragma("unroll") for (int r = 0; r < 8; ++r) v_[r] = LOADV(r); \
        _Pragma("unroll") for (int r = 0; r < 8; ++r) { float a_ = 0.f; _Pragma("unroll") for (int j = 0; j < 4; ++j) { const float lo_ = bf2f(v_[r][j] & 0xffffu), hi_ = bf2f(v_[r][j] >> 16); a_ += lo_ * lo_ + hi_ * hi_; } ss_[r] = a_; } \
        _Pragma("unroll") for (int o = 1; o < 64; o <<= 1) { _Pragma("unroll") for (int r = 0; r < 8; ++r) ss_[r] += __shfl_xor(ss_[r], o); } \
        _Pragma("unroll") for (int r = 0; r < 8; ++r) { const float rs = rsqrtf(ss_[r] * (1.0f / 512.0f) + EPS); float e[8]; \
            _Pragma("unroll") for (int j = 0; j < 4; ++j) { e[2 * j] = bf2f(v_[r][j] & 0xffffu); e[2 * j + 1] = bf2f(v_[r][j] >> 16); } \
            u32x4 o; o.x = pk2(e[0] * rs * g0[0], e[1] * rs * g0[1]); o.y = pk2(e[2] * rs * g0[2], e[3] * rs * g0[3]); o.z = pk2(e[4] * rs * g1[0], e[5] * rs * g1[1]); o.w = pk2(e[6] * rs * g1[2], e[7] * rs * g1[3]); \
            *(u32x4*)(AY + (size_t)(m0 + wid * 8 + r) * DM + (DSTCOL) + 8 * lane) = o; } } while (0)
#define P4_LOAD_A(r) (*(const u32x4*)(A + (size_t)(m0 + wid * 8 + (r)) * AW + 8 * lane))
#define P4_LOAD_T(r) (*(const LAS u32x4*)(T2 + (wid * 8 + (r)) * TP + 8 * lane))
    P4_ROWS8(P4_LOAD_A, kin(I_AONW), 0);
    __syncthreads();
    P4_ROWS8(P4_LOAD_T, kin(I_HONW), 512);
#undef P4_ROWS8
#undef P4_LOAD_A
#undef P4_LOAD_T
    __syncthreads();
}


#define DPPF(x, ctrl) __builtin_bit_cast(float, __builtin_amdgcn_mov_dpp(__builtin_bit_cast(int, (x)), (ctrl), 0xf, 0xf, true))
#define DPPI(x, ctrl) __builtin_amdgcn_mov_dpp((x), (ctrl), 0xf, 0xf, true)
struct RouteSel { int ea, eb; unsigned wa, wb, la, lb; };
__device__ __forceinline__ void p8_route16(Frame& F, int t0, RouteSel& R, LAS unsigned* lcnt) {
    const int lane = F.lane; const int j = lane & 3; const int t = t0 + (lane >> 2);
    const f32x4* lg = (const f32x4*)(WSP(const float, WS_LOGIT) + (size_t)t * NE + 64 * j);
    const f32x4* rbp = (const f32x4*)(kin(I_RB) + 64 * j);
    float b[64];
#pragma unroll
    for (int i = 0; i < 16; ++i) { const f32x4 v = lg[i], rb = rbp[i];
#pragma unroll
        for (int c = 0; c < 4; ++c) b[4 * i + c] = __builtin_amdgcn_rcpf(1.0f + __builtin_amdgcn_exp2f(-1.4426950408889634f * v[c])) + rb[c]; }
    float gsc[2];
#pragma unroll
    for (int g = 0; g < 2; ++g) { float a1 = fmaxf(b[32 * g], b[32 * g + 1]), a2 = fminf(b[32 * g], b[32 * g + 1]);
#pragma unroll
        for (int i = 2; i < 32; ++i) { const float x = b[32 * g + i]; a2 = fmaxf(a2, fminf(a1, x)); a1 = fmaxf(a1, x); }
        gsc[g] = a1 + a2; }
    float G[8];
    G[0] = DPPF(gsc[0], 0x00); G[1] = DPPF(gsc[1], 0x00); G[2] = DPPF(gsc[0], 0x55); G[3] = DPPF(gsc[1], 0x55);
    G[4] = DPPF(gsc[0], 0xAA); G[5] = DPPF(gsc[1], 0xAA); G[6] = DPPF(gsc[0], 0xFF); G[7] = DPPF(gsc[1], 0xFF);
#pragma unroll
    for (int g = 0; g < 2; ++g) { const int gid = 2 * j + g; int rank = 0;
#pragma unroll
        for (int h = 0; h < 8; ++h) rank += (G[h] > gsc[g] || (G[h] == gsc[g] && h < gid)) ? 1 : 0;
        if (rank >= 4) {
#pragma unroll
            for (int i = 0; i < 32; ++i) b[32 * g + i] = -INFINITY; } }
    unsigned key[64];
#pragma unroll
    for (int i = 0; i < 64; ++i) key[i] = b[i] == -INFINITY ? 0u : ((__builtin_bit_cast(unsigned, b[i] + 2.0f) & ~63u) | (unsigned)(63 - i));
    float lv[8]; int li[8];
#pragma unroll
    for (int r = 0; r < 8; ++r) { unsigned mx = key[0];
#pragma unroll
        for (int i = 1; i < 64; i += 2) { const unsigned a_ = key[i], b_ = i + 1 < 64 ? key[i + 1] : 0u; const unsigned m_ = a_ > b_ ? a_ : b_; mx = mx > m_ ? mx : m_; }
        lv[r] = mx ? __builtin_bit_cast(float, mx & ~63u) - 2.0f : -INFINITY; li[r] = mx ? 64 * j + 63 - (int)(mx & 63u) : 0x7ffffff0 + j;
#pragma unroll
        for (int i = 0; i < 64; ++i) key[i] = key[i] == mx ? 0u : key[i]; }
    int se[8]; float sv[8];
#pragma unroll
    for (int r = 0; r < 8; ++r) { float hv = lv[0]; int hi = li[0];
        { const float ov = DPPF(hv, 0xB1); const int oi = DPPI(hi, 0xB1); if (ov > hv || (ov == hv && oi < hi)) { hv = ov; hi = oi; } }
        { const float ov = DPPF(hv, 0x4E); const int oi = DPPI(hi, 0x4E); if (ov > hv || (ov == hv && oi < hi)) { hv = ov; hi = oi; } }
        se[r] = hi; sv[r] = hv;
        if (hi == li[0]) {
#pragma unroll
            for (int k = 0; k < 7; ++k) { lv[k] = lv[k + 1]; li[k] = li[k + 1]; }
            lv[7] = -INFINITY; li[7] = 0x7fffffff; } }
    const float* rbias = kin(I_RB); float wsum = 0.f;
#pragma unroll
    for (int r = 0; r < 8; ++r) { sv[r] -= rbias[se[r]]; wsum += sv[r]; }
    const float inv = 2.5f / wsum;
    const int ea = j == 0 ? se[0] : j == 1 ? se[2] : j == 2 ? se[4] : se[6], eb = j == 0 ? se[1] : j == 1 ? se[3] : j == 2 ? se[5] : se[7];
    const float wa = (j == 0 ? sv[0] : j == 1 ? sv[2] : j == 2 ? sv[4] : sv[6]) * inv, wb = (j == 0 ? sv[1] : j == 1 ? sv[3] : j == 2 ? sv[5] : sv[7]) * inv;
    R.ea = ea; R.eb = eb; R.wa = f2bf(wa); R.wb = f2bf(wb);
    R.la = __hip_atomic_fetch_add(lcnt + ea, 1u, __ATOMIC_RELAXED, __HIP_MEMORY_SCOPE_WORKGROUP); R.lb = __hip_atomic_fetch_add(lcnt + eb, 1u, __ATOMIC_RELAXED, __HIP_MEMORY_SCOPE_WORKGROUP);
}
__device__ __forceinline__ void route_commit(Frame& F, int t0, const RouteSel& R, const LAS unsigned* lbase) {
    const int lane = F.lane; const int j = lane & 3; const int t = t0 + (lane >> 2);
    unsigned* list = WSP(unsigned, WS_LIST); unsigned* asg = WSP(unsigned, WS_ASSIGN) + (size_t)t * 8 + 2 * j;
    const unsigned ra = lbase[R.ea] + R.la, rb2 = lbase[R.eb] + R.lb;
    list[(size_t)R.ea * 65536 + ra] = ((unsigned)t << 16) | R.wa; list[(size_t)R.eb * 65536 + rb2] = ((unsigned)t << 16) | R.wb;
    asg[0] = ((unsigned)R.ea << 16) | ra; asg[1] = ((unsigned)R.eb << 16) | rb2;
    if (j == 0) list[(size_t)256 * 65536 + t] = ((unsigned)t << 16) | 0x3F80u;
}
#undef DPPF
#undef DPPI

__device__ __forceinline__ MoeTab moe_tables(Frame& F) {
    LAS int* tp = (LAS int*)(F.lds + AUX_OFF + AUX_TP); LAS int* cnt = (LAS int*)(F.lds + AUX_OFF + AUX_CNT); LAS unsigned short* t2e = (LAS unsigned short*)(F.lds + AUX_OFF + AUX_T2E);
    __syncthreads();
    if (F.tid < 257) cnt[F.tid] = F.tid < 256 ? (int)__hip_atomic_load(F.ctl + CW_CNT + 32 * F.tid, RLX_AGENT) : MTOK;
    __syncthreads();
    if (F.tid < 258) { int run = 0; for (int j = 0; j < F.tid && j < 257; ++j) run += (cnt[j] + 255) >> 8; tp[F.tid] = run; }
    __syncthreads();
    if (F.tid < 257) { const int t0 = tp[F.tid], t1 = tp[F.tid + 1]; for (int T = t0; T < t1; ++T) t2e[T] = (unsigned short)F.tid; }
    __syncthreads();
    MoeTab t; t.tp = tp; t.cnt = cnt; t.t2e = t2e; return t;
}

__device__ __forceinline__ void down_phase(Frame& F, const MoeTab& tab) {
    using namespace pg8;
    int tid_ = F.wave * 64 + lane_id(); asm volatile("" : "+v"(tid_));
    const int tid = tid_, wid = F.wave, lane = tid & 63, wq = wid, fr = lane & 15, fq = lane >> 4;
    LAS unsigned char* lds = F.lds + RING_OFF;
    const unsigned char* ACT = WSP(const unsigned char, WS_ACT); const unsigned char* WD = WSP(const unsigned char, WS_WD); const unsigned char* WSD = WSP(const unsigned char, WS_WSD);
    unsigned char* SLOT = WSP(unsigned char, WS_SLOT);
    unsigned voA[2], voB[2];
#pragma unroll
    for (int i = 0; i < 2; ++i) { int R, C; stage_rc(tid * 16 + i * 8192, R, C); const int rho = R & 63, ii = rho & 15, nn = rho >> 4; const int Rb = (R & ~63) + 16 * (ii >> 2) + 4 * nn + (ii & 3);
        voA[i] = (unsigned)(R * 256 + C * 2); voB[i] = (unsigned)(Rb * 256 + C * 2); }
    const unsigned ldsw = (unsigned)wid * 1024u;
#define DN_STAGE(buf, gptr, vo) do { _Pragma("unroll") for (int _i = 0; _i < 2; ++_i) \
        __builtin_amdgcn_global_load_lds((const unsigned*)((gptr) + (vo)[_i]), (LAS unsigned*)(lds + (buf) * HTB + ldsw + _i * 8192), 16, 0, 0); } while (0)
    const int arow = (wq & 3) * 32 + fr;
    const int aoff = lds_byte(arow, fq * 8), boff = lds_byte(fr, fq * 8);
    const int TT = __builtin_amdgcn_readfirstlane(tab.tp[257]);
#define DN_STAGE_A(Ag_) do { _Pragma("unroll") for (int ai = 0; ai < 2; ++ai) _Pragma("unroll") for (int kt = 0; kt < 2; ++kt) DN_STAGE(ai * 2 + kt, (Ag_) + (size_t)ai * (128 * 256) + kt * 128, voA); } while (0)
#define DN_STAGE_B(slot, Bg_, c_) do { _Pragma("unroll") for (int kt = 0; kt < 2; ++kt) DN_STAGE(4 + 2 * (slot) + kt, (Bg_) + (size_t)(c_) * (128 * 256) + kt * 128, voB); } while (0)
    int T = F.vcu;
    const unsigned char* Bg = WD;
    if (T < TT) { const int e0 = __builtin_amdgcn_readfirstlane((int)tab.t2e[T]); Bg = e0 < 256 ? WD + (size_t)e0 * (1024 * 256) : WSD;
        DN_STAGE_A(ACT + (size_t)T * (256 * 256)); DN_STAGE_B(0, Bg, 0); }
    for (; T < TT; T += F.G) {
        const int Tn = T + F.G; const bool hn = Tn < TT;
        const unsigned char* Bn = WD;
        if (hn) { const int en = __builtin_amdgcn_readfirstlane((int)tab.t2e[Tn]); Bn = en < 256 ? WD + (size_t)en * (1024 * 256) : WSD; }
        asm volatile("s_waitcnt vmcnt(0)" ::: "memory"); __builtin_amdgcn_s_barrier(); asm volatile("" ::: "memory");
        v8i Af[2][2];
#pragma unroll
        for (int m = 0; m < 2; ++m)
#pragma unroll
            for (int kt = 0; kt < 2; ++kt) { const LAS unsigned char* p = lds + ((wq >> 2) * 2 + kt) * HTB + aoff + m * 2048;
                Af[m][kt] = cat8(*(const LAS bf16x8*)p, *(const LAS bf16x8*)(p + 1024)); }
        asm volatile("s_waitcnt lgkmcnt(0)" ::: "memory");
#pragma unroll 1
        for (int c = 0; c < 8; ++c) {
            const int sb = c & 1;
            if (c > 0) { if (c == 3 && hn) asm volatile("s_waitcnt vmcnt(12)" ::: "memory"); else asm volatile("s_waitcnt vmcnt(4)" ::: "memory"); }
            __builtin_amdgcn_s_barrier(); asm volatile("" ::: "memory");
            if (c < 7) DN_STAGE_B(sb ^ 1, Bg, c + 1); else if (hn) DN_STAGE_B(0, Bn, 0);
            if (c == 2 && hn) DN_STAGE_A(ACT + (size_t)Tn * (256 * 256));
            f32x4 acc[2][8];
#pragma unroll
            for (int m = 0; m < 2; ++m)
#pragma unroll
                for (int n = 0; n < 8; ++n) { acc[m][n] = (f32x4){0.f, 0.f, 0.f, 0.f}; asm volatile("" : "+v"(acc[m][n])); }
#pragma unroll
            for (int g = 0; g < 2; ++g) {
                v8i Bf[4][2];
#pragma unroll
                for (int n = 0; n < 4; ++n)
#pragma unroll
                    for (int kt = 0; kt < 2; ++kt) { const LAS unsigned char* p = lds + (4 + 2 * sb + kt) * HTB + boff + (4 * g + n) * 2048;
                        Bf[n][kt] = cat8(*(const LAS bf16x8*)p, *(const LAS bf16x8*)(p + 1024)); }
                asm volatile("s_waitcnt lgkmcnt(0)\n\ts_nop 4" ::: "memory");
#pragma unroll
                for (int kt = 0; kt < 2; ++kt)
#pragma unroll
                    for (int m = 0; m < 2; ++m)
#pragma unroll
                        for (int n = 0; n < 4; ++n) mfma_fp8(acc[m][4 * g + n], Bf[n][kt], Af[m][kt]);
            }
            asm volatile("s_nop 15\n\ts_nop 15" : "+v"(acc[0][0]), "+v"(acc[0][1]), "+v"(acc[0][2]), "+v"(acc[0][3]), "+v"(acc[0][4]), "+v"(acc[0][5]), "+v"(acc[0][6]), "+v"(acc[0][7]),
                         "+v"(acc[1][0]), "+v"(acc[1][1]), "+v"(acc[1][2]), "+v"(acc[1][3]), "+v"(acc[1][4]), "+v"(acc[1][5]), "+v"(acc[1][6]), "+v"(acc[1][7]) :: "memory");
            unsigned char* orow = SLOT + (size_t)(T * 256 + (wq >> 2) * 128 + (wq & 3) * 32 + fr) * DM + c * 128 + 16 * fq;
#pragma unroll
            for (int m = 0; m < 2; ++m)
#pragma unroll
                for (int g = 0; g < 2; ++g) { u32x4 pk;
#pragma unroll
                    for (int n = 0; n < 4; ++n) { const f32x4 a = acc[m][4 * g + n] * 0.125f; pk[n] = pk4_fp8c(a[0], a[1], a[2], a[3]); }
                    *(u32x4*)(orow + (size_t)(16 * m) * DM + 64 * g) = pk; }
        }
        Bg = Bn;
    }
    asm volatile("s_waitcnt vmcnt(0) lgkmcnt(0)" ::: "memory"); __builtin_amdgcn_s_barrier(); asm volatile("" ::: "memory");
#undef DN_STAGE_A
#undef DN_STAGE_B
#undef DN_STAGE
}

__device__ __forceinline__ void combine_token(Frame& F, const MoeTab& tab, int t0) {
    const int lane = F.lane; const int b = t0 >> 12;
    const unsigned* asg = WSP(const unsigned, WS_ASSIGN) + (size_t)t0 * 8; const unsigned char* SLOT = WSP(const unsigned char, WS_SLOT);
    const size_t Rs = (size_t)tab.tp[256] * 256;
    u32x4 sv[2][9];
#pragma unroll
    for (int q = 0; q < 2; ++q) {
#pragma unroll
        for (int k = 0; k < 8; ++k) { const unsigned av = asg[q * 8 + k]; const int e = av >> 16, rk = av & 0xffffu; const size_t R = (size_t)tab.tp[e] * 256 + rk;
            sv[q][k] = *(const u32x4*)(SLOT + R * DM + 16 * lane); }
        sv[q][8] = *(const u32x4*)(SLOT + (Rs + t0 + q) * DM + 16 * lane); }
    const float* g2 = WSP(const float, WS_MODV) + (size_t)b * 6144 + 5 * 1024 + 16 * lane; const float* fw = kin(I_FNW) + 16 * lane;
    f32x4 x[2][4]; float ss[2];
#pragma unroll
    for (int q = 0; q < 2; ++q) {
#if X1_BF16
        const u32x4* xr = (const u32x4*)((const bf16_t*)(F.out + (size_t)(t0 + q) * DM) + 16 * lane); const u32x4 r0 = xr[0], r1 = xr[1];
        const unsigned w[8] = {r0.x, r0.y, r0.z, r0.w, r1.x, r1.y, r1.z, r1.w};
#pragma unroll
        for (int j = 0; j < 4; ++j) x[q][j] = (f32x4){__uint_as_float(w[2 * j] << 16), __uint_as_float(w[2 * j] & 0xffff0000u), __uint_as_float(w[2 * j + 1] << 16), __uint_as_float(w[2 * j + 1] & 0xffff0000u)};
#else
        const float* xr = F.out + (size_t)(t0 + q) * DM + 16 * lane;
#pragma unroll
        for (int j = 0; j < 4; ++j) x[q][j] = *(const f32x4*)(xr + 4 * j);
#endif
    }
#pragma unroll
    for (int q = 0; q < 2; ++q) { float a[16];
#pragma unroll
        for (int j = 0; j < 16; ++j) a[j] = 0.f;
#pragma unroll
        for (int k = 0; k < 9; ++k)
#pragma unroll
            for (int j = 0; j < 4; ++j) { const f32x2 lo = __builtin_amdgcn_cvt_pk_f32_fp8((int)sv[q][k][j], false), hi = __builtin_amdgcn_cvt_pk_f32_fp8((int)sv[q][k][j], true);
                a[4 * j] += lo[0]; a[4 * j + 1] += lo[1]; a[4 * j + 2] += hi[0]; a[4 * j + 3] += hi[1]; }
        ss[q] = 0.f;
#pragma unroll
        for (int j = 0; j < 4; ++j) { const f32x4 g = *(const f32x4*)(g2 + 4 * j) * (1.0f / 16.0f);
            x[q][j] = x[q][j] + g * (f32x4){a[4 * j], a[4 * j + 1], a[4 * j + 2], a[4 * j + 3]};
            ss[q] += (x[q][j][0] * x[q][j][0] + x[q][j][1] * x[q][j][1]) + (x[q][j][2] * x[q][j][2] + x[q][j][3] * x[q][j][3]); } }
#pragma unroll
    for (int o = 1; o < 64; o <<= 1) { ss[0] += __shfl_xor(ss[0], o); ss[1] += __shfl_xor(ss[1], o); }
#pragma unroll
    for (int q = 0; q < 2; ++q) { const float rs = rsqrtf(ss[q] * (1.0f / DM) + EPS); float* orow = F.out + (size_t)(t0 + q) * DM + 16 * lane;
#pragma unroll
        for (int j = 0; j < 4; ++j) *(f32x4*)(orow + 4 * j) = x[q][j] * rs * *(const f32x4*)(fw + 4 * j); }
}

constexpr int N_LAUNCHES = MK_N_LAUNCHES;
static_assert(N_LAUNCHES == 1 || N_LAUNCHES == NPHASE, "MK_N_LAUNCHES must be 1 or 14");
struct Args { const float* in[N_IN]; float* out; unsigned char* ws; int ph_lo, ph_hi; };
__global__ void __launch_bounds__(NWAVES * 64, 2) fwd_kernel(Args args) {
    extern __shared__ __attribute__((aligned(16))) unsigned char lds[];
    Frame F;
    F.lds = (LAS unsigned char*)lds;
    F.MISC = (volatile LAS unsigned*)(F.lds + MISC_OFF);
    F.tid = threadIdx.x; F.lane = F.tid & 63; F.wave = __builtin_amdgcn_readfirstlane(F.tid >> 6);
    F.G = gridDim.x; { const int bx = blockIdx.x; F.vcu = (F.G % 8 == 0) ? (bx % 8) * (F.G / 8) + bx / 8 : bx; }
    F.out = args.out; F.ws = args.ws; F.ctl = (unsigned*)(args.ws + WS_CTL);
    if (F.tid < 128) ((LAS unsigned*)(F.lds + MISC_OFF))[F.tid] = 0u;
    __syncthreads();
    XcdBarrier bar; bar.wv = (unsigned)F.wave; bar.bar = F.ctl + CW_BAR; bar.x = 0; bar.st = nullptr;
    if (N_LAUNCHES == 1) bar = xcd_barrier_post(F.ctl + CW_BAR, F.MISC + 8);
#define GRID_BAR() do { if (N_LAUNCHES == 1) xcd_barrier(bar); } while (0)
    const int lo = args.ph_lo, hi = args.ph_hi;
#ifndef PHASE_MASK
#define PHASE_MASK 0x3fff
#endif
#define IN(k) ((((PHASE_MASK) >> (k)) & 1) && lo <= (k) && (k) < hi)
#ifndef PHASE_DUP
#define PHASE_DUP 0
#endif
#define REPS(k) ((((PHASE_DUP) >> (k)) & 1) ? 2 : 1)
#ifndef PROBE_K
#define PROBE_K (-1)
#endif
#ifndef PROBE_AMP
#define PROBE_AMP 8
#endif
    unsigned long long tA_ = 0, tB_ = 0;
#define STAMP(j) do { if (PROBE_K >= 0 && (j) == PROBE_K) tA_ = __builtin_amdgcn_s_memrealtime(); if (PROBE_K >= 0 && (j) == PROBE_K + 1) tB_ = __builtin_amdgcn_s_memrealtime(); } while (0)
#define SEAM(k) do { if (IN(k) && IN((k) + 1)) GRID_BAR(); STAMP((k) + 1); } while (0)
#define PHASE_ENTER() do { int t_ = F.wave * 64 + lane_id(); asm volatile("" : "+v"(t_)); F.tid = t_; F.lane = t_ & 63; GAS unsigned char* w_ = (GAS unsigned char*)args.ws; GAS float* o_ = (GAS float*)args.out; asm volatile("" : "+s"(w_), "+s"(o_)); F.ws = (unsigned char*)w_; F.out = (float*)o_; F.ctl = (unsigned*)(F.ws + WS_CTL); } while (0)
#define PHASE_ENTER_V() do { int l_; asm volatile("v_mbcnt_lo_u32_b32 %0, -1, 0\n\tv_mbcnt_hi_u32_b32 %0, -1, %0" : "=v"(l_)); int t_ = F.wave * 64 + l_; asm volatile("" : "+v"(t_)); F.tid = t_; F.lane = t_ & 63; GAS unsigned char* w_ = (GAS unsigned char*)args.ws; GAS float* o_ = (GAS float*)args.out; asm volatile("" : "+s"(w_), "+s"(o_)); F.ws = (unsigned char*)w_; F.out = (float*)o_; F.ctl = (unsigned*)(F.ws + WS_CTL); } while (0)
    const int gw = F.vcu * NWAVES + F.wave, NGW = F.G * NWAVES;
#define modv WSP(const float, WS_MODV)
    LAS unsigned char* ring = F.lds + RING_OFF;
    LAS unsigned* idxw = (LAS unsigned*)(F.lds + AUX_OFF + AUX_IDX + F.wave * 1024);

    STAMP(0);
    if (IN(0)) for (int rep_ = 0; rep_ < REPS(0); ++rep_) { PHASE_ENTER(); p0_prologue(F); }
    SEAM(0);
    if (IN(1)) for (int rep_ = 0; rep_ < REPS(1); ++rep_) { PHASE_ENTER();
        for (int rb = gw; rb < MTOK / 32; rb += NGW) { const int row0 = rb * 32; const int b = row0 >> 12;
            modulate_rows<true>(F, kin(I_X), WSP(bf16_t, WS_H), row0, 32, kin(I_NORM1), modv + (size_t)b * 6144 + 1024, modv + (size_t)b * 6144, WSP(unsigned char, WS_H8)); }
        for (int rb = gw; rb < MCTX / 2; rb += NGW)
            modulate_rows(F, kin(I_CTX), WSP(bf16_t, WS_HC), rb * 2, 2, kin(I_NORM1), modv + (size_t)16 * 6144 + 1024, modv + (size_t)16 * 6144);
    }
    SEAM(1);
    if (IN(2)) for (int rep_ = 0; rep_ < REPS(2); ++rep_) { PHASE_ENTER();
        { SchedQKV S{WSP(const bf16_t, WS_H), (long)WS_HC - (long)WS_H, WSP(const bf16_t, WS_WQKV), F.G, F.vcu};
          EpiQKV E{WSP(bf16_t, WS_Q), WSP(bf16_t, WS_K), WSP(bf16_t, WS_V), kin(I_QNW), kin(I_KNW), WSP(const f32x2, WS_ROPE)};
          pg8::gemm_phase<EpiQKV, SchedQKV, false, true>(ring, idxw, DM, S, E, F.wave); }
        { SchedDense S{WSP(const bf16_t, WS_WU), WSP(const bf16_t, WS_H8), DM / 2, 6, MTOK / 256, F.G, F.vcu, true};
          EpiPlainBf16 E{WSP(bf16_t, WS_UT), (size_t)MTOK, 1.0f / 256.0f};
          pg8::gemm_phase<EpiPlainBf16, SchedDense, false, true, true>(ring, idxw, DM / 2, S, E, F.wave); }
    }
    SEAM(2);
    if (IN(3)) for (int rep_ = 0; rep_ < REPS(3); ++rep_) { PHASE_ENTER();
        const int xq = (XP_TILES + F.G - 1) / F.G;
        if ((F.vcu & 3) == 0) { xp_tiles(F, xq); PHASE_ENTER_V(); }
        { const attn_body::AttnTensors AT{WSP(const attn_body::bf16, WS_Q), WSP(const attn_body::bf16, WS_K), WSP(const attn_body::bf16, WS_V), WSP(attn_body::bf16, WS_AO)};
          const attn_body::StaticOrderR S(F.vcu, 0, 4);
          for (int r2_ = 0; r2_ < REPS(14); ++r2_) attn_body::attn_phase<attn_body::StaticOrderR>((char*)lds + RING_OFF, AT, S, F.wave); }
        __syncthreads(); PHASE_ENTER_V();
        if ((F.vcu & 3) == 1) { xp_tiles(F, xq); PHASE_ENTER_V(); }
        { const attn_body::AttnTensors AT{WSP(const attn_body::bf16, WS_Q), WSP(const attn_body::bf16, WS_K), WSP(const attn_body::bf16, WS_V), WSP(attn_body::bf16, WS_AO)};
          const attn_body::StaticOrderR S(F.vcu, 4, 8);
          for (int r2_ = 0; r2_ < REPS(14); ++r2_) attn_body::attn_phase<attn_body::StaticOrderR>((char*)lds + RING_OFF, AT, S, F.wave); }
        __syncthreads(); PHASE_ENTER_V();
        if ((F.vcu & 3) == 2) { xp_tiles(F, xq); PHASE_ENTER_V(); }
        for (int r2_ = 0; r2_ < REPS(15); ++r2_) for (int c = F.vcu; c < HW; c += F.G) {
#if HYENA_FP8
            hyena_unit8(F, c);
#else
            hyena_unit(F, c);
#endif
        }
        __syncthreads(); PHASE_ENTER_V();
        if ((F.vcu & 3) == 3) xp_tiles(F, 1 << 30);
    }
    SEAM(3);
    if (IN(4)) for (int rep_ = 0; rep_ < REPS(4); ++rep_) { PHASE_ENTER();
        for (int pm = F.vcu; pm < MTOK / 256; pm += F.G) {
            for (int q4 = 0; q4 < 4; ++q4) p4_norm_tile(F, pm * 4 + q4);
            VM_WAIT(); __syncthreads(); PHASE_ENTER();
            { SchedDense S{WSP(const bf16_t, WS_AY) + (size_t)pm * 256 * DM, WSP(const bf16_t, WS_WO), DM, 1, 4, 1, 0, false};
              EpiOutProj E{kin(I_X), F.out, modv, pm};
              pg8::gemm_phase<EpiOutProj, SchedDense, false, true>(ring, idxw, DM, S, E, F.wave); }
            VM_WAIT(); __syncthreads(); PHASE_ENTER();
            { const int row0 = pm * 256 + F.wave * 32; const int b = row0 >> 12;
              modulate_rows<true, X1_BF16 != 0>(F, F.out, WSP(bf16_t, WS_H), row0, 32, kin(I_NORM2), modv + (size_t)b * 6144 + 4 * 1024, modv + (size_t)b * 6144 + 3 * 1024, WSP(unsigned char, WS_H8)); }
            VM_WAIT(); __syncthreads(); PHASE_ENTER();
            { SchedDense S{WSP(const bf16_t, WS_H) + (size_t)pm * 256 * DM, WSP(const bf16_t, WS_WR), DM, 1, 1, 1, 0, false};
              EpiF32 E{WSP(float, WS_LOGIT) + (size_t)pm * 256 * NE, (size_t)NE};
              pg8::gemm_phase<EpiF32, SchedDense, false, true>(ring, idxw, DM, S, E, F.wave); }
            VM_WAIT(); __syncthreads(); PHASE_ENTER();
            {
                LAS unsigned* lcnt = (LAS unsigned*)(F.lds + AUX_OFF); LAS unsigned* lbase = lcnt + 256;
                if (F.tid < 256) lcnt[F.tid] = 0u;
                __syncthreads();
                RouteSel R0, R1;
                p8_route16(F, pm * 256 + F.wave * 32, R0, lcnt); p8_route16(F, pm * 256 + F.wave * 32 + 16, R1, lcnt);
                __syncthreads();
                if (F.tid < 256) { const unsigned c = lcnt[F.tid]; lbase[F.tid] = c ? __hip_atomic_fetch_add(F.ctl + CW_CNT + 32 * F.tid, c, RLX_AGENT) : 0u; }
                __syncthreads();
                route_commit(F, pm * 256 + F.wave * 32, R0, lbase); route_commit(F, pm * 256 + F.wave * 32 + 16, R1, lbase);
                __syncthreads();
            }
        }
    }
    SEAM(4); STAMP(6); STAMP(7); STAMP(8); STAMP(9);
    if (IN(9)) for (int rep_ = 0; rep_ < REPS(9); ++rep_) { PHASE_ENTER();
        const MoeTab tab = moe_tables(F);
        SchedGU S{WSP(const bf16_t, WS_H8), WSP(const bf16_t, WS_WGU), WSP(const bf16_t, WS_WSGU8), WSP(const unsigned, WS_LIST), tab, F.G, F.vcu};
        EpiGU E{WSP(unsigned char, WS_ACT), WSP(const unsigned, WS_LIST), tab};
        pg8::gemm_phase<EpiGU, SchedGU, true, true, true>(ring, idxw, DM / 2, S, E, F.wave);
    }
    SEAM(9);
    if (IN(10)) for (int rep_ = 0; rep_ < REPS(10); ++rep_) { PHASE_ENTER();
        const MoeTab tab = moe_tables(F);
        down_phase(F, tab);
    }
    SEAM(10);
    if (IN(11)) for (int rep_ = 0; rep_ < REPS(11); ++rep_) { PHASE_ENTER(); const MoeTab tab = moe_tables(F); for (int rb = gw; rb < MTOK / 32; rb += NGW) for (int r = 0; r < 32; r += 2) combine_token(F, tab, rb * 32 + r); }
    STAMP(12); STAMP(13); STAMP(14);
    if (PROBE_K >= 0 && blockIdx.x == 0) {
        const unsigned long long until = __builtin_amdgcn_s_memrealtime() + (unsigned long long)PROBE_AMP * (tB_ - tA_);
        while (__builtin_amdgcn_s_memrealtime() < until) __builtin_amdgcn_s_sleep(32);
    }
#undef modv
#undef PHASE_ENTER
#undef PHASE_ENTER_V
#undef IN
#undef SEAM
#undef GRID_BAR
}

extern "C" void kernel_launch(void* const* d_in, const int* in_sizes, int n_in, void* d_out, int out_size, void* d_ws, size_t ws_size, hipStream_t stream) {
    static int grid = 0;
    if (grid == 0) {
        if (n_in != N_IN || in_sizes[0] != MTOK * DM || out_size != MTOK * DM || ws_size < WS_END) {
            fprintf(stderr, "kernel_launch: unexpected problem (n_in %d, in0 %d, out %d, ws %zu < %zu); nothing launched\n", n_in, n_in > 0 ? in_sizes[0] : -1, out_size, ws_size, (size_t)WS_END); grid = -1; return; }
        int dev = 0, cus = 0, per_cu = 0;
        if (hipGetDevice(&dev) != hipSuccess || hipDeviceGetAttribute(&cus, hipDeviceAttributeMultiprocessorCount, dev) != hipSuccess) { grid = -1; return; }
        if (hipFuncSetAttribute((const void*)fwd_kernel, hipFuncAttributeMaxDynamicSharedMemorySize, LDS_BYTES) != hipSuccess) { fprintf(stderr, "kernel_launch: hipFuncSetAttribute failed\n"); grid = -1; return; }
        if (hipOccupancyMaxActiveBlocksPerMultiprocessor(&per_cu, (const void*)fwd_kernel, NWAVES * 64, LDS_BYTES) != hipSuccess || per_cu < 1)
            fprintf(stderr, "kernel_launch: note: occupancy query reports %d workgroups per CU\n", per_cu);
        (void)hipGetLastError();
        grid = cus;
    }
    if (grid < 0) return;
    if (hipMemsetAsync((char*)d_ws + WS_CTL, 0, CTL_ZERO_BYTES, stream) != hipSuccess) return;
    Args a{};
    for (int i = 0; i < N_IN; ++i) a.in[i] = (const float*)d_in[i];
    a.out = (float*)d_out; a.ws = (unsigned char*)d_ws;
    for (int li = 0; li < N_LAUNCHES; ++li) {
        a.ph_lo = (N_LAUNCHES == 1) ? 0 : li; a.ph_hi = (N_LAUNCHES == 1) ? NPHASE : li + 1;
        hipLaunchKernelGGL(fwd_kernel, dim3(grid), dim3(NWAVES * 64), LDS_BYTES, stream, a);
        const hipError_t le = hipPeekAtLastError();
        if (le != hipSuccess) { fprintf(stderr, "kernel_launch: launch %d failed: %s\n", li, hipGetErrorName(le)); break; }
    }
}
```

```cpp
#include <hip/hip_runtime.h>
#include <cstdio>
#include <cstdint>
#include <cmath>

#ifndef HYENA_FP8
#define X1_BF16 1
#define HYENA_FP8 1
#endif
#ifndef MK_N_LAUNCHES
#define MK_N_LAUNCHES 1
#endif

#define LAS __attribute__((address_space(3)))
#define GAS __attribute__((address_space(1)))
typedef unsigned short bf16_t;
typedef short bf16x8 __attribute__((ext_vector_type(8)));
typedef float f32x4 __attribute__((ext_vector_type(4)));
typedef float f32x2 __attribute__((ext_vector_type(2)));
typedef unsigned u32x4 __attribute__((ext_vector_type(4)));
typedef unsigned u32x2 __attribute__((ext_vector_type(2)));

constexpr int NB = 16, SEQ = 4096, DM = 1024, MTOK = NB * SEQ, CTXL = 256, MCTX = NB * CTXL;
constexpr int NH = 8, HD = 64, AW = 512, HW = 512, KVP = 128, KVLEN = CTXL + SEQ;
constexpr int NE = 256, TOPK = 8, FF = 256;
constexpr float EPS = 1e-6f;
constexpr int NPHASE = 14;

constexpr size_t MiB = 1u << 20;
constexpr size_t WS_CTL = 0, CTL_ZERO_BYTES = 128 * 1024;
constexpr size_t WS_MODV = 512 * 1024;
constexpr size_t WS_ROPE = 1 * MiB;
constexpr size_t WS_SS = 1 * MiB + 256 * 1024;
constexpr size_t WS_ASSIGN = 2 * MiB;
constexpr size_t WS_KR = 4 * MiB;
constexpr size_t WS_WQKV = 12 * MiB;
constexpr size_t WS_WU = 14 * MiB;
constexpr size_t WS_WO = 17 * MiB;
constexpr size_t WS_WR = 19 * MiB;
constexpr size_t WS_WSGU = 20 * MiB;
constexpr size_t WS_WSD = 21 * MiB;
constexpr size_t WS_WD = 22 * MiB;
constexpr size_t WS_ACT = 150 * MiB;
constexpr size_t WS_SLOT = 406 * MiB;
constexpr size_t WS_END = 1048 * MiB;
constexpr size_t WS_Q = 150 * MiB;
constexpr size_t WS_K = 214 * MiB;
constexpr size_t WS_V = 231 * MiB;
constexpr size_t WS_UT = 248 * MiB;
constexpr size_t WS_HC = 440 * MiB;
constexpr size_t WS_AY = 248 * MiB;
constexpr size_t WS_LOGIT = 150 * MiB;
constexpr size_t WS_WGU = 470 * MiB;
constexpr size_t WS_H8 = 598 * MiB;
constexpr size_t WS_WSGU8 = 662 * MiB;
constexpr size_t WS_H = 726 * MiB;
constexpr size_t WS_HYW = 726 * MiB;
constexpr size_t WS_HYX = 790 * MiB;
constexpr size_t WS_LIST = 854 * MiB;
constexpr size_t WS_YT = 919 * MiB;
constexpr size_t WS_AO = 983 * MiB;
static_assert(WS_LIST + (size_t)257 * 65536 * 4 <= WS_YT && WS_YT + 64 * MiB <= WS_AO && WS_AO + 64 * MiB <= WS_END, "ws map");
constexpr size_t MAXROWS_R = 524288 + 256 * 255;
static_assert(WS_SLOT + (MAXROWS_R + 65536) * 1024 <= WS_END && WS_ACT + (MAXROWS_R + 65536) * 256 <= WS_SLOT, "ws map 2");

constexpr int CW_TMO = 0, CW_CODE = 1, CW_TILEQ = 64;
constexpr int CW_BAR = 4096;
constexpr int CW_CNT = 16384;
static_assert((CW_CNT + 257 * 32) * 4 <= (int)CTL_ZERO_BYTES && (CW_BAR + 3456) * 4 <= (int)CTL_ZERO_BYTES, "control words inside the memset region");

constexpr int RING_OFF = 0, RING_BYTES = 131072;
constexpr int AUX_OFF = 131072, AUX_BYTES = 16384;
constexpr int MISC_OFF = AUX_OFF + AUX_BYTES;
constexpr int LDS_BYTES = MISC_OFF + 512;
constexpr int AUX_TP = 0, AUX_CNT = 1280, AUX_T2E = 2560, AUX_IDX = 8192;

constexpr int NWAVES = 8;
constexpr float C2 = 0.125f * 1.4426950408889634f;

__device__ __forceinline__ unsigned f2bf(float f) { unsigned u = __builtin_bit_cast(unsigned, f); return (u + 0x7fffu + ((u >> 16) & 1u)) >> 16; }
__device__ __forceinline__ unsigned pk2(float lo, float hi) { unsigned r; asm("v_cvt_pk_bf16_f32 %0, %1, %2" : "=v"(r) : "v"(lo), "v"(hi)); return r; }
__device__ __forceinline__ float bf2f(unsigned h) { return __builtin_bit_cast(float, h << 16); }
__device__ __forceinline__ unsigned cvt_pk_bf16(float lo, float hi) { unsigned r; asm volatile("v_cvt_pk_bf16_f32 %0, %1, %2" : "=v"(r) : "v"(lo), "v"(hi)); return r; }
__device__ __forceinline__ int lane_id() { return (int)__builtin_amdgcn_mbcnt_hi(~0u, __builtin_amdgcn_mbcnt_lo(~0u, 0u)); }
__device__ __forceinline__ float wave_sum(float v) {
#pragma unroll
    for (int o = 1; o < 64; o <<= 1) v += __shfl_xor(v, o);
    return v;
}

namespace pg8 {
constexpr int BM = 256, BK = 64, HALF = 128, HTB = HALF * BK * 2, STAGE_BYTES = 8 * HTB;
__host__ __device__ __forceinline__ int lds_byte(int r, int c) { const int st = (r >> 4) * 2 + (c >> 5), rr = r & 15, cc = c & 31, ob = rr * 64 + cc * 2; return st * 1024 + (ob ^ (((ob >> 9) & 1) << 5)); }
__host__ __device__ __forceinline__ void stage_rc(int b, int& R, int& C) { const int st = b / 1024, sb = b % 1024, swz = sb ^ (((sb >> 9) & 1) << 5); R = (st >> 1) * 16 + swz / 64; C = (st & 1) * 32 + (swz % 64) / 2; }
__host__ __device__ __forceinline__ int perm32(int rho) { const int n = rho >> 4, i = rho & 15; return 8 * (i >> 2) + 4 * n + (i & 3); }

struct Unit { int pm, pn, aux, aux2; };
typedef int v8i __attribute__((ext_vector_type(8)));
typedef int v4i __attribute__((ext_vector_type(4)));
__device__ __forceinline__ void mfma_fp8(f32x4& acc, v8i a, v8i b) { asm volatile("v_mfma_f32_16x16x128_f8f6f4 %0, %1, %2, %0" : "+v"(acc) : "v"(a), "v"(b)); }
__device__ __forceinline__ v8i cat8(bf16x8 lo, bf16x8 hi) { const v4i a = __builtin_bit_cast(v4i, lo), b = __builtin_bit_cast(v4i, hi); return __builtin_shufflevector(a, b, 0, 1, 2, 3, 4, 5, 6, 7); }

template <class Epi, class Sched, bool GATHER, bool ALIGN_EPI, bool FP8 = false>
__device__ __forceinline__ void gemm_phase(LAS unsigned char* lds, LAS unsigned* idxw, const int K, const Sched& S, const Epi& E, const int wave) {
    int tid_ = wave * 64 + lane_id(); asm volatile("" : "+v"(tid_));
    const int tid = tid_, wid = __builtin_amdgcn_readfirstlane(tid >> 6), lane = tid & 63, wr = wid >> 2, wc = wid & 3, fr = lane & 15, fq = lane >> 4;
    const int nt = K / BK;
    int Rr[2], Cc[2]; unsigned voffB[2];
#pragma unroll
    for (int i = 0; i < 2; ++i) { stage_rc(tid * 16 + i * 8192, Rr[i], Cc[i]); const int Rb = (Rr[i] & ~31) + perm32(Rr[i] & 31); voffB[i] = (unsigned)(Rb * K + Cc[i]) * 2u; }
    const unsigned kstep = (unsigned)(BK * 2);
    const unsigned hstep = (unsigned)HALF * (unsigned)K * 2u;
    const unsigned ldsw = (unsigned)wid * 1024u;
    const int aoff = lds_byte(wr * 64 + fr, fq * 8), boff = lds_byte(wc * 32 + fr, fq * 8);
#define PG8_SA(b, h) (((b) * 2 + (h)) * HTB)
#define PG8_SB(b, h) ((4 + (b) * 2 + (h)) * HTB)
#define PG8_STAGE_B(bufoff, gbase) do { _Pragma("unroll") for (int _i = 0; _i < 2; ++_i) \
        __builtin_amdgcn_global_load_lds((const unsigned*)((const char*)(gbase) + voffB[_i]), (LAS unsigned*)(lds + (bufoff) + ldsw + _i * 8192), 16, 0, 0); } while (0)
#define PG8_STAGE_A(bufoff, gbase, VV, h) do { _Pragma("unroll") for (int _i = 0; _i < 2; ++_i) \
        __builtin_amdgcn_global_load_lds((const unsigned*)((const char*)(gbase) + VV[h][_i]), (LAS unsigned*)(lds + (bufoff) + ldsw + _i * 8192), 16, 0, 0); } while (0)
#define PG8_LDA(dst, b, h) do { _Pragma("unroll") for (int m = 0; m < 4; ++m) _Pragma("unroll") for (int k = 0; k < 2; ++k) dst[m][k] = *(const LAS bf16x8*)(lds + PG8_SA(b, h) + aoff + m * 2048 + k * 1024); } while (0)
#define PG8_LDB(dst, b, h) do { _Pragma("unroll") for (int n = 0; n < 2; ++n) _Pragma("unroll") for (int k = 0; k < 2; ++k) dst[n][k] = *(const LAS bf16x8*)(lds + PG8_SB(b, h) + boff + n * 2048 + k * 1024); } while (0)
#define PG8_MMA(ai, bj, At, Bt) do { __builtin_amdgcn_s_setprio(1); _Pragma("unroll") for (int m = 0; m < 4; ++m) _Pragma("unroll") for (int n = 0; n < 2; ++n) { \
        if constexpr (FP8) { mfma_fp8(acc[ai][bj][m][n], cat8(Bt[n][0], Bt[n][1]), cat8(At[m][0], At[m][1])); } \
        else { _Pragma("unroll") for (int k = 0; k < 2; ++k) acc[ai][bj][m][n] = __builtin_amdgcn_mfma_f32_16x16x32_bf16(Bt[n][k], At[m][k], acc[ai][bj][m][n], 0, 0, 0); } } __builtin_amdgcn_s_setprio(0); } while (0)
#define PG8_WAIT_V(n) asm volatile("s_waitcnt vmcnt(" #n ")" ::: "memory")
#define PG8_WAIT_L(n) asm volatile("s_waitcnt lgkmcnt(" #n ")" ::: "memory")
#define PG8_BAR __builtin_amdgcn_s_barrier()
#define PG8_SCHED __builtin_amdgcn_sched_barrier(0)
    Unit cur, nxt; int ui = 0;
    if (!S.next(0, cur)) return;
    f32x4 acc[2][2][4][2];
#pragma unroll
    for (int a = 0; a < 2; ++a)
#pragma unroll
        for (int b = 0; b < 2; ++b)
#pragma unroll
            for (int m = 0; m < 4; ++m)
#pragma unroll
                for (int n = 0; n < 2; ++n) { acc[a][b][m][n] = (f32x4){0.f, 0.f, 0.f, 0.f}; if constexpr (FP8) asm volatile("" : "+v"(acc[a][b][m][n])); }
    bf16x8 At[4][2], B0[2][2], B1[2][2];
    unsigned va[2][2], vn[2][2];
    if constexpr (GATHER) {
        const unsigned* ip = S.idx_ptr(cur); const int nv = S.nvalid(cur);
#pragma unroll
        for (int h = 0; h < 2; ++h)
#pragma unroll
            for (int i = 0; i < 2; ++i) { const int r = Rr[i] + HALF * h; const unsigned e = ip[r]; const unsigned tok = r < nv ? (e >> 16) : 0u; va[h][i] = tok * (unsigned)K * 2u + (unsigned)Cc[i] * 2u; }
    } else {
#pragma unroll
        for (int h = 0; h < 2; ++h)
#pragma unroll
            for (int i = 0; i < 2; ++i) va[h][i] = (unsigned)((Rr[i] + HALF * h) * K + Cc[i]) * 2u;
    }
#pragma unroll
    for (int h = 0; h < 2; ++h)
#pragma unroll
        for (int i = 0; i < 2; ++i) vn[h][i] = va[h][i];
    const char* cA = S.a_base(cur); const char* cB = S.b_base(cur);
    PG8_STAGE_B(PG8_SB(0, 0), cB); PG8_STAGE_B(PG8_SB(0, 1), cB + hstep); PG8_STAGE_A(PG8_SA(0, 0), cA, va, 0); PG8_STAGE_A(PG8_SA(0, 1), cA, va, 1);
    if (wr == 1) PG8_BAR;
    PG8_WAIT_V(2); PG8_BAR;
    PG8_STAGE_B(PG8_SB(1, 0), cB + kstep); PG8_STAGE_A(PG8_SA(1, 0), cA + kstep, va, 0); PG8_STAGE_B(PG8_SB(1, 1), cB + hstep + kstep);
    PG8_WAIT_V(6); PG8_BAR;
    for (;;) {
        const bool has_next = S.next(ui + 1, nxt);
        const char* nA = has_next ? S.a_base(nxt) : cA; const char* nB = has_next ? S.b_base(nxt) : cB;
        int nvn = 0;
        if constexpr (GATHER) {
            if (has_next) { nvn = S.nvalid(nxt);
                __builtin_amdgcn_global_load_lds((const unsigned*)(S.idx_ptr(nxt) + lane * 4), (LAS unsigned*)idxw, 16, 0, 0); }
        }
#pragma unroll 1
        for (int t = 0; t < nt; t += 2) {
            const bool last = (t == nt - 2);
            if constexpr (GATHER) {
                if (last && has_next) {
                    asm volatile("" ::: "memory");
#pragma unroll
                    for (int h = 0; h < 2; ++h)
#pragma unroll
                        for (int i = 0; i < 2; ++i) { const int r = Rr[i] + HALF * h; const unsigned e = idxw[r]; const unsigned tok = r < nvn ? (e >> 16) : 0u; vn[h][i] = tok * (unsigned)K * 2u + (unsigned)Cc[i] * 2u; }
                }
            }
            unsigned v2[2][2];
#pragma unroll
            for (int h = 0; h < 2; ++h)
#pragma unroll
                for (int i = 0; i < 2; ++i) v2[h][i] = (GATHER && last) ? vn[h][i] : va[h][i];
            const char* a1 = cA + (size_t)(t + 1) * kstep;
            const char* a2 = last ? nA : cA + (size_t)(t + 2) * kstep; const char* b2 = last ? nB : cB + (size_t)(t + 2) * kstep;
            const char* a3 = a2 + kstep; const char* b3 = b2 + kstep;
            PG8_LDB(B0, 0, 0); PG8_LDB(B1, 0, 1); PG8_SCHED; PG8_LDA(At, 0, 0); PG8_STAGE_A(PG8_SA(1, 1), a1, va, 1);
            PG8_WAIT_V(8); PG8_WAIT_L(0); PG8_BAR; PG8_MMA(0, 0, At, B0); PG8_MMA(0, 1, At, B1); PG8_BAR; PG8_SCHED;
            PG8_LDA(At, 0, 1); PG8_STAGE_B(PG8_SB(0, 0), b2); PG8_STAGE_B(PG8_SB(0, 1), b2 + hstep); PG8_STAGE_A(PG8_SA(0, 0), a2, v2, 0);
            PG8_WAIT_V(8); PG8_WAIT_L(0); PG8_BAR; PG8_MMA(1, 0, At, B0); PG8_MMA(1, 1, At, B1); PG8_BAR; PG8_SCHED;
            PG8_LDB(B0, 1, 0); PG8_LDB(B1, 1, 1); PG8_SCHED; PG8_LDA(At, 1, 0); PG8_STAGE_A(PG8_SA(0, 1), a2, v2, 1);
            PG8_WAIT_V(8); PG8_WAIT_L(0); PG8_BAR; PG8_MMA(0, 0, At, B0); PG8_MMA(0, 1, At, B1); PG8_BAR; PG8_SCHED;
            PG8_LDA(At, 1, 1); PG8_STAGE_B(PG8_SB(1, 0), b3); PG8_STAGE_B(PG8_SB(1, 1), b3 + hstep); PG8_STAGE_A(PG8_SA(1, 0), a3, v2, 0);
            PG8_WAIT_V(8); PG8_WAIT_L(0); PG8_BAR; PG8_MMA(1, 0, At, B0); PG8_MMA(1, 1, At, B1); PG8_BAR; PG8_SCHED;
        }
        if constexpr (ALIGN_EPI) { if (wr == 0) PG8_BAR; }
        if constexpr (FP8) {
#define PG8_A4(a, b) "+v"(acc[a][b][0][0]), "+v"(acc[a][b][0][1]), "+v"(acc[a][b][1][0]), "+v"(acc[a][b][1][1]), "+v"(acc[a][b][2][0]), "+v"(acc[a][b][2][1]), "+v"(acc[a][b][3][0]), "+v"(acc[a][b][3][1])
            asm volatile("s_nop 15\n\ts_nop 15" : PG8_A4(0, 0), PG8_A4(0, 1) :: "memory");
            asm volatile("" : PG8_A4(1, 0), PG8_A4(1, 1) :: "memory");
#undef PG8_A4
        }
        E(acc, cur, wr, wc, fr, fq);
        if (!has_next) break;
#pragma unroll
        for (int a = 0; a < 2; ++a)
#pragma unroll
            for (int b = 0; b < 2; ++b)
#pragma unroll
                for (int m = 0; m < 4; ++m)
#pragma unroll
                    for (int n = 0; n < 2; ++n) { acc[a][b][m][n] = (f32x4){0.f, 0.f, 0.f, 0.f}; if constexpr (FP8) asm volatile("" : "+v"(acc[a][b][m][n])); }
        cur = nxt; cA = nA; cB = nB; ++ui;
#pragma unroll
        for (int h = 0; h < 2; ++h)
#pragma unroll
            for (int i = 0; i < 2; ++i) va[h][i] = vn[h][i];
        if constexpr (ALIGN_EPI) { if (wr == 1) PG8_BAR; }
    }
    PG8_WAIT_V(0);
    if constexpr (!ALIGN_EPI) { if (wr == 0) PG8_BAR; }
    PG8_BAR;
#undef PG8_SA
#undef PG8_SB
#undef PG8_STAGE_A
#undef PG8_STAGE_B
#undef PG8_LDA
#undef PG8_LDB
#undef PG8_MMA
#undef PG8_WAIT_V
#undef PG8_WAIT_L
#undef PG8_BAR
#undef PG8_SCHED
}
}

using pg8::Unit;
struct MoeTab { const LAS int* tp; const LAS int* cnt; const LAS unsigned short* t2e; };
__device__ __forceinline__ int moe_find(const LAS int* tp, int T) {
    int lo = 0, hi = 256;
    while (lo < hi) { const int mid = (lo + hi + 1) >> 1; if (tp[mid] <= T) lo = mid; else hi = mid - 1; }
    return lo;
}

struct SchedQKV {
    const bf16_t *H; long hc_delta; const bf16_t *W; int G, c;
    __device__ __forceinline__ bool next(int i, Unit& u) const {
        const int L = i * G + c; if (L >= 784) return false;
        if (L < 768) { u.pm = L / 3; u.pn = L % 3; u.aux = 0; } else { u.pm = L - 768; u.pn = 2; u.aux = 1; }
        u.aux2 = 0; return true;
    }
    __device__ __forceinline__ const char* a_base(const Unit& u) const { return (const char*)H + (u.aux ? hc_delta : 0L) + (size_t)u.pm * (256 * 1024 * 2); }
    __device__ __forceinline__ const char* b_base(const Unit& u) const { return (const char*)W + (size_t)u.pn * (256 * 1024 * 2); }
    __device__ __forceinline__ const unsigned* idx_ptr(const Unit&) const { return nullptr; }
    __device__ __forceinline__ int nvalid(const Unit&) const { return 256; }
};
struct SchedDense {
    const bf16_t *A, *Bt; int K, nM, nN, G, c; bool m_fast;
    __device__ __forceinline__ bool next(int i, Unit& u) const {
        const int L = i * G + c; if (L >= nM * nN) return false;
        if (m_fast) { u.pm = L % nM; u.pn = L / nM; } else { u.pm = L / nN; u.pn = L % nN; }
        u.aux = 0; u.aux2 = 0; return true;
    }
    __device__ __forceinline__ const char* a_base(const Unit& u) const { return (const char*)A + (size_t)u.pm * 512 * (size_t)K; }
    __device__ __forceinline__ const char* b_base(const Unit& u) const { return (const char*)Bt + (size_t)u.pn * 512 * (size_t)K; }
    __device__ __forceinline__ const unsigned* idx_ptr(const Unit&) const { return nullptr; }
    __device__ __forceinline__ int nvalid(const Unit&) const { return 256; }
};
struct SchedUT {
    const bf16_t *A, *Bt; int K, G, c;
    __device__ __forceinline__ bool next(int i, Unit& u) const {
        u.aux = 0; u.aux2 = 0; int L;
        if (G != 256) { L = i * G + c; if (L >= 256 * 6) return false; }
        else { const int n_own = c < 16 ? 5 : 6;
            if (i < n_own) L = i * 256 + c; else if (i == 6 && c >= 16 && c < 32) L = 5 * 256 + (c - 16); else return false; }
        u.pm = L % 6; u.pn = L / 6; return true;
    }
    __device__ __forceinline__ const char* a_base(const Unit& u) const { return (const char*)A + (size_t)u.pm * 512 * (size_t)K; }
    __device__ __forceinline__ const char* b_base(const Unit& u) const { return (const char*)Bt + (size_t)u.pn * 512 * (size_t)K; }
    __device__ __forceinline__ const unsigned* idx_ptr(const Unit&) const { return nullptr; }
    __device__ __forceinline__ int nvalid(const Unit&) const { return 256; }
};
struct TileDeal {
    int nT, NP, G, c;
    __device__ __forceinline__ bool get(int i, int& tile, int& slot) const {
        const int full = nT / G, rem = nT - full * G;
        if (i < full * NP) { tile = (i / NP) * G + c; slot = i % NP; return true; }
        const int j = i - full * NP;
        if (rem * NP <= G) { if (j > 0 || c >= rem * NP) return false; tile = full * G + c / NP; slot = c % NP; return true; }
        if (j >= NP || c >= rem) return false; tile = full * G + c; slot = j; return true;
    }
};
struct SchedGU {
    const bf16_t *H2, *WGU, *WSGU; const unsigned* LIST; MoeTab tab; int G, c;
    __device__ __forceinline__ bool next(int i, Unit& u) const {
        const int Ttot = __builtin_amdgcn_readfirstlane(tab.tp[257]); const int L = i * G + c; if (L >= 2 * Ttot) return false;
        const int T = L >> 1, half = L & 1;
        const int e = __builtin_amdgcn_readfirstlane((int)tab.t2e[T]);
        u.pm = T; u.pn = half; u.aux = e; u.aux2 = __builtin_amdgcn_readfirstlane(T - tab.tp[e]); return true;
    }
    __device__ __forceinline__ const char* a_base(const Unit&) const { return (const char*)H2; }
    __device__ __forceinline__ const char* b_base(const Unit& u) const { return (u.aux < 256 ? (const char*)WGU + (size_t)u.aux * (512 * 1024) : (const char*)WSGU) + (size_t)u.pn * (256 * 1024); }
    __device__ __forceinline__ const unsigned* idx_ptr(const Unit& u) const { return LIST + (size_t)u.aux * 65536 + (size_t)u.aux2 * 256; }
    __device__ __forceinline__ int nvalid(const Unit& u) const { const int r = __builtin_amdgcn_readfirstlane(tab.cnt[u.aux]) - u.aux2 * 256; return r < 256 ? r : 256; }
};
struct SchedDown {
    const bf16_t *ACT, *WD, *WSD; MoeTab tab; int G, c;
    __device__ __forceinline__ bool next(int i, Unit& u) const {
        const int TT = __builtin_amdgcn_readfirstlane(tab.tp[257]);
        const int L = i * G + c; if (L >= 4 * TT) return false;
        u.pm = L >> 2; u.pn = L & 3;
        u.aux = __builtin_amdgcn_readfirstlane((int)tab.t2e[u.pm]); u.aux2 = 0; return true;
    }
    __device__ __forceinline__ const char* a_base(const Unit& u) const { return (const char*)ACT + (size_t)u.pm * (256 * 256); }
    __device__ __forceinline__ const char* b_base(const Unit& u) const { return (u.aux < 256 ? (const char*)WD + (size_t)u.aux * (1024 * 256) : (const char*)WSD) + (size_t)u.pn * (256 * 256); }
    __device__ __forceinline__ const unsigned* idx_ptr(const Unit&) const { return nullptr; }
    __device__ __forceinline__ int nvalid(const Unit&) const { return 256; }
};

#define EPI_ARGS const f32x4 (&acc)[2][2][4][2], const Unit& u, int wr, int wc, int fr_, int fq_
#define EPI_PIN int fr = fr_, fq = fq_; asm volatile("" : "+v"(fr), "+v"(fq))
__device__ __forceinline__ u32x4 pack8(const f32x4& a, const f32x4& b) { u32x4 o; o.x = cvt_pk_bf16(a[0], a[1]); o.y = cvt_pk_bf16(a[2], a[3]); o.z = cvt_pk_bf16(b[0], b[1]); o.w = cvt_pk_bf16(b[2], b[3]); return o; }

__device__ __forceinline__ unsigned pk4_fp8c(float a, float b, float c, float d) {
    a = __builtin_amdgcn_fmed3f(a, -440.f, 440.f); b = __builtin_amdgcn_fmed3f(b, -440.f, 440.f); c = __builtin_amdgcn_fmed3f(c, -440.f, 440.f); d = __builtin_amdgcn_fmed3f(d, -440.f, 440.f);
    int w = __builtin_amdgcn_cvt_pk_fp8_f32(a, b, 0, false); w = __builtin_amdgcn_cvt_pk_fp8_f32(c, d, w, true); return (unsigned)w; }
struct EpiQKV {
    bf16_t *Q, *Kb, *Vb; const float *qnw, *knw; const f32x2* rope;
    __device__ __forceinline__ void operator()(EPI_ARGS) const {
        EPI_PIN;
        const bool ctx = u.aux != 0;
        const int kind = (u.pn < 2) ? 0 : (wc < 2 ? 1 : 2);
        f32x4 w[2][2];
#pragma unroll
        for (int bj = 0; bj < 2; ++bj)
#pragma unroll
            for (int n = 0; n < 2; ++n) w[bj][n] = (kind == 2) ? (f32x4){1.f, 1.f, 1.f, 1.f} : *(const f32x4*)((kind == 0 ? qnw : knw) + 32 * bj + 8 * fq + 4 * n);
        f32x4 rrow[2][2], rcol[4][2];
        if (kind != 2 && !ctx) {
#pragma unroll
            for (int ai = 0; ai < 2; ++ai)
#pragma unroll
                for (int n = 0; n < 2; ++n) rrow[ai][n] = ((const f32x4*)(rope + (((u.pm * 4 + 2 * ai + wr) & 63) * 16) + 4 * fq))[n];
#pragma unroll
            for (int m = 0; m < 4; ++m)
#pragma unroll
                for (int n = 0; n < 2; ++n) rcol[m][n] = ((const f32x4*)(rope + (16 * m + fr) * 16 + 4 * fq))[n];
        }
#pragma unroll
        for (int ai = 0; ai < 2; ++ai)
#pragma unroll
            for (int m = 0; m < 4; ++m) {
                const int rl = ai * 128 + wr * 64 + m * 16 + fr; const int row = u.pm * 256 + rl;
                f32x4 v[2][2];
#pragma unroll
                for (int bj = 0; bj < 2; ++bj)
#pragma unroll
                    for (int n = 0; n < 2; ++n) v[bj][n] = acc[ai][bj][m][n];
                if (kind != 2) {
                    float ss = 0.f;
#pragma unroll
                    for (int bj = 0; bj < 2; ++bj)
#pragma unroll
                        for (int n = 0; n < 2; ++n) ss += (v[bj][n][0] * v[bj][n][0] + v[bj][n][1] * v[bj][n][1]) + (v[bj][n][2] * v[bj][n][2] + v[bj][n][3] * v[bj][n][3]);
                    ss += __shfl_xor(ss, 16); ss += __shfl_xor(ss, 32);
                    const float rs = rsqrtf(ss * (1.f / 64.f) + EPS);
#pragma unroll
                    for (int bj = 0; bj < 2; ++bj)
#pragma unroll
                        for (int n = 0; n < 2; ++n) v[bj][n] = v[bj][n] * rs * w[bj][n];
                    if (!ctx) {
#pragma unroll
                        for (int bj = 0; bj < 2; ++bj)
#pragma unroll
                            for (int n = 0; n < 2; ++n) { const f32x4 cs = bj == 0 ? rrow[ai][n] : rcol[m][n]; const f32x4 x = v[bj][n];
                                v[bj][n] = (f32x4){x[0] * cs[0] - x[1] * cs[1], x[0] * cs[1] + x[1] * cs[0], x[2] * cs[2] - x[3] * cs[3], x[2] * cs[3] + x[3] * cs[2]}; }
                    }
                    if (kind == 0) {
#pragma unroll
                        for (int bj = 0; bj < 2; ++bj)
#pragma unroll
                            for (int n = 0; n < 2; ++n) v[bj][n] = v[bj][n] * C2;
                    }
                }
                bf16_t* dst;
                if (kind == 0) dst = Q + (size_t)row * AW + 64 * (4 * u.pn + wc) + 8 * fq;
                else { const int kvrow = ctx ? (row >> 8) * KVLEN + (row & 255) : (row >> 12) * KVLEN + CTXL + (row & (SEQ - 1));
                       dst = (kind == 1 ? Kb : Vb) + (size_t)kvrow * KVP + 64 * (wc & 1) + 8 * fq; }
#pragma unroll
                for (int bj = 0; bj < 2; ++bj) *(u32x4*)(dst + 32 * bj) = pack8(v[bj][0], v[bj][1]);
            }
    }
};
struct EpiPlainBf16 {
    bf16_t* O; size_t ldc; float scale;
    __device__ __forceinline__ void operator()(EPI_ARGS) const {
        EPI_PIN;
#pragma unroll
        for (int ai = 0; ai < 2; ++ai)
#pragma unroll
            for (int m = 0; m < 4; ++m) { bf16_t* rowp = O + (size_t)(u.pm * 256 + ai * 128 + wr * 64 + m * 16 + fr) * ldc + u.pn * 256 + wc * 32 + 8 * fq;
#pragma unroll
                for (int bj = 0; bj < 2; ++bj) *(u32x4*)(rowp + bj * 128) = pack8(acc[ai][bj][m][0] * scale, acc[ai][bj][m][1] * scale); }
    }
};
struct EpiOutProj {
    const float* x; float* out; const float* modv; int pm0;
    __device__ __forceinline__ void operator()(EPI_ARGS) const {
        EPI_PIN;
        const int pmt = pm0 + u.pm;
        const float* g1 = modv + (size_t)(pmt >> 4) * 6144 + 2 * 1024; const int col0 = u.pn * 256 + wc * 32 + 8 * fq;
        f32x4 gv[2][2];
#pragma unroll
        for (int bj = 0; bj < 2; ++bj)
#pragma unroll
            for (int n = 0; n < 2; ++n) gv[bj][n] = *(const f32x4*)(g1 + col0 + bj * 128 + 4 * n);
#if X1_BF16
#pragma unroll
        for (int ai = 0; ai < 2; ++ai) {
            f32x4 xv[4][2][2];
#pragma unroll
            for (int m = 0; m < 4; ++m) { const size_t off = (size_t)(pmt * 256 + ai * 128 + wr * 64 + m * 16 + fr) * DM + col0;
#pragma unroll
                for (int bj = 0; bj < 2; ++bj)
#pragma unroll
                    for (int n = 0; n < 2; ++n) xv[m][bj][n] = __builtin_nontemporal_load((const f32x4*)(x + off + bj * 128 + 4 * n)); }
            asm volatile("" ::: "memory");
#pragma unroll
            for (int m = 0; m < 4; ++m) { const size_t rowoff = (size_t)(pmt * 256 + ai * 128 + wr * 64 + m * 16 + fr) * DM;
#pragma unroll
                for (int bj = 0; bj < 2; ++bj)
                    *(u32x4*)((bf16_t*)(out + rowoff) + col0 + bj * 128) = pack8(xv[m][bj][0] + gv[bj][0] * acc[ai][bj][m][0], xv[m][bj][1] + gv[bj][1] * acc[ai][bj][m][1]); }
            asm volatile("" ::: "memory");
        }
#else
#pragma unroll
        for (int ai = 0; ai < 2; ++ai)
#pragma unroll
            for (int m = 0; m < 4; ++m) { const size_t off = (size_t)(pmt * 256 + ai * 128 + wr * 64 + m * 16 + fr) * DM + col0;
#pragma unroll
                for (int bj = 0; bj < 2; ++bj)
#pragma unroll
                    for (int n = 0; n < 2; ++n) { const f32x4 xv = *(const f32x4*)(x + off + bj * 128 + 4 * n); *(f32x4*)(out + off + bj * 128 + 4 * n) = xv + gv[bj][n] * acc[ai][bj][m][n]; }
                if (m & 1) asm volatile("" ::: "memory"); }
#endif
    }
};
struct EpiF32 {
    float* O; size_t ldc;
    __device__ __forceinline__ void operator()(EPI_ARGS) const {
        EPI_PIN;
#pragma unroll
        for (int ai = 0; ai < 2; ++ai)
#pragma unroll
            for (int m = 0; m < 4; ++m) { float* rowp = O + (size_t)(u.pm * 256 + ai * 128 + wr * 64 + m * 16 + fr) * ldc + u.pn * 256 + wc * 32 + 8 * fq;
#pragma unroll
                for (int bj = 0; bj < 2; ++bj)
#pragma unroll
                    for (int n = 0; n < 2; ++n) *(f32x4*)(rowp + bj * 128 + 4 * n) = acc[ai][bj][m][n]; }
    }
};
struct EpiGU {
    unsigned char* ACT; const unsigned* LIST; MoeTab tab;
    __device__ __forceinline__ void operator()(EPI_ARGS) const {
        EPI_PIN;
        const int e = u.aux, tile = u.aux2; int nv = __builtin_amdgcn_readfirstlane(tab.cnt[e]) - tile * 256; nv = nv < 256 ? nv : 256;
        const unsigned* ip = LIST + (size_t)e * 65536 + (size_t)tile * 256;
        constexpr float C1 = -1.4426950408889634f / 256.0f;
        unsigned lw[2][4];
#pragma unroll
        for (int ai = 0; ai < 2; ++ai)
#pragma unroll
            for (int m = 0; m < 4; ++m) { const int rl = ai * 128 + wr * 64 + m * 16 + fr; lw[ai][m] = ip[rl < nv ? rl : 0]; }
#pragma unroll
        for (int ai = 0; ai < 2; ++ai)
#pragma unroll
            for (int m = 0; m < 4; ++m) { const int rl = ai * 128 + wr * 64 + m * 16 + fr;
                const float ws = rl < nv ? bf2f(lw[ai][m] & 0xffffu) * (4.0f / 65536.0f) : 0.f;
                unsigned pk[2];
#pragma unroll
                for (int n = 0; n < 2; ++n) { const f32x4 g = acc[ai][0][m][n], up = acc[ai][1][m][n]; f32x2 r[2];
#pragma unroll
                    for (int h = 0; h < 2; ++h) { const f32x2 gg = {g[2 * h], g[2 * h + 1]}, uu = {up[2 * h], up[2 * h + 1]};
                        const f32x2 ea = gg * C1; f32x2 d; d.x = __builtin_amdgcn_exp2f(ea.x); d.y = __builtin_amdgcn_exp2f(ea.y); d = d + 1.0f;
                        f32x2 q; q.x = __builtin_amdgcn_rcpf(d.x); q.y = __builtin_amdgcn_rcpf(d.y);
                        f32x2 p = (gg * uu) * (q * ws);
                        p.x = __builtin_amdgcn_fmed3f(p.x, -440.f, 440.f); p.y = __builtin_amdgcn_fmed3f(p.y, -440.f, 440.f); r[h] = p; }
                    int w = __builtin_amdgcn_cvt_pk_fp8_f32(r[0].x, r[0].y, 0, false); w = __builtin_amdgcn_cvt_pk_fp8_f32(r[1].x, r[1].y, w, true); pk[n] = (unsigned)w; }
                u32x2 o; o.x = pk[0]; o.y = pk[1];
                *(u32x2*)(ACT + (size_t)(u.pm * 256 + rl) * FF + u.pn * 128 + wc * 32 + 8 * fq) = o; }
    }
};
struct EpiDown {
    unsigned char* SLOT;
    __device__ __forceinline__ void operator()(EPI_ARGS) const {
        EPI_PIN;
#pragma unroll
        for (int ai = 0; ai < 2; ++ai)
#pragma unroll
            for (int m = 0; m < 4; ++m) { unsigned char* rowp = SLOT + (size_t)(u.pm * 256 + ai * 128 + wr * 64 + m * 16 + fr) * DM + u.pn * 256 + wc * 32 + 8 * fq;
#pragma unroll
                for (int bj = 0; bj < 2; ++bj) { const f32x4 a = acc[ai][bj][m][0] * 0.125f, b = acc[ai][bj][m][1] * 0.125f;
                    u32x2 pk; pk.x = pk4_fp8c(a[0], a[1], a[2], a[3]); pk.y = pk4_fp8c(b[0], b[1], b[2], b[3]); *(u32x2*)(rowp + bj * 128) = pk; } }
    }
};
#include <hip/hip_bf16.h>
#include <cmath>
namespace attn_body {
using bf16=__hip_bfloat16;
using bf16x8=__attribute__((ext_vector_type(8)))short;
using s16x4=__attribute__((ext_vector_type(4)))short;
using f32x16=__attribute__((ext_vector_type(16)))float;
using u32x4=__attribute__((ext_vector_type(4)))unsigned;
constexpr int SEQ=4096,D=64,QP=512,KVP=128,KVLEN=4352;
constexpr int NW=8,QBLK=32,QB=QBLK*NW,KVBLK=64,NQB=SEQ/QB;
constexpr int ATTN_UNIT_ROWS=QB;
__device__ __forceinline__ int crow(int r,int hi){return (r&3)+8*(r>>2)+4*hi;}
#define SBAR() __builtin_amdgcn_sched_barrier(0)

constexpr int NSLOT=3, SLOTB=8192;
constexpr int LDS_K=0, LDS_V=NSLOT*SLOTB, LDS_WS=2*NSLOT*SLOTB, LDS_OST=LDS_WS+NW*64*4, LDS_BYTES=LDS_OST+NW*4096;
constexpr float C2=0.125f*1.4426950408889634f;
__device__ __forceinline__ void glds16(const void*gsrc,unsigned lds_dst){unsigned keep;
  asm volatile("s_mov_b32 %0, m0\n\ts_mov_b32 m0, %2\n\ts_nop 0\n\tglobal_load_lds_dwordx4 %1, off\n\ts_mov_b32 m0, %0":"=&s"(keep):"v"(gsrc),"s"(lds_dst):"memory");}
__device__ __forceinline__ float max3f(float a,float b,float c){float r;asm("v_max3_f32 %0, %1, %2, %3":"=v"(r):"v"(a),"v"(b),"v"(c));return r;}
__device__ __forceinline__ float max2f(float a,float b){float r;asm("v_max_f32_e32 %0, %1, %2":"=v"(r):"v"(a),"v"(b));return r;}
__device__ __forceinline__ float fadd_s(float a,float b){float r;asm("v_add_f32_e32 %0, %1, %2":"=v"(r):"v"(a),"v"(b));return r;}
__device__ __forceinline__ float fsub_s(float a,float b){float r;asm("v_sub_f32_e32 %0, %1, %2":"=v"(r):"v"(a),"v"(b));return r;}
typedef float f32x2_t __attribute__((ext_vector_type(2))); typedef __bf16 bf16x2_t __attribute__((ext_vector_type(2)));
__device__ __forceinline__ unsigned cvtpk_s(float lo,float hi){f32x2_t v={lo,hi};bf16x2_t b=__builtin_convertvector(v,bf16x2_t);return __builtin_bit_cast(unsigned,b);}
#define WAIT_BAR(N) asm volatile("s_waitcnt vmcnt(" #N ") lgkmcnt(0)\n\ts_barrier":::"memory")

__device__ __forceinline__ void qkt(f32x16&p0,f32x16&p1,const char*Kslot,const bf16x8*qr,const f32x16&negm,int r32,int hi){
  const char*kb=Kslot+hi*1024+r32*16;
  #pragma unroll
  for(int d0=0;d0<4;++d0){
    const bf16x8 b0=*reinterpret_cast<const bf16x8*>(kb+d0*2048);
    const bf16x8 b1=*reinterpret_cast<const bf16x8*>(kb+d0*2048+512);
    if(d0==0){p0=__builtin_amdgcn_mfma_f32_32x32x16_bf16(b0,qr[0],negm,0,0,0);p1=__builtin_amdgcn_mfma_f32_32x32x16_bf16(b1,qr[0],negm,0,0,0);}
    else{p0=__builtin_amdgcn_mfma_f32_32x32x16_bf16(b0,qr[d0],p0,0,0,0);p1=__builtin_amdgcn_mfma_f32_32x32x16_bf16(b1,qr[d0],p1,0,0,0);}}
}
typedef __attribute__((address_space(3))) const char* lds_cptr;
typedef short v4i16_t __attribute__((ext_vector_type(4)));
__device__ __forceinline__ void kload8(bf16x8*kf,lds_cptr kp){
  kf[0]=*(const __attribute__((address_space(3))) bf16x8*)(kp);      kf[1]=*(const __attribute__((address_space(3))) bf16x8*)(kp+512);
  kf[2]=*(const __attribute__((address_space(3))) bf16x8*)(kp+2048); kf[3]=*(const __attribute__((address_space(3))) bf16x8*)(kp+2560);
  kf[4]=*(const __attribute__((address_space(3))) bf16x8*)(kp+4096); kf[5]=*(const __attribute__((address_space(3))) bf16x8*)(kp+4608);
  kf[6]=*(const __attribute__((address_space(3))) bf16x8*)(kp+6144); kf[7]=*(const __attribute__((address_space(3))) bf16x8*)(kp+6656);
}
__device__ __forceinline__ void kload2(bf16x8*kf,lds_cptr kp,int j){ kf[2*j]=*(const __attribute__((address_space(3))) bf16x8*)(kp+j*2048); kf[2*j+1]=*(const __attribute__((address_space(3))) bf16x8*)(kp+j*2048+512); }
__device__ __forceinline__ s16x4 vtr(lds_cptr p){ return __builtin_bit_cast(s16x4,__builtin_amdgcn_ds_read_tr16_b64_v4i16((__attribute__((address_space(3))) v4i16_t*)p)); }
__device__ __forceinline__ float rowmax(const f32x16&p0,const f32x16&p1){
  float a=max3f(p0[0],p0[1],p1[0]),b=max3f(p0[2],p0[3],p1[1]);a=max3f(a,p1[2],p1[3]);
  #pragma unroll
  for(int r=4;r<16;r+=4){a=max3f(a,p0[r],p0[r+1]);b=max3f(b,p0[r+2],p0[r+3]);a=max3f(a,p1[r],p1[r+1]);b=max3f(b,p1[r+2],p1[r+3]);}
  const float m=max2f(a,b);
  auto rr=__builtin_amdgcn_permlane32_swap(__float_as_uint(m),__float_as_uint(m),false,false);
  return max2f(__uint_as_float(rr[0]),__uint_as_float(rr[1]));
}
__device__ __forceinline__ void pv(f32x16*o,int vb,bf16x8 pa0,bf16x8 pa1,bf16x8 pa2,bf16x8 pa3){
  #pragma unroll
  for(int d0=0;d0<2;++d0){s16x4 lo[4],hi[4];
    #pragma unroll
    for(int ks=0;ks<4;++ks){
      asm volatile("ds_read_b64_tr_b16 %0,%1 offset:%c2":"=&v"(lo[ks]):"v"(vb),"i"(d0*4096+ks*1024):"memory");
      asm volatile("ds_read_b64_tr_b16 %0,%1 offset:%c2":"=&v"(hi[ks]):"v"(vb),"i"(d0*4096+ks*1024+512):"memory");}
    asm volatile("s_waitcnt lgkmcnt(0)":::"memory");SBAR();
    #define PK(k) (bf16x8){lo[k][0],lo[k][1],lo[k][2],lo[k][3],hi[k][0],hi[k][1],hi[k][2],hi[k][3]}
    o[d0]=__builtin_amdgcn_mfma_f32_32x32x16_bf16(pa0,PK(0),o[d0],0,0,0);
    o[d0]=__builtin_amdgcn_mfma_f32_32x32x16_bf16(pa1,PK(1),o[d0],0,0,0);
    o[d0]=__builtin_amdgcn_mfma_f32_32x32x16_bf16(pa2,PK(2),o[d0],0,0,0);
    o[d0]=__builtin_amdgcn_mfma_f32_32x32x16_bf16(pa3,PK(3),o[d0],0,0,0);
    #undef PK
  }
}

#ifndef ATTN_STORE16
#define ATTN_STORE16(p,v) (*(u32x4*)(p)=(v))
#endif
template<int THRL> __device__ __forceinline__ void attn_unit(int b,int h,int qb,const bf16*Q,const bf16*__restrict__ K,const bf16*__restrict__ V,bf16*O,char*shm,int wave_,float negB){
  const int lane=::lane_id(),tid=wave_*64+lane,r32=lane&31,hi=lane>>5; const int wid=wave_;
  const int q0=qb*QB; const long qrow0=(long)b*SEQ+q0+wid*QBLK;
  const bf16*Qw=Q+qrow0*QP+h*D;
  const bf16*Kh=K+(long)b*KVLEN*KVP+(h>>2)*D,*Vh=V+(long)b*KVLEN*KVP+(h>>2)*D;
  const unsigned lds0=(unsigned)(uintptr_t)shm;
  float*wsf=(float*)(shm+LDS_WS)+wid*64;
  const bf16*ksrc=Kh+(long)lane*KVP+wid*8;
  const bf16*vsrc=Vh+(long)(16*(wid&3)+(lane>>2))*KVP+(wid>>2)*32+(lane&3)*8;
  const unsigned kdst=lds0+LDS_K+wid*1024, vdst=lds0+LDS_V+wid*1024;
  #define DMA_K(t,slot) glds16(ksrc+(long)(t)*KVBLK*KVP,(unsigned)__builtin_amdgcn_readfirstlane(kdst+(slot)))
  #define DMA_V(t,slot) glds16(vsrc+(long)(t)*KVBLK*KVP,(unsigned)__builtin_amdgcn_readfirstlane(vdst+(slot)))
  const int vb0=(int)(lds0+LDS_V)+((lane>>4)&1)*32+(lane&3)*8+(4*hi+((lane&15)>>2))*64;
  const char*Kbase=shm+LDS_K; bf16x8 kf[8];
  const lds_cptr shm3=(lds_cptr)shm; const lds_cptr kp0=shm3+LDS_K+hi*1024+r32*16; const lds_cptr vp0=shm3+LDS_V+((lane>>4)&1)*32+(lane&3)*8+(4*hi+((lane&15)>>2))*64;
  constexpr int NT=KVLEN/KVBLK;
  DMA_K(0,0);DMA_V(0,0);DMA_K(1,SLOTB);
  bf16x8 qr[4];
  #pragma unroll
  for(int d0=0;d0<4;++d0)qr[d0]=*reinterpret_cast<const bf16x8*>(&Qw[(long)r32*QP+d0*16+hi*8]);
  float l_reg=0.f;f32x16 o[2];o[0]=f32x16{};o[1]=f32x16{};f32x16 negm;
  _Pragma("unroll") for(int r=0;r<16;++r)negm[r]=negB; asm volatile("":"+v"(negm));
  #define CMASK(P0,P1,t) do{}while(0)
  #define START(P0,P1) do{ _Pragma("unroll") for(int r=0;r<16;++r)P0[r]=__builtin_amdgcn_exp2f(P0[r]); }while(0)
  #define RESC() do{}while(0)
  f32x16 pA0,pA1,pB0,pB1;
  int sl_prev=0,sl_cur=0,sl_next=SLOTB;
  #define ROT() do{sl_prev=sl_cur;sl_cur=sl_next;sl_next=(sl_next==(NSLOT-1)*SLOTB)?0:sl_next+SLOTB;}while(0)
  DMA_K(2,2*SLOTB);
  WAIT_BAR(3);
  qkt(pA0,pA1,Kbase,qr,negm,r32,hi);asm volatile("s_nop 15\n\ts_nop 7":"+v"(pA0),"+v"(pA1));CMASK(pA0,pA1,0);
  START(pA0,pA1);
  _Pragma("unroll") for(int r=0;r<16;++r)pA1[r]=__builtin_amdgcn_exp2f(pA1[r]);
  WAIT_BAR(0);
  DMA_K(3,0);DMA_V(1,SLOTB);
  ROT();
  kload8(kf,kp0+sl_cur);
  WAIT_BAR(2);
  s16x4 vlo[8],vhi[8]; u32x4 pw0,pw1,pw2,pw3;
  #define PKW(P,B) cvtpk_s(P[B],P[B+1])
  #define PAF(k) __builtin_bit_cast(bf16x8,pw##k)
  #define VFR(i) (bf16x8){vlo[i][0],vlo[i][1],vlo[i][2],vlo[i][3],vhi[i][0],vhi[i][1],vhi[i][2],vhi[i][3]}
  #define PIN(x) asm volatile("":"+v"(x))
  #define MX3(a,b,c) __builtin_fmaxf(__builtin_fmaxf((a),(b)),(c))
  #define GAPA(MF,A0,A1,A2,A3,W0,W1,PW) do{ MF; sacc+=A0; sacc+=A1; sacc+=A2; sacc+=A3; PIN(sacc); W0; W1; PIN(PW); SBAR(); }while(0)
  #define EX(v) __builtin_amdgcn_exp2f(v)
  #define GAPB(MF,X,B) do{ MF; X[B]=EX(X[B]); X[B+1]=EX(X[B+1]); X[B+2]=EX(X[B+2]); X[B+3]=EX(X[B+3]); PIN(X); SBAR(); }while(0)
  #define VRD(i) do{ vlo[i]=vtr(vp_+(((i)>>2)*4096+((i)&3)*1024)); vhi[i]=vtr(vp_+(((i)>>2)*4096+((i)&3)*1024+512)); }while(0)
  #define KRD(G,j) do{ if(G){ kload2(kf,kp0+sl_next,j); SBAR(); } }while(0)
  #define STEP(C0,C1,P0,P1,t,GK,GV,GL) do{ SBAR(); \
    const lds_cptr vp_=vp0+sl_prev; \
    VRD(0); SBAR(); float sacc=(P0[0]+P0[1]); \
    GAPA(C0=__builtin_amdgcn_mfma_f32_32x32x16_bf16(kf[0],qr[0],negm,0,0,0), P0[2],P0[3],P0[4],P0[5],     pw0[0]=PKW(P0,0), pw0[1]=PKW(P0,2), pw0); \
    VRD(4); SBAR(); GAPA(C1=__builtin_amdgcn_mfma_f32_32x32x16_bf16(kf[1],qr[0],negm,0,0,0), P0[6],P0[7],P0[8],P0[9],     pw0[2]=PKW(P0,4), pw0[3]=PKW(P0,6), pw0); \
    VRD(1); SBAR(); GAPA(C0=__builtin_amdgcn_mfma_f32_32x32x16_bf16(kf[2],qr[1],C0,0,0,0),   P0[10],P0[11],P0[12],P0[13], pw1[0]=PKW(P0,8), pw1[1]=PKW(P0,10), pw1); \
    VRD(5); SBAR(); GAPA(C1=__builtin_amdgcn_mfma_f32_32x32x16_bf16(kf[3],qr[1],C1,0,0,0),   P0[14],P0[15],P1[0],P1[1],   pw1[2]=PKW(P0,12),pw1[3]=PKW(P0,14), pw1); \
    VRD(2); SBAR(); GAPA(C0=__builtin_amdgcn_mfma_f32_32x32x16_bf16(kf[4],qr[2],C0,0,0,0),   P1[2],P1[3],P1[4],P1[5],     pw2[0]=PKW(P1,0), pw2[1]=PKW(P1,2), pw2); \
    VRD(6); SBAR(); GAPA(C1=__builtin_amdgcn_mfma_f32_32x32x16_bf16(kf[5],qr[2],C1,0,0,0),   P1[6],P1[7],P1[8],P1[9],     pw2[2]=PKW(P1,4), pw2[3]=PKW(P1,6), pw2); \
    VRD(3); SBAR(); GAPA(C0=__builtin_amdgcn_mfma_f32_32x32x16_bf16(kf[6],qr[3],C0,0,0,0),   P1[10],P1[11],P1[12],P1[13], pw3[0]=PKW(P1,8), pw3[1]=PKW(P1,10), pw3); \
    VRD(7); SBAR(); GAPA(C1=__builtin_amdgcn_mfma_f32_32x32x16_bf16(kf[7],qr[3],C1,0,0,0),   P1[14],P1[15],0.f,0.f,       pw3[2]=PKW(P1,12),pw3[3]=PKW(P1,14), pw3); \
    l_reg+=sacc; \
    if(GK){DMA_K((t)+3,sl_cur);} if(GV){DMA_V((t)+1,sl_next);} \
    CMASK(C0,C1,t); \
    SBAR(); \
    GAPB(o[0]=__builtin_amdgcn_mfma_f32_32x32x16_bf16(PAF(0),VFR(0),o[0],0,0,0), C0,0); \
    GAPB(o[1]=__builtin_amdgcn_mfma_f32_32x32x16_bf16(PAF(0),VFR(4),o[1],0,0,0), C0,4); \
    KRD(GL,0); GAPB(o[0]=__builtin_amdgcn_mfma_f32_32x32x16_bf16(PAF(1),VFR(1),o[0],0,0,0), C0,8); \
    KRD(GL,1); GAPB(o[1]=__builtin_amdgcn_mfma_f32_32x32x16_bf16(PAF(1),VFR(5),o[1],0,0,0), C0,12); \
    KRD(GL,2); GAPB(o[0]=__builtin_amdgcn_mfma_f32_32x32x16_bf16(PAF(2),VFR(2),o[0],0,0,0), C1,0); \
    KRD(GL,3); GAPB(o[1]=__builtin_amdgcn_mfma_f32_32x32x16_bf16(PAF(2),VFR(6),o[1],0,0,0), C1,4); \
    GAPB(o[0]=__builtin_amdgcn_mfma_f32_32x32x16_bf16(PAF(3),VFR(3),o[0],0,0,0), C1,8); \
    GAPB(o[1]=__builtin_amdgcn_mfma_f32_32x32x16_bf16(PAF(3),VFR(7),o[1],0,0,0), C1,12); \
    }while(0)
  int t=1;
  #undef CMASK
  #define CMASK(P0,P1,t) do{}while(0)
  for(;t+5<NT;t+=2){
    STEP(pB0,pB1,pA0,pA1,t,true,true,true);     WAIT_BAR(2); RESC(); ROT();
    STEP(pA0,pA1,pB0,pB1,t+1,true,true,true);   WAIT_BAR(2); RESC(); ROT();
  }
  #undef CMASK
  #define CMASK(P0,P1,t) do{}while(0)
  #define ENDW(tt) do{ if((tt)+3<NT){WAIT_BAR(2);} else if((tt)+2<NT){WAIT_BAR(1);} else {WAIT_BAR(0);} }while(0)
  for(;t+1<NT;t+=2){
    STEP(pB0,pB1,pA0,pA1,t,(t+3<NT),(t+1<NT),(t+1<NT));       ENDW(t);   RESC(); ROT();
    STEP(pA0,pA1,pB0,pB1,t+1,(t+4<NT),(t+2<NT),(t+2<NT));     ENDW(t+1); RESC(); ROT();
  }
  STEP(pB0,pB1,pA0,pA1,NT-1,false,false,false); RESC();
  { float sacc=pB0[0]+pB0[1]; _Pragma("unroll") for(int r=2;r<16;++r)sacc+=pB0[r]; _Pragma("unroll") for(int r=0;r<16;++r)sacc+=pB1[r]; l_reg+=sacc;
    pw0=(u32x4){PKW(pB0,0),PKW(pB0,2),PKW(pB0,4),PKW(pB0,6)};pw1=(u32x4){PKW(pB0,8),PKW(pB0,10),PKW(pB0,12),PKW(pB0,14)};pw2=(u32x4){PKW(pB1,0),PKW(pB1,2),PKW(pB1,4),PKW(pB1,6)};pw3=(u32x4){PKW(pB1,8),PKW(pB1,10),PKW(pB1,12),PKW(pB1,14)};
    SBAR(); pv(o,vb0+sl_cur,PAF(0),PAF(1),PAF(2),PAF(3)); }
  #undef PKW
  #undef PAF
  #undef VFR
  #undef PIN
  #undef MX3
  #undef GAPA
  #undef GAPB
  #undef EX
  #undef VRD
  #undef KRD
  #undef STEP
  #undef ENDW
  {auto rr=__builtin_amdgcn_permlane32_swap(__float_as_uint(l_reg),__float_as_uint(l_reg),false,false);l_reg=__uint_as_float(rr[0])+__uint_as_float(rr[1]);}
  if(hi==0)wsf[32+r32]=l_reg;asm volatile("s_waitcnt lgkmcnt(0)":::"memory");
  float rli[16];
  #pragma unroll
  for(int r=0;r<16;++r)rli[r]=__builtin_amdgcn_rcpf(wsf[32+crow(r,hi)]);
  bf16*Ow=O+qrow0*QP+h*D;
  { bf16*stg=(bf16*)(shm+LDS_OST)+wid*2048;
    #pragma unroll
    for(int r=0;r<16;++r){const int orow=crow(r,hi);
      #pragma unroll
      for(int d0=0;d0<2;++d0)stg[orow*64+d0*32+r32]=__float2bfloat16(o[d0][r]*rli[r]);}
    asm volatile("s_waitcnt lgkmcnt(0)":::"memory");
    #pragma unroll
    for(int i=0;i<4;++i){const int row=i*8+(lane>>3),ch=lane&7; const u32x4 v=*(const u32x4*)(stg+row*64+ch*8); ATTN_STORE16(Ow+(long)row*QP+ch*8,v);} }
  asm volatile("s_waitcnt lgkmcnt(0)\n\ts_barrier":::"memory");
  #undef DMA_K
  #undef DMA_V
  #undef CMASK
  #undef START
  #undef RESC
  #undef ROT
}
constexpr int ATTN_LDS_BYTES=LDS_BYTES;
struct AttnTensors { const bf16* Q; const bf16* K; const bf16* V; bf16* O; };
struct AttnUnit { int b; int h; int qb; };
struct StaticOrder {
  int vcu;
  __device__ __forceinline__ explicit StaticOrder(int v):vcu(v){}
  __device__ __forceinline__ bool next(int i,AttnUnit&u)const{ if(i>=8)return false; const int xcd=vcu>>5,lc=vcu&31; const int grp=xcd*4+(i>>1); const int idx=(i&1)*32+lc;
    u.b=grp>>1; u.h=(grp&1)*4+(idx>>4); u.qb=idx&15; return true; }
};
struct StaticOrderR {
  int vcu,i0,i1;
  __device__ __forceinline__ StaticOrderR(int v,int a,int b):vcu(v),i0(a),i1(b){}
  __device__ __forceinline__ bool next(int j,AttnUnit&u)const{ const int i=i0+j; if(i>=i1)return false; const int xcd=vcu>>5,lc=vcu&31; const int grp=xcd*4+(i>>1); const int idx=(i&1)*32+lc;
    u.b=grp>>1; u.h=(grp&1)*4+(idx>>4); u.qb=idx&15; return true; }
};
template<class Sched,int THRL=8> __device__ __forceinline__ void attn_phase(char*lds,const AttnTensors&T,const Sched&S,int wave_,float negB){
  AttnUnit u;
  for(int i=0;S.next(i,u);++i){ attn_unit<THRL>(u.b,u.h,u.qb,T.Q,T.K,T.V,T.O,lds,wave_,negB); }
}
#undef SBAR
#undef WAIT_BAR
}
#define XB_TMO      128
#define XB_XCNT(j)  (256  + 64 * (j))
#define XB_XSUB(j)  (1280 + 64 * (j))
#define XB_XGEN(j)  (2304 + 64 * (j))
#define XB_TOP      3328
#define XB_TOPGEN   3392
#define XCD_BAR_WORDS 3456
#define XB_SPIN_CAP (1u << 18)

__device__ __forceinline__ unsigned xb_ld(unsigned* p)              { return __hip_atomic_load(p, __ATOMIC_RELAXED, __HIP_MEMORY_SCOPE_AGENT); }
__device__ __forceinline__ unsigned xb_add(unsigned* p, unsigned v) { return __hip_atomic_fetch_add(p, v, __ATOMIC_RELAXED, __HIP_MEMORY_SCOPE_AGENT); }
__device__ __forceinline__ unsigned xb_xcc_id() { return (unsigned)__builtin_amdgcn_s_getreg((3 << 11) | 20) & 0xFu; }
#define XB_SPIN(cond, bar) do { unsigned _sp = 0; while (cond) { __builtin_amdgcn_s_sleep(1); \
    if ((++_sp & 255u) == 0u) { if (xb_ld(&(bar)[XB_TMO])) break; if (_sp > XB_SPIN_CAP) { atomicAdd(&(bar)[XB_TMO], 1u); break; } } } } while (0)

struct XcdBarrier {
    unsigned wv; unsigned* bar; unsigned x;
    volatile LAS unsigned* st;
};

__device__ __forceinline__ XcdBarrier xcd_barrier_post(unsigned* bar, volatile LAS unsigned* st) {
    XcdBarrier b; b.bar = bar; b.x = xb_xcc_id(); b.st = st;
    if (threadIdx.x == 0) (void)xb_add(&bar[XB_XCNT(b.x)], 1u);
    b.wv = (unsigned)__builtin_amdgcn_readfirstlane((int)(threadIdx.x >> 6));
    return b;
}
__device__ __forceinline__ void xcd_barrier_complete(unsigned* bar, unsigned x, unsigned& nloc, unsigned& nx) {
    const unsigned G = gridDim.x * gridDim.y * gridDim.z;
    unsigned sum, cnt, mine, sp = 0u;
    for (;;) {
        sum = 0u; cnt = 0u; mine = 0u;
#pragma unroll
        for (unsigned j = 0; j < 16; ++j) { const unsigned c = xb_ld(&bar[XB_XCNT(j)]); sum += c; cnt += (c > 0u) ? 1u : 0u; mine = (j == x) ? c : mine; }
        if (sum == G) break;
        __builtin_amdgcn_s_sleep(1);
        if ((++sp & 255u) == 0u) { if (xb_ld(&bar[XB_TMO])) break; if (sp > XB_SPIN_CAP) { atomicAdd(&bar[XB_TMO], 1u); break; } }
    }
    nloc = mine > 0u ? mine : 1u; nx = cnt > 0u ? cnt : 1u;
}

__device__ __forceinline__ void xcd_barrier(const XcdBarrier& b) {
    asm volatile("s_waitcnt vmcnt(0)" ::: "memory");
    __syncthreads();
    if (b.wv == 0u && lane_id() == 0) {
        unsigned* bar = b.bar;
        __builtin_amdgcn_s_waitcnt(0);
        unsigned nloc = b.st[0], nx = b.st[1];
        if (nloc == 0u) { xcd_barrier_complete(bar, b.x, nloc, nx); b.st[0] = nloc; b.st[1] = nx; }
        const unsigned old = xb_add(&bar[XB_XSUB(b.x)], 1u);
        const unsigned gen = old / nloc;
        if (old + 1u == (gen + 1u) * nloc) {
            __builtin_amdgcn_fence(__ATOMIC_RELEASE, "agent");
            asm volatile("s_waitcnt vmcnt(0)" ::: "memory");
            const unsigned og = xb_add(&bar[XB_TOP], 1u);
            const unsigned tg = og / nx;
            if (og + 1u == (tg + 1u) * nx) xb_add(&bar[XB_TOPGEN], 1u);
            else XB_SPIN(xb_ld(&bar[XB_TOPGEN]) == tg, bar);
            __builtin_amdgcn_fence(__ATOMIC_ACQUIRE, "agent");
            xb_add(&bar[XB_XGEN(b.x)], 1u);
            asm volatile("s_waitcnt vmcnt(0)" ::: "memory");
        } else {
            XB_SPIN(xb_ld(&bar[XB_XGEN(b.x)]) == gen, bar);
            __builtin_amdgcn_fence(__ATOMIC_ACQUIRE, "agent");
            asm volatile("s_waitcnt vmcnt(0)" ::: "memory");
        }
    }
    __syncthreads();
}


typedef GAS unsigned gu32;
#define RLX_AGENT __ATOMIC_RELAXED, __HIP_MEMORY_SCOPE_AGENT
#define LDS_WAIT() asm volatile("s_waitcnt lgkmcnt(0)" ::: "memory")
#define VM_WAIT() asm volatile("s_waitcnt vmcnt(0)" ::: "memory")
constexpr int N_IN = 34;
enum { I_X = 0, I_C, I_CTX, I_CCTX, I_MODW, I_MODB, I_NORM1, I_WIN, I_QNW, I_KNW, I_CONVW, I_CONVB, I_FW1, I_FB1, I_FW2, I_FB2, I_FW3, I_FB3, I_FW4, I_FFREQ,
       I_HBIAS, I_AONW, I_HONW, I_WOUT, I_NORM2, I_RW, I_RB, I_EG, I_EU, I_ED, I_SG, I_SU, I_SD, I_FNW };
struct Frame {
    LAS unsigned char* lds;
    volatile LAS unsigned* MISC;
    unsigned* ctl;
    int tid, lane, wave, vcu, G;
    float* out; unsigned char* ws;
};
typedef const __attribute__((address_space(4))) char* kargp_t;
__device__ __forceinline__ const float* kin(int i) { kargp_t p = (kargp_t)__builtin_amdgcn_kernarg_segment_ptr(); asm volatile("" : "+s"(p)); return (const float*)*(const GAS float* const __attribute__((address_space(4)))*)(p + 8 * i); }
#define WSP(T, off) ((T*)(F.ws + (off)))

__device__ __forceinline__ void tr_item(const float* W, int ldw, int k0, int n0, bf16_t* WT, int Kd, int drow0, LAS float* scr, int lane) {
#pragma unroll 8
    for (int i = 0; i < 32; ++i) { const int kk = 2 * i + (lane >> 5); scr[kk * 33 + (lane & 31)] = W[(size_t)(k0 + kk) * ldw + n0 + (lane & 31)]; }
    LDS_WAIT(); asm volatile("" ::: "memory");
    const int c = lane & 7;
#pragma unroll
    for (int j = 0; j < 4; ++j) { const int n = (lane >> 3) + 8 * j; const LAS float* s = scr + (8 * c) * 33 + n;
        u32x4 o; o.x = pk2(s[0 * 33], s[1 * 33]); o.y = pk2(s[2 * 33], s[3 * 33]); o.z = pk2(s[4 * 33], s[5 * 33]); o.w = pk2(s[6 * 33], s[7 * 33]);
        *(u32x4*)(WT + (size_t)(drow0 + n) * Kd + k0 + 8 * c) = o; }
    LDS_WAIT(); asm volatile("" ::: "memory");
}
__device__ __forceinline__ unsigned pk4_fp8(float a, float b, float c, float d) { int w = __builtin_amdgcn_cvt_pk_fp8_f32(a, b, 0, false); w = __builtin_amdgcn_cvt_pk_fp8_f32(c, d, w, true); return (unsigned)w; }
__device__ __forceinline__ void tr_item8(const float* W, int ldw, int k0, int n0, unsigned char* WT, int Kd, int drow0, float scl, LAS float* scr, int lane) {
#pragma unroll 8
    for (int i = 0; i < 32; ++i) { const int kk = 2 * i + (lane >> 5); scr[kk * 33 + (lane & 31)] = W[(size_t)(k0 + kk) * ldw + n0 + (lane & 31)]; }
    LDS_WAIT(); asm volatile("" ::: "memory");
    const int c = lane & 7;
#pragma unroll
    for (int j = 0; j < 4; ++j) { const int n = (lane >> 3) + 8 * j; const LAS float* s = scr + (8 * c) * 33 + n;
        u32x2 o; o.x = pk4_fp8(s[0 * 33] * scl, s[1 * 33] * scl, s[2 * 33] * scl, s[3 * 33] * scl); o.y = pk4_fp8(s[4 * 33] * scl, s[5 * 33] * scl, s[6 * 33] * scl, s[7 * 33] * scl);
        *(u32x2*)(WT + (size_t)(drow0 + n) * Kd + k0 + 8 * c) = o; }
    LDS_WAIT(); asm volatile("" ::: "memory");
}
constexpr int IT_FILT = 2048, IT_MODV = 0, IT_ROPE = 1, IT_QKV = 384, IT_WU = 768, IT_WO = 512, IT_WR = 128, IT_SGU = 256, IT_SD = 128, IT_EXP = 256 * 384;
constexpr int IT_TILES = IT_QKV + IT_WU + IT_WO + IT_WR + IT_SGU + IT_SD;
constexpr int XP_TILES = 256 * 48;

template <int NT_> __device__ __forceinline__ void p0_filter_item(Frame& F, int item, LAS float* hsc) {
    const int lane = F.lane; const int t0 = NT_ * item;
    const float* w1 = kin(I_FW1); const float* b1 = kin(I_FB1); const float* w2 = kin(I_FW2); const float* b2 = kin(I_FB2);
    const float* w3 = kin(I_FW3); const float* b3 = kin(I_FB3); const float* w4 = kin(I_FW4); const float fr = kin(I_FFREQ)[lane];
    float h[NT_], a[NT_];
#pragma unroll
    for (int tt = 0; tt < NT_; ++tt) { const int t = t0 + tt; float v = 0.f;
        if (lane == 0) v = (float)t * (1.0f / 4095.0f);
        else if (lane < 33) { const int m = (lane - 1) & 15; const float f = 1e-4f + (float)m * ((15.0f - 1e-4f) / 15.0f);
            float rev = f * ((float)t * (1.0f / 4096.0f)); rev -= floorf(rev); const float ang = 6.283185307179586f * rev;
            v = lane <= 16 ? cosf(ang) : -sinf(ang); }
        h[tt] = v; }
#pragma unroll
    for (int l = 0; l < 3; ++l) { const float* ww = l == 0 ? w1 : l == 1 ? w2 : w3; const float bb = (l == 0 ? b1 : l == 1 ? b2 : b3)[lane];
        float wc[64];
#pragma unroll
        for (int i = 0; i < 64; ++i) wc[i] = (l == 0 && i >= 33) ? 0.f : ww[i * 64 + lane];
#pragma unroll
        for (int tt = 0; tt < NT_; ++tt) a[tt] = bb;
#pragma unroll
        for (int i = 0; i < 64; ++i) { if (l == 0 && i >= 33) break;
#pragma unroll
            for (int tt = 0; tt < NT_; ++tt) a[tt] += __builtin_bit_cast(float, __builtin_amdgcn_readlane(__builtin_bit_cast(int, h[tt]), i)) * wc[i]; }
#pragma unroll
        for (int tt = 0; tt < NT_; ++tt) h[tt] = sinf(fr * a[tt]); }
#pragma unroll
    for (int tt = 0; tt < NT_; ++tt) hsc[tt * 64 + lane] = h[tt];
    LDS_WAIT(); asm volatile("" ::: "memory");
    bf16_t* KR = WSP(bf16_t, WS_KR);
    const float dmin = logf(1e-2f) / 0.3f, dmax = logf(1e-2f) / 1.5f;
#pragma unroll 1
    for (int q = 0; q < 16; ++q) {
        const int n = lane + 64 * q; float wc[64];
#pragma unroll
        for (int i = 0; i < 64; ++i) wc[i] = w4[i * 1024 + n];
        float o[NT_];
#pragma unroll
        for (int tt = 0; tt < NT_; ++tt) o[tt] = 0.f;
#pragma unroll
        for (int i4 = 0; i4 < 16; ++i4)
#pragma unroll
            for (int tt = 0; tt < NT_; ++tt) { const f32x4 hv = *(const LAS f32x4*)(hsc + tt * 64 + 4 * i4);
                o[tt] += (hv[0] * wc[4 * i4] + hv[1] * wc[4 * i4 + 1]) + (hv[2] * wc[4 * i4 + 2] + hv[3] * wc[4 * i4 + 3]); }
        const int c = n & 511; const bool bwd = n >= 512;
        const float delta = fabsf(dmin + (float)c * ((dmax - dmin) / 511.0f));
#pragma unroll
        for (int tt = 0; tt < NT_; ++tt) { const int t = t0 + tt; const float tl = (float)t * (1.0f / 4095.0f);
            const float val = o[tt] * expf(-tl * delta);
            if (!(bwd && t == 0)) {
#if HYENA_FP8
                ((unsigned char*)KR)[(size_t)c * 8192 + (bwd ? 4096 + t : 4096 - t)] = (unsigned char)(pk4_fp8c(val * 64.0f, 0.f, 0.f, 0.f) & 0xffu);
#else
                KR[(size_t)c * 8192 + (bwd ? 4096 + t : 4096 - t)] = (bf16_t)f2bf(val);
#endif
            } }
    }
}
__device__ __forceinline__ void p0_modv_block(Frame& F, int chunk) {
    const int lane = F.lane, kc = F.wave; const int n0 = 64 * chunk, k0 = 128 * kc;
    LAS float* sv = (LAS float*)(F.lds + RING_OFF + F.wave * 8704);
    LAS float* part = (LAS float*)(F.lds + RING_OFF + 8 * 8704);
    float cv[17][2];
#pragma unroll
    for (int r = 0; r < 17; ++r)
#pragma unroll
        for (int hh = 0; hh < 2; ++hh) { const int kk = lane + 64 * hh; cv[r][hh] = r < 16 ? kin(I_C)[r * 1024 + k0 + kk] : kin(I_CCTX)[k0 + kk]; }
#pragma unroll
    for (int r = 0; r < 17; ++r)
#pragma unroll
        for (int hh = 0; hh < 2; ++hh) { const float v = cv[r][hh]; sv[r * 128 + lane + 64 * hh] = v / (1.0f + expf(-v)); }
    LDS_WAIT(); asm volatile("" ::: "memory");
    float acc[17];
#pragma unroll
    for (int r = 0; r < 17; ++r) acc[r] = 0.f;
    const float* W = kin(I_MODW) + (size_t)k0 * 6144 + n0 + lane;
#pragma unroll 4
    for (int k4 = 0; k4 < 32; ++k4) {
        const float w0 = W[(size_t)(4 * k4 + 0) * 6144], w1 = W[(size_t)(4 * k4 + 1) * 6144], w2 = W[(size_t)(4 * k4 + 2) * 6144], w3 = W[(size_t)(4 * k4 + 3) * 6144];
#pragma unroll
        for (int r = 0; r < 17; ++r) { const f32x4 s = *(const LAS f32x4*)(sv + r * 128 + 4 * k4); acc[r] += (s[0] * w0 + s[1] * w1) + (s[2] * w2 + s[3] * w3); }
    }
#pragma unroll
    for (int r = 0; r < 17; ++r) part[(kc * 17 + r) * 64 + lane] = acc[r];
    __syncthreads();
    if (F.wave == 0) { float* mv = WSP(float, WS_MODV); const float bb = kin(I_MODB)[n0 + lane];
#pragma unroll
        for (int r = 0; r < 17; ++r) { float s = bb;
#pragma unroll
            for (int k = 0; k < 8; ++k) s += part[(k * 17 + r) * 64 + lane];
            mv[r * 6144 + n0 + lane] = s; } }
    __syncthreads();
}
struct XpT { const float* src; unsigned char* dst; int ldw, Kd, which; };
__device__ __forceinline__ XpT xp_params(Frame& F, int ti) {
    XpT p; const int e = ti / 48, q = ti % 48;
    if (q < 32) { const int which = q >> 4, kb = q & 15; p.src = kin(which ? I_EU : I_EG) + (size_t)e * (1024 * 256) + (size_t)(64 * kb) * 256; p.ldw = 256;
        p.dst = WSP(unsigned char, WS_WGU) + (size_t)e * (512 * 1024) + 64 * kb; p.Kd = 1024; p.which = which; }
    else { const int r = q - 32, kb = r & 3, cb = r >> 2; p.src = kin(I_ED) + (size_t)e * (256 * 1024) + (size_t)(64 * kb) * 1024 + 256 * cb; p.ldw = 1024;
        p.dst = WSP(unsigned char, WS_WD) + (size_t)e * (1024 * 256) + (size_t)(256 * cb) * 256 + 64 * kb; p.Kd = 256; p.which = -1; }
    return p;
}
__device__ __forceinline__ void xp_load(const XpT& p, f32x4 (&v)[8], int tid) {
#pragma unroll
    for (int i = 0; i < 8; ++i) { const int g = tid + 512 * i; v[i] = __builtin_nontemporal_load((const f32x4*)(p.src + (size_t)(g >> 6) * p.ldw + 4 * (g & 63))); }
}
__device__ __forceinline__ void xp_tiles(Frame& F, int quota) {
    constexpr int PK = 65, PLANE = 64 * PK + 2, BUF = 4 * PLANE;
    LAS float* L0 = (LAS float*)(F.lds + RING_OFF);
    const int tid = F.tid;
    volatile LAS int* qw = (volatile LAS int*)(F.MISC + 16);
    if (tid == 0) {
#pragma unroll
        for (int k = 0; k < 5; ++k) qw[k] = (int)__hip_atomic_fetch_add(F.ctl + CW_TILEQ, 1u, RLX_AGENT); }
    LDS_WAIT(); __syncthreads();
    int t0 = qw[0], t1 = qw[1], t2 = qw[2], t3 = qw[3], t4 = qw[4], par = 0, ng = 5;
    __syncthreads();
    f32x4 v0[8], v1[8], v2[8], v3[8];
#define XP_CLAMP(t_) ((t_) < XP_TILES ? (t_) : XP_TILES - 1)
    { const XpT p = xp_params(F, XP_CLAMP(t0)); xp_load(p, v0, tid); }
    { const XpT p = xp_params(F, XP_CLAMP(t1)); xp_load(p, v1, tid); }
    { const XpT p = xp_params(F, XP_CLAMP(t2)); xp_load(p, v2, tid); }
    { const XpT p = xp_params(F, XP_CLAMP(t3)); xp_load(p, v3, tid); }
#define XP_STEP(V) { if (t0 >= XP_TILES) break; \
        if (tid == 0) qw[6 + par] = (t4 < XP_TILES && ng < quota) ? (int)__hip_atomic_fetch_add(F.ctl + CW_TILEQ, 1u, RLX_AGENT) : XP_TILES;     \
        ++ng; \
        LAS float* buf = L0 + par * BUF; \
        _Pragma("unroll") for (int i = 0; i < 8; ++i) { const int g = tid + 512 * i; LAS float* d = buf + (g >> 6) * PK + (g & 63); \
            d[0] = V[i][0]; d[PLANE] = V[i][1]; d[2 * PLANE] = V[i][2]; d[3 * PLANE] = V[i][3]; } \
        { const XpT p = xp_params(F, XP_CLAMP(t4)); xp_load(p, V, tid); } \
        LDS_WAIT(); __syncthreads(); \
        const int t5 = qw[6 + par]; \
        const XpT pa = xp_params(F, t0); \
        _Pragma("unroll") for (int i = 0; i < 4; ++i) { const int pr = tid + 512 * i; const int kc = pr & 7, n = pr >> 3; \
            const LAS float* s_ = buf + (n & 3) * PLANE + (8 * kc) * PK + (n >> 2); \
            u32x2 o; o.x = pk4_fp8(s_[0] * 32.f, s_[PK] * 32.f, s_[2 * PK] * 32.f, s_[3 * PK] * 32.f); o.y = pk4_fp8(s_[4 * PK] * 32.f, s_[5 * PK] * 32.f, s_[6 * PK] * 32.f, s_[7 * PK] * 32.f); \
            const int row = pa.which < 0 ? n : 256 * (n >> 7) + 128 * pa.which + (n & 127); \
            *(u32x2*)(pa.dst + (size_t)row * pa.Kd + 8 * kc) = o; } \
        t0 = t1; t1 = t2; t2 = t3; t3 = t4; t4 = t5; par ^= 1; }
    for (;;) { XP_STEP(v0) XP_STEP(v1) XP_STEP(v2) XP_STEP(v3) }
#undef XP_STEP
#undef XP_CLAMP
    LDS_WAIT(); __syncthreads();
}
__device__ __forceinline__ void p0_prologue(Frame& F) {
    LAS float* scr = (LAS float*)(F.lds + RING_OFF + F.wave * 16384);
    const int gw = F.vcu * NWAVES + F.wave, NGW = F.G * NWAVES; const int lane = F.lane;
    __syncthreads();
    for (int ch = F.vcu; ch < 96; ch += F.G) p0_modv_block(F, ch);
    for (int it = gw; it < IT_FILT; it += NGW) { p0_filter_item<2>(F, it, scr); LDS_WAIT(); }
    if (gw == NGW - 1) { f32x2* rope = WSP(f32x2, WS_ROPE);
        for (int idx = lane; idx < 1024; idx += 64) { const int pos = idx >> 4, f = idx & 15; const float inv = powf(10000.0f, -(float)f / 16.0f); const float ang = (float)pos * inv;
            rope[idx] = (f32x2){cosf(ang), sinf(ang)}; } }
    for (int it = gw; it < IT_TILES; it += NGW) {
        int r = it;
        if (r < IT_QKV) { const int cb = r >> 4, kb = r & 15, n0 = 32 * cb; const int pn = n0 >> 8, hl = (n0 & 255) >> 6, dh = (n0 & 63) >> 5;
            tr_item(kin(I_WIN), 2304, 64 * kb, n0, WSP(bf16_t, WS_WQKV), 1024, 256 * pn + 128 * dh + 32 * hl, scr, lane); continue; } r -= IT_QKV;
        if (r < IT_WU) { const int cb = r >> 4, kb = r & 15; tr_item8(kin(I_WIN), 2304, 64 * kb, 768 + 32 * cb, WSP(unsigned char, WS_WU), 1024, 32 * cb, 32.0f, scr, lane); continue; } r -= IT_WU;
        if (r < IT_WO) { const int cb = r >> 4, kb = r & 15; tr_item(kin(I_WOUT), 1024, 64 * kb, 32 * cb, WSP(bf16_t, WS_WO), 1024, 32 * cb, scr, lane); continue; } r -= IT_WO;
        if (r < IT_WR) { const int cb = r >> 4, kb = r & 15; tr_item(kin(I_RW), 256, 64 * kb, 32 * cb, WSP(bf16_t, WS_WR), 1024, 32 * cb, scr, lane); continue; } r -= IT_WR;
        if (r < IT_SGU) { const int which = r >> 7, rr = r & 127, cb = rr >> 4, kb = rr & 15, j0 = 32 * cb;
            tr_item8(kin(which ? I_SU : I_SG), 256, 64 * kb, j0, WSP(unsigned char, WS_WSGU8), 1024, 256 * (j0 >> 7) + 128 * which + (j0 & 127), 32.0f, scr, lane); continue; } r -= IT_SGU;
        if (r < IT_SD) { const int kb = r & 3, cb = r >> 2; tr_item8(kin(I_SD), 1024, 64 * kb, 32 * cb, WSP(unsigned char, WS_WSD), 256, 32 * cb, 32.0f, scr, lane); continue; } r -= IT_SD;
    }
    __syncthreads();
}

template <int NR, bool F8, bool SRC16 = false, bool NT = false> __device__ __forceinline__ void modulate_group(Frame& F, const float* src, bf16_t* dst, unsigned char* dst8, int row, const f32x4 (&A)[4], const f32x4 (&Bv)[4]) {
    const f32x4* xr = (const f32x4*)(src + (size_t)row * DM) + F.lane;
    f32x4 v[NR][4]; float ss[NR];
    if (SRC16) {
        u32x2 raw[NR][4];
#pragma unroll
        for (int q = 0; q < NR; ++q)
#pragma unroll
            for (int j = 0; j < 4; ++j) raw[q][j] = ((const u32x2*)(src + (size_t)(row + q) * DM))[F.lane + 64 * j];
#pragma unroll
        for (int q = 0; q < NR; ++q)
#pragma unroll
            for (int j = 0; j < 4; ++j) v[q][j] = (f32x4){__uint_as_float(raw[q][j].x << 16), __uint_as_float(raw[q][j].x & 0xffff0000u), __uint_as_float(raw[q][j].y << 16), __uint_as_float(raw[q][j].y & 0xffff0000u)};
    } else {
#pragma unroll
    for (int q = 0; q < NR; ++q)
#pragma unroll
        for (int j = 0; j < 4; ++j) v[q][j] = NT ? __builtin_nontemporal_load(xr + q * (DM / 4) + 64 * j) : xr[q * (DM / 4) + 64 * j];
    }
#pragma unroll
    for (int q = 0; q < NR; ++q) { float a = 0.f;
#pragma unroll
        for (int j = 0; j < 4; ++j) a += (v[q][j][0] * v[q][j][0] + v[q][j][1] * v[q][j][1]) + (v[q][j][2] * v[q][j][2] + v[q][j][3] * v[q][j][3]);
        ss[q] = a; }
#pragma unroll
    for (int o = 1; o < 64; o <<= 1) {
#pragma unroll
        for (int q = 0; q < NR; ++q) ss[q] += __shfl_xor(ss[q], o); }
#pragma unroll
    for (int q = 0; q < NR; ++q) { const float rs = rsqrtf(ss[q] * (1.0f / DM) + EPS);
        u32x2* o8 = (u32x2*)(dst + (size_t)(row + q) * DM) + F.lane;
#pragma unroll
        for (int j = 0; j < 4; ++j) { const f32x4 o = v[q][j] * rs * A[j] + Bv[j]; u32x2 w; w.x = pk2(o[0], o[1]); w.y = pk2(o[2], o[3]); o8[64 * j] = w;
            if (F8) ((unsigned*)(dst8 + (size_t)(row + q) * DM))[F.lane + 64 * j] = pk4_fp8c(o[0] * 8.0f, o[1] * 8.0f, o[2] * 8.0f, o[3] * 8.0f); } }
}
template <bool F8 = false, bool SRC16 = false, bool NT = false> __device__ __forceinline__ void modulate_rows(Frame& F, const float* src, bf16_t* dst, int row0, int nrows, const float* nw, const float* sc, const float* sh, unsigned char* dst8 = nullptr) {
    f32x4 A[4], Bv[4];
#pragma unroll
    for (int j = 0; j < 4; ++j) { const int c = 4 * F.lane + 256 * j; const f32x4 n4 = *(const f32x4*)(nw + c), s4 = *(const f32x4*)(sc + c); A[j] = n4 * (s4 + 1.0f); Bv[j] = *(const f32x4*)(sh + c); }
    int r = 0;
    for (; r + 4 <= nrows; r += 4) modulate_group<4, F8, SRC16, NT>(F, src, dst, dst8, row0 + r, A, Bv);
    if (r + 2 <= nrows) modulate_group<2, F8, SRC16, NT>(F, src, dst, dst8, row0 + r, A, Bv);
}

constexpr unsigned HY_SK_PACKED = 0xCB885410u;
__device__ __forceinline__ void hyena_unit(Frame& F, int c) {
    const int tid = F.tid, lane = F.lane, wid = F.wave;
    LAS unsigned char* Lc = F.lds + RING_OFF;
    const bf16_t* UT = WSP(const bf16_t, WS_UT);
    bf16_t* Wg = WSP(bf16_t, WS_HYW) + (size_t)c * MTOK;
    bf16_t* Xg = WSP(bf16_t, WS_HYX) + (size_t)c * MTOK;
    {
        const u32x4* src = (const u32x4*)(WSP(const bf16_t, WS_KR) + (size_t)c * 8192);
#pragma unroll
        for (int i = 0; i < 2; ++i) { const int jc = tid + 512 * i; const u32x4 lo = src[jc]; const u32x4 hi = jc < 1023 ? src[jc + 1] : (u32x4){0u, 0u, 0u, 0u};
            const unsigned w[8] = {lo.x, lo.y, lo.z, lo.w, hi.x, hi.y, hi.z, hi.w};
#pragma unroll
            for (int cc = 0; cc < 8; ++cc) { u32x4 o;
#pragma unroll
                for (int k = 0; k < 4; ++k) { const int idx = (cc >> 1) + k; o[k] = (cc & 1) ? __builtin_amdgcn_alignbyte(w[idx + 1], w[idx], 2u) : w[idx]; }
                *(LAS u32x4*)(Lc + cc * 16384 + 16 * ((HY_SK_PACKED >> (4 * cc)) & 15u) + 16 * jc) = o; } }
    }
    const float* cw = kin(I_CONVW); const float* cb = kin(I_CONVB);
    {
        const bf16_t* vrow = UT + (size_t)(1024 + c) * MTOK; const bf16_t* x1row = UT + (size_t)(512 + c) * MTOK; const bf16_t* x0row = UT + (size_t)c * MTOK;
        const float v0 = cw[1024 + c], v1 = cw[1536 + 1024 + c], v2 = cw[3072 + 1024 + c], vb = cb[1024 + c];
        const float a0 = cw[512 + c], a1 = cw[1536 + 512 + c], a2 = cw[3072 + 512 + c], ab = cb[512 + c];
        const float g0 = cw[c], g1 = cw[1536 + c], g2 = cw[3072 + c], gb = cb[c];
        const int s0 = tid * 8;
#pragma unroll 4
        for (int it = 0; it < 16; ++it) {
            const size_t base = (size_t)it * SEQ + s0;
            const u32x4 vv = *(const u32x4*)(vrow + base), xx = *(const u32x4*)(x1row + base), gg = *(const u32x4*)(x0row + base);
            float ve[10], xe[10], ge[10];
            ve[0] = s0 > 0 ? bf2f(vrow[base - 1]) : 0.f; xe[0] = s0 > 0 ? bf2f(x1row[base - 1]) : 0.f; ge[0] = s0 > 0 ? bf2f(x0row[base - 1]) : 0.f;
            ve[9] = s0 + 8 < SEQ ? bf2f(vrow[base + 8]) : 0.f; xe[9] = s0 + 8 < SEQ ? bf2f(x1row[base + 8]) : 0.f; ge[9] = s0 + 8 < SEQ ? bf2f(x0row[base + 8]) : 0.f;
#pragma unroll
            for (int j = 0; j < 4; ++j) { ve[1 + 2 * j] = bf2f(vv[j] & 0xffffu); ve[2 + 2 * j] = bf2f(vv[j] >> 16); xe[1 + 2 * j] = bf2f(xx[j] & 0xffffu); xe[2 + 2 * j] = bf2f(xx[j] >> 16);
                ge[1 + 2 * j] = bf2f(gg[j] & 0xffffu); ge[2 + 2 * j] = bf2f(gg[j] >> 16); }
            float w[8], g[8];
#pragma unroll
            for (int j = 0; j < 8; ++j) { w[j] = (v0 * ve[j] + v1 * ve[j + 1] + v2 * ve[j + 2] + vb) * (a0 * xe[j] + a1 * xe[j + 1] + a2 * xe[j + 2] + ab); g[j] = g0 * ge[j] + g1 * ge[j + 1] + g2 * ge[j + 2] + gb; }
            u32x4 o; o.x = pk2(w[0], w[1]); o.y = pk2(w[2], w[3]); o.z = pk2(w[4], w[5]); o.w = pk2(w[6], w[7]);
            *(u32x4*)(Wg + (size_t)(tid * 16 + it) * 8) = o;
            u32x4 p; p.x = pk2(g[0], g[1]); p.y = pk2(g[2], g[3]); p.z = pk2(g[4], g[5]); p.w = pk2(g[6], g[7]);
            *(u32x4*)(Xg + base) = p;
        }
    }
    VM_WAIT(); __syncthreads();
    const float hb = kin(I_HBIAS)[c];
    bf16_t* yrow = WSP(bf16_t, WS_YT) + (size_t)c * MTOK;
    const int li = lane & 15, lg = lane >> 4;
#pragma unroll 1
    for (int pass = 0; pass < 2; ++pass) {
        const int T0 = (pass * 8 + wid) * 256;
        f32x4 acc[16]; bf16x8 AF[16], Bf[8];
#pragma unroll
        for (int q = 0; q < 16; ++q) acc[q] = (f32x4){0.f, 0.f, 0.f, 0.f};
        const int xbase = 4096 - T0 - li + 8 * lg; const int cl = xbase & 7;
        const LAS unsigned char* pA = Lc + cl * 16384 + 16 * (int)((HY_SK_PACKED >> (4 * cl)) & 15u) + 2 * (xbase - cl);
        const bf16x8* Bg = (const bf16x8*)Wg + lg * 16 + li;
#define HY_LOADA(dst, q) dst = *(const LAS bf16x8*)(pA - 32 * (q))
#pragma unroll
        for (int q = 0; q < 16; ++q) HY_LOADA(AF[q], q);
#pragma unroll
        for (int v = 0; v < 8; ++v) Bf[v] = Bg[64 * v];
#pragma unroll 1
        for (int S8 = 0; S8 < 128; S8 += 8) {
#pragma unroll
            for (int v = 0; v < 8; ++v) { const int S = S8 + v;
#pragma unroll
                for (int tau = 15; tau >= 0; --tau) acc[tau] = __builtin_amdgcn_mfma_f32_16x16x32_bf16(AF[(tau - 2 * v) & 15], Bf[v], acc[tau], 0, 0, 0);
                if (S + 8 < 128) Bf[v] = Bg[64 * (S + 8)];
                if (S + 1 < 128) { HY_LOADA(AF[(-2 * (v + 1)) & 15], -2 * (S + 1)); HY_LOADA(AF[(-2 * (v + 1) + 1) & 15], -2 * (S + 1) + 1); }
            }
        }
#undef HY_LOADA
        u32x2 wv[16], xv[16];
#pragma unroll
        for (int tau = 0; tau < 16; ++tau) { const int t = T0 + 16 * tau + 4 * lg;
            wv[tau] = *(const u32x2*)(Wg + (size_t)((t >> 3) * 16 + li) * 8 + (t & 7)); xv[tau] = *(const u32x2*)(Xg + (size_t)li * SEQ + t); }
#pragma unroll
        for (int tau = 0; tau < 16; ++tau) { const int t = T0 + 16 * tau + 4 * lg;
            const float we[4] = {bf2f(wv[tau].x & 0xffffu), bf2f(wv[tau].x >> 16), bf2f(wv[tau].y & 0xffffu), bf2f(wv[tau].y >> 16)};
            const float xe[4] = {bf2f(xv[tau].x & 0xffffu), bf2f(xv[tau].x >> 16), bf2f(xv[tau].y & 0xffffu), bf2f(xv[tau].y >> 16)};
            float z[4];
#pragma unroll
            for (int j = 0; j < 4; ++j) z[j] = (acc[tau][j] + hb * we[j]) * xe[j];
            u32x2 o; o.x = pk2(z[0], z[1]); o.y = pk2(z[2], z[3]); *(u32x2*)(yrow + (size_t)li * SEQ + t) = o; }
    }
    __syncthreads();
}

constexpr unsigned long long HY8_SK = 0xea6eda965212d950ull; constexpr int HY8_STR = 8448;
__device__ __forceinline__ void hyena_unit8(Frame& F, int c) {
    int tid_ = F.tid; asm volatile("" : "+v"(tid_));
    const int tid = tid_, lane = tid & 63, wid = F.wave;
    LAS unsigned char* Lc = F.lds + RING_OFF;
    const bf16_t* UT = WSP(const bf16_t, WS_UT);
    unsigned char* W8 = WSP(unsigned char, WS_HYW) + (size_t)c * MTOK;
    bf16_t* Xg = WSP(bf16_t, WS_HYX) + (size_t)c * MTOK;
    {
        const u32x4* src = (const u32x4*)(WSP(const unsigned char, WS_KR) + (size_t)c * 8192);
        const u32x4 lo = src[tid]; const u32x4 hi = tid < 511 ? src[tid + 1] : (u32x4){0u, 0u, 0u, 0u};
        const unsigned w[8] = {lo.x, lo.y, lo.z, lo.w, hi.x, hi.y, hi.z, hi.w};
#pragma unroll
        for (int sh = 0; sh < 16; ++sh) { u32x4 o;
#pragma unroll
            for (int k = 0; k < 4; ++k) { const int idx = (sh >> 2) + k; o[k] = (sh & 3) ? __builtin_amdgcn_alignbyte(w[idx + 1], w[idx], (unsigned)(sh & 3)) : w[idx]; }
            *(LAS u32x4*)(Lc + sh * HY8_STR + 16 * (int)((HY8_SK >> (4 * sh)) & 15ull) + 16 * tid) = o; }
    }
    const float* cw = kin(I_CONVW); const float* cb = kin(I_CONVB);
    {
        const bf16_t* vrow = UT + (size_t)(1024 + c) * MTOK; const bf16_t* x1row = UT + (size_t)(512 + c) * MTOK; const bf16_t* x0row = UT + (size_t)c * MTOK;
        const float v0 = cw[1024 + c], v1 = cw[1536 + 1024 + c], v2 = cw[3072 + 1024 + c], vb = cb[1024 + c];
        const float a0 = cw[512 + c], a1 = cw[1536 + 512 + c], a2 = cw[3072 + 512 + c], ab = cb[512 + c];
        const float g0 = cw[c], g1 = cw[1536 + c], g2 = cw[3072 + c], gb = cb[c];
        const int s0 = tid * 8;
#pragma unroll 4
        for (int it = 0; it < 16; ++it) {
            const size_t base = (size_t)it * SEQ + s0;
            const u32x4 vv = *(const u32x4*)(vrow + base), xx = *(const u32x4*)(x1row + base), gg = *(const u32x4*)(x0row + base);
            float ve[10], xe[10], ge[10];
            const size_t bm = base - (s0 > 0 ? 1 : 0), bp = base + (s0 + 8 < SEQ ? 8 : 7); const float fm = s0 > 0 ? 1.f : 0.f, fp = s0 + 8 < SEQ ? 1.f : 0.f;
            const unsigned short hv0 = *(const unsigned short*)(vrow + bm), hx0 = *(const unsigned short*)(x1row + bm), hg0 = *(const unsigned short*)(x0row + bm);
            const unsigned short hv9 = *(const unsigned short*)(vrow + bp), hx9 = *(const unsigned short*)(x1row + bp), hg9 = *(const unsigned short*)(x0row + bp);
            ve[0] = fm * bf2f(hv0); xe[0] = fm * bf2f(hx0); ge[0] = fm * bf2f(hg0);
            ve[9] = fp * bf2f(hv9); xe[9] = fp * bf2f(hx9); ge[9] = fp * bf2f(hg9);
#pragma unroll
            for (int j = 0; j < 4; ++j) { ve[1 + 2 * j] = bf2f(vv[j] & 0xffffu); ve[2 + 2 * j] = bf2f(vv[j] >> 16); xe[1 + 2 * j] = bf2f(xx[j] & 0xffffu); xe[2 + 2 * j] = bf2f(xx[j] >> 16);
                ge[1 + 2 * j] = bf2f(gg[j] & 0xffffu); ge[2 + 2 * j] = bf2f(gg[j] >> 16); }
            float w[8], g[8];
#pragma unroll
            for (int j = 0; j < 8; ++j) { w[j] = 8.0f * (v0 * ve[j] + v1 * ve[j + 1] + v2 * ve[j + 2] + vb) * (a0 * xe[j] + a1 * xe[j + 1] + a2 * xe[j + 2] + ab); g[j] = g0 * ge[j] + g1 * ge[j + 1] + g2 * ge[j + 2] + gb; }
            u32x2 o; o.x = pk4_fp8c(w[0], w[1], w[2], w[3]); o.y = pk4_fp8c(w[4], w[5], w[6], w[7]);
            *(u32x2*)(W8 + (size_t)((tid >> 2) * 16 + it) * 32 + (tid & 3) * 8) = o;
            u32x4 p; p.x = pk2(g[0], g[1]); p.y = pk2(g[2], g[3]); p.z = pk2(g[4], g[5]); p.w = pk2(g[6], g[7]);
            *(u32x4*)(Xg + base) = p;
        }
    }
    VM_WAIT(); __syncthreads();
    const float hb = kin(I_HBIAS)[c];
    bf16_t* yrow = WSP(bf16_t, WS_YT) + (size_t)c * MTOK;
    const int li = lane & 15, lg = lane >> 4;
#pragma unroll 1
    for (int pass = 0; pass < 2; ++pass) {
        const int T0 = (pass * 8 + wid) * 256;
        f32x4 acc[16]; pg8::v8i AF[16], Bf[2];
#pragma unroll
        for (int q = 0; q < 16; ++q) { acc[q] = (f32x4){0.f, 0.f, 0.f, 0.f}; asm volatile("" : "+v"(acc[q])); }
        const int x00 = 4096 - T0 - li + 32 * lg; const int cl = x00 & 15;
        const LAS unsigned char* pA = Lc + cl * HY8_STR + 16 * (int)((HY8_SK >> (4 * cl)) & 15ull) + (x00 - cl);
        const u32x4* Bg = (const u32x4*)W8 + (lg * 16 + li) * 2;
#define HY8_LOADA(dst, q) do { const LAS unsigned char* p_ = pA - 16 * (q); dst = pg8::cat8(*(const volatile LAS bf16x8*)p_, *(const volatile LAS bf16x8*)(p_ + 16)); } while (0)
#define HY8_LOADB(dst, S_) do { const u32x4 b0_ = Bg[128 * (S_)], b1_ = Bg[128 * (S_) + 1]; dst = pg8::cat8(__builtin_bit_cast(bf16x8, b0_), __builtin_bit_cast(bf16x8, b1_)); } while (0)
#pragma unroll
        for (int q = 0; q < 16; ++q) HY8_LOADA(AF[q], q);
#pragma unroll
        for (int v = 0; v < 2; ++v) HY8_LOADB(Bf[v], v);
        asm volatile("s_waitcnt lgkmcnt(0)\n\ts_nop 4" ::: "memory");
#pragma unroll 1
        for (int S4 = 0; S4 < 32; S4 += 2) {
#pragma unroll
            for (int v = 0; v < 2; ++v) { const int S = S4 + v; const int p = v & 1;
#pragma unroll
                for (int tau = 15; tau >= 8; --tau) pg8::mfma_fp8(acc[tau], AF[(tau - 8 * p) & 15], Bf[v]);
                asm volatile("s_waitcnt lgkmcnt(0)\n\ts_nop 4" ::: "memory");
                if (S + 1 < 32) {
#pragma unroll
                    for (int i = 0; i < 8; ++i) HY8_LOADA(AF[(i + 8 * (1 - p)) & 15], i - 8 * (S + 1)); }
#pragma unroll
                for (int tau = 7; tau >= 0; --tau) pg8::mfma_fp8(acc[tau], AF[(tau - 8 * p) & 15], Bf[v]);
                HY8_LOADB(Bf[v], S + 2 < 32 ? S + 2 : 31);
            }
            asm volatile("s_nop 15\n\ts_nop 7" : "+v"(acc[0]), "+v"(acc[1]), "+v"(acc[2]), "+v"(acc[3]), "+v"(acc[4]), "+v"(acc[5]), "+v"(acc[6]), "+v"(acc[7]),
                         "+v"(acc[8]), "+v"(acc[9]), "+v"(acc[10]), "+v"(acc[11]), "+v"(acc[12]), "+v"(acc[13]), "+v"(acc[14]), "+v"(acc[15]));
        }
#undef HY8_LOADA
#undef HY8_LOADB
        asm volatile("s_nop 15\n\ts_nop 15" : "+v"(acc[0]), "+v"(acc[1]), "+v"(acc[2]), "+v"(acc[3]), "+v"(acc[4]), "+v"(acc[5]), "+v"(acc[6]), "+v"(acc[7]),
                     "+v"(acc[8]), "+v"(acc[9]), "+v"(acc[10]), "+v"(acc[11]), "+v"(acc[12]), "+v"(acc[13]), "+v"(acc[14]), "+v"(acc[15]) :: "memory");
        unsigned wv[16]; u32x2 xv[16];
#pragma unroll
        for (int tau = 0; tau < 16; ++tau) { const int t = T0 + 16 * tau + 4 * lg;
            wv[tau] = *(const unsigned*)(W8 + (size_t)((t >> 5) * 16 + li) * 32 + (t & 31)); xv[tau] = *(const u32x2*)(Xg + (size_t)li * SEQ + t); }
#pragma unroll
        for (int tau = 0; tau < 16; ++tau) { const int t = T0 + 16 * tau + 4 * lg;
            const f32x2 wlo = __builtin_amdgcn_cvt_pk_f32_fp8((int)wv[tau], false), whi = __builtin_amdgcn_cvt_pk_f32_fp8((int)wv[tau], true);
            const float we[4] = {wlo[0] * 0.125f, wlo[1] * 0.125f, whi[0] * 0.125f, whi[1] * 0.125f};
            const float xe[4] = {bf2f(xv[tau].x & 0xffffu), bf2f(xv[tau].x >> 16), bf2f(xv[tau].y & 0xffffu), bf2f(xv[tau].y >> 16)};
            float z[4];
#pragma unroll
            for (int j = 0; j < 4; ++j) z[j] = (acc[tau][j] * (1.0f / 512.0f) + hb * we[j]) * xe[j];
            u32x2 o; o.x = pk2(z[0], z[1]); o.y = pk2(z[2], z[3]); *(u32x2*)(yrow + (size_t)li * SEQ + t) = o; }
    }
    __syncthreads();
}

__device__ __forceinline__ void p4_norm_tile(Frame& F, int it) {
    const int lane = F.lane, wid = F.wave, tid = F.tid; const int m0 = it * 64;
    bf16_t* AY = WSP(bf16_t, WS_AY); const bf16_t* A = WSP(const bf16_t, WS_AO); const bf16_t* YT = WSP(const bf16_t, WS_YT);
    constexpr int TP = 520;
    LAS bf16_t* T2 = (LAS bf16_t*)(F.lds + RING_OFF);
    {
        const u32x4* src = (const u32x4*)(YT + (size_t)tid * MTOK + m0);
#pragma unroll
        for (int i = 0; i < 8; ++i) { const u32x4 v = src[i];
#pragma unroll
            for (int j = 0; j < 4; ++j) { T2[(8 * i + 2 * j) * TP + tid] = (bf16_t)(v[j] & 0xffffu); T2[(8 * i + 2 * j + 1) * TP + tid] = (bf16_t)(v[j] >> 16); } }
    }
#define P4_ROWS8(LOADV, GAIN, DSTCOL) do { const float* gw_ = (GAIN) + 8 * lane; const f32x4 g0 = *(const f32x4*)gw_, g1 = *(const f32x4*)(gw_ + 4); \
        u32x4 v_[8]; float ss_[8]; \
        _Pragma("unroll") for (int r = 0; r < 8; ++r) v_[r] = LOADV(r); \
        _Pragma("unroll") for (int r = 0; r < 8; ++r) { float a_ = 0.f; _Pragma("unroll") for (int j = 0; j < 4; ++j) { const float lo_ = bf2f(v_[r][j] & 0xffffu), hi_ = bf2f(v_[r][j] >> 16); a_ += lo_ * lo_ + hi_ * hi_; } ss_[r] = a_; } \
        _Pragma("unroll") for (int o = 1; o < 64; o <<= 1) { _Pragma("unroll") for (int r = 0; r < 8; ++r) ss_[r] += __shfl_xor(ss_[r], o); } \
        _Pragma("unroll") for (int r = 0; r < 8; ++r) { const float rs = rsqrtf(ss_[r] * (1.0f / 512.0f) + EPS); float e[8]; \
            _Pragma("unroll") for (int j = 0; j < 4; ++j) { e[2 * j] = bf2f(v_[r][j] & 0xffffu); e[2 * j + 1] = bf2f(v_[r][j] >> 16); } \
            u32x4 o; o.x = pk2(e[0] * rs * g0[0], e[1] * rs * g0[1]); o.y = pk2(e[2] * rs * g0[2], e[3] * rs * g0[3]); o.z = pk2(e[4] * rs * g1[0], e[5] * rs * g1[1]); o.w = pk2(e[6] * rs * g1[2], e[7] * rs * g1[3]); \
            *(u32x4*)(AY + (size_t)(m0 + wid * 8 + r) * DM + (DSTCOL) + 8 * lane) = o; } } while (0)
#define P4_LOAD_A(r) (*(const u32x4*)(A + (size_t)(m0 + wid * 8 + (r)) * AW + 8 * lane))
#define P4_LOAD_T(r) (*(const LAS u32x4*)(T2 + (wid * 8 + (r)) * TP + 8 * lane))
    P4_ROWS8(P4_LOAD_A, kin(I_AONW), 0);
    __syncthreads();
    P4_ROWS8(P4_LOAD_T, kin(I_HONW), 512);
#undef P4_ROWS8
#undef P4_LOAD_A
#undef P4_LOAD_T
    __syncthreads();
}


#define DPPF(x, ctrl) __builtin_bit_cast(float, __builtin_amdgcn_mov_dpp(__builtin_bit_cast(int, (x)), (ctrl), 0xf, 0xf, true))
#define DPPI(x, ctrl) __builtin_amdgcn_mov_dpp((x), (ctrl), 0xf, 0xf, true)
struct RouteSel { int ea, eb; unsigned wa, wb, la, lb; };
__device__ __forceinline__ void p8_route16(Frame& F, int t0, RouteSel& R, LAS unsigned* lcnt) {
    const int lane = F.lane; const int j = lane & 3; const int t = t0 + (lane >> 2);
    const f32x4* lg = (const f32x4*)(WSP(const float, WS_LOGIT) + (size_t)t * NE + 64 * j);
    const f32x4* rbp = (const f32x4*)(kin(I_RB) + 64 * j);
    float b[64];
#pragma unroll
    for (int i = 0; i < 16; ++i) { const f32x4 v = lg[i], rb = rbp[i];
#pragma unroll
        for (int c = 0; c < 4; ++c) b[4 * i + c] = __builtin_amdgcn_rcpf(1.0f + __builtin_amdgcn_exp2f(-1.4426950408889634f * v[c])) + rb[c]; }
    float gsc[2];
#pragma unroll
    for (int g = 0; g < 2; ++g) { float a1 = fmaxf(b[32 * g], b[32 * g + 1]), a2 = fminf(b[32 * g], b[32 * g + 1]);
#pragma unroll
        for (int i = 2; i < 32; ++i) { const float x = b[32 * g + i]; a2 = fmaxf(a2, fminf(a1, x)); a1 = fmaxf(a1, x); }
        gsc[g] = a1 + a2; }
    float G[8];
    G[0] = DPPF(gsc[0], 0x00); G[1] = DPPF(gsc[1], 0x00); G[2] = DPPF(gsc[0], 0x55); G[3] = DPPF(gsc[1], 0x55);
    G[4] = DPPF(gsc[0], 0xAA); G[5] = DPPF(gsc[1], 0xAA); G[6] = DPPF(gsc[0], 0xFF); G[7] = DPPF(gsc[1], 0xFF);
#pragma unroll
    for (int g = 0; g < 2; ++g) { const int gid = 2 * j + g; int rank = 0;
#pragma unroll
        for (int h = 0; h < 8; ++h) rank += (G[h] > gsc[g] || (G[h] == gsc[g] && h < gid)) ? 1 : 0;
        if (rank >= 4) {
#pragma unroll
            for (int i = 0; i < 32; ++i) b[32 * g + i] = -INFINITY; } }
    unsigned key[64];
#pragma unroll
    for (int i = 0; i < 64; ++i) key[i] = b[i] == -INFINITY ? 0u : ((__builtin_bit_cast(unsigned, b[i] + 2.0f) & ~63u) | (unsigned)(63 - i));
    float lv[8]; int li[8];
#pragma unroll
    for (int r = 0; r < 8; ++r) { unsigned mx = key[0];
#pragma unroll
        for (int i = 1; i < 64; i += 2) { const unsigned a_ = key[i], b_ = i + 1 < 64 ? key[i + 1] : 0u; const unsigned m_ = a_ > b_ ? a_ : b_; mx = mx > m_ ? mx : m_; }
        lv[r] = mx ? __builtin_bit_cast(float, mx & ~63u) - 2.0f : -INFINITY; li[r] = mx ? 64 * j + 63 - (int)(mx & 63u) : 0x7ffffff0 + j;
#pragma unroll
        for (int i = 0; i < 64; ++i) key[i] = key[i] == mx ? 0u : key[i]; }
    int se[8]; float sv[8];
#pragma unroll
    for (int r = 0; r < 8; ++r) { float hv = lv[0]; int hi = li[0];
        { const float ov = DPPF(hv, 0xB1); const int oi = DPPI(hi, 0xB1); if (ov > hv || (ov == hv && oi < hi)) { hv = ov; hi = oi; } }
        { const float ov = DPPF(hv, 0x4E); const int oi = DPPI(hi, 0x4E); if (ov > hv || (ov == hv && oi < hi)) { hv = ov; hi = oi; } }
        se[r] = hi; sv[r] = hv;
        if (hi == li[0]) {
#pragma unroll
            for (int k = 0; k < 7; ++k) { lv[k] = lv[k + 1]; li[k] = li[k + 1]; }
            lv[7] = -INFINITY; li[7] = 0x7fffffff; } }
    const float* rbias = kin(I_RB); float wsum = 0.f;
#pragma unroll
    for (int r = 0; r < 8; ++r) { sv[r] -= rbias[se[r]]; wsum += sv[r]; }
    const float inv = 2.5f / wsum;
    const int ea = j == 0 ? se[0] : j == 1 ? se[2] : j == 2 ? se[4] : se[6], eb = j == 0 ? se[1] : j == 1 ? se[3] : j == 2 ? se[5] : se[7];
    const float wa = (j == 0 ? sv[0] : j == 1 ? sv[2] : j == 2 ? sv[4] : sv[6]) * inv, wb = (j == 0 ? sv[1] : j == 1 ? sv[3] : j == 2 ? sv[5] : sv[7]) * inv;
    R.ea = ea; R.eb = eb; R.wa = f2bf(wa); R.wb = f2bf(wb);
    R.la = __hip_atomic_fetch_add(lcnt + ea, 1u, __ATOMIC_RELAXED, __HIP_MEMORY_SCOPE_WORKGROUP); R.lb = __hip_atomic_fetch_add(lcnt + eb, 1u, __ATOMIC_RELAXED, __HIP_MEMORY_SCOPE_WORKGROUP);
}
__device__ __forceinline__ void route_commit(Frame& F, int t0, const RouteSel& R, const LAS unsigned* lbase) {
    const int lane = F.lane; const int j = lane & 3; const int t = t0 + (lane >> 2);
    unsigned* list = WSP(unsigned, WS_LIST); unsigned* asg = WSP(unsigned, WS_ASSIGN) + (size_t)t * 8 + 2 * j;
    const unsigned ra = lbase[R.ea] + R.la, rb2 = lbase[R.eb] + R.lb;
    list[(size_t)R.ea * 65536 + ra] = ((unsigned)t << 16) | R.wa; list[(size_t)R.eb * 65536 + rb2] = ((unsigned)t << 16) | R.wb;
    asg[0] = ((unsigned)R.ea << 16) | ra; asg[1] = ((unsigned)R.eb << 16) | rb2;
    if (j == 0) list[(size_t)256 * 65536 + t] = ((unsigned)t << 16) | 0x3F80u;
}
#undef DPPF
#undef DPPI

__device__ __forceinline__ MoeTab moe_tables(Frame& F) {
    LAS int* tp = (LAS int*)(F.lds + AUX_OFF + AUX_TP); LAS int* cnt = (LAS int*)(F.lds + AUX_OFF + AUX_CNT); LAS unsigned short* t2e = (LAS unsigned short*)(F.lds + AUX_OFF + AUX_T2E);
    __syncthreads();
    if (F.tid < 257) cnt[F.tid] = F.tid < 256 ? (int)__hip_atomic_load(F.ctl + CW_CNT + 32 * F.tid, RLX_AGENT) : MTOK;
    __syncthreads();
    if (F.tid < 258) { int run = 0; for (int j = 0; j < F.tid && j < 257; ++j) run += (cnt[j] + 255) >> 8; tp[F.tid] = run; }
    __syncthreads();
    if (F.tid < 257) { const int t0 = tp[F.tid], t1 = tp[F.tid + 1]; for (int T = t0; T < t1; ++T) t2e[T] = (unsigned short)F.tid; }
    __syncthreads();
    MoeTab t; t.tp = tp; t.cnt = cnt; t.t2e = t2e; return t;
}

__device__ __forceinline__ void down_phase(Frame& F, const MoeTab& tab) {
    using namespace pg8;
    int tid_ = F.wave * 64 + lane_id(); asm volatile("" : "+v"(tid_));
    const int tid = tid_, wid = F.wave, lane = tid & 63, wq = wid, fr = lane & 15, fq = lane >> 4;
    LAS unsigned char* lds = F.lds + RING_OFF;
    const unsigned char* ACT = WSP(const unsigned char, WS_ACT); const unsigned char* WD = WSP(const unsigned char, WS_WD); const unsigned char* WSD = WSP(const unsigned char, WS_WSD);
    unsigned char* SLOT = WSP(unsigned char, WS_SLOT);
    unsigned voA[2], voB[2];
#pragma unroll
    for (int i = 0; i < 2; ++i) { int R, C; stage_rc(tid * 16 + i * 8192, R, C); const int rho = R & 63, ii = rho & 15, nn = rho >> 4; const int Rb = (R & ~63) + 16 * (ii >> 2) + 4 * nn + (ii & 3);
        voA[i] = (unsigned)(R * 256 + C * 2); voB[i] = (unsigned)(Rb * 256 + C * 2); }
    const unsigned ldsw = (unsigned)wid * 1024u;
#define DN_STAGE(buf, gptr, vo, pol) do { _Pragma("unroll") for (int _i = 0; _i < 2; ++_i) \
        __builtin_amdgcn_global_load_lds((const unsigned*)((gptr) + (vo)[_i]), (LAS unsigned*)(lds + (buf) * HTB + ldsw + _i * 8192), 16, 0, pol); } while (0)
    const int arow = (wq & 3) * 32 + fr;
    const int aoff = lds_byte(arow, fq * 8), boff = lds_byte(fr, fq * 8);
    const int TT = __builtin_amdgcn_readfirstlane(tab.tp[257]);
#define DN_STAGE_A(Ag_) do { _Pragma("unroll") for (int ai = 0; ai < 2; ++ai) _Pragma("unroll") for (int kt = 0; kt < 2; ++kt) DN_STAGE(ai * 2 + kt, (Ag_) + (size_t)ai * (128 * 256) + kt * 128, voA, 2); } while (0)
#define DN_STAGE_B(slot, Bg_, c_) do { _Pragma("unroll") for (int kt = 0; kt < 2; ++kt) DN_STAGE(4 + 2 * (slot) + kt, (Bg_) + (size_t)(c_) * (128 * 256) + kt * 128, voB, 0); } while (0)
    int T = F.vcu;
    const unsigned char* Bg = WD;
    if (T < TT) { const int e0 = __builtin_amdgcn_readfirstlane((int)tab.t2e[T]); Bg = e0 < 256 ? WD + (size_t)e0 * (1024 * 256) : WSD;
        DN_STAGE_A(ACT + (size_t)T * (256 * 256)); DN_STAGE_B(0, Bg, 0); }
    for (; T < TT; T += F.G) {
        const int Tn = T + F.G; const bool hn = Tn < TT;
        int nv; { const int e_ = __builtin_amdgcn_readfirstlane((int)tab.t2e[T]); nv = __builtin_amdgcn_readfirstlane(tab.cnt[e_]) - (T - __builtin_amdgcn_readfirstlane(tab.tp[e_])) * 256; }
        const int rloc = (wq >> 2) * 128 + (wq & 3) * 32 + fr;
        const unsigned char* Bn = WD;
        if (hn) { const int en = __builtin_amdgcn_readfirstlane((int)tab.t2e[Tn]); Bn = en < 256 ? WD + (size_t)en * (1024 * 256) : WSD; }
        asm volatile("s_waitcnt vmcnt(0)" ::: "memory"); __builtin_amdgcn_s_barrier(); asm volatile("" ::: "memory");
        v8i Af[2][2];
#pragma unroll
        for (int m = 0; m < 2; ++m)
#pragma unroll
            for (int kt = 0; kt < 2; ++kt) { const LAS unsigned char* p = lds + ((wq >> 2) * 2 + kt) * HTB + aoff + m * 2048;
                Af[m][kt] = cat8(*(const LAS bf16x8*)p, *(const LAS bf16x8*)(p + 1024)); }
        asm volatile("s_waitcnt lgkmcnt(0)" ::: "memory");
#pragma unroll 1
        for (int c = 0; c < 8; ++c) {
            const int sb = c & 1;
            if (c > 0) { if (nv < 256) asm volatile("s_waitcnt vmcnt(0)" ::: "memory");
                         else if (c == 3 && hn) asm volatile("s_waitcnt vmcnt(12)" ::: "memory"); else asm volatile("s_waitcnt vmcnt(4)" ::: "memory"); }
            __builtin_amdgcn_s_barrier(); asm volatile("" ::: "memory");
            if (c < 7) DN_STAGE_B(sb ^ 1, Bg, c + 1); else if (hn) DN_STAGE_B(0, Bn, 0);
            if (c == 2 && hn) DN_STAGE_A(ACT + (size_t)Tn * (256 * 256));
            f32x4 acc[2][8];
#pragma unroll
            for (int m = 0; m < 2; ++m)
#pragma unroll
                for (int n = 0; n < 8; ++n) { acc[m][n] = (f32x4){0.f, 0.f, 0.f, 0.f}; asm volatile("" : "+v"(acc[m][n])); }
#pragma unroll
            for (int g = 0; g < 2; ++g) {
                v8i Bf[4][2];
#pragma unroll
                for (int n = 0; n < 4; ++n)
#pragma unroll
                    for (int kt = 0; kt < 2; ++kt) { const LAS unsigned char* p = lds + (4 + 2 * sb + kt) * HTB + boff + (4 * g + n) * 2048;
                        Bf[n][kt] = cat8(*(const LAS bf16x8*)p, *(const LAS bf16x8*)(p + 1024)); }
                asm volatile("s_waitcnt lgkmcnt(0)\n\ts_nop 4" ::: "memory");
#pragma unroll
                for (int kt = 0; kt < 2; ++kt)
#pragma unroll
                    for (int m = 0; m < 2; ++m)
#pragma unroll
                        for (int n = 0; n < 4; ++n) mfma_fp8(acc[m][4 * g + n], Bf[n][kt], Af[m][kt]);
            }
            asm volatile("s_nop 15\n\ts_nop 15" : "+v"(acc[0][0]), "+v"(acc[0][1]), "+v"(acc[0][2]), "+v"(acc[0][3]), "+v"(acc[0][4]), "+v"(acc[0][5]), "+v"(acc[0][6]), "+v"(acc[0][7]),
                         "+v"(acc[1][0]), "+v"(acc[1][1]), "+v"(acc[1][2]), "+v"(acc[1][3]), "+v"(acc[1][4]), "+v"(acc[1][5]), "+v"(acc[1][6]), "+v"(acc[1][7]) :: "memory");
            unsigned char* orow = SLOT + (size_t)(T * 256 + (wq >> 2) * 128 + (wq & 3) * 32 + fr) * DM + c * 128 + 16 * fq;
#pragma unroll
            for (int m = 0; m < 2; ++m)
#pragma unroll
                for (int g = 0; g < 2; ++g) { u32x4 pk;
#pragma unroll
                    for (int n = 0; n < 4; ++n) { const f32x4 a = acc[m][4 * g + n] * 0.125f; pk[n] = pk4_fp8c(a[0], a[1], a[2], a[3]); }
                    if (rloc + 16 * m < nv) *(u32x4*)(orow + (size_t)(16 * m) * DM + 64 * g) = pk; }
        }
        Bg = Bn;
    }
    asm volatile("s_waitcnt vmcnt(0) lgkmcnt(0)" ::: "memory"); __builtin_amdgcn_s_barrier(); asm volatile("" ::: "memory");
#undef DN_STAGE_A
#undef DN_STAGE_B
#undef DN_STAGE
}

__device__ __forceinline__ void combine_token(Frame& F, const MoeTab& tab, int t0) {
    const int lane = F.lane; const int b = t0 >> 12;
    const unsigned* asg = WSP(const unsigned, WS_ASSIGN) + (size_t)t0 * 8; const unsigned char* SLOT = WSP(const unsigned char, WS_SLOT);
    const size_t Rs = (size_t)tab.tp[256] * 256;
    u32x4 sv[2][9];
#pragma unroll
    for (int q = 0; q < 2; ++q) {
#pragma unroll
        for (int k = 0; k < 8; ++k) { const unsigned av = asg[q * 8 + k]; const int e = av >> 16, rk = av & 0xffffu; const size_t R = (size_t)tab.tp[e] * 256 + rk;
            sv[q][k] = __builtin_nontemporal_load((const u32x4*)(SLOT + R * DM + 16 * lane)); }
        sv[q][8] = __builtin_nontemporal_load((const u32x4*)(SLOT + (Rs + t0 + q) * DM + 16 * lane)); }
    const LAS float* g2 = (const LAS float*)(F.lds + AUX_OFF + AUX_IDX + 4096) + 16 * lane; const LAS float* fwl = (const LAS float*)(F.lds + AUX_OFF + AUX_IDX) + 16 * lane;
    f32x4 x[2][4]; float ss[2];
#pragma unroll
    for (int q = 0; q < 2; ++q) {
#if X1_BF16
        const u32x4* xr = (const u32x4*)((const bf16_t*)(F.out + (size_t)(t0 + q) * DM) + 16 * lane); const u32x4 r0 = __builtin_nontemporal_load(xr), r1 = __builtin_nontemporal_load(xr + 1);
        const unsigned w[8] = {r0.x, r0.y, r0.z, r0.w, r1.x, r1.y, r1.z, r1.w};
#pragma unroll
        for (int j = 0; j < 4; ++j) x[q][j] = (f32x4){__uint_as_float(w[2 * j] << 16), __uint_as_float(w[2 * j] & 0xffff0000u), __uint_as_float(w[2 * j + 1] << 16), __uint_as_float(w[2 * j + 1] & 0xffff0000u)};
#else
        const float* xr = F.out + (size_t)(t0 + q) * DM + 16 * lane;
#pragma unroll
        for (int j = 0; j < 4; ++j) x[q][j] = *(const f32x4*)(xr + 4 * j);
#endif
    }
#pragma unroll
    for (int q = 0; q < 2; ++q) { float a[16];
#pragma unroll
        for (int j = 0; j < 16; ++j) a[j] = 0.f;
#pragma unroll
        for (int k = 0; k < 9; ++k)
#pragma unroll
            for (int j = 0; j < 4; ++j) { const f32x2 lo = __builtin_amdgcn_cvt_pk_f32_fp8((int)sv[q][k][j], false), hi = __builtin_amdgcn_cvt_pk_f32_fp8((int)sv[q][k][j], true);
                a[4 * j] += lo[0]; a[4 * j + 1] += lo[1]; a[4 * j + 2] += hi[0]; a[4 * j + 3] += hi[1]; }
        ss[q] = 0.f;
#pragma unroll
        for (int j = 0; j < 4; ++j) { const f32x4 g = *(const LAS f32x4*)(g2 + 4 * j) * (1.0f / 16.0f);
            x[q][j] = x[q][j] + g * (f32x4){a[4 * j], a[4 * j + 1], a[4 * j + 2], a[4 * j + 3]};
            ss[q] += (x[q][j][0] * x[q][j][0] + x[q][j][1] * x[q][j][1]) + (x[q][j][2] * x[q][j][2] + x[q][j][3] * x[q][j][3]); } }
#pragma unroll
    for (int o = 1; o < 64; o <<= 1) { ss[0] += __shfl_xor(ss[0], o); ss[1] += __shfl_xor(ss[1], o); }
#pragma unroll
    for (int q = 0; q < 2; ++q) { const float rs = rsqrtf(ss[q] * (1.0f / DM) + EPS); float* orow = F.out + (size_t)(t0 + q) * DM + 16 * lane;
#pragma unroll
        for (int j = 0; j < 4; ++j) *(f32x4*)(orow + 4 * j) = x[q][j] * rs * *(const LAS f32x4*)(fwl + 4 * j); }
}

constexpr int N_LAUNCHES = MK_N_LAUNCHES;
static_assert(N_LAUNCHES == 1 || N_LAUNCHES == NPHASE, "MK_N_LAUNCHES must be 1 or 14");
struct Args { const float* in[N_IN]; float* out; unsigned char* ws; int ph_lo, ph_hi; };
__global__ void __launch_bounds__(NWAVES * 64, 2) fwd_kernel(Args args) {
    extern __shared__ __attribute__((aligned(16))) unsigned char lds[];
    Frame F;
    F.lds = (LAS unsigned char*)lds;
    F.MISC = (volatile LAS unsigned*)(F.lds + MISC_OFF);
    F.tid = threadIdx.x; F.lane = F.tid & 63; F.wave = __builtin_amdgcn_readfirstlane(F.tid >> 6);
    F.G = gridDim.x; { const int bx = blockIdx.x; F.vcu = (F.G % 8 == 0) ? (bx % 8) * (F.G / 8) + bx / 8 : bx; }
    F.out = args.out; F.ws = args.ws; F.ctl = (unsigned*)(args.ws + WS_CTL);
    if (F.tid < 128) ((LAS unsigned*)(F.lds + MISC_OFF))[F.tid] = 0u;
    __syncthreads();
    XcdBarrier bar; bar.wv = (unsigned)F.wave; bar.bar = F.ctl + CW_BAR; bar.x = 0; bar.st = nullptr;
    if (N_LAUNCHES == 1) bar = xcd_barrier_post(F.ctl + CW_BAR, F.MISC + 8);
#define GRID_BAR() do { if (N_LAUNCHES == 1) xcd_barrier(bar); } while (0)
    const int lo = args.ph_lo, hi = args.ph_hi;
#ifndef PHASE_MASK
#define PHASE_MASK 0x3fff
#endif
#define IN(k) ((((PHASE_MASK) >> (k)) & 1) && lo <= (k) && (k) < hi)
#ifndef PHASE_DUP
#define PHASE_DUP 0
#endif
#define REPS(k) ((((PHASE_DUP) >> (k)) & 1) ? 2 : 1)
#ifndef PROBE_K
#define PROBE_K (-1)
#endif
#ifndef PROBE_AMP
#define PROBE_AMP 8
#endif
    unsigned long long tA_ = 0, tB_ = 0;
#define STAMP(j) do { if (PROBE_K >= 0 && (j) == PROBE_K) tA_ = __builtin_amdgcn_s_memrealtime(); if (PROBE_K >= 0 && (j) == PROBE_K + 1) tB_ = __builtin_amdgcn_s_memrealtime(); } while (0)
#define SEAM(k) do { if (IN(k) && IN((k) + 1)) GRID_BAR(); STAMP((k) + 1); } while (0)
#define PHASE_ENTER() do { int t_ = F.wave * 64 + lane_id(); asm volatile("" : "+v"(t_)); F.tid = t_; F.lane = t_ & 63; GAS unsigned char* w_ = (GAS unsigned char*)args.ws; GAS float* o_ = (GAS float*)args.out; asm volatile("" : "+s"(w_), "+s"(o_)); F.ws = (unsigned char*)w_; F.out = (float*)o_; F.ctl = (unsigned*)(F.ws + WS_CTL); } while (0)
#define PHASE_ENTER_V() do { int l_; asm volatile("v_mbcnt_lo_u32_b32 %0, -1, 0\n\tv_mbcnt_hi_u32_b32 %0, -1, %0" : "=v"(l_)); int t_ = F.wave * 64 + l_; asm volatile("" : "+v"(t_)); F.tid = t_; F.lane = t_ & 63; GAS unsigned char* w_ = (GAS unsigned char*)args.ws; GAS float* o_ = (GAS float*)args.out; asm volatile("" : "+s"(w_), "+s"(o_)); F.ws = (unsigned char*)w_; F.out = (float*)o_; F.ctl = (unsigned*)(F.ws + WS_CTL); } while (0)
    const int gw = F.vcu * NWAVES + F.wave, NGW = F.G * NWAVES;
#define modv WSP(const float, WS_MODV)
    LAS unsigned char* ring = F.lds + RING_OFF;
    LAS unsigned* idxw = (LAS unsigned*)(F.lds + AUX_OFF + AUX_IDX + F.wave * 1024);

    STAMP(0);
    if (IN(0)) for (int rep_ = 0; rep_ < REPS(0); ++rep_) { PHASE_ENTER(); p0_prologue(F); }
    SEAM(0);
    if (IN(1)) for (int rep_ = 0; rep_ < REPS(1); ++rep_) { PHASE_ENTER();
        for (int rb = gw; rb < MTOK / 32; rb += NGW) { const int row0 = rb * 32; const int b = row0 >> 12;
            modulate_rows<true, false, true>(F, kin(I_X), WSP(bf16_t, WS_H), row0, 32, kin(I_NORM1), modv + (size_t)b * 6144 + 1024, modv + (size_t)b * 6144, WSP(unsigned char, WS_H8)); }
        for (int rb = gw; rb < MCTX / 2; rb += NGW)
            modulate_rows(F, kin(I_CTX), WSP(bf16_t, WS_HC), rb * 2, 2, kin(I_NORM1), modv + (size_t)16 * 6144 + 1024, modv + (size_t)16 * 6144);
    }
    SEAM(1);
    if (IN(2)) for (int rep_ = 0; rep_ < REPS(2); ++rep_) { PHASE_ENTER();
        { SchedQKV S{WSP(const bf16_t, WS_H), (long)WS_HC - (long)WS_H, WSP(const bf16_t, WS_WQKV), F.G, F.vcu};
          EpiQKV E{WSP(bf16_t, WS_Q), WSP(bf16_t, WS_K), WSP(bf16_t, WS_V), kin(I_QNW), kin(I_KNW), WSP(const f32x2, WS_ROPE)};
          pg8::gemm_phase<EpiQKV, SchedQKV, false, true>(ring, idxw, DM, S, E, F.wave); }
        { SchedUT S{WSP(const bf16_t, WS_WU), WSP(const bf16_t, WS_H8), DM / 2, F.G, F.vcu};
          EpiPlainBf16 E{WSP(bf16_t, WS_UT), (size_t)MTOK, 1.0f / 256.0f};
          pg8::gemm_phase<EpiPlainBf16, SchedUT, false, true, true>(ring, idxw, DM / 2, S, E, F.wave); }
    }
    SEAM(2);
    if (IN(3)) for (int rep_ = 0; rep_ < REPS(3); ++rep_) { PHASE_ENTER();
        const int xq = (XP_TILES + F.G - 1) / F.G;
        float negB;
        { float wq = fabsf(kin(I_QNW)[F.lane]), wk = fabsf(kin(I_KNW)[F.lane]);
#pragma unroll
          for (int o = 1; o < 64; o <<= 1) { wq = fmaxf(wq, __shfl_xor(wq, o)); wk = fmaxf(wk, __shfl_xor(wk, o)); }
          negB = -(64.0f * attn_body::C2 * 1.02f * wq * wk + 0.5f); negB = __builtin_bit_cast(float, __builtin_amdgcn_readfirstlane(__builtin_bit_cast(int, negB))); }
        if ((F.vcu & 3) == 0) { xp_tiles(F, xq); PHASE_ENTER_V(); }
        { const attn_body::AttnTensors AT{WSP(const attn_body::bf16, WS_Q), WSP(const attn_body::bf16, WS_K), WSP(const attn_body::bf16, WS_V), WSP(attn_body::bf16, WS_AO)};
          const attn_body::StaticOrderR S(F.vcu, 0, 4);
          for (int r2_ = 0; r2_ < REPS(14); ++r2_) attn_body::attn_phase<attn_body::StaticOrderR>((char*)lds + RING_OFF, AT, S, F.wave, negB); }
        __syncthreads(); PHASE_ENTER_V();
        if ((F.vcu & 3) == 1) { xp_tiles(F, xq); PHASE_ENTER_V(); }
        { const attn_body::AttnTensors AT{WSP(const attn_body::bf16, WS_Q), WSP(const attn_body::bf16, WS_K), WSP(const attn_body::bf16, WS_V), WSP(attn_body::bf16, WS_AO)};
          const attn_body::StaticOrderR S(F.vcu, 4, 8);
          for (int r2_ = 0; r2_ < REPS(14); ++r2_) attn_body::attn_phase<attn_body::StaticOrderR>((char*)lds + RING_OFF, AT, S, F.wave, negB); }
        __syncthreads(); PHASE_ENTER_V();
        if ((F.vcu & 3) == 2) { xp_tiles(F, xq); PHASE_ENTER_V(); }
        for (int r2_ = 0; r2_ < REPS(15); ++r2_) for (int c = F.vcu; c < HW; c += F.G) {
#if HYENA_FP8
            hyena_unit8(F, c);
#else
            hyena_unit(F, c);
#endif
        }
        __syncthreads(); PHASE_ENTER_V();
        if ((F.vcu & 3) == 3) xp_tiles(F, 1 << 30);
    }
    SEAM(3);
    if (IN(4)) for (int rep_ = 0; rep_ < REPS(4); ++rep_) { PHASE_ENTER();
        for (int pm = F.vcu; pm < MTOK / 256; pm += F.G) {
            for (int q4 = 0; q4 < 4; ++q4) p4_norm_tile(F, pm * 4 + q4);
            VM_WAIT(); __syncthreads(); PHASE_ENTER();
            { SchedDense S{WSP(const bf16_t, WS_AY) + (size_t)pm * 256 * DM, WSP(const bf16_t, WS_WO), DM, 1, 4, 1, 0, false};
              EpiOutProj E{kin(I_X), F.out, modv, pm};
              pg8::gemm_phase<EpiOutProj, SchedDense, false, true>(ring, idxw, DM, S, E, F.wave); }
            VM_WAIT(); __syncthreads(); PHASE_ENTER();
            { const int row0 = pm * 256 + F.wave * 32; const int b = row0 >> 12;
              modulate_rows<true, X1_BF16 != 0>(F, F.out, WSP(bf16_t, WS_H), row0, 32, kin(I_NORM2), modv + (size_t)b * 6144 + 4 * 1024, modv + (size_t)b * 6144 + 3 * 1024, WSP(unsigned char, WS_H8)); }
            VM_WAIT(); __syncthreads(); PHASE_ENTER();
            { SchedDense S{WSP(const bf16_t, WS_H) + (size_t)pm * 256 * DM, WSP(const bf16_t, WS_WR), DM, 1, 1, 1, 0, false};
              EpiF32 E{WSP(float, WS_LOGIT) + (size_t)pm * 256 * NE, (size_t)NE};
              pg8::gemm_phase<EpiF32, SchedDense, false, true>(ring, idxw, DM, S, E, F.wave); }
            VM_WAIT(); __syncthreads(); PHASE_ENTER();
            {
                LAS unsigned* lcnt = (LAS unsigned*)(F.lds + AUX_OFF); LAS unsigned* lbase = lcnt + 256;
                if (F.tid < 256) lcnt[F.tid] = 0u;
                __syncthreads();
                RouteSel R0, R1;
                p8_route16(F, pm * 256 + F.wave * 32, R0, lcnt); p8_route16(F, pm * 256 + F.wave * 32 + 16, R1, lcnt);
                __syncthreads();
                if (F.tid < 256) { const unsigned c = lcnt[F.tid]; lbase[F.tid] = c ? __hip_atomic_fetch_add(F.ctl + CW_CNT + 32 * F.tid, c, RLX_AGENT) : 0u; }
                __syncthreads();
                route_commit(F, pm * 256 + F.wave * 32, R0, lbase); route_commit(F, pm * 256 + F.wave * 32 + 16, R1, lbase);
                __syncthreads();
            }
        }
    }
    SEAM(4); STAMP(6); STAMP(7); STAMP(8); STAMP(9);
    if (IN(9)) for (int rep_ = 0; rep_ < REPS(9); ++rep_) { PHASE_ENTER();
        const MoeTab tab = moe_tables(F);
        SchedGU S{WSP(const bf16_t, WS_H8), WSP(const bf16_t, WS_WGU), WSP(const bf16_t, WS_WSGU8), WSP(const unsigned, WS_LIST), tab, F.G, F.vcu};
        EpiGU E{WSP(unsigned char, WS_ACT), WSP(const unsigned, WS_LIST), tab};
        pg8::gemm_phase<EpiGU, SchedGU, true, true, true>(ring, idxw, DM / 2, S, E, F.wave);
    }
    SEAM(9);
    if (IN(10)) for (int rep_ = 0; rep_ < REPS(10); ++rep_) { PHASE_ENTER();
        const MoeTab tab = moe_tables(F);
        down_phase(F, tab);
    }
    SEAM(10);
    if (IN(11)) for (int rep_ = 0; rep_ < REPS(11); ++rep_) { PHASE_ENTER(); const MoeTab tab = moe_tables(F);
        for (int rb = gw; rb < MTOK / 32; rb += NGW) {
            __syncthreads();
            { LAS float* fwl = (LAS float*)(F.lds + AUX_OFF + AUX_IDX); const float* g2g = WSP(const float, WS_MODV) + (size_t)((rb * 32) >> 12) * 6144 + 5 * 1024;
              int i0 = F.tid; asm volatile("" : "+v"(i0));
              for (int i = i0; i < DM; i += NWAVES * 64) { fwl[i] = kin(I_FNW)[i]; fwl[1024 + i] = g2g[i]; } }
            __syncthreads();
            for (int r = 0; r < 32; r += 2) combine_token(F, tab, rb * 32 + r);
        } }
    STAMP(12); STAMP(13); STAMP(14);
    if (PROBE_K >= 0 && blockIdx.x == 0) {
        const unsigned long long until = __builtin_amdgcn_s_memrealtime() + (unsigned long long)PROBE_AMP * (tB_ - tA_);
        while (__builtin_amdgcn_s_memrealtime() < until) __builtin_amdgcn_s_sleep(32);
    }
#undef modv
#undef PHASE_ENTER
#undef PHASE_ENTER_V
#undef IN
#undef SEAM
#undef GRID_BAR
}

extern "C" void kernel_launch(void* const* d_in, const int* in_sizes, int n_in, void* d_out, int out_size, void* d_ws, size_t ws_size, hipStream_t stream) {
    static int grid = 0;
    if (grid == 0) {
        if (n_in != N_IN || in_sizes[0] != MTOK * DM || out_size != MTOK * DM || ws_size < WS_END) {
            fprintf(stderr, "kernel_launch: unexpected problem (n_in %d, in0 %d, out %d, ws %zu < %zu); nothing launched\n", n_in, n_in > 0 ? in_sizes[0] : -1, out_size, ws_size, (size_t)WS_END); grid = -1; return; }
        int dev = 0, cus = 0, per_cu = 0;
        if (hipGetDevice(&dev) != hipSuccess || hipDeviceGetAttribute(&cus, hipDeviceAttributeMultiprocessorCount, dev) != hipSuccess) { grid = -1; return; }
        if (hipFuncSetAttribute((const void*)fwd_kernel, hipFuncAttributeMaxDynamicSharedMemorySize, LDS_BYTES) != hipSuccess) { fprintf(stderr, "kernel_launch: hipFuncSetAttribute failed\n"); grid = -1; return; }
        if (hipOccupancyMaxActiveBlocksPerMultiprocessor(&per_cu, (const void*)fwd_kernel, NWAVES * 64, LDS_BYTES) != hipSuccess || per_cu < 1)
            fprintf(stderr, "kernel_launch: note: occupancy query reports %d workgroups per CU\n", per_cu);
        (void)hipGetLastError();
        grid = cus;
    }
    if (grid < 0) return;
    if (hipMemsetAsync((char*)d_ws + WS_CTL, 0, CTL_ZERO_BYTES, stream) != hipSuccess) return;
    Args a{};
    for (int i = 0; i < N_IN; ++i) a.in[i] = (const float*)d_in[i];
    a.out = (float*)d_out; a.ws = (unsigned char*)d_ws;
    for (int li = 0; li < N_LAUNCHES; ++li) {
        a.ph_lo = (N_LAUNCHES == 1) ? 0 : li; a.ph_hi = (N_LAUNCHES == 1) ? NPHASE : li + 1;
        hipLaunchKernelGGL(fwd_kernel, dim3(grid), dim3(NWAVES * 64), LDS_BYTES, stream, a);
        const hipError_t le = hipPeekAtLastError();
        if (le != hipSuccess) { fprintf(stderr, "kernel_launch: launch %d failed: %s\n", li, hipGetErrorName(le)); break; }
    }
}
```
